# Optimizing an MI355X kernel written in HIP

```python
import math
import jax
import jax.numpy as jnp
from jax import lax
import numpy as np

D_MODEL = 2048
BATCH = 2
SEQ = 8192
DEPTH = 2

PLE_DIM = 256
D_FF = 5632
A_HEADS = 8
A_QK_DIM = 64
A_V_DIM = 128
B_HEADS = 4
B_QK_DIM = 128
B_V_DIM = 256
CONV_WIDTH = 4
C_HEADS = 4
C_QK_DIM = 256
C_V_DIM = 512
C_GATE_RANK = 16
C_GATE_TEMP = 16.0
CHUNK = 64
Q_BLOCK = 128
N_BUCKETS = 32
MAX_DISTANCE = 128
LN_EPS = 1e-5
NORM_EPS = 1e-6
DEEPNORM_ALPHA = (2 * DEPTH) ** 0.25
DEEPNORM_BETA = (8 * DEPTH) ** -0.25
N_EVEN = (DEPTH + 1) // 2
N_ODD = DEPTH // 2

A_WIDTH = A_HEADS * A_V_DIM
B_WIDTH = B_HEADS * B_V_DIM
MIX_WIDTH = A_WIDTH + B_WIDTH
AB_SIZES = (A_HEADS * 2 * A_QK_DIM, A_HEADS * 2 * A_QK_DIM, A_WIDTH, 2 * B_HEADS * B_QK_DIM, B_WIDTH, B_WIDTH, B_HEADS, B_HEADS)
AB_PROJ = sum(AB_SIZES)
C_WIDTH = C_HEADS * C_V_DIM
C_SIZES = (C_HEADS * C_QK_DIM, C_HEADS * C_QK_DIM, C_WIDTH, C_WIDTH, C_GATE_RANK)
C_PROJ = sum(C_SIZES)

kernel_name = 'hybrid_diffattn_mlstm_gla_macaron'


def split_cols(t, sizes):
    points = np.cumsum(np.array(sizes))[:-1].tolist()
    return jnp.split(t, points, axis=-1)


def layer_norm(x, g, b):
    xf = x.astype(jnp.float32)
    mu = jnp.mean(xf, -1, keepdims=True)
    var = jnp.mean(jnp.square(xf - mu), -1, keepdims=True)
    return ((xf - mu) * lax.rsqrt(var + LN_EPS)).astype(x.dtype) * g + b


def head_rms_norm(h, g):
    hf = h.astype(jnp.float32)
    hn = hf * lax.rsqrt(jnp.mean(hf * hf, -1, keepdims=True) + NORM_EPS)
    bsz, s = h.shape[:2]
    return hn.astype(h.dtype).reshape(bsz, s, -1) * g


def swiglu(x, w_in, w_out):
    gate, up = jnp.split(x @ w_in, 2, axis=-1)
    return (jax.nn.silu(gate) * up) @ w_out


def causal_dwconv(x, w, b):
    s = x.shape[1]
    xp = jnp.pad(x, ((0, 0), (CONV_WIDTH - 1, 0), (0, 0)))
    return sum(w[j] * xp[:, j:j + s] for j in range(CONV_WIDTH)) + b


def t5_bucket(rel):
    n = jnp.maximum(rel, 0)
    max_exact = N_BUCKETS // 2
    nf = jnp.maximum(n, 1).astype(jnp.float32)
    large = max_exact + (jnp.log(nf / max_exact) / math.log(MAX_DISTANCE / max_exact) * (N_BUCKETS - max_exact)).astype(jnp.int32)
    large = jnp.minimum(large, N_BUCKETS - 1)
    return jnp.where(n < max_exact, n, large)


def to_chunks(t):
    bsz, s, h = t.shape[:3]
    t = t.reshape((bsz, s // CHUNK, CHUNK, h) + t.shape[3:])
    return jnp.moveaxis(t, (1, 3), (0, 2))


def from_chunks(t):
    nc, bsz, h, l = t.shape[:4]
    return jnp.moveaxis(t, (0, 2), (1, 3)).reshape((bsz, nc * l, h) + t.shape[4:])


def diff_attention(q, k, v, lam, rel_bias):
    bsz, s, h = q.shape[:3]
    nb = s // Q_BLOCK
    qb = jnp.moveaxis(q.reshape(bsz, nb, Q_BLOCK, h, 2, A_QK_DIM), 1, 0)
    k_pos = jnp.arange(s)
    scale = A_QK_DIM ** -0.5

    def block(args):
        q_blk, blk = args
        q_pos = blk * Q_BLOCK + jnp.arange(Q_BLOCK)
        rel = q_pos[:, None] - k_pos[None, :]
        bias = jnp.transpose(rel_bias[t5_bucket(rel)], (2, 0, 1)).astype(jnp.float32)
        logits = jnp.einsum('bqhcd,bkhcd->bhcqk', q_blk, k).astype(jnp.float32) * scale + bias[None, :, None]
        logits = jnp.where((rel >= 0)[None, None, None], logits, -jnp.inf)
        probs = jax.nn.softmax(logits, axis=-1)
        attn = probs[:, :, 0] - lam * probs[:, :, 1]
        return jnp.einsum('bhqk,bkhd->bqhd', attn.astype(v.dtype), v)

    out = lax.map(block, (qb, jnp.arange(nb)))
    return jnp.moveaxis(out, 0, 1).reshape(bsz, s, h, A_V_DIM)


def mlstm_chunkwise(q, k, v, i_pre, f_pre):
    bsz, _, heads, dk = q.shape
    dv = v.shape[-1]
    f32 = jnp.float32
    qc = to_chunks(q.astype(f32) * dk ** -0.5)
    kc = to_chunks(k.astype(f32))
    vc = to_chunks(v.astype(f32))
    ic = to_chunks(i_pre.astype(f32))
    fc = to_chunks(jax.nn.log_sigmoid(f_pre.astype(f32)))
    tril = jnp.tril(jnp.ones((CHUNK, CHUNK), bool))

    def step(carry, xs):
        c_mat, n_vec, m_prev = carry
        q_, k_, v_, i_, lf = xs
        b = jnp.cumsum(lf, axis=-1)
        a = b + m_prev[..., None]
        d = jnp.where(tril, b[..., :, None] - b[..., None, :] + i_[..., None, :], -jnp.inf)
        m_t = jnp.maximum(a, jnp.max(d, -1))
        w_inter = jnp.exp(a - m_t)
        sw = jnp.einsum('bhtd,bhsd->bhts', q_, k_) * jnp.exp(d - m_t[..., None])
        num = w_inter[..., None] * jnp.einsum('bhtd,bhde->bhte', q_, c_mat) + jnp.einsum('bhts,bhse->bhte', sw, v_)
        den = w_inter * jnp.einsum('bhtd,bhd->bht', q_, n_vec) + jnp.sum(sw, -1)
        h = num / jnp.maximum(jnp.abs(den), jnp.exp(-m_t))[..., None]
        b_last = b[..., -1]
        g = b_last[..., None] - b + i_
        m_new = jnp.maximum(b_last + m_prev, jnp.max(g, -1))
        decay = jnp.exp(b_last + m_prev - m_new)
        wk = jnp.exp(g - m_new[..., None])
        c_new = decay[..., None, None] * c_mat + jnp.einsum('bhsd,bhse->bhde', k_ * wk[..., None], v_)
        n_new = decay[..., None] * n_vec + jnp.einsum('bhsd,bhs->bhd', k_, wk)
        return (c_new, n_new, m_new), h

    init = (jnp.zeros((bsz, heads, dk, dv), f32), jnp.zeros((bsz, heads, dk), f32), jnp.zeros((bsz, heads), f32))
    _, h = lax.scan(step, init, (qc, kc, vc, ic, fc))
    return from_chunks(h).astype(v.dtype)


def gla_chunkwise(q, k, v, log_a):
    bsz, _, heads, dk = q.shape
    dv = v.shape[-1]
    f32 = jnp.float32
    qc = to_chunks(q.astype(f32) * dk ** -0.5)
    kc = to_chunks(k.astype(f32))
    vc = to_chunks(v.astype(f32))
    gc = to_chunks(log_a.astype(f32))
    tril = jnp.tril(jnp.ones((CHUNK, CHUNK), bool))

    def step(s_mat, xs):
        q_, k_, v_, g_ = xs
        b = jnp.cumsum(g_, axis=2)
        q_dec = q_ * jnp.exp(b)
        k_dec = k_ * jnp.exp(-b)
        att = jnp.where(tril, jnp.einsum('bhtd,bhsd->bhts', q_dec, k_dec), 0.0)
        o = jnp.einsum('bhts,bhse->bhte', att, v_) + jnp.einsum('bhtd,bhde->bhte', q_dec, s_mat)
        b_last = b[:, :, -1]
        s_new = jnp.exp(b_last)[..., None] * s_mat + jnp.einsum('bhsd,bhse->bhde', k_ * jnp.exp(b_last[:, :, None] - b), v_)
        return s_new, o

    _, o = lax.scan(step, jnp.zeros((bsz, heads, dk, dv), f32), (qc, kc, vc, gc))
    return from_chunks(o).astype(v.dtype)


def mixer_ab(x, w_in, w_out, rel_bias, lq1, lk1, lq2, lk2, lam_init, diff_g, conv_w, conv_b, b_i, b_f, mlstm_g):
    bsz, s, _ = x.shape
    qa, ka, va, qkb, vb, ob, ib, fb = split_cols(x @ w_in, AB_SIZES)
    lam = (jnp.exp(jnp.sum(lq1 * lk1)) - jnp.exp(jnp.sum(lq2 * lk2)) + lam_init).astype(jnp.float32)
    ya = diff_attention(qa.reshape(bsz, s, A_HEADS, 2, A_QK_DIM), ka.reshape(bsz, s, A_HEADS, 2, A_QK_DIM),
                        va.reshape(bsz, s, A_HEADS, A_V_DIM), lam, rel_bias)
    ya = head_rms_norm(ya, diff_g) * (1.0 - lam_init)
    qkb = jax.nn.silu(causal_dwconv(qkb, conv_w, conv_b))
    qb, kb = jnp.split(qkb, 2, axis=-1)
    yb = mlstm_chunkwise(qb.reshape(bsz, s, B_HEADS, B_QK_DIM), kb.reshape(bsz, s, B_HEADS, B_QK_DIM),
                         vb.reshape(bsz, s, B_HEADS, B_V_DIM), ib + b_i, fb + b_f)
    yb = head_rms_norm(yb, mlstm_g) * jax.nn.sigmoid(ob)
    return jnp.concatenate([ya, yb], axis=-1) @ w_out


def mixer_c(x, w_in, w_a2, b_a, gla_g, w_out):
    bsz, s, _ = x.shape
    q, k, v, r, a1 = split_cols(x @ w_in, C_SIZES)
    log_a = jax.nn.log_sigmoid((a1 @ w_a2 + b_a).astype(jnp.float32)) / C_GATE_TEMP
    y = gla_chunkwise(q.reshape(bsz, s, C_HEADS, C_QK_DIM), k.reshape(bsz, s, C_HEADS, C_QK_DIM),
                      v.reshape(bsz, s, C_HEADS, C_V_DIM), log_a.reshape(bsz, s, C_HEADS, C_QK_DIM))
    y = head_rms_norm(y, gla_g) * jax.nn.silu(r)
    return y @ w_out


def setup_inputs(seed: int = 0) -> dict:
    key = jax.random.key(seed)
    ks = jax.random.split(key, 32)
    f32 = jnp.float32

    def nrm(k, shape, scale):
        return jax.random.normal(k, shape, f32) * scale

    return {
        'x': nrm(ks[0], (BATCH, SEQ, D_MODEL), 1.0),
        'p': nrm(ks[1], (DEPTH, BATCH, SEQ, PLE_DIM), 1.0),
        'ln_g': 1.0 + nrm(ks[2], (DEPTH, 3, D_MODEL), 0.02),
        'ln_b': nrm(ks[3], (DEPTH, 3, D_MODEL), 0.02),
        'w_ffn_in': nrm(ks[4], (DEPTH, 2, D_MODEL, 2 * D_FF), D_MODEL ** -0.5),
        'w_ffn_out': nrm(ks[5], (DEPTH, 2, D_FF, D_MODEL), D_FF ** -0.5 * DEEPNORM_BETA),
        'w_in_ab': nrm(ks[6], (N_EVEN, D_MODEL, AB_PROJ), D_MODEL ** -0.5),
        'w_out_ab': nrm(ks[7], (N_EVEN, MIX_WIDTH, D_MODEL), MIX_WIDTH ** -0.5 * DEEPNORM_BETA),
        'rel_bias': nrm(ks[8], (N_BUCKETS, A_HEADS), 0.5),
        'lambda_q1': nrm(ks[9], (N_EVEN, A_QK_DIM), 0.1),
        'lambda_k1': nrm(ks[10], (N_EVEN, A_QK_DIM), 0.1),
        'lambda_q2': nrm(ks[11], (N_EVEN, A_QK_DIM), 0.1),
        'lambda_k2': nrm(ks[12], (N_EVEN, A_QK_DIM), 0.1),
        'diff_norm': 1.0 + nrm(ks[13], (N_EVEN, A_WIDTH), 0.02),
        'conv_w': nrm(ks[14], (N_EVEN, CONV_WIDTH, 2 * B_HEADS * B_QK_DIM), 0.5),
        'conv_b': nrm(ks[15], (N_EVEN, 2 * B_HEADS * B_QK_DIM), 0.02),
        'b_igate': nrm(ks[16], (N_EVEN, B_HEADS), 0.1),
        'b_fgate': jnp.linspace(3.0, 6.0, B_HEADS, dtype=f32)[None] + nrm(ks[17], (N_EVEN, B_HEADS), 0.1),
        'mlstm_norm': 1.0 + nrm(ks[18], (N_EVEN, B_WIDTH), 0.02),
        'w_in_c': nrm(ks[19], (N_ODD, D_MODEL, C_PROJ), D_MODEL ** -0.5),
        'w_alpha2': nrm(ks[20], (N_ODD, C_GATE_RANK, C_HEADS * C_QK_DIM), C_GATE_RANK ** -0.5),
        'b_alpha': nrm(ks[21], (N_ODD, C_HEADS * C_QK_DIM), 0.1),
        'gla_norm': 1.0 + nrm(ks[22], (N_ODD, C_WIDTH), 0.02),
        'w_out_c': nrm(ks[23], (N_ODD, C_WIDTH, D_MODEL), C_WIDTH ** -0.5 * DEEPNORM_BETA),
        'w_ple_proj': nrm(ks[24], (DEPTH, PLE_DIM, D_MODEL), PLE_DIM ** -0.5),
        'w_ple_gate': nrm(ks[25], (DEPTH, D_MODEL, D_MODEL), D_MODEL ** -0.5),
    }


def reference(x, p, ln_g, ln_b, w_ffn_in, w_ffn_out, w_in_ab, w_out_ab, rel_bias, lambda_q1, lambda_k1,
              lambda_q2, lambda_k2, diff_norm, conv_w, conv_b, b_igate, b_fgate, mlstm_norm, w_in_c,
              w_alpha2, b_alpha, gla_norm, w_out_c, w_ple_proj, w_ple_gate):
    for i in range(DEPTH):
        x = layer_norm(DEEPNORM_ALPHA * x + 0.5 * swiglu(x, w_ffn_in[i, 0], w_ffn_out[i, 0]), ln_g[i, 0], ln_b[i, 0])
        if i % 2 == 0:
            e = i // 2
            lam_init = 0.8 - 0.6 * math.exp(-0.3 * i)
            y = mixer_ab(x, w_in_ab[e], w_out_ab[e], rel_bias, lambda_q1[e], lambda_k1[e], lambda_q2[e],
                         lambda_k2[e], lam_init, diff_norm[e], conv_w[e], conv_b[e], b_igate[e], b_fgate[e],
                         mlstm_norm[e])
        else:
            o = i // 2
            y = mixer_c(x, w_in_c[o], w_alpha2[o], b_alpha[o], gla_norm[o], w_out_c[o])
        x = layer_norm(DEEPNORM_ALPHA * x + y, ln_g[i, 1], ln_b[i, 1])
        x = layer_norm(DEEPNORM_ALPHA * x + 0.5 * swiglu(x, w_ffn_in[i, 1], w_ffn_out[i, 1]), ln_g[i, 2], ln_b[i, 2])
        x = x + (p[i] @ w_ple_proj[i]) * jax.nn.sigmoid(x @ w_ple_gate[i])
    return x
```

```cpp
#include <hip/hip_runtime.h>
#include <hip/hip_cooperative_groups.h>
#include <cstdio>
#include <cstdint>
namespace cg = cooperative_groups;
namespace pg8 {
#define PG8_LAS __attribute__((address_space(3)))
typedef unsigned short bf16_t;
typedef short bf16x8 __attribute__((ext_vector_type(8)));
typedef float f32x4 __attribute__((ext_vector_type(4)));
typedef unsigned u32x4 __attribute__((ext_vector_type(4)));
constexpr int BM = 256, BK = 64, HALF = 128, HTB = HALF * BK * 2  , STAGE_BYTES = 8 * HTB, NXCD = 8, WGM = 8;

__host__ __device__ __forceinline__ int lds_byte(int r, int c) { const int st = (r >> 4) * 2 + (c >> 5), rr = r & 15, cc = c & 31, ob = rr * 64 + cc * 2; return st * 1024 + (ob ^ (((ob >> 9) & 1) << 5)); }
__host__ __device__ __forceinline__ void stage_rc(int b, int& R, int& C) { const int st = b / 1024, sb = b % 1024, swz = sb ^ (((sb >> 9) & 1) << 5); R = (st >> 1) * 16 + swz / 64; C = (st & 1) * 32 + (swz % 64) / 2; }
__host__ __device__ __forceinline__ int perm32(int rho) { const int n = rho >> 4, i = rho & 15; return 8 * (i >> 2) + 4 * n + (i & 3); }

struct Unit { int pm, pn; };
struct Gemm { const bf16_t* A; const bf16_t* Bt; int M, N, K; };

struct StaticOrder {
    int nM, nN, nwg, G, c;
    __host__ __device__ void init(int M, int N, int G_, int c_) { nM = M / BM; nN = N / BM; nwg = nM * nN; G = G_; c = c_; }
    __host__ __device__ bool next(int i, Unit& u) const {
        const long L = (long)i * G + c; if (L >= nwg) return false;
        int wgid = (int)L; { const int q = nwg / NXCD, r = nwg % NXCD, xcd = wgid % NXCD, off = wgid / NXCD; wgid = (xcd < r ? xcd * (q + 1) : r * (q + 1) + (xcd - r) * q) + off; }
        const int nig = WGM * nN, gid = wgid / nig, fm = gid * WGM, gsz = (nM - fm) < WGM ? (nM - fm) : WGM;
        u.pm = fm + ((wgid % nig) % gsz); u.pn = (wgid % nig) / gsz; return true;
    }
    __device__ __forceinline__ void a_ready(const Unit&) const {}
    __device__ __forceinline__ void done(const Unit&) const {}
};

__device__ __forceinline__ unsigned cvt_pk_bf16(float lo, float hi) { unsigned r; asm volatile("v_cvt_pk_bf16_f32 %0, %1, %2" : "=v"(r) : "v"(lo), "v"(hi)); return r; }
typedef float f32x2 __attribute__((ext_vector_type(2)));
template <class Epi, class Sched, bool ALIGN_EPI = false, bool SP2 = false>
__device__ __forceinline__ void gemm_phase(PG8_LAS unsigned char* lds, const Gemm g, const Sched& S, const Epi& E, const int tid_in) {
    const int tid = tid_in, wid = __builtin_amdgcn_readfirstlane(tid >> 6), lane = tid & 63, wr = wid >> 2, wc = wid & 3, fr = lane & 15, fq = lane >> 4;
    const int K = g.K, nt = K / BK;
    unsigned voffA[2], voffB[2];
#pragma unroll
    for (int i = 0; i < 2; ++i) { int R, C; stage_rc(tid * 16 + i * 8192, R, C); const int Rb = Epi::PERM ? ((R & ~31) + perm32(R & 31)) : R;
        voffA[i] = (unsigned)(R * K + C) * 2u; voffB[i] = (unsigned)(Rb * K + C) * 2u; }
    const size_t kstep = (size_t)(BK * 2);
    const size_t hstep = (size_t)HALF * K * 2;
    const size_t tstep = 2 * hstep;
    const unsigned ldsw = (unsigned)wid * 1024u;
    const int aoff = lds_byte(wr * 64 + fr, fq * 8), boff = lds_byte(wc * 32 + fr, fq * 8);
#define PG8_SA(b, h) (((b) * 2 + (h)) * HTB)
#define PG8_SB(b, h) ((4 + (b) * 2 + (h)) * HTB)
#define PG8_STAGE(bufoff, gbase, voff) do { _Pragma("unroll") for (int _i = 0; _i < 2; ++_i) \
        __builtin_amdgcn_global_load_lds((const unsigned*)((const char*)(gbase) + (voff)[_i]), (PG8_LAS unsigned*)(lds + (bufoff) + ldsw + _i * 8192), 16, 0, 0); } while (0)
#define PG8_LDA(dst, b, h) do { _Pragma("unroll") for (int m = 0; m < 4; ++m) _Pragma("unroll") for (int k = 0; k < 2; ++k) dst[m][k] = *(const PG8_LAS bf16x8*)(lds + PG8_SA(b, h) + aoff + m * 2048 + k * 1024); } while (0)
#define PG8_LDB(dst, b, h) do { _Pragma("unroll") for (int n = 0; n < 2; ++n) _Pragma("unroll") for (int k = 0; k < 2; ++k) dst[n][k] = *(const PG8_LAS bf16x8*)(lds + PG8_SB(b, h) + boff + n * 2048 + k * 1024); } while (0)
#define PG8_MMA(ai, bj, At, Bt) do { __builtin_amdgcn_s_setprio(1); _Pragma("unroll") for (int m = 0; m < 4; ++m) _Pragma("unroll") for (int n = 0; n < 2; ++n) _Pragma("unroll") for (int k = 0; k < 2; ++k) \
        acc[ai][bj][m][n] = __builtin_amdgcn_mfma_f32_16x16x32_bf16(Bt[n][k], At[m][k], acc[ai][bj][m][n], 0, 0, 0); __builtin_amdgcn_s_setprio(0); } while (0)
#define PG8_WAIT_V(n) asm volatile("s_waitcnt vmcnt(" #n ")" ::: "memory")
#define PG8_WAIT_L(n) asm volatile("s_waitcnt lgkmcnt(" #n ")" ::: "memory")
#define PG8_BAR __builtin_amdgcn_s_barrier()
#define PG8_SCHED __builtin_amdgcn_sched_barrier(0)
    Unit cur, nxt; int ui = 0;
    if (!S.next(0, cur)) return;
    f32x4 acc[2][2][4][2];
#pragma unroll
    for (int a = 0; a < 2; ++a)
#pragma unroll
        for (int b = 0; b < 2; ++b)
#pragma unroll
            for (int m = 0; m < 4; ++m)
#pragma unroll
                for (int n = 0; n < 2; ++n) acc[a][b][m][n] = (f32x4){0.f, 0.f, 0.f, 0.f};
    bf16x8 At[4][2], B0[2][2], B1[2][2];
    const char* cA = (const char*)g.A + (size_t)cur.pm * tstep; const char* cB = (const char*)g.Bt + (size_t)cur.pn * tstep;
    S.a_ready(cur);
    if constexpr (SP2) {
        PG8_STAGE(PG8_SB(0, 0), cB, voffB); PG8_STAGE(PG8_SB(0, 1), cB + hstep, voffB); PG8_STAGE(PG8_SA(0, 0), cA, voffA); PG8_STAGE(PG8_SA(0, 1), cA + hstep, voffA);
        if (wr == 1) PG8_BAR;
        PG8_WAIT_V(2); PG8_BAR;
        PG8_STAGE(PG8_SB(1, 0), cB + kstep, voffB); PG8_STAGE(PG8_SA(1, 0), cA + kstep, voffA); PG8_STAGE(PG8_SB(1, 1), cB + hstep + kstep, voffB);
        PG8_WAIT_V(6); PG8_BAR;
    } else {
        PG8_STAGE(PG8_SB(0, 0), cB, voffB); PG8_STAGE(PG8_SA(0, 0), cA, voffA); PG8_STAGE(PG8_SB(0, 1), cB + hstep, voffB); PG8_STAGE(PG8_SA(0, 1), cA + hstep, voffA);
        if (wr == 1) PG8_BAR;
        PG8_WAIT_V(4); PG8_BAR;
        PG8_STAGE(PG8_SB(1, 0), cB + kstep, voffB); PG8_STAGE(PG8_SA(1, 0), cA + kstep, voffA); PG8_STAGE(PG8_SB(1, 1), cB + hstep + kstep, voffB);
        PG8_WAIT_V(6); PG8_BAR;
    }
    for (;;) {
        const bool has_next = S.next(ui + 1, nxt);
        const char* nA = has_next ? (const char*)g.A + (size_t)nxt.pm * tstep : cA; const char* nB = has_next ? (const char*)g.Bt + (size_t)nxt.pn * tstep : cB;
        for (int t = 0; t < nt; t += 2) {
            const bool last = (t == nt - 2);
            const char* a1 = cA + (size_t)(t + 1) * kstep;
            const char* a2 = last ? nA : cA + (size_t)(t + 2) * kstep; const char* b2 = last ? nB : cB + (size_t)(t + 2) * kstep;
            const char* a3 = a2 + kstep; const char* b3 = b2 + kstep;
            if (last && has_next) S.a_ready(nxt);
            if constexpr (SP2) {
            PG8_LDB(B0, 0, 0); PG8_LDB(B1, 0, 1); PG8_SCHED; PG8_LDA(At, 0, 0); PG8_STAGE(PG8_SA(1, 1), a1 + hstep, voffA);
            PG8_WAIT_V(8); PG8_WAIT_L(0); PG8_BAR; PG8_MMA(0, 0, At, B0); PG8_MMA(0, 1, At, B1); PG8_BAR; PG8_SCHED;
            PG8_LDA(At, 0, 1); PG8_STAGE(PG8_SB(0, 0), b2, voffB); PG8_STAGE(PG8_SB(0, 1), b2 + hstep, voffB); PG8_STAGE(PG8_SA(0, 0), a2, voffA);
            PG8_WAIT_V(8); PG8_WAIT_L(0); PG8_BAR; PG8_MMA(1, 0, At, B0); PG8_MMA(1, 1, At, B1); PG8_BAR; PG8_SCHED;
            PG8_LDB(B0, 1, 0); PG8_LDB(B1, 1, 1); PG8_SCHED; PG8_LDA(At, 1, 0); PG8_STAGE(PG8_SA(0, 1), a2 + hstep, voffA);
            PG8_WAIT_V(8); PG8_WAIT_L(0); PG8_BAR; PG8_MMA(0, 0, At, B0); PG8_MMA(0, 1, At, B1); PG8_BAR; PG8_SCHED;
            PG8_LDA(At, 1, 1); PG8_STAGE(PG8_SB(1, 0), b3, voffB); PG8_STAGE(PG8_SB(1, 1), b3 + hstep, voffB); PG8_STAGE(PG8_SA(1, 0), a3, voffA);
            PG8_WAIT_V(8); PG8_WAIT_L(0); PG8_BAR; PG8_MMA(1, 0, At, B0); PG8_MMA(1, 1, At, B1); PG8_BAR; PG8_SCHED;
            } else {
            PG8_LDB(B0, 0, 0); PG8_SCHED; PG8_LDA(At, 0, 0); PG8_STAGE(PG8_SA(1, 1), a1 + hstep, voffA);
            PG8_WAIT_L(8); PG8_BAR; PG8_WAIT_L(0); PG8_MMA(0, 0, At, B0); PG8_BAR; PG8_SCHED;
            PG8_LDB(B1, 0, 1); PG8_STAGE(PG8_SB(0, 0), b2, voffB);
            PG8_BAR; PG8_WAIT_L(0); PG8_MMA(0, 1, At, B1); PG8_BAR;
            PG8_LDA(At, 0, 1); PG8_STAGE(PG8_SA(0, 0), a2, voffA);
            PG8_BAR; PG8_WAIT_L(0); PG8_MMA(1, 0, At, B0); PG8_BAR; PG8_SCHED;
            PG8_STAGE(PG8_SB(0, 1), b2 + hstep, voffB);
            PG8_WAIT_V(6); PG8_BAR; PG8_MMA(1, 1, At, B1); PG8_BAR;
            PG8_LDB(B0, 1, 0); PG8_SCHED; PG8_LDA(At, 1, 0); PG8_STAGE(PG8_SA(0, 1), a2 + hstep, voffA);
            PG8_WAIT_L(8); PG8_BAR; PG8_WAIT_L(0); PG8_MMA(0, 0, At, B0); PG8_BAR; PG8_SCHED;
            PG8_LDB(B1, 1, 1); PG8_STAGE(PG8_SB(1, 0), b3, voffB);
            PG8_BAR; PG8_WAIT_L(0); PG8_MMA(0, 1, At, B1); PG8_BAR;
            PG8_LDA(At, 1, 1); PG8_STAGE(PG8_SA(1, 0), a3, voffA);
            PG8_BAR; PG8_WAIT_L(0); PG8_MMA(1, 0, At, B0); PG8_BAR; PG8_SCHED;
            PG8_STAGE(PG8_SB(1, 1), b3 + hstep, voffB);
            PG8_WAIT_V(6); PG8_BAR; PG8_MMA(1, 1, At, B1); PG8_BAR;
            }
        }
        if constexpr (ALIGN_EPI) { if (wr == 0) PG8_BAR; }
        if constexpr (!Epi::AFTER_DRAIN) { E(acc, cur, wr, wc, fr, fq); S.done(cur); }
        if (!has_next) break;
#pragma unroll
        for (int a = 0; a < 2; ++a)
#pragma unroll
            for (int b = 0; b < 2; ++b)
#pragma unroll
                for (int m = 0; m < 4; ++m)
#pragma unroll
                    for (int n = 0; n < 2; ++n) acc[a][b][m][n] = (f32x4){0.f, 0.f, 0.f, 0.f};
        cur = nxt; cA = nA; cB = nB; ++ui;
        if constexpr (ALIGN_EPI) { if (wr == 1) PG8_BAR; }
    }
    PG8_WAIT_V(0);
    if constexpr (!ALIGN_EPI) { if (wr == 0) PG8_BAR; }
    PG8_BAR;
    if constexpr (Epi::AFTER_DRAIN) { E.fused(acc, cur, wr, wc, fr, fq, lds, wid, lane); S.done(cur); }
#undef PG8_SA
#undef PG8_SB
#undef PG8_STAGE
#undef PG8_LDA
#undef PG8_LDB
#undef PG8_MMA
#undef PG8_WAIT_V
#undef PG8_WAIT_L
#undef PG8_BAR
#undef PG8_SCHED
}
}

namespace pg8 {
typedef unsigned u32x2 __attribute__((ext_vector_type(2)));
__device__ __forceinline__ float sigmoidf_(float v) { return 1.0f / (1.0f + __expf(-v)); }

struct EpiSwiglu {
    static constexpr bool PERM = true, AFTER_DRAIN = false;
    bf16_t* H; int ldh;
    __device__ __forceinline__ void operator()(const f32x4 (&acc)[2][2][4][2], const Unit& u, int wr, int wc, int fr, int fq) const {
        const int row0 = u.pm * BM + wr * 64 + fr; const int col0 = u.pn * HALF + wc * 32 + 8 * fq;
#pragma unroll
        for (int ai = 0; ai < 2; ++ai)
#pragma unroll
            for (int m = 0; m < 4; ++m) {
                bf16_t* p = H + (size_t)(row0 + ai * HALF + m * 16) * ldh + col0;
                f32x4 h0, h1;
#pragma unroll
                for (int e = 0; e < 4; ++e) {
                    const float g0 = acc[ai][0][m][0][e], g1 = acc[ai][0][m][1][e];
                    h0[e] = g0 * sigmoidf_(g0) * acc[ai][1][m][0][e];
                    h1[e] = g1 * sigmoidf_(g1) * acc[ai][1][m][1][e];
                }
                u32x4 w; w.x = cvt_pk_bf16(h0[0], h0[1]); w.y = cvt_pk_bf16(h0[2], h0[3]); w.z = cvt_pk_bf16(h1[0], h1[1]); w.w = cvt_pk_bf16(h1[2], h1[3]);
                *(u32x4*)p = w;
            }
    }
};

template <bool RF32> struct EpiZ {
    static constexpr bool PERM = true, AFTER_DRAIN = false;
    const void* R; bf16_t* Z; float alpha, s;
    __device__ __forceinline__ void operator()(const f32x4 (&acc)[2][2][4][2], const Unit& u, int wr, int wc, int fr, int fq) const {
        const int row0 = u.pm * BM + wr * 64 + fr; const int col0 = u.pn * BM + wc * 32 + 8 * fq;
#pragma unroll
        for (int ai = 0; ai < 2; ++ai)
#pragma unroll
            for (int m = 0; m < 4; ++m) {
                const size_t off = (size_t)(row0 + ai * HALF + m * 16) * 2048 + col0;
#pragma unroll
                for (int bj = 0; bj < 2; ++bj) {
                    f32x4 r0, r1;
                    if (RF32) { r0 = *(const f32x4*)((const float*)R + off + bj * HALF); r1 = *(const f32x4*)((const float*)R + off + bj * HALF + 4); }
                    else { const u32x4 rb = *(const u32x4*)((const bf16_t*)R + off + bj * HALF);
                        r0[0] = __uint_as_float(rb.x << 16); r0[1] = __uint_as_float(rb.x & 0xffff0000u); r0[2] = __uint_as_float(rb.y << 16); r0[3] = __uint_as_float(rb.y & 0xffff0000u);
                        r1[0] = __uint_as_float(rb.z << 16); r1[1] = __uint_as_float(rb.z & 0xffff0000u); r1[2] = __uint_as_float(rb.w << 16); r1[3] = __uint_as_float(rb.w & 0xffff0000u); }
                    const f32x4 z0 = r0 * alpha + acc[ai][bj][m][0] * s, z1 = r1 * alpha + acc[ai][bj][m][1] * s;
                    u32x4 w; w.x = cvt_pk_bf16(z0[0], z0[1]); w.y = cvt_pk_bf16(z0[2], z0[3]); w.z = cvt_pk_bf16(z1[0], z1[1]); w.w = cvt_pk_bf16(z1[2], z1[3]);
                    *(u32x4*)(Z + off + bj * HALF) = w;
                }
            }
    }
};

struct EpiStore {
    static constexpr bool PERM = true, AFTER_DRAIN = false;
    bf16_t* O; int ldc; int ncols; float* GT;
    __device__ __forceinline__ void operator()(const f32x4 (&acc)[2][2][4][2], const Unit& u, int wr, int wc, int fr, int fq) const {
        const int row0 = u.pm * BM + wr * 64 + fr; const int colt = u.pn * BM;
        if (colt < ncols) {
            const int col0 = colt + wc * 32 + 8 * fq;
#pragma unroll
            for (int ai = 0; ai < 2; ++ai)
#pragma unroll
                for (int m = 0; m < 4; ++m) {
                    bf16_t* rowp = O + (size_t)(row0 + ai * HALF + m * 16) * ldc + col0;
#pragma unroll
                    for (int bj = 0; bj < 2; ++bj) {
                        const f32x4 v0 = acc[ai][bj][m][0], v1 = acc[ai][bj][m][1];
                        u32x4 w; w.x = cvt_pk_bf16(v0[0], v0[1]); w.y = cvt_pk_bf16(v0[2], v0[3]); w.z = cvt_pk_bf16(v1[0], v1[1]); w.w = cvt_pk_bf16(v1[2], v1[3]);
                        *(u32x4*)(rowp + bj * HALF) = w;
                    }
                }
        } else if (GT != nullptr && wc == 0 && fq < 2) {
#pragma unroll
            for (int ai = 0; ai < 2; ++ai)
#pragma unroll
                for (int m = 0; m < 4; ++m) {
                    float* g = GT + (size_t)(row0 + ai * HALF + m * 16) * 16 + 8 * fq;
                    *(f32x4*)(g) = acc[ai][0][m][0];
                    *(f32x4*)(g + 4) = acc[ai][0][m][1];
                }
        }
    }
};

struct EpiPle {
    static constexpr bool PERM = true, AFTER_DRAIN = false;
    const bf16_t* X; const bf16_t* E; float* OUTF; bf16_t* XBO;
    __device__ __forceinline__ void operator()(const f32x4 (&acc)[2][2][4][2], const Unit& u, int wr, int wc, int fr, int fq) const {
        const int row0 = u.pm * BM + wr * 64 + fr; const int col0 = u.pn * BM + wc * 32 + 8 * fq;
#pragma unroll
        for (int ai = 0; ai < 2; ++ai)
#pragma unroll
            for (int m = 0; m < 4; ++m) {
                const size_t off = (size_t)(row0 + ai * HALF + m * 16) * 2048 + col0;
#pragma unroll
                for (int bj = 0; bj < 2; ++bj) {
                    const size_t o2 = off + bj * HALF;
                    const u32x4 xb = *(const u32x4*)(X + o2), eb = *(const u32x4*)(E + o2);
                    const unsigned xw[4] = {xb.x, xb.y, xb.z, xb.w}, ew[4] = {eb.x, eb.y, eb.z, eb.w};
                    float o[8];
#pragma unroll
                    for (int q = 0; q < 4; ++q) {
                        const float a0 = acc[ai][bj][m][q >> 1][2 * (q & 1)], a1 = acc[ai][bj][m][q >> 1][2 * (q & 1) + 1];
                        o[2 * q] = __uint_as_float(xw[q] << 16) + __uint_as_float(ew[q] << 16) * sigmoidf_(a0);
                        o[2 * q + 1] = __uint_as_float(xw[q] & 0xffff0000u) + __uint_as_float(ew[q] & 0xffff0000u) * sigmoidf_(a1);
                    }
                    if (OUTF != nullptr) { *(f32x4*)(OUTF + o2) = (f32x4){o[0], o[1], o[2], o[3]}; *(f32x4*)(OUTF + o2 + 4) = (f32x4){o[4], o[5], o[6], o[7]}; }
                    if (XBO != nullptr) { u32x4 w; w.x = cvt_pk_bf16(o[0], o[1]); w.y = cvt_pk_bf16(o[2], o[3]); w.z = cvt_pk_bf16(o[4], o[5]); w.w = cvt_pk_bf16(o[6], o[7]); *(u32x4*)(XBO + o2) = w; }
                }
            }
    }
};
}

#define LAS __attribute__((address_space(3)))
using pg8::bf16_t; using pg8::bf16x8; using pg8::f32x4; using pg8::u32x4; using pg8::u32x2;
typedef short s16x4 __attribute__((ext_vector_type(4)));
typedef float f32x16 __attribute__((ext_vector_type(16)));
typedef short v4i16_t __attribute__((ext_vector_type(4)));

constexpr int MT = 16384, SEQ = 8192, DM = 2048, DFF = 5632, NFF2 = 11264, NIN = 6144, UW = 6144, PLE = 256;
constexpr int LDS_BYTES = 147456;
constexpr float ALPHA = 1.4142135623730951f;
constexpr float LOG2E = 1.4426950408889634f;

constexpr size_t SZ_WFI = (size_t)NFF2 * DM * 2, SZ_WFO = (size_t)DM * DFF * 2, SZ_WIN = (size_t)NIN * DM * 2, SZ_WSQ = (size_t)DM * DM * 2, SZ_WPP = (size_t)DM * PLE * 2;
constexpr size_t OFF_WFI = 0;
constexpr size_t OFF_WFO = OFF_WFI + 4 * SZ_WFI;
constexpr size_t OFF_WAB = OFF_WFO + 4 * SZ_WFO;
constexpr size_t OFF_WC = OFF_WAB + SZ_WIN;
constexpr size_t OFF_WOAB = OFF_WC + SZ_WIN;
constexpr size_t OFF_WOC = OFF_WOAB + SZ_WSQ;
constexpr size_t OFF_WPG = OFF_WOC + SZ_WSQ;
constexpr size_t OFF_WPP = OFF_WPG + 2 * SZ_WSQ;
constexpr size_t OFF_XF = OFF_WPP + 2 * SZ_WPP;
constexpr size_t OFF_XB = OFF_XF + (size_t)MT * DM * 4;
constexpr size_t OFF_Z = OFF_XB + (size_t)MT * DM * 2;
constexpr size_t OFF_H = OFF_Z + (size_t)MT * DM * 4;
constexpr size_t OFF_MIX = OFF_H + (size_t)MT * UW * 2;
constexpr size_t OFF_PB = OFF_MIX + (size_t)MT * DM * 2;
constexpr size_t OFF_GT = OFF_PB + (size_t)2 * MT * PLE * 2;
constexpr size_t OFF_QB = OFF_GT + (size_t)MT * 16 * 4;
constexpr size_t OFF_KB = OFF_QB + (size_t)MT * 512 * 2;
constexpr size_t OFF_BC = OFF_KB + (size_t)MT * 512 * 2;
constexpr size_t OFF_IP = OFF_BC + (size_t)MT * 4 * 4;
constexpr size_t OFF_MSC = OFF_IP + (size_t)MT * 4 * 4;
constexpr size_t OFF_NL = OFF_MSC + 3 * 1024 * 4;
constexpr size_t OFF_DC = OFF_NL + (size_t)8 * 128 * 128 * 4;
constexpr size_t OFF_ST = OFF_DC + (size_t)8 * 128 * 256 * 4;
constexpr size_t OFF_CTL = OFF_ST + (size_t)8 * 128 * 512 * 256 * 2;
constexpr size_t WS_NEED = OFF_CTL + 32768;

#define LDS_WAIT() asm volatile("s_waitcnt lgkmcnt(0)" ::: "memory")
__device__ __forceinline__ unsigned f2bf(float f) { unsigned u = __builtin_bit_cast(unsigned, f); return (u + 0x7fffu + ((u >> 16) & 1u)) >> 16; }
__device__ __forceinline__ unsigned pk2(float lo, float hi) { return f2bf(lo) | (f2bf(hi) << 16); }
__device__ __forceinline__ float bf2f(unsigned h) { return __uint_as_float(h << 16); }
__device__ __forceinline__ float bflo(unsigned w) { return __uint_as_float(w << 16); }
__device__ __forceinline__ float bfhi(unsigned w) { return __uint_as_float(w & 0xffff0000u); }
__device__ __forceinline__ float wave_sum(float v) {
#pragma unroll
    for (int o = 1; o < 64; o <<= 1) v += __shfl_xor(v, o);
    return v;
}
__device__ __forceinline__ float logsigmoidf_(float x) { return fminf(x, 0.f) - log1pf(__expf(-fabsf(x))); }
__device__ __forceinline__ s16x4 vtr(const LAS unsigned char* p) { return __builtin_bit_cast(s16x4, __builtin_amdgcn_ds_read_tr16_b64_v4i16((LAS v4i16_t*)p)); }
__device__ __forceinline__ bf16x8 tr8(const LAS unsigned char* p0, const LAS unsigned char* p1) {
    const s16x4 a = vtr(p0), b = vtr(p1); bf16x8 r; r[0] = a[0]; r[1] = a[1]; r[2] = a[2]; r[3] = a[3]; r[4] = b[0]; r[5] = b[1]; r[6] = b[2]; r[7] = b[3]; return r;
}
__device__ __forceinline__ f32x4 mfma16(bf16x8 a, bf16x8 b, f32x4 c) { return __builtin_amdgcn_mfma_f32_16x16x32_bf16(a, b, c, 0, 0, 0); }
__device__ __forceinline__ f32x16 mfma32(bf16x8 a, bf16x8 b, f32x16 c) { return __builtin_amdgcn_mfma_f32_32x32x16_bf16(a, b, c, 0, 0, 0); }
__device__ __forceinline__ bf16x8 ldsv8(const LAS unsigned char* p) { return *(const LAS bf16x8*)p; }

struct Ctx { LAS unsigned char* lds; int tid, lane, wave, G, bid, gw, NGW; };

__device__ __forceinline__ void tr_decode(int it, int nnb, int mode, int& k0, int& n0, int& drow0, float& scale) {
    const int kb = it / nnb, nb = it - kb * nnb; k0 = 64 * kb; n0 = 64 * nb; drow0 = n0; scale = 1.f;
    if (mode == 1) { const int half = n0 >= DFF ? 1 : 0; const int j0 = n0 - half * DFF; drow0 = 256 * (j0 >> 7) + 128 * half + (j0 & 127); }
    if (mode == 2 && n0 < 1024) scale = 0.125f;
}
__device__ __forceinline__ void tr_load(float (&r)[64], const float* __restrict__ W, int N, int k0, int n0, int lane) {
    const int n = n0 + lane; const bool ok = n < N; const float* src = W + (size_t)k0 * N + (ok ? n : 0);
#pragma unroll
    for (int i = 0; i < 64; ++i) { const float v = src[(size_t)i * N]; r[i] = ok ? v : 0.f; }
}
__device__ __forceinline__ void conv_matrix(const Ctx& C, const float* W, int K, int N, int Npad, bf16_t* WT, int mode, int& base) {
    LAS float* scr = (LAS float*)(C.lds + C.wave * 16640);
    const int nnb = Npad / 64, nitems = (K / 64) * nnb, lane = C.lane;
    int first = (C.gw - base) % C.NGW; if (first < 0) first += C.NGW;
    float r[64]; int k0 = 0, n0 = 0, drow0 = 0; float scale = 1.f;
    int it = first;
    if (it < nitems) { tr_decode(it, nnb, mode, k0, n0, drow0, scale); tr_load(r, W, N, k0, n0, lane); }
    while (it < nitems) {
#pragma unroll
        for (int i = 0; i < 64; ++i) scr[i * 65 + lane] = r[i] * scale;
        const int ck0 = k0, cdrow0 = drow0;
        it += C.NGW;
        if (it < nitems) { tr_decode(it, nnb, mode, k0, n0, drow0, scale); tr_load(r, W, N, k0, n0, lane); }
        LDS_WAIT(); asm volatile("" ::: "memory");
        const int c = lane & 7;
#pragma unroll
        for (int j = 0; j < 8; ++j) { const int nn = (lane >> 3) + 8 * j; const LAS float* s = scr + (8 * c) * 65 + nn;
            u32x4 o; o.x = pk2(s[0 * 65], s[1 * 65]); o.y = pk2(s[2 * 65], s[3 * 65]); o.z = pk2(s[4 * 65], s[5 * 65]); o.w = pk2(s[6 * 65], s[7 * 65]);
            *(u32x4*)(WT + (size_t)(cdrow0 + nn) * K + ck0 + 8 * c) = o; }
        LDS_WAIT(); asm volatile("" ::: "memory");
    }
    base = (base + nitems) % C.NGW;
}
__device__ __forceinline__ void cvt_rows(const Ctx& C, const float* src, bf16_t* dst, size_t n4) {
    const size_t stride = (size_t)C.G * 512;
    for (size_t i = (size_t)C.bid * 512 + C.tid; i < n4; i += 4 * stride) {
        f32x4 v[4];
#pragma unroll
        for (int j = 0; j < 4; ++j) if (i + j * stride < n4) v[j] = *(const f32x4*)(src + 4 * (i + j * stride));
#pragma unroll
        for (int j = 0; j < 4; ++j) if (i + j * stride < n4) { u32x2 w; w.x = pk2(v[j][0], v[j][1]); w.y = pk2(v[j][2], v[j][3]); *(u32x2*)(dst + 4 * (i + j * stride)) = w; }
    }
}

template <bool GATES>
__device__ __forceinline__ void ln_phase(const Ctx& C, const bf16_t* Z, const float* g, const float* b, bf16_t* XB, const float* Wsrc, int ldw, int ngate, float* GT) {
    LAS float* WG = (LAS float*)C.lds;
    if (GATES) {
        for (int col = C.tid; col < DM; col += 512) {
            const float* src = Wsrc + (size_t)col * ldw + 6144;
#pragma unroll
            for (int gi = 0; gi < 16; ++gi) WG[gi * DM + col] = (gi < ngate) ? src[gi] : 0.f;
        }
        __syncthreads();
    }
    f32x4 gv[8], bv[8];
#pragma unroll
    for (int j = 0; j < 4; ++j) { gv[2 * j] = *(const f32x4*)(g + 512 * j + 8 * C.lane); gv[2 * j + 1] = *(const f32x4*)(g + 512 * j + 8 * C.lane + 4);
                                  bv[2 * j] = *(const f32x4*)(b + 512 * j + 8 * C.lane); bv[2 * j + 1] = *(const f32x4*)(b + 512 * j + 8 * C.lane + 4); }
    const bool grp = (C.G & 7) == 0; const int nwg_ = grp ? (C.G >> 3) * 8 : C.NGW; const int first_ = grp ? (C.bid >> 3) * 8 + C.wave : C.gw; const int base_ = grp ? 2048 * (C.bid & 7) : 0; const int lim_ = grp ? 2048 : MT;
    for (int lrow = first_; lrow < lim_; lrow += nwg_) {
        const int row = base_ + lrow;
        const bf16_t* z = Z + (size_t)row * DM + 8 * C.lane;
        u32x4 zb[4];
#pragma unroll
        for (int j = 0; j < 4; ++j) zb[j] = *(const u32x4*)(z + 512 * j);
        f32x4 v[8]; float s = 0.f;
#pragma unroll
        for (int j = 0; j < 4; ++j) { v[2 * j] = (f32x4){bflo(zb[j].x), bfhi(zb[j].x), bflo(zb[j].y), bfhi(zb[j].y)}; v[2 * j + 1] = (f32x4){bflo(zb[j].z), bfhi(zb[j].z), bflo(zb[j].w), bfhi(zb[j].w)}; }
#pragma unroll
        for (int j = 0; j < 8; ++j) s += (v[j][0] + v[j][1]) + (v[j][2] + v[j][3]);
        const float mean = wave_sum(s) * (1.f / DM); float s2 = 0.f;
#pragma unroll
        for (int j = 0; j < 8; ++j) { v[j] = v[j] - mean; s2 += (v[j][0] * v[j][0] + v[j][1] * v[j][1]) + (v[j][2] * v[j][2] + v[j][3] * v[j][3]); }
        const float rstd = 1.f / sqrtf(wave_sum(s2) * (1.f / DM) + 1e-5f);
        bf16_t* bo = XB + (size_t)row * DM + 8 * C.lane;
#pragma unroll
        for (int j = 0; j < 4; ++j) { const f32x4 o0 = v[2 * j] * rstd * gv[2 * j] + bv[2 * j], o1 = v[2 * j + 1] * rstd * gv[2 * j + 1] + bv[2 * j + 1];
            u32x4 w; w.x = pg8::cvt_pk_bf16(o0[0], o0[1]); w.y = pg8::cvt_pk_bf16(o0[2], o0[3]); w.z = pg8::cvt_pk_bf16(o1[0], o1[1]); w.w = pg8::cvt_pk_bf16(o1[2], o1[3]); *(u32x4*)(bo + 512 * j) = w;
            if (GATES) { v[2 * j] = o0; v[2 * j + 1] = o1; } }
        if (GATES) {
            float mine = 0.f;
#pragma unroll 4
            for (int gi = 0; gi < 16; ++gi) {
                float s0 = 0.f, s1 = 0.f;
#pragma unroll
                for (int j = 0; j < 4; ++j) { const f32x4 w0 = *(const LAS f32x4*)(WG + gi * DM + 512 * j + 8 * C.lane), w1 = *(const LAS f32x4*)(WG + gi * DM + 512 * j + 8 * C.lane + 4);
                    s0 += (v[2 * j][0] * w0[0] + v[2 * j][1] * w0[1]) + (v[2 * j][2] * w0[2] + v[2 * j][3] * w0[3]);
                    s1 += (v[2 * j + 1][0] * w1[0] + v[2 * j + 1][1] * w1[1]) + (v[2 * j + 1][2] * w1[2] + v[2 * j + 1][3] * w1[3]); }
                const float tot = wave_sum(s0 + s1);
                mine = (C.lane == gi) ? tot : mine;
            }
            if (C.lane < 16) GT[(size_t)row * 16 + C.lane] = mine;
        }
    }
    if (GATES) __syncthreads();
}

__device__ __forceinline__ void m1_phase(const Ctx& C, const bf16_t* U, const float* GT, const float* conv_w, const float* conv_b, const float* b_i, const float* b_f,
                                         bf16_t* QB, bf16_t* KB, float* BC, float* IP, float* MSC) {
    if (C.bid < 8) {
        LAS float* sb = (LAS float*)C.lds; LAS float* su = sb + 128;
        const int bh = C.bid, b = bh >> 2, h = bh & 3;
        {
            const float bi = b_i[h], bf = b_f[h]; const int ln = C.lane;
            float fv[16], iv[16];
#pragma unroll
            for (int k = 0; k < 16; ++k) { const size_t row = (size_t)b * SEQ + (C.wave * 16 + k) * 64 + ln; fv[k] = GT[row * 16 + 4 + h]; iv[k] = GT[row * 16 + h]; }
#pragma unroll
            for (int k = 0; k < 16; ++k) {
                const int c = C.wave * 16 + k; const size_t row = (size_t)b * SEQ + c * 64 + ln;
                float cum = logsigmoidf_(fv[k] + bf);
#pragma unroll
                for (int off = 1; off < 64; off <<= 1) { const float t = __shfl_up(cum, off); if (ln >= off) cum += t; }
                const float ip = iv[k] + bi;
                BC[row * 4 + h] = cum; IP[row * 4 + h] = ip;
                float um = ip - cum;
#pragma unroll
                for (int off = 1; off < 64; off <<= 1) um = fmaxf(um, __shfl_xor(um, off));
                const float bl = __shfl(cum, 63);
                if (ln == 0) { sb[c] = bl; su[c] = um; }
            }
        }
        __syncthreads();
        if (C.tid == 0) {
            float m = 0.f;
#pragma unroll 1
            for (int c = 0; c < 128; ++c) {
                const float bl = sb[c], mn = fmaxf(bl + m, bl + su[c]);
                MSC[bh * 128 + c] = m; MSC[1024 + bh * 128 + c] = mn; MSC[2048 + bh * 128 + c] = __expf(bl + m - mn); m = mn;
            }
        }
        __syncthreads();
    }
    for (size_t i = (size_t)C.bid * 512 + C.tid; i < (size_t)MT * 128; i += (size_t)C.G * 512) {
        const int row = (int)(i >> 7), c0 = (int)(i & 127) * 8, t = row & (SEQ - 1);
        float acc[8];
#pragma unroll
        for (int e = 0; e < 8; ++e) acc[e] = conv_b[c0 + e];
#pragma unroll
        for (int j = 0; j < 4; ++j) {
            const int tt = t - 3 + j;
            if (tt >= 0) {
                const u32x4 xv = *(const u32x4*)(U + (size_t)(row - 3 + j) * UW + 3072 + c0);
                const f32x4 w0 = *(const f32x4*)(conv_w + j * 1024 + c0), w1 = *(const f32x4*)(conv_w + j * 1024 + c0 + 4);
                acc[0] += w0[0] * bflo(xv.x); acc[1] += w0[1] * bfhi(xv.x); acc[2] += w0[2] * bflo(xv.y); acc[3] += w0[3] * bfhi(xv.y);
                acc[4] += w1[0] * bflo(xv.z); acc[5] += w1[1] * bfhi(xv.z); acc[6] += w1[2] * bflo(xv.w); acc[7] += w1[3] * bfhi(xv.w);
            }
        }
        const float sc = (c0 < 512) ? 0.08838834764831845f : 1.f;
#pragma unroll
        for (int e = 0; e < 8; ++e) acc[e] = acc[e] * pg8::sigmoidf_(acc[e]) * sc;
        u32x4 w; w.x = pk2(acc[0], acc[1]); w.y = pk2(acc[2], acc[3]); w.z = pk2(acc[4], acc[5]); w.w = pk2(acc[6], acc[7]);
        if (c0 < 512) *(u32x4*)(QB + (size_t)row * 512 + c0) = w; else *(u32x4*)(KB + (size_t)row * 512 + c0 - 512) = w;
    }
}

__device__ __forceinline__ void mlstm_passA(const Ctx& C, const bf16_t* U, const bf16_t* KB, const float* BC, const float* IP, const float* MSC, bf16_t* ST, float* NL) {
    LAS unsigned char* KW = C.lds; LAS unsigned char* V = C.lds + 17408; LAS float* wk = (LAS float*)(C.lds + 52224);
    const int l = C.lane, g = l >> 4, q = (l & 15) >> 2, p = l & 3, w = C.wave;
    for (int u = C.bid; u < 1024; u += C.G) {
        const int bh = u >> 7, c = u & 127, b = bh >> 2, h = bh & 3; const size_t row0 = (size_t)b * SEQ + c * 64;
        if (C.tid < 64) { const float bl = BC[(row0 + 63) * 4 + h], mn = MSC[1024 + bh * 128 + c]; wk[C.tid] = __expf(bl - BC[(row0 + C.tid) * 4 + h] + IP[(row0 + C.tid) * 4 + h] - mn); }
        __syncthreads();
        { const int s = C.tid >> 3, seg = C.tid & 7; const float ws = wk[s];
          const bf16_t* kp = KB + (row0 + s) * 512 + h * 128 + seg * 16;
#pragma unroll
          for (int i = 0; i < 2; ++i) { const u32x4 kv = *(const u32x4*)(kp + 8 * i); u32x4 o;
              o.x = pk2(bflo(kv.x) * ws, bfhi(kv.x) * ws); o.y = pk2(bflo(kv.y) * ws, bfhi(kv.y) * ws); o.z = pk2(bflo(kv.z) * ws, bfhi(kv.z) * ws); o.w = pk2(bflo(kv.w) * ws, bfhi(kv.w) * ws);
              *(LAS u32x4*)(KW + s * 272 + seg * 32 + 16 * i) = o; }
          const bf16_t* vp = U + (row0 + s) * UW + 4096 + h * 256 + seg * 32;
#pragma unroll
          for (int i = 0; i < 4; ++i) *(LAS u32x4*)(V + s * 544 + seg * 64 + 16 * i) = *(const u32x4*)(vp + 8 * i); }
        __syncthreads();
        f32x4 acc[2][8];
#pragma unroll
        for (int mi = 0; mi < 2; ++mi)
#pragma unroll
            for (int ni = 0; ni < 8; ++ni) acc[mi][ni] = (f32x4){0.f, 0.f, 0.f, 0.f};
#pragma unroll
        for (int ks = 0; ks < 2; ++ks) {
            const int r0 = 32 * ks + 8 * g + q;
            bf16x8 a[2];
#pragma unroll
            for (int mi = 0; mi < 2; ++mi) { const LAS unsigned char* ap = V + r0 * 544 + (32 * w + 16 * mi + 4 * p) * 2; a[mi] = tr8(ap, ap + 4 * 544); }
#pragma unroll
            for (int ni = 0; ni < 8; ++ni) { const LAS unsigned char* bp = KW + r0 * 272 + (16 * ni + 4 * p) * 2; const bf16x8 bb = tr8(bp, bp + 4 * 272);
#pragma unroll
                for (int mi = 0; mi < 2; ++mi) acc[mi][ni] = mfma16(bb, a[mi], acc[mi][ni]); }
        }
        bf16_t* st = ST + ((size_t)(bh * 128 + c) << 15);
#pragma unroll
        for (int mi = 0; mi < 2; ++mi)
#pragma unroll
            for (int ni = 0; ni < 8; ++ni) { u32x2 wv; wv.x = pg8::cvt_pk_bf16(acc[mi][ni][0], acc[mi][ni][1]); wv.y = pg8::cvt_pk_bf16(acc[mi][ni][2], acc[mi][ni][3]);
                *(u32x2*)(st + (32 * w + 16 * mi + (l & 15)) * 128 + 16 * ni + 4 * g) = wv; }
        if (C.tid < 128) { float s = 0.f;
#pragma unroll 4
            for (int t = 0; t < 64; ++t) s += bf2f(*(const LAS unsigned short*)(KW + t * 272 + C.tid * 2)); NL[(size_t)(bh * 128 + c) * 128 + C.tid] = s; }
        __syncthreads();
    }
}

__device__ __forceinline__ void mlstm_scan(const Ctx& C, bf16_t* ST, float* NL, const float* MSC) {
    for (int e2 = C.bid * 512 + C.tid; e2 < 8 * 16384; e2 += C.G * 512) {
        const int bh = e2 >> 14, off = e2 & 16383; float c0 = 0.f, c1 = 0.f;
        unsigned* p = (unsigned*)(ST + ((size_t)(bh * 128) << 15)) + off;
#pragma unroll 1
        for (int cb = 0; cb < 128; cb += 8) {
            unsigned t[8]; float d[8];
#pragma unroll
            for (int i = 0; i < 8; ++i) { t[i] = p[(size_t)(cb + i) << 14]; d[i] = MSC[2048 + bh * 128 + cb + i]; }
#pragma unroll
            for (int i = 0; i < 8; ++i) { p[(size_t)(cb + i) << 14] = pk2(c0, c1); c0 = d[i] * c0 + bflo(t[i]); c1 = d[i] * c1 + bfhi(t[i]); }
        }
    }
    const int gt = C.bid * 512 + C.tid;
    if (gt < 1024) { const int bh = gt >> 7, dk = gt & 127; float n = 0.f;
#pragma unroll 2
        for (int c = 0; c < 128; ++c) { float* p = NL + (size_t)(bh * 128 + c) * 128 + dk; const float t = *p; *p = n; n = MSC[2048 + bh * 128 + c] * n + t; } }
}

__device__ __forceinline__ void mlstm_passC(const Ctx& C, const bf16_t* U, const bf16_t* QB, const bf16_t* KB, const float* BC, const float* IP, const float* MSC,
                                            const bf16_t* ST, const float* NL, const float* mg, bf16_t* MIX) {
    LAS unsigned char* Q = C.lds; LAS unsigned char* K = C.lds + 17408; LAS unsigned char* V = C.lds + 34816; LAS unsigned char* SW = C.lds + 69632;
    LAS float* fu = (LAS float*)(C.lds + 78848); LAS float* fM = fu + 64; LAS float* fw = fu + 128; LAS float* fb = fu + 192; LAS float* finv = fu + 256; LAS float* fn = fu + 320; LAS float* fss = fu + 448;
    const int l = C.lane, g = l >> 4, q = (l & 15) >> 2, p = l & 3, w = C.wave, lr = l & 15;
    for (int u = C.bid; u < 1024; u += C.G) {
        const int bh = u >> 7, c = u & 127, b = bh >> 2, h = bh & 3; const size_t row0 = (size_t)b * SEQ + c * 64;
        const float mprev = MSC[bh * 128 + c];
        if (C.tid < 64) { const float bt = BC[(row0 + C.tid) * 4 + h]; fb[C.tid] = bt; fu[C.tid] = IP[(row0 + C.tid) * 4 + h] - bt; }
        if (C.tid >= 64 && C.tid < 192) fn[C.tid - 64] = NL[(size_t)(bh * 128 + c) * 128 + C.tid - 64];
        { const int s = C.tid >> 3, seg = C.tid & 7;
          const bf16_t* qp = QB + (row0 + s) * 512 + h * 128 + seg * 16; const bf16_t* kp = KB + (row0 + s) * 512 + h * 128 + seg * 16;
#pragma unroll
          for (int i = 0; i < 2; ++i) { *(LAS u32x4*)(Q + s * 272 + seg * 32 + 16 * i) = *(const u32x4*)(qp + 8 * i); *(LAS u32x4*)(K + s * 272 + seg * 32 + 16 * i) = *(const u32x4*)(kp + 8 * i); }
          const bf16_t* vp = U + (row0 + s) * UW + 4096 + h * 256 + seg * 32;
#pragma unroll
          for (int i = 0; i < 4; ++i) *(LAS u32x4*)(V + s * 544 + seg * 64 + 16 * i) = *(const u32x4*)(vp + 8 * i); }
        __syncthreads();
        if (C.tid < 64) { float pm = -3.0e38f;
#pragma unroll 1
            for (int s = 0; s <= C.tid; ++s) pm = fmaxf(pm, fu[s]); const float Mt = fmaxf(mprev, pm); fM[C.tid] = Mt; fw[C.tid] = __expf(mprev - Mt); }
        __syncthreads();
#pragma unroll
        for (int tt = 0; tt < 2; ++tt) {
            const int tile = 2 * w + tt, ti = tile >> 2, si = tile & 3;
            f32x4 s4 = (f32x4){0.f, 0.f, 0.f, 0.f};
            if (si <= ti) {
#pragma unroll
                for (int ks = 0; ks < 4; ++ks) { const bf16x8 a = ldsv8(Q + (16 * ti + lr) * 272 + (32 * ks + 8 * g) * 2), bb = ldsv8(K + (16 * si + lr) * 272 + (32 * ks + 8 * g) * 2); s4 = mfma16(a, bb, s4); }
            }
            const int sidx = 16 * si + lr; const float us = fu[sidx];
#pragma unroll
            for (int j = 0; j < 4; ++j) { const int t = 16 * ti + 4 * g + j; const float wgt = (sidx <= t) ? __expf(us - fM[t]) : 0.f;
                *(LAS unsigned short*)(SW + t * 144 + sidx * 2) = (unsigned short)f2bf(s4[j] * wgt); }
        }
        __syncthreads();
        if (C.tid < 64) { const int t = C.tid; float rs = 0.f, qn = 0.f;
#pragma unroll 4
            for (int s = 0; s < 64; ++s) rs += bf2f(*(const LAS unsigned short*)(SW + t * 144 + s * 2));
#pragma unroll 4
            for (int d = 0; d < 128; ++d) qn += bf2f(*(const LAS unsigned short*)(Q + t * 272 + d * 2)) * fn[d];
            const float den = fw[t] * qn + rs; finv[t] = 1.f / fmaxf(fabsf(den), __expf(-(fb[t] + fM[t]))); }
        f32x4 acc[4][2];
#pragma unroll
        for (int mi = 0; mi < 4; ++mi)
#pragma unroll
            for (int ni = 0; ni < 2; ++ni) acc[mi][ni] = (f32x4){0.f, 0.f, 0.f, 0.f};
        const bf16_t* st = ST + ((size_t)(bh * 128 + c) << 15);
#pragma unroll
        for (int ks = 0; ks < 4; ++ks) {
            bf16x8 bb[2];
#pragma unroll
            for (int ni = 0; ni < 2; ++ni) bb[ni] = *(const bf16x8*)(st + (32 * w + 16 * ni + lr) * 128 + 32 * ks + 8 * g);
#pragma unroll
            for (int mi = 0; mi < 4; ++mi) { const bf16x8 a = ldsv8(Q + (16 * mi + lr) * 272 + (32 * ks + 8 * g) * 2);
#pragma unroll
                for (int ni = 0; ni < 2; ++ni) acc[mi][ni] = mfma16(bb[ni], a, acc[mi][ni]); }
        }
#pragma unroll
        for (int mi = 0; mi < 4; ++mi) { const float wi = fw[16 * mi + lr]; acc[mi][0] = acc[mi][0] * wi; acc[mi][1] = acc[mi][1] * wi; }
#pragma unroll
        for (int ks = 0; ks < 2; ++ks) {
            const int r0 = 32 * ks + 8 * g + q; bf16x8 bb[2];
#pragma unroll
            for (int ni = 0; ni < 2; ++ni) { const LAS unsigned char* bp = V + r0 * 544 + (32 * w + 16 * ni + 4 * p) * 2; bb[ni] = tr8(bp, bp + 4 * 544); }
#pragma unroll
            for (int mi = 0; mi < 4; ++mi) { const bf16x8 a = ldsv8(SW + (16 * mi + lr) * 144 + (32 * ks + 8 * g) * 2);
#pragma unroll
                for (int ni = 0; ni < 2; ++ni) acc[mi][ni] = mfma16(bb[ni], a, acc[mi][ni]); }
        }
        __syncthreads();
#pragma unroll
        for (int mi = 0; mi < 4; ++mi) { const float iv = finv[16 * mi + lr]; acc[mi][0] = acc[mi][0] * iv; acc[mi][1] = acc[mi][1] * iv;
            float ss = 0.f;
#pragma unroll
            for (int ni = 0; ni < 2; ++ni) ss += (acc[mi][ni][0] * acc[mi][ni][0] + acc[mi][ni][1] * acc[mi][ni][1]) + (acc[mi][ni][2] * acc[mi][ni][2] + acc[mi][ni][3] * acc[mi][ni][3]);
            ss += __shfl_xor(ss, 16); ss += __shfl_xor(ss, 32);
            if (g == 0) fss[w * 64 + 16 * mi + lr] = ss; }
        __syncthreads();
#pragma unroll
        for (int mi = 0; mi < 4; ++mi) { const int t = 16 * mi + lr; float tot = 0.f;
#pragma unroll
            for (int ww = 0; ww < 8; ++ww) tot += fss[ww * 64 + t];
            const float r = 1.f / sqrtf(tot * (1.f / 256.f) + 1e-6f);
#pragma unroll
            for (int ni = 0; ni < 2; ++ni) { const int dv = 32 * w + 16 * ni + 4 * g;
                const u32x2 ogb = *(const u32x2*)(U + (row0 + t) * UW + 5120 + h * 256 + dv); const f32x4 gv = *(const f32x4*)(mg + h * 256 + dv);
                const float o0 = acc[mi][ni][0] * r * gv[0] * pg8::sigmoidf_(bflo(ogb.x)), o1 = acc[mi][ni][1] * r * gv[1] * pg8::sigmoidf_(bfhi(ogb.x));
                const float o2 = acc[mi][ni][2] * r * gv[2] * pg8::sigmoidf_(bflo(ogb.y)), o3 = acc[mi][ni][3] * r * gv[3] * pg8::sigmoidf_(bfhi(ogb.y));
                u32x2 wv; wv.x = pg8::cvt_pk_bf16(o0, o1); wv.y = pg8::cvt_pk_bf16(o2, o3);
                *(u32x2*)(MIX + (row0 + t) * DM + 1024 + h * 256 + dv) = wv; } }
        __syncthreads();
    }
}

__device__ __forceinline__ float gla_decay(const Ctx& C, const float* w_a2, const float* b_a, int h, LAS float* A1, LAS float* tot0, LAS unsigned char* QD, LAS unsigned char* KD) {
    const int ch = C.tid & 255, half = C.tid >> 8, t0 = 32 * half;
    float wv[16];
#pragma unroll
    for (int i = 0; i < 16; ++i) wv[i] = w_a2[i * 1024 + h * 256 + ch];
    const float ba = b_a[h * 256 + ch];
    float c[32]; float run = 0.f;
#pragma unroll
    for (int i = 0; i < 32; ++i) {
        const LAS float* ap = A1 + (t0 + i) * 16;
        const f32x4 a0 = *(const LAS f32x4*)(ap), a1 = *(const LAS f32x4*)(ap + 4), a2 = *(const LAS f32x4*)(ap + 8), a3 = *(const LAS f32x4*)(ap + 12);
        float z0 = ba, z1 = 0.f, z2 = 0.f, z3 = 0.f;
#pragma unroll
        for (int j = 0; j < 4; ++j) { z0 += a0[j] * wv[j]; z1 += a1[j] * wv[4 + j]; z2 += a2[j] * wv[8 + j]; z3 += a3[j] * wv[12 + j]; }
        const float z = (z0 + z1) + (z2 + z3);
        run += (fminf(z, 0.f) - __logf(1.f + __expf(-fabsf(z)))) * 0.0625f;
        c[i] = run;
    }
    if (half == 0) tot0[ch] = run;
    __syncthreads();
    const float off = half ? tot0[ch] : 0.f;
#pragma unroll
    for (int i = 0; i < 32; ++i) {
        const float cum = c[i] + off; const int t = t0 + i;
        LAS unsigned short* kp = (LAS unsigned short*)(KD + t * 528 + ch * 2); *kp = (unsigned short)f2bf(bf2f(*kp) * __expf(-cum));
        LAS unsigned short* qp = (LAS unsigned short*)(QD + t * 528 + ch * 2); *qp = (unsigned short)f2bf(bf2f(*qp) * __expf(cum) * 0.0625f);
    }
    return __expf(c[31] + off);
}

__device__ __forceinline__ void gla_passA(const Ctx& C, const bf16_t* U, const float* GT, const float* w_a2, const float* b_a, bf16_t* ST, float* DC, bf16_t* QDG, bf16_t* KDG) {
    LAS unsigned char* QD = C.lds; LAS unsigned char* KD = C.lds + 33792; LAS unsigned char* V = C.lds + 67584;
    LAS float* A1 = (LAS float*)(C.lds + 135168); LAS float* bl = (LAS float*)(C.lds + 139264); LAS float* tot0 = (LAS float*)(C.lds + 140288);
    const int l = C.lane, g = l >> 4, q = (l & 15) >> 2, p = l & 3, w = C.wave, lr = l & 15;
    for (int u = C.bid; u < 1024; u += C.G) {
        const int bh = u >> 7, c = u & 127, b = bh >> 2, h = bh & 3; const size_t row0 = (size_t)b * SEQ + c * 64;
        A1[C.tid] = GT[row0 * 16 + C.tid]; A1[C.tid + 512] = GT[row0 * 16 + C.tid + 512];
        { const int s = C.tid >> 3, seg = C.tid & 7; const bf16_t* vp = U + (row0 + s) * UW + 2048 + h * 512 + seg * 64;
#pragma unroll
          for (int i = 0; i < 8; ++i) *(LAS u32x4*)(V + s * 1056 + seg * 128 + 16 * i) = *(const u32x4*)(vp + 8 * i);
          const bf16_t* qp = U + (row0 + s) * UW + h * 256 + seg * 32;
#pragma unroll
          for (int i = 0; i < 4; ++i) { *(LAS u32x4*)(QD + s * 528 + seg * 64 + 16 * i) = *(const u32x4*)(qp + 8 * i); *(LAS u32x4*)(KD + s * 528 + seg * 64 + 16 * i) = *(const u32x4*)(qp + 1024 + 8 * i); } }
        __syncthreads();
        const float eb = gla_decay(C, w_a2, b_a, h, A1, tot0, QD, KD);
        if (C.tid >= 256) { bl[C.tid - 256] = eb; DC[(size_t)(bh * 128 + c) * 256 + C.tid - 256] = eb; }
        __syncthreads();
        { const int s = C.tid >> 3, seg = C.tid & 7; bf16_t* qg = QDG + (row0 + s) * 1024 + h * 256 + seg * 32; bf16_t* kg = KDG + (row0 + s) * 1024 + h * 256 + seg * 32;
#pragma unroll
          for (int i = 0; i < 4; ++i) { *(u32x4*)(qg + 8 * i) = *(const LAS u32x4*)(QD + s * 528 + seg * 64 + 16 * i); *(u32x4*)(kg + 8 * i) = *(const LAS u32x4*)(KD + s * 528 + seg * 64 + 16 * i); } }
#pragma unroll 1
        for (int dvq = 0; dvq < 4; ++dvq) {
            f32x4 acc[16];
#pragma unroll
            for (int ni = 0; ni < 16; ++ni) acc[ni] = (f32x4){0.f, 0.f, 0.f, 0.f};
#pragma unroll
            for (int ks = 0; ks < 2; ++ks) {
                const int r0 = 32 * ks + 8 * g + q;
                const LAS unsigned char* ap = V + r0 * 1056 + (dvq * 128 + 16 * w + 4 * p) * 2; const bf16x8 a = tr8(ap, ap + 4 * 1056);
#pragma unroll
                for (int ni = 0; ni < 16; ++ni) { const LAS unsigned char* bp = KD + r0 * 528 + (16 * ni + 4 * p) * 2; acc[ni] = mfma16(tr8(bp, bp + 4 * 528), a, acc[ni]); }
            }
            bf16_t* st = ST + ((size_t)(bh * 128 + c) << 17) + (size_t)(dvq * 128 + 16 * w + lr) * 256 + 4 * g;
#pragma unroll
            for (int ni = 0; ni < 16; ++ni) { const f32x4 e4 = *(const LAS f32x4*)(bl + 16 * ni + 4 * g); const f32x4 v4 = acc[ni] * e4;
                u32x2 wv; wv.x = pg8::cvt_pk_bf16(v4[0], v4[1]); wv.y = pg8::cvt_pk_bf16(v4[2], v4[3]); *(u32x2*)(st + 16 * ni) = wv; }
        }
        __syncthreads();
    }
}

__device__ __forceinline__ void gla_scan(const Ctx& C, bf16_t* ST, const float* DC) {
    for (int e8 = C.bid * 512 + C.tid; e8 < 8 * 16384; e8 += C.G * 512) {
        const int bh = e8 >> 14, off = e8 & 16383, dk = (off * 8) & 255;
        float s[8];
#pragma unroll
        for (int i = 0; i < 8; ++i) s[i] = 0.f;
        u32x4* p = (u32x4*)(ST + ((size_t)(bh * 128) << 17)) + off;
#pragma unroll 1
        for (int cb = 0; cb < 128; cb += 4) {
            u32x4 t[4]; f32x4 d0[4], d1[4];
#pragma unroll
            for (int i = 0; i < 4; ++i) { t[i] = p[(size_t)(cb + i) << 14]; const float* d = DC + (size_t)(bh * 128 + cb + i) * 256 + dk; d0[i] = *(const f32x4*)d; d1[i] = *(const f32x4*)(d + 4); }
#pragma unroll
            for (int i = 0; i < 4; ++i) {
                u32x4 o; o.x = pk2(s[0], s[1]); o.y = pk2(s[2], s[3]); o.z = pk2(s[4], s[5]); o.w = pk2(s[6], s[7]); p[(size_t)(cb + i) << 14] = o;
                s[0] = d0[i][0] * s[0] + bflo(t[i].x); s[1] = d0[i][1] * s[1] + bfhi(t[i].x); s[2] = d0[i][2] * s[2] + bflo(t[i].y); s[3] = d0[i][3] * s[3] + bfhi(t[i].y);
                s[4] = d1[i][0] * s[4] + bflo(t[i].z); s[5] = d1[i][1] * s[5] + bfhi(t[i].z); s[6] = d1[i][2] * s[6] + bflo(t[i].w); s[7] = d1[i][3] * s[7] + bfhi(t[i].w);
            }
        }
    }
}

__device__ __forceinline__ void gla_passC(const Ctx& C, const bf16_t* U, const bf16_t* QDG, const bf16_t* KDG, const bf16_t* ST, const float* gg, bf16_t* MIX) {
    LAS unsigned char* QD = C.lds; LAS unsigned char* KD = C.lds + 33792; LAS unsigned char* V = C.lds + 67584; LAS unsigned char* ATT = C.lds + 135168;
    LAS float* fss = (LAS float*)(C.lds + 144384);
    const int l = C.lane, g = l >> 4, q = (l & 15) >> 2, p = l & 3, w = C.wave, lr = l & 15;
    for (int u = C.bid; u < 1024; u += C.G) {
        const int bh = u >> 7, c = u & 127, b = bh >> 2, h = bh & 3; const size_t row0 = (size_t)b * SEQ + c * 64;
        { const int s = C.tid >> 3, seg = C.tid & 7; const bf16_t* vp = U + (row0 + s) * UW + 2048 + h * 512 + seg * 64;
#pragma unroll
          for (int i = 0; i < 8; ++i) *(LAS u32x4*)(V + s * 1056 + seg * 128 + 16 * i) = *(const u32x4*)(vp + 8 * i);
          const bf16_t* qg = QDG + (row0 + s) * 1024 + h * 256 + seg * 32; const bf16_t* kg = KDG + (row0 + s) * 1024 + h * 256 + seg * 32;
#pragma unroll
          for (int i = 0; i < 4; ++i) { *(LAS u32x4*)(QD + s * 528 + seg * 64 + 16 * i) = *(const u32x4*)(qg + 8 * i); *(LAS u32x4*)(KD + s * 528 + seg * 64 + 16 * i) = *(const u32x4*)(kg + 8 * i); } }
        __syncthreads();
#pragma unroll
        for (int tt = 0; tt < 2; ++tt) {
            const int tile = 2 * w + tt, ti = tile >> 2, si = tile & 3;
            f32x4 s4 = (f32x4){0.f, 0.f, 0.f, 0.f};
            if (si <= ti) {
#pragma unroll
                for (int ks = 0; ks < 8; ++ks) { const bf16x8 a = ldsv8(QD + (16 * ti + lr) * 528 + (32 * ks + 8 * g) * 2), bb = ldsv8(KD + (16 * si + lr) * 528 + (32 * ks + 8 * g) * 2); s4 = mfma16(a, bb, s4); }
            }
            const int sidx = 16 * si + lr;
#pragma unroll
            for (int j = 0; j < 4; ++j) { const int t = 16 * ti + 4 * g + j; *(LAS unsigned short*)(ATT + t * 144 + sidx * 2) = (unsigned short)f2bf((sidx <= t) ? s4[j] : 0.f); }
        }
        __syncthreads();
        f32x4 acc[4][4];
#pragma unroll
        for (int mi = 0; mi < 4; ++mi)
#pragma unroll
            for (int ni = 0; ni < 4; ++ni) acc[mi][ni] = (f32x4){0.f, 0.f, 0.f, 0.f};
        const bf16_t* st = ST + ((size_t)(bh * 128 + c) << 17);
#pragma unroll 4
        for (int ks = 0; ks < 8; ++ks) {
            bf16x8 bb[4];
#pragma unroll
            for (int ni = 0; ni < 4; ++ni) bb[ni] = *(const bf16x8*)(st + (size_t)(64 * w + 16 * ni + lr) * 256 + 32 * ks + 8 * g);
#pragma unroll
            for (int mi = 0; mi < 4; ++mi) { const bf16x8 a = ldsv8(QD + (16 * mi + lr) * 528 + (32 * ks + 8 * g) * 2);
#pragma unroll
                for (int ni = 0; ni < 4; ++ni) acc[mi][ni] = mfma16(bb[ni], a, acc[mi][ni]); }
        }
#pragma unroll
        for (int ks = 0; ks < 2; ++ks) {
            const int r0 = 32 * ks + 8 * g + q; bf16x8 bb[4];
#pragma unroll
            for (int ni = 0; ni < 4; ++ni) { const LAS unsigned char* bp = V + r0 * 1056 + (64 * w + 16 * ni + 4 * p) * 2; bb[ni] = tr8(bp, bp + 4 * 1056); }
#pragma unroll
            for (int mi = 0; mi < 4; ++mi) { const bf16x8 a = ldsv8(ATT + (16 * mi + lr) * 144 + (32 * ks + 8 * g) * 2);
#pragma unroll
                for (int ni = 0; ni < 4; ++ni) acc[mi][ni] = mfma16(bb[ni], a, acc[mi][ni]); }
        }
#pragma unroll
        for (int mi = 0; mi < 4; ++mi) { float ss = 0.f;
#pragma unroll
            for (int ni = 0; ni < 4; ++ni) ss += (acc[mi][ni][0] * acc[mi][ni][0] + acc[mi][ni][1] * acc[mi][ni][1]) + (acc[mi][ni][2] * acc[mi][ni][2] + acc[mi][ni][3] * acc[mi][ni][3]);
            ss += __shfl_xor(ss, 16); ss += __shfl_xor(ss, 32);
            if (g == 0) fss[w * 64 + 16 * mi + lr] = ss; }
        __syncthreads();
#pragma unroll
        for (int mi = 0; mi < 4; ++mi) { const int t = 16 * mi + lr; float tot = 0.f;
#pragma unroll
            for (int ww = 0; ww < 8; ++ww) tot += fss[ww * 64 + t];
            const float r = 1.f / sqrtf(tot * (1.f / 512.f) + 1e-6f);
#pragma unroll
            for (int ni = 0; ni < 4; ++ni) { const int dv = 64 * w + 16 * ni + 4 * g;
                const u32x2 rgb = *(const u32x2*)(U + (row0 + t) * UW + 4096 + h * 512 + dv); const f32x4 gv = *(const f32x4*)(gg + h * 512 + dv);
                const float r0 = bflo(rgb.x), r1 = bfhi(rgb.x), r2 = bflo(rgb.y), r3 = bfhi(rgb.y);
                const float o0 = acc[mi][ni][0] * r * gv[0] * r0 * pg8::sigmoidf_(r0), o1 = acc[mi][ni][1] * r * gv[1] * r1 * pg8::sigmoidf_(r1);
                const float o2 = acc[mi][ni][2] * r * gv[2] * r2 * pg8::sigmoidf_(r2), o3 = acc[mi][ni][3] * r * gv[3] * r3 * pg8::sigmoidf_(r3);
                u32x2 wv; wv.x = pg8::cvt_pk_bf16(o0, o1); wv.y = pg8::cvt_pk_bf16(o2, o3);
                *(u32x2*)(MIX + (row0 + t) * DM + h * 512 + dv) = wv; } }
        __syncthreads();
    }
}

__device__ __forceinline__ int crow(int r, int hi) { return (r & 3) + 8 * (r >> 2) + 4 * hi; }
__device__ __forceinline__ void attn_unit(const Ctx& C, const bf16_t* U, const float* rel_bias, const float* dg, float lam, int b, int h, int qb, bf16_t* MIX) {
    LAS unsigned char* KT0 = C.lds; LAS unsigned char* VT0 = C.lds + 2 * 17408; LAS float* tab = (LAS float*)(C.lds + 131072); LAS float* OX = (LAS float*)(C.lds);
    constexpr int KS = 272, VS = 320;
    const int l = C.lane, ql = l & 31, hi = l >> 5, g = l >> 4, qq = (l & 15) >> 2, pp = l & 3, w = C.wave, comp = w >> 2, rw = w & 3;
    const int qpos = qb * 128 + 32 * rw + ql;
    const size_t rowq = (size_t)b * SEQ + qpos;
    __syncthreads();
    if (C.tid < 128) { const int n = C.tid; int bk;
        if (n < 16) bk = n; else { bk = 16 + (int)(__logf((float)n * 0.0625f) / 2.0794415416798357f * 16.f); bk = bk < 31 ? bk : 31; }
        tab[n] = rel_bias[bk * 8 + h] * LOG2E; }
    const float b31 = rel_bias[31 * 8 + h] * LOG2E;
    LAS unsigned char* QT = C.lds + 96256;
    { const int row = C.tid >> 2, part = C.tid & 3; const bf16_t* qsrc = U + ((size_t)b * SEQ + qb * 128 + row) * UW + h * 128 + part * 32;
#pragma unroll
      for (int i = 0; i < 4; ++i) *(LAS u32x4*)(QT + row * 272 + part * 64 + 16 * i) = *(const u32x4*)(qsrc + 8 * i); }
    const LAS unsigned char* qfrag = QT + (32 * rw + ql) * 272 + (comp * 64 + 8 * hi) * 2;
    f32x16 o[4];
#pragma unroll
    for (int mb = 0; mb < 4; ++mb)
#pragma unroll
        for (int r = 0; r < 16; ++r) o[mb][r] = 0.f;
    float mrun = -1.0e30f, lrun = 0.f;
    u32x4 kreg[2], vreg[2];
    const bf16_t* srcb = U + ((size_t)b * SEQ + (C.tid >> 4)) * UW + h * 128 + (C.tid & 15) * 8;
    const int ntiles = 2 * (qb + 1);
#pragma unroll
    for (int i = 0; i < 2; ++i) { kreg[i] = *(const u32x4*)(srcb + (size_t)(32 * i) * UW + 1024); vreg[i] = *(const u32x4*)(srcb + (size_t)(32 * i) * UW + 2048); }
#pragma unroll
    for (int i = 0; i < 2; ++i) { const int key = (C.tid >> 4) + 32 * i, seg = C.tid & 15;
        *(LAS u32x4*)(KT0 + key * KS + seg * 16) = kreg[i]; *(LAS u32x4*)(VT0 + key * VS + seg * 16) = vreg[i]; }
#pragma unroll
    for (int i = 0; i < 2; ++i) { kreg[i] = *(const u32x4*)(srcb + (size_t)(64 + 32 * i) * UW + 1024); vreg[i] = *(const u32x4*)(srcb + (size_t)(64 + 32 * i) * UW + 2048); }
    int vs_cur = 0, vs_prev = 0; const bool rot = comp == 1;
    bf16x8 pb[4];
#pragma unroll
    for (int i = 0; i < 4; ++i) pb[i] = (bf16x8){0, 0, 0, 0, 0, 0, 0, 0};
#define ATT_PV(VSLOT) do { const LAS unsigned char* vb_ = VT0 + (VSLOT) * 20480 + (4 * hi + qq) * VS + (16 * (g & 1) + 4 * pp) * 2; _Pragma("unroll") for (int k2 = 0; k2 < 2; ++k2) _Pragma("unroll") for (int ks = 0; ks < 2; ++ks) { \
        bf16x8 af_[4]; _Pragma("unroll") for (int mb = 0; mb < 4; ++mb) { const LAS unsigned char* ap = vb_ + (32 * k2 + 16 * ks) * VS + 64 * mb; af_[mb] = tr8(ap, ap + 8 * VS); } \
        __builtin_amdgcn_sched_barrier(0); \
        _Pragma("unroll") for (int mb = 0; mb < 4; ++mb) o[mb] = mfma32(af_[mb], pb[2 * k2 + ks], o[mb]); } } while (0)
    for (int kt = 0; kt < ntiles; ++kt) {
        const int kb = kt * 64;
        __syncthreads();
        LAS unsigned char* KT = KT0 + (kt & 1) * 17408; LAS unsigned char* VT = VT0 + vs_cur * 20480;
        const int vs_nxt = vs_cur == 2 ? 0 : vs_cur + 1;
        if (kt + 1 < ntiles) {
            LAS unsigned char* KN = KT0 + ((kt + 1) & 1) * 17408; LAS unsigned char* VN = VT0 + vs_nxt * 20480;
#pragma unroll
            for (int i = 0; i < 2; ++i) { const int key = (C.tid >> 4) + 32 * i, seg = C.tid & 15;
                *(LAS u32x4*)(KN + key * KS + seg * 16) = kreg[i]; *(LAS u32x4*)(VN + key * VS + seg * 16) = vreg[i]; }
            if (kt + 2 < ntiles) {
#pragma unroll
                for (int i = 0; i < 2; ++i) { kreg[i] = *(const u32x4*)(srcb + (size_t)(kb + 128 + 32 * i) * UW + 1024); vreg[i] = *(const u32x4*)(srcb + (size_t)(kb + 128 + 32 * i) * UW + 2048); }
            }
        }
        if (rot && kt > 0) { __builtin_amdgcn_s_setprio(1); ATT_PV(vs_prev); __builtin_amdgcn_s_setprio(0); }
        __builtin_amdgcn_sched_barrier(0);
        f32x16 st[2];
        __builtin_amdgcn_s_setprio(1);
#pragma unroll
        for (int k2 = 0; k2 < 2; ++k2) {
#pragma unroll
            for (int r = 0; r < 16; ++r) st[k2][r] = 0.f;
#pragma unroll
            for (int kk = 0; kk < 4; ++kk) st[k2] = mfma32(ldsv8(KT + (32 * k2 + ql) * KS + (comp * 64 + 16 * kk + 8 * hi) * 2), ldsv8(qfrag + 32 * kk), st[k2]);
        }
        __builtin_amdgcn_s_setprio(0);
        __builtin_amdgcn_sched_barrier(0);
        const bool far = (qb * 128 + 32 * rw - (kb + 63)) >= 127;
        float mx = -1.0e30f, cadd;
        if (far) {
#pragma unroll
            for (int k2 = 0; k2 < 2; ++k2)
#pragma unroll
                for (int r = 0; r < 16; r += 2) mx = fmaxf(fmaxf(st[k2][r], st[k2][r + 1]), mx);
            mx = mx * LOG2E + b31; cadd = b31;
        } else {
#pragma unroll
            for (int k2 = 0; k2 < 2; ++k2)
#pragma unroll
                for (int r = 0; r < 16; ++r) { const int rel = qpos - (kb + 32 * k2 + crow(r, hi)); const int ri = rel < 0 ? 0 : (rel > 127 ? 127 : rel);
                    const float t = st[k2][r] * LOG2E + tab[ri]; st[k2][r] = (rel >= 0 ? t : -1.0e30f) * (1.0f / LOG2E); mx = fmaxf(mx, rel >= 0 ? t : -1.0e30f); }
            cadd = 0.f;
        }
        mx = fmaxf(mx, __shfl_xor(mx, 32));
        const float mnew = fmaxf(mrun, mx), alpha = __builtin_amdgcn_exp2f(mrun - mnew);
        const bool grew = mnew > mrun; mrun = mnew;
        const float cst = cadd - mnew;
        float ps = 0.f;
#pragma unroll
        for (int k2 = 0; k2 < 2; ++k2)
#pragma unroll
            for (int r = 0; r < 16; ++r) { const float pv = __builtin_amdgcn_exp2f(__builtin_fmaf(st[k2][r], LOG2E, cst)); st[k2][r] = pv; ps += pv; }
        lrun = lrun * alpha + ps;
        if (__any(grew)) {
#pragma unroll
            for (int mb = 0; mb < 4; ++mb)
#pragma unroll
                for (int r = 0; r < 16; ++r) o[mb][r] *= alpha;
        }
        __builtin_amdgcn_sched_barrier(0);
#pragma unroll
        for (int k2 = 0; k2 < 2; ++k2)
#pragma unroll
            for (int ks = 0; ks < 2; ++ks) { const int r8 = 8 * ks;
                const unsigned w0 = pg8::cvt_pk_bf16(st[k2][r8 + 0], st[k2][r8 + 1]), w1 = pg8::cvt_pk_bf16(st[k2][r8 + 2], st[k2][r8 + 3]), w2 = pg8::cvt_pk_bf16(st[k2][r8 + 4], st[k2][r8 + 5]), w3 = pg8::cvt_pk_bf16(st[k2][r8 + 6], st[k2][r8 + 7]);
                const u32x4 wv = (u32x4){w0, w1, w2, w3}; pb[2 * k2 + ks] = __builtin_bit_cast(bf16x8, wv); }
        __builtin_amdgcn_sched_barrier(0);
        if (!rot) { __builtin_amdgcn_s_setprio(1); ATT_PV(vs_cur); __builtin_amdgcn_s_setprio(0); }
        vs_prev = vs_cur; vs_cur = vs_nxt;
    }
    if (rot) ATT_PV(vs_prev);
#undef ATT_PV
    const float ltot = lrun + __shfl_xor(lrun, 32), inv = 1.f / ltot;
    int l2 = C.lane; asm volatile("" : "+v"(l2));
    const int ql_e = l2 & 31, hi_e = l2 >> 5;
    const size_t rowq_e = (size_t)b * SEQ + qb * 128 + 32 * rw + ql_e;
    __syncthreads();
    if (comp == 1) {
#pragma unroll
        for (int mb = 0; mb < 4; ++mb)
#pragma unroll
            for (int r = 0; r < 16; ++r) OX[(rw * 128 + 32 * mb + crow(r, hi_e)) * 32 + ql_e] = o[mb][r] * inv;
    }
    __syncthreads();
    if (comp == 0) {
        float ss = 0.f;
#pragma unroll
        for (int mb = 0; mb < 4; ++mb)
#pragma unroll
            for (int r = 0; r < 16; ++r) { const float y = o[mb][r] * inv - lam * OX[(rw * 128 + 32 * mb + crow(r, hi_e)) * 32 + ql_e]; o[mb][r] = y; ss += y * y; }
        ss += __shfl_xor(ss, 32);
        const float rn = (1.f / sqrtf(ss * (1.f / 128.f) + 1e-6f)) * 0.8f;
#pragma unroll
        for (int mb = 0; mb < 4; ++mb)
#pragma unroll
            for (int r4 = 0; r4 < 4; ++r4) { const int dv = 32 * mb + 8 * r4 + 4 * hi_e; const f32x4 gv = *(const f32x4*)(dg + h * 128 + dv);
                u32x2 wv; wv.x = pk2(o[mb][4 * r4] * rn * gv[0], o[mb][4 * r4 + 1] * rn * gv[1]); wv.y = pk2(o[mb][4 * r4 + 2] * rn * gv[2], o[mb][4 * r4 + 3] * rn * gv[3]);
                *(u32x2*)(MIX + rowq_e * DM + h * 128 + dv) = wv; }
    }
}
__device__ __forceinline__ void attn_phase(const Ctx& C, const bf16_t* U, const float* rel_bias, const float* dg, const float* lq1, const float* lk1, const float* lq2, const float* lk2, bf16_t* MIX) {
    float s1 = 0.f, s2 = 0.f;
#pragma unroll 4
    for (int i = 0; i < 64; ++i) { s1 += lq1[i] * lk1[i]; s2 += lq2[i] * lk2[i]; }
    const float lam = __expf(s1) - __expf(s2) + 0.2f;
    const bool xa = (C.G == 256);
#pragma unroll 1
    for (int k = 0; k < 512; ++k) {
        int pr;
        if (xa) { if (k >= 2) break; pr = (2 * (C.bid & 7) + k) * 32 + (C.bid >> 3); } else { pr = C.bid + k * C.G; if (pr >= 512) break; }
        const int bh = pr >> 5, i = pr & 31, b = bh >> 3, h = bh & 7;
        attn_unit(C, U, rel_bias, dg, lam, b, h, i, MIX);
        attn_unit(C, U, rel_bias, dg, lam, b, h, 63 - i, MIX);
    }
    __syncthreads();
}

struct Args {
    const float* x; const float* p; const float* ln_g; const float* ln_b; const float* w_ffn_in; const float* w_ffn_out; const float* w_in_ab; const float* w_out_ab;
    const float* rel_bias; const float* lq1; const float* lk1; const float* lq2; const float* lk2; const float* diff_norm; const float* conv_w; const float* conv_b;
    const float* b_igate; const float* b_fgate; const float* mlstm_norm; const float* w_in_c; const float* w_alpha2; const float* b_alpha; const float* gla_norm;
    const float* w_out_c; const float* w_ple_proj; const float* w_ple_gate;
    float* out; unsigned char* ws;
    int ph_lo, ph_hi;
};


constexpr int ARGS_OFF = 147200;
enum { A_x = 0, A_p, A_ln_g, A_ln_b, A_w_ffn_in, A_w_ffn_out, A_w_in_ab, A_w_out_ab, A_rel_bias, A_lq1, A_lk1, A_lq2, A_lk2, A_diff_norm, A_conv_w, A_conv_b,
       A_b_igate, A_b_fgate, A_mlstm_norm, A_w_in_c, A_w_alpha2, A_b_alpha, A_gla_norm, A_w_out_c, A_w_ple_proj, A_w_ple_gate, A_out, A_ws };
__device__ __forceinline__ unsigned char* ldarg(LAS unsigned char* lds, int i) {
    volatile LAS unsigned* p = (volatile LAS unsigned*)(lds + ARGS_OFF) + 2 * i;
    const unsigned lo = __builtin_amdgcn_readfirstlane(p[0]), hi = __builtin_amdgcn_readfirstlane(p[1]);
    return (unsigned char*)(__attribute__((address_space(1))) unsigned char*)(((unsigned long long)hi << 32) | lo);
}
#define ARGF(i) ((const float*)ldarg(C.lds, (i)))
#define WSP(T, off) ((T*)(ldarg(C.lds, A_ws) + (off)))


__device__ __forceinline__ void grid_barrier(unsigned* ctr, unsigned target, bool leader) {
    asm volatile("s_waitcnt vmcnt(0) lgkmcnt(0)" ::: "memory");
    __syncthreads();
    if (leader) {
        __builtin_amdgcn_fence(__ATOMIC_RELEASE, "agent");
        asm volatile("s_waitcnt vmcnt(0)" ::: "memory");
        (void)__hip_atomic_fetch_add(ctr, 1u, __ATOMIC_RELAXED, __HIP_MEMORY_SCOPE_AGENT);
        while (__hip_atomic_load(ctr, __ATOMIC_RELAXED, __HIP_MEMORY_SCOPE_AGENT) < target) __builtin_amdgcn_s_sleep(1);
        __builtin_amdgcn_fence(__ATOMIC_ACQUIRE, "agent");
        asm volatile("s_waitcnt vmcnt(0)" ::: "memory");
    }
    __syncthreads();
}

#define XB_TMO      128
#define XB_XCNT(j)  (256  + 64 * (j))
#define XB_XSUB(j)  (1280 + 64 * (j))
#define XB_XGEN(j)  (2304 + 64 * (j))
#define XB_TOP      3328
#define XB_TOPGEN   3392
#define XCD_BAR_WORDS 3456
#define XB_SPIN_CAP (1u << 22)
__device__ __forceinline__ unsigned xb_ld(unsigned* p)              { return __hip_atomic_load(p, __ATOMIC_RELAXED, __HIP_MEMORY_SCOPE_AGENT); }
__device__ __forceinline__ unsigned xb_add(unsigned* p, unsigned v) { return __hip_atomic_fetch_add(p, v, __ATOMIC_RELAXED, __HIP_MEMORY_SCOPE_AGENT); }
__device__ __forceinline__ unsigned xb_xcc_id() { return (unsigned)__builtin_amdgcn_s_getreg((3 << 11) | 20) & 0xFu; }
#define XB_SPIN(cond, bar) do { unsigned _sp = 0; while (cond) { __builtin_amdgcn_s_sleep(1); \
    if ((++_sp & 255u) == 0u) { if (xb_ld(&(bar)[XB_TMO])) break; if (_sp > XB_SPIN_CAP) { atomicAdd(&(bar)[XB_TMO], 1u); break; } } } } while (0)
__device__ __forceinline__ void xcd_barrier_complete(unsigned* bar, unsigned x, unsigned& nloc, unsigned& nx) {
    const unsigned G = gridDim.x;
    unsigned sum, cnt, mine, sp = 0u;
    for (;;) {
        sum = 0u; cnt = 0u; mine = 0u;
#pragma unroll
        for (unsigned j = 0; j < 16; ++j) { const unsigned c = xb_ld(&bar[XB_XCNT(j)]); sum += c; cnt += (c > 0u) ? 1u : 0u; mine = (j == x) ? c : mine; }
        if (sum == G) break;
        __builtin_amdgcn_s_sleep(1);
        if ((++sp & 255u) == 0u) { if (xb_ld(&bar[XB_TMO])) break; if (sp > XB_SPIN_CAP) { atomicAdd(&bar[XB_TMO], 1u); break; } }
    }
    nloc = mine > 0u ? mine : 1u; nx = cnt > 0u ? cnt : 1u;
}
__device__ __forceinline__ void xcd_barrier(unsigned* bar, volatile LAS unsigned* st, bool leader) {
    asm volatile("s_waitcnt vmcnt(0)" ::: "memory");
    __syncthreads();
    if (leader) {
        __builtin_amdgcn_s_waitcnt(0);
        const unsigned x = xb_xcc_id();
        unsigned nloc = st[0], nx = st[1];
        if (nloc == 0u) { xcd_barrier_complete(bar, x, nloc, nx); st[0] = nloc; st[1] = nx; }
        const unsigned old = xb_add(&bar[XB_XSUB(x)], 1u);
        const unsigned gen = old / nloc;
        if (old + 1u == (gen + 1u) * nloc) {
            __builtin_amdgcn_fence(__ATOMIC_RELEASE, "agent");
            asm volatile("s_waitcnt vmcnt(0)" ::: "memory");
            const unsigned og = xb_add(&bar[XB_TOP], 1u);
            const unsigned tg = og / nx;
            if (og + 1u == (tg + 1u) * nx) xb_add(&bar[XB_TOPGEN], 1u);
            else XB_SPIN(xb_ld(&bar[XB_TOPGEN]) == tg, bar);
            __builtin_amdgcn_fence(__ATOMIC_ACQUIRE, "agent");
            xb_add(&bar[XB_XGEN(x)], 1u);
            asm volatile("s_waitcnt vmcnt(0)" ::: "memory");
        } else {
            XB_SPIN(xb_ld(&bar[XB_XGEN(x)]) == gen, bar);
            __builtin_amdgcn_fence(__ATOMIC_ACQUIRE, "agent");
            asm volatile("s_waitcnt vmcnt(0)" ::: "memory");
        }
    }
    __syncthreads();
}

#define GEMM_CALL(EPI, Aptr, Bptr, Nn, Kk, Eobj) do { pg8::Gemm g_{(const bf16_t*)(Aptr), (const bf16_t*)(Bptr), MT, (Nn), (Kk)}; pg8::StaticOrder S_; S_.init(MT, (Nn), C.G, C.bid); \
    pg8::gemm_phase<EPI, pg8::StaticOrder, true, true>(C.lds, g_, S_, Eobj, C.tid); } while (0)

__global__ void __launch_bounds__(512, 2) mega_fwd(Args a) {
    extern __shared__ __attribute__((aligned(16))) unsigned char lds_raw[];
    cg::grid_group grid = cg::this_grid();
    if (threadIdx.x == 0) {
        LAS unsigned long long* t = (LAS unsigned long long*)((LAS unsigned char*)lds_raw + ARGS_OFF);
        t[A_x] = (unsigned long long)a.x; t[A_p] = (unsigned long long)a.p; t[A_ln_g] = (unsigned long long)a.ln_g; t[A_ln_b] = (unsigned long long)a.ln_b;
        t[A_w_ffn_in] = (unsigned long long)a.w_ffn_in; t[A_w_ffn_out] = (unsigned long long)a.w_ffn_out; t[A_w_in_ab] = (unsigned long long)a.w_in_ab; t[A_w_out_ab] = (unsigned long long)a.w_out_ab;
        t[A_rel_bias] = (unsigned long long)a.rel_bias; t[A_lq1] = (unsigned long long)a.lq1; t[A_lk1] = (unsigned long long)a.lk1; t[A_lq2] = (unsigned long long)a.lq2; t[A_lk2] = (unsigned long long)a.lk2;
        t[A_diff_norm] = (unsigned long long)a.diff_norm; t[A_conv_w] = (unsigned long long)a.conv_w; t[A_conv_b] = (unsigned long long)a.conv_b; t[A_b_igate] = (unsigned long long)a.b_igate;
        t[A_b_fgate] = (unsigned long long)a.b_fgate; t[A_mlstm_norm] = (unsigned long long)a.mlstm_norm; t[A_w_in_c] = (unsigned long long)a.w_in_c; t[A_w_alpha2] = (unsigned long long)a.w_alpha2;
        t[A_b_alpha] = (unsigned long long)a.b_alpha; t[A_gla_norm] = (unsigned long long)a.gla_norm; t[A_w_out_c] = (unsigned long long)a.w_out_c; t[A_w_ple_proj] = (unsigned long long)a.w_ple_proj;
        t[A_w_ple_gate] = (unsigned long long)a.w_ple_gate; t[A_out] = (unsigned long long)a.out; t[A_ws] = (unsigned long long)a.ws;
        t[30] = 0ull;
    }
    __syncthreads();
    const int ph_lo = a.ph_lo, ph_hi = a.ph_hi;
    int ph = 0; unsigned nbar = 0, ngb = 0;
    const int wave_s = __builtin_amdgcn_readfirstlane((int)(threadIdx.x >> 6));
#ifndef REPMASK
#define REPMASK 0
#endif
#define PHASE_BEGIN_G(grp) if (ph >= ph_lo && ph < ph_hi) for (int rep_ = 0; rep_ < (((REPMASK >> (grp)) & 1) ? 2 : 1); ++rep_) { Ctx C; { int t_ = wave_s * 64 + (int)__builtin_amdgcn_mbcnt_hi(~0u, __builtin_amdgcn_mbcnt_lo(~0u, 0u)); asm volatile("" : "+v"(t_)); C.lds = (LAS unsigned char*)lds_raw; C.tid = t_; C.lane = t_ & 63; C.wave = __builtin_amdgcn_readfirstlane(t_ >> 6); \
    C.G = gridDim.x; C.bid = blockIdx.x; C.gw = C.bid * 8 + C.wave; C.NGW = C.G * 8; }
#define PHASE_BEGIN PHASE_BEGIN_G(31)
#ifndef SYNCREP
#define SYNCREP 1
#endif
#define PHASE_END_K(GROUPWISE) } ++ph; if (ph > ph_lo && ph < ph_hi) { for (int sr_ = 0; sr_ < SYNCREP; ++sr_) { \
        unsigned* ctl_ = (unsigned*)(ldarg((LAS unsigned char*)lds_raw, A_ws) + OFF_CTL); const bool lead_ = wave_s == 0 && __builtin_amdgcn_mbcnt_hi(~0u, __builtin_amdgcn_mbcnt_lo(~0u, 0u)) == 0u; \
        if ((GROUPWISE) && (gridDim.x & 7u) == 0u) { ++ngb; grid_barrier(ctl_ + 64 * (1 + (blockIdx.x & 7u)), ngb * (gridDim.x >> 3), lead_); } \
        else { xcd_barrier(ctl_ + 1024, (volatile LAS unsigned*)((LAS unsigned char*)lds_raw + ARGS_OFF + 240), lead_); } } }
#define PHASE_END PHASE_END_K(0)
#define PHASE_END_NONE } ++ph;
#define PHASE_END_ROWS PHASE_END_K(0)

    PHASE_BEGIN_G(0)
        if (C.bid == 0) { unsigned* ctl0_ = (unsigned*)(ldarg(C.lds, A_ws) + OFF_CTL); for (int i_ = C.tid; i_ < 1024 + XCD_BAR_WORDS; i_ += 512) ctl0_[i_] = 0u; }
        int base = 0;
        for (int i = 0; i < 4; ++i) conv_matrix(C, ARGF(A_w_ffn_in) + (size_t)i * DM * NFF2, DM, NFF2, NFF2, WSP(bf16_t, OFF_WFI) + (size_t)i * NFF2 * DM, 1, base);
        for (int i = 0; i < 4; ++i) conv_matrix(C, ARGF(A_w_ffn_out) + (size_t)i * DFF * DM, DFF, DM, DM, WSP(bf16_t, OFF_WFO) + (size_t)i * DM * DFF, 0, base);
        conv_matrix(C, ARGF(A_w_in_ab), DM, 6152, NIN, WSP(bf16_t, OFF_WAB), 2, base);
        conv_matrix(C, ARGF(A_w_in_c), DM, 6160, NIN, WSP(bf16_t, OFF_WC), 0, base);
        conv_matrix(C, ARGF(A_w_out_ab), DM, DM, DM, WSP(bf16_t, OFF_WOAB), 0, base);
        conv_matrix(C, ARGF(A_w_out_c), DM, DM, DM, WSP(bf16_t, OFF_WOC), 0, base);
        for (int i = 0; i < 2; ++i) conv_matrix(C, ARGF(A_w_ple_gate) + (size_t)i * DM * DM, DM, DM, DM, WSP(bf16_t, OFF_WPG) + (size_t)i * DM * DM, 0, base);
        for (int i = 0; i < 2; ++i) conv_matrix(C, ARGF(A_w_ple_proj) + (size_t)i * PLE * DM, PLE, DM, DM, WSP(bf16_t, OFF_WPP) + (size_t)i * DM * PLE, 0, base);
        cvt_rows(C, ARGF(A_x), WSP(bf16_t, OFF_XB), (size_t)MT * DM / 4);
        cvt_rows(C, ARGF(A_p), WSP(bf16_t, OFF_PB), (size_t)2 * MT * PLE / 4);
        __syncthreads();
    } ++ph; if (ph > ph_lo && ph < ph_hi) { grid.sync(); if (wave_s == 0 && __builtin_amdgcn_mbcnt_hi(~0u, __builtin_amdgcn_mbcnt_lo(~0u, 0u)) == 0u) (void)xb_add((unsigned*)(ldarg((LAS unsigned char*)lds_raw, A_ws) + OFF_CTL) + 1024 + XB_XCNT(xb_xcc_id()), 1u); }

    { constexpr int L = 0;
        PHASE_BEGIN_G(1) { pg8::EpiSwiglu e{WSP(bf16_t, OFF_H), DFF}; GEMM_CALL(pg8::EpiSwiglu, WSP(bf16_t, (L == 0 ? OFF_XB : OFF_MIX)), WSP(bf16_t, OFF_WFI) + (size_t)(2 * L) * NFF2 * DM, NFF2, DM, e); }
            if (L == 0) { for (int l2 = 0; l2 < 2; ++l2) { pg8::EpiStore e2{WSP(bf16_t, OFF_XF) + (size_t)l2 * MT * DM, DM, DM, nullptr}; GEMM_CALL(pg8::EpiStore, WSP(bf16_t, OFF_PB) + (size_t)l2 * MT * PLE, WSP(bf16_t, OFF_WPP) + (size_t)l2 * DM * PLE, DM, PLE, e2); } } PHASE_END_ROWS
        PHASE_BEGIN_G(1) { if (L == 0) { pg8::EpiZ<true> e{(const void*)ARGF(A_x), WSP(bf16_t, OFF_Z), ALPHA, 0.5f}; GEMM_CALL(pg8::EpiZ<true>, WSP(bf16_t, OFF_H), WSP(bf16_t, OFF_WFO) + (size_t)(2 * L) * DM * DFF, DM, DFF, e); } else { pg8::EpiZ<false> e{(const void*)WSP(bf16_t, OFF_MIX), WSP(bf16_t, OFF_Z), ALPHA, 0.5f}; GEMM_CALL(pg8::EpiZ<false>, WSP(bf16_t, OFF_H), WSP(bf16_t, OFF_WFO) + (size_t)(2 * L) * DM * DFF, DM, DFF, e); } } PHASE_END_ROWS
        PHASE_BEGIN_G(3) ln_phase<true>(C, WSP(bf16_t, OFF_Z), ARGF(A_ln_g) + (size_t)(3 * L) * DM, ARGF(A_ln_b) + (size_t)(3 * L) * DM, WSP(bf16_t, OFF_XB), (L == 0 ? ARGF(A_w_in_ab) : ARGF(A_w_in_c)), (L == 0 ? 6152 : 6160), (L == 0 ? 8 : 16), WSP(float, OFF_GT)); PHASE_END
        PHASE_BEGIN_G(2) { pg8::EpiStore e{WSP(bf16_t, OFF_H), UW, UW, nullptr}; GEMM_CALL(pg8::EpiStore, WSP(bf16_t, OFF_XB), WSP(bf16_t, (L == 0 ? OFF_WAB : OFF_WC)), NIN, DM, e); } PHASE_END
        if (L == 0) {
            PHASE_BEGIN_G(5) m1_phase(C, WSP(bf16_t, OFF_H), WSP(float, OFF_GT), ARGF(A_conv_w), ARGF(A_conv_b), ARGF(A_b_igate), ARGF(A_b_fgate), WSP(bf16_t, OFF_QB), WSP(bf16_t, OFF_KB), WSP(float, OFF_BC), WSP(float, OFF_IP), WSP(float, OFF_MSC)); PHASE_END
            PHASE_BEGIN
                mlstm_passA(C, WSP(bf16_t, OFF_H), WSP(bf16_t, OFF_KB), WSP(float, OFF_BC), WSP(float, OFF_IP), WSP(float, OFF_MSC), WSP(bf16_t, OFF_ST), WSP(float, OFF_NL));
                for (int rep2_ = 0; rep2_ < (((REPMASK >> 4) & 1) ? 2 : 1); ++rep2_)
                attn_phase(C, WSP(bf16_t, OFF_H), ARGF(A_rel_bias), ARGF(A_diff_norm), ARGF(A_lq1), ARGF(A_lk1), ARGF(A_lq2), ARGF(A_lk2), WSP(bf16_t, OFF_MIX));
            PHASE_END
            PHASE_BEGIN mlstm_scan(C, WSP(bf16_t, OFF_ST), WSP(float, OFF_NL), WSP(float, OFF_MSC)); PHASE_END
            PHASE_BEGIN_G(5) mlstm_passC(C, WSP(bf16_t, OFF_H), WSP(bf16_t, OFF_QB), WSP(bf16_t, OFF_KB), WSP(float, OFF_BC), WSP(float, OFF_IP), WSP(float, OFF_MSC), WSP(bf16_t, OFF_ST), WSP(float, OFF_NL), ARGF(A_mlstm_norm), WSP(bf16_t, OFF_MIX)); PHASE_END
        } else {
            PHASE_BEGIN_G(6) gla_passA(C, WSP(bf16_t, OFF_H), WSP(float, OFF_GT), ARGF(A_w_alpha2), ARGF(A_b_alpha), WSP(bf16_t, OFF_ST), WSP(float, OFF_DC), WSP(bf16_t, OFF_Z), WSP(bf16_t, OFF_Z + (size_t)MT * 1024 * 2)); PHASE_END
            PHASE_BEGIN gla_scan(C, WSP(bf16_t, OFF_ST), WSP(float, OFF_DC)); PHASE_END
            PHASE_BEGIN_G(7) gla_passC(C, WSP(bf16_t, OFF_H), WSP(bf16_t, OFF_Z), WSP(bf16_t, OFF_Z + (size_t)MT * 1024 * 2), WSP(bf16_t, OFF_ST), ARGF(A_gla_norm), WSP(bf16_t, OFF_MIX)); PHASE_END
        }
        PHASE_BEGIN_G(1) { pg8::EpiZ<false> e{(const void*)WSP(bf16_t, OFF_XB), WSP(bf16_t, OFF_Z), ALPHA, 1.0f}; GEMM_CALL(pg8::EpiZ<false>, WSP(bf16_t, OFF_MIX), WSP(bf16_t, (L == 0 ? OFF_WOAB : OFF_WOC)), DM, DM, e); } PHASE_END_ROWS
        PHASE_BEGIN_G(3) ln_phase<false>(C, WSP(bf16_t, OFF_Z), ARGF(A_ln_g) + (size_t)(3 * L + 1) * DM, ARGF(A_ln_b) + (size_t)(3 * L + 1) * DM, WSP(bf16_t, OFF_XB), nullptr, 0, 0, nullptr); PHASE_END_ROWS
        PHASE_BEGIN_G(1) { pg8::EpiSwiglu e{WSP(bf16_t, OFF_H), DFF}; GEMM_CALL(pg8::EpiSwiglu, WSP(bf16_t, OFF_XB), WSP(bf16_t, OFF_WFI) + (size_t)(2 * L + 1) * NFF2 * DM, NFF2, DM, e); } PHASE_END_ROWS
        PHASE_BEGIN_G(1) { pg8::EpiZ<false> e{(const void*)WSP(bf16_t, OFF_XB), WSP(bf16_t, OFF_Z), ALPHA, 0.5f}; GEMM_CALL(pg8::EpiZ<false>, WSP(bf16_t, OFF_H), WSP(bf16_t, OFF_WFO) + (size_t)(2 * L + 1) * DM * DFF, DM, DFF, e); } PHASE_END_ROWS
        PHASE_BEGIN_G(3) ln_phase<false>(C, WSP(bf16_t, OFF_Z), ARGF(A_ln_g) + (size_t)(3 * L + 2) * DM, ARGF(A_ln_b) + (size_t)(3 * L + 2) * DM, WSP(bf16_t, OFF_XB), nullptr, 0, 0, nullptr); PHASE_END_ROWS
        PHASE_BEGIN { pg8::EpiPle e{WSP(const bf16_t, OFF_XB), WSP(const bf16_t, OFF_XF) + (size_t)L * MT * DM, (L == 1) ? (float*)ldarg(C.lds, A_out) : (float*)nullptr, (L == 1) ? (bf16_t*)nullptr : WSP(bf16_t, OFF_MIX)}; GEMM_CALL(pg8::EpiPle, WSP(bf16_t, OFF_XB), WSP(bf16_t, OFF_WPG) + (size_t)L * DM * DM, DM, DM, e); } PHASE_END_ROWS
        }
    { constexpr int L = 1;
        PHASE_BEGIN_G(1) { pg8::EpiSwiglu e{WSP(bf16_t, OFF_H), DFF}; GEMM_CALL(pg8::EpiSwiglu, WSP(bf16_t, (L == 0 ? OFF_XB : OFF_MIX)), WSP(bf16_t, OFF_WFI) + (size_t)(2 * L) * NFF2 * DM, NFF2, DM, e); }
            if (L == 0) { for (int l2 = 0; l2 < 2; ++l2) { pg8::EpiStore e2{WSP(bf16_t, OFF_XF) + (size_t)l2 * MT * DM, DM, DM, nullptr}; GEMM_CALL(pg8::EpiStore, WSP(bf16_t, OFF_PB) + (size_t)l2 * MT * PLE, WSP(bf16_t, OFF_WPP) + (size_t)l2 * DM * PLE, DM, PLE, e2); } } PHASE_END_ROWS
        PHASE_BEGIN_G(1) { if (L == 0) { pg8::EpiZ<true> e{(const void*)ARGF(A_x), WSP(bf16_t, OFF_Z), ALPHA, 0.5f}; GEMM_CALL(pg8::EpiZ<true>, WSP(bf16_t, OFF_H), WSP(bf16_t, OFF_WFO) + (size_t)(2 * L) * DM * DFF, DM, DFF, e); } else { pg8::EpiZ<false> e{(const void*)WSP(bf16_t, OFF_MIX), WSP(bf16_t, OFF_Z), ALPHA, 0.5f}; GEMM_CALL(pg8::EpiZ<false>, WSP(bf16_t, OFF_H), WSP(bf16_t, OFF_WFO) + (size_t)(2 * L) * DM * DFF, DM, DFF, e); } } PHASE_END_ROWS
        PHASE_BEGIN_G(3) ln_phase<true>(C, WSP(bf16_t, OFF_Z), ARGF(A_ln_g) + (size_t)(3 * L) * DM, ARGF(A_ln_b) + (size_t)(3 * L) * DM, WSP(bf16_t, OFF_XB), (L == 0 ? ARGF(A_w_in_ab) : ARGF(A_w_in_c)), (L == 0 ? 6152 : 6160), (L == 0 ? 8 : 16), WSP(float, OFF_GT)); PHASE_END
        PHASE_BEGIN_G(2) { pg8::EpiStore e{WSP(bf16_t, OFF_H), UW, UW, nullptr}; GEMM_CALL(pg8::EpiStore, WSP(bf16_t, OFF_XB), WSP(bf16_t, (L == 0 ? OFF_WAB : OFF_WC)), NIN, DM, e); } PHASE_END
        if (L == 0) {
            PHASE_BEGIN_G(5) m1_phase(C, WSP(bf16_t, OFF_H), WSP(float, OFF_GT), ARGF(A_conv_w), ARGF(A_conv_b), ARGF(A_b_igate), ARGF(A_b_fgate), WSP(bf16_t, OFF_QB), WSP(bf16_t, OFF_KB), WSP(float, OFF_BC), WSP(float, OFF_IP), WSP(float, OFF_MSC)); PHASE_END
            PHASE_BEGIN
                mlstm_passA(C, WSP(bf16_t, OFF_H), WSP(bf16_t, OFF_KB), WSP(float, OFF_BC), WSP(float, OFF_IP), WSP(float, OFF_MSC), WSP(bf16_t, OFF_ST), WSP(float, OFF_NL));
                for (int rep2_ = 0; rep2_ < (((REPMASK >> 4) & 1) ? 2 : 1); ++rep2_)
                attn_phase(C, WSP(bf16_t, OFF_H), ARGF(A_rel_bias), ARGF(A_diff_norm), ARGF(A_lq1), ARGF(A_lk1), ARGF(A_lq2), ARGF(A_lk2), WSP(bf16_t, OFF_MIX));
            PHASE_END
            PHASE_BEGIN mlstm_scan(C, WSP(bf16_t, OFF_ST), WSP(float, OFF_NL), WSP(float, OFF_MSC)); PHASE_END
            PHASE_BEGIN_G(5) mlstm_passC(C, WSP(bf16_t, OFF_H), WSP(bf16_t, OFF_QB), WSP(bf16_t, OFF_KB), WSP(float, OFF_BC), WSP(float, OFF_IP), WSP(float, OFF_MSC), WSP(bf16_t, OFF_ST), WSP(float, OFF_NL), ARGF(A_mlstm_norm), WSP(bf16_t, OFF_MIX)); PHASE_END
        } else {
            PHASE_BEGIN_G(6) gla_passA(C, WSP(bf16_t, OFF_H), WSP(float, OFF_GT), ARGF(A_w_alpha2), ARGF(A_b_alpha), WSP(bf16_t, OFF_ST), WSP(float, OFF_DC), WSP(bf16_t, OFF_Z), WSP(bf16_t, OFF_Z + (size_t)MT * 1024 * 2)); PHASE_END
            PHASE_BEGIN gla_scan(C, WSP(bf16_t, OFF_ST), WSP(float, OFF_DC)); PHASE_END
            PHASE_BEGIN_G(7) gla_passC(C, WSP(bf16_t, OFF_H), WSP(bf16_t, OFF_Z), WSP(bf16_t, OFF_Z + (size_t)MT * 1024 * 2), WSP(bf16_t, OFF_ST), ARGF(A_gla_norm), WSP(bf16_t, OFF_MIX)); PHASE_END
        }
        PHASE_BEGIN_G(1) { pg8::EpiZ<false> e{(const void*)WSP(bf16_t, OFF_XB), WSP(bf16_t, OFF_Z), ALPHA, 1.0f}; GEMM_CALL(pg8::EpiZ<false>, WSP(bf16_t, OFF_MIX), WSP(bf16_t, (L == 0 ? OFF_WOAB : OFF_WOC)), DM, DM, e); } PHASE_END_ROWS
        PHASE_BEGIN_G(3) ln_phase<false>(C, WSP(bf16_t, OFF_Z), ARGF(A_ln_g) + (size_t)(3 * L + 1) * DM, ARGF(A_ln_b) + (size_t)(3 * L + 1) * DM, WSP(bf16_t, OFF_XB), nullptr, 0, 0, nullptr); PHASE_END_ROWS
        PHASE_BEGIN_G(1) { pg8::EpiSwiglu e{WSP(bf16_t, OFF_H), DFF}; GEMM_CALL(pg8::EpiSwiglu, WSP(bf16_t, OFF_XB), WSP(bf16_t, OFF_WFI) + (size_t)(2 * L + 1) * NFF2 * DM, NFF2, DM, e); } PHASE_END_ROWS
        PHASE_BEGIN_G(1) { pg8::EpiZ<false> e{(const void*)WSP(bf16_t, OFF_XB), WSP(bf16_t, OFF_Z), ALPHA, 0.5f}; GEMM_CALL(pg8::EpiZ<false>, WSP(bf16_t, OFF_H), WSP(bf16_t, OFF_WFO) + (size_t)(2 * L + 1) * DM * DFF, DM, DFF, e); } PHASE_END_ROWS
        PHASE_BEGIN_G(3) ln_phase<false>(C, WSP(bf16_t, OFF_Z), ARGF(A_ln_g) + (size_t)(3 * L + 2) * DM, ARGF(A_ln_b) + (size_t)(3 * L + 2) * DM, WSP(bf16_t, OFF_XB), nullptr, 0, 0, nullptr); PHASE_END_ROWS
        PHASE_BEGIN { pg8::EpiPle e{WSP(const bf16_t, OFF_XB), WSP(const bf16_t, OFF_XF) + (size_t)L * MT * DM, (L == 1) ? (float*)ldarg(C.lds, A_out) : (float*)nullptr, (L == 1) ? (bf16_t*)nullptr : WSP(bf16_t, OFF_MIX)}; GEMM_CALL(pg8::EpiPle, WSP(bf16_t, OFF_XB), WSP(bf16_t, OFF_WPG) + (size_t)L * DM * DM, DM, DM, e); } PHASE_END_NONE
        }
}

extern "C" void kernel_launch(void* const* d_in, const int* in_sizes, int n_in, void* d_out, int out_size, void* d_ws, size_t ws_size, hipStream_t stream) {
    static int grid = 0;
    if (grid == 0) {
        int dev = 0, cus = 0, per_cu = 0;
        (void)hipGetDevice(&dev); (void)hipDeviceGetAttribute(&cus, hipDeviceAttributeMultiprocessorCount, dev);
        (void)hipFuncSetAttribute((const void*)mega_fwd, hipFuncAttributeMaxDynamicSharedMemorySize, LDS_BYTES);
        (void)hipOccupancyMaxActiveBlocksPerMultiprocessor(&per_cu, (const void*)mega_fwd, 512, LDS_BYTES);
        if (per_cu < 1) per_cu = 1;
        if (cus < 8) cus = 256;
        grid = cus * per_cu;
        if (ws_size < WS_NEED || n_in != 26) { fprintf(stderr, "kernel_launch: ws %zu < %zu or n_in %d != 26\n", ws_size, (size_t)WS_NEED, n_in); }
        (void)hipGetLastError();
    }
    Args a{};
    const float** fp = (const float**)&a;
    for (int i = 0; i < 26; ++i) fp[i] = (const float*)d_in[i];
    a.out = (float*)d_out; a.ws = (unsigned char*)d_ws; a.ph_lo = 0; a.ph_hi = 1000;
    void* args[] = {&a};
    hipError_t e = hipLaunchCooperativeKernel((const void*)mega_fwd, dim3(grid), dim3(512), args, LDS_BYTES, stream);
    if (e != hipSuccess) fprintf(stderr, "cooperative launch failed: %s (grid %d)\n", hipGetErrorString(e), grid);
}
```

```cpp
#include <hip/hip_runtime.h>
#include <hip/hip_cooperative_groups.h>
#include <cstdio>
#include <cstdint>
namespace cg = cooperative_groups;
namespace pg8 {
#define PG8_LAS __attribute__((address_space(3)))
typedef unsigned short bf16_t;
typedef short bf16x8 __attribute__((ext_vector_type(8)));
typedef float f32x4 __attribute__((ext_vector_type(4)));
typedef unsigned u32x4 __attribute__((ext_vector_type(4)));
constexpr int BM = 256, BK = 64, HALF = 128, HTB = HALF * BK * 2  , STAGE_BYTES = 8 * HTB, NXCD = 8, WGM = 8;

__host__ __device__ __forceinline__ int lds_byte(int r, int c) { const int st = (r >> 4) * 2 + (c >> 5), rr = r & 15, cc = c & 31, ob = rr * 64 + cc * 2; return st * 1024 + (ob ^ (((ob >> 9) & 1) << 5)); }
__host__ __device__ __forceinline__ void stage_rc(int b, int& R, int& C) { const int st = b / 1024, sb = b % 1024, swz = sb ^ (((sb >> 9) & 1) << 5); R = (st >> 1) * 16 + swz / 64; C = (st & 1) * 32 + (swz % 64) / 2; }
__host__ __device__ __forceinline__ int perm32(int rho) { const int n = rho >> 4, i = rho & 15; return 8 * (i >> 2) + 4 * n + (i & 3); }

struct Unit { int pm, pn; };
struct Gemm { const bf16_t* A; const bf16_t* Bt; int M, N, K; };

struct StaticOrder {
    int nM, nN, nwg, G, c;
    __host__ __device__ void init(int M, int N, int G_, int c_) { nM = M / BM; nN = N / BM; nwg = nM * nN; G = G_; c = c_; }
    __host__ __device__ bool next(int i, Unit& u) const {
        const long L = (long)i * G + c; if (L >= nwg) return false;
        int wgid = (int)L; { const int q = nwg / NXCD, r = nwg % NXCD, xcd = wgid % NXCD, off = wgid / NXCD; wgid = (xcd < r ? xcd * (q + 1) : r * (q + 1) + (xcd - r) * q) + off; }
        const int nig = WGM * nN, gid = wgid / nig, fm = gid * WGM, gsz = (nM - fm) < WGM ? (nM - fm) : WGM;
        u.pm = fm + ((wgid % nig) % gsz); u.pn = (wgid % nig) / gsz; return true;
    }
    __device__ __forceinline__ void a_ready(const Unit&) const {}
    __device__ __forceinline__ void done(const Unit&) const {}
};

__device__ __forceinline__ unsigned cvt_pk_bf16(float lo, float hi) { unsigned r; asm volatile("v_cvt_pk_bf16_f32 %0, %1, %2" : "=v"(r) : "v"(lo), "v"(hi)); return r; }
typedef float f32x2 __attribute__((ext_vector_type(2)));
template <class Epi, class Sched, bool ALIGN_EPI = false, bool SP2 = false>
__device__ __forceinline__ void gemm_phase(PG8_LAS unsigned char* lds, const Gemm g, const Sched& S, const Epi& E, const int tid_in) {
    const int tid = tid_in, wid = __builtin_amdgcn_readfirstlane(tid >> 6), lane = tid & 63, wr = wid >> 2, wc = wid & 3, fr = lane & 15, fq = lane >> 4;
    const int K = g.K, nt = K / BK;
    unsigned voffA[2], voffB[2];
#pragma unroll
    for (int i = 0; i < 2; ++i) { int R, C; stage_rc(tid * 16 + i * 8192, R, C); const int Rb = Epi::PERM ? ((R & ~31) + perm32(R & 31)) : R;
        voffA[i] = (unsigned)(R * K + C) * 2u; voffB[i] = (unsigned)(Rb * K + C) * 2u; }
    const size_t kstep = (size_t)(BK * 2);
    const size_t hstep = (size_t)HALF * K * 2;
    const size_t tstep = 2 * hstep;
    const unsigned ldsw = (unsigned)wid * 1024u;
    const int aoff = lds_byte(wr * 64 + fr, fq * 8), boff = lds_byte(wc * 32 + fr, fq * 8);
#define PG8_SA(b, h) (((b) * 2 + (h)) * HTB)
#define PG8_SB(b, h) ((4 + (b) * 2 + (h)) * HTB)
#define PG8_STAGE(bufoff, gbase, voff) do { _Pragma("unroll") for (int _i = 0; _i < 2; ++_i) \
        __builtin_amdgcn_global_load_lds((const unsigned*)((const char*)(gbase) + (voff)[_i]), (PG8_LAS unsigned*)(lds + (bufoff) + ldsw + _i * 8192), 16, 0, 0); } while (0)
#define PG8_LDA(dst, b, h) do { _Pragma("unroll") for (int m = 0; m < 4; ++m) _Pragma("unroll") for (int k = 0; k < 2; ++k) dst[m][k] = *(const PG8_LAS bf16x8*)(lds + PG8_SA(b, h) + aoff + m * 2048 + k * 1024); } while (0)
#define PG8_LDB(dst, b, h) do { _Pragma("unroll") for (int n = 0; n < 2; ++n) _Pragma("unroll") for (int k = 0; k < 2; ++k) dst[n][k] = *(const PG8_LAS bf16x8*)(lds + PG8_SB(b, h) + boff + n * 2048 + k * 1024); } while (0)
#define PG8_MMA(ai, bj, At, Bt) do { __builtin_amdgcn_s_setprio(1); _Pragma("unroll") for (int m = 0; m < 4; ++m) _Pragma("unroll") for (int n = 0; n < 2; ++n) _Pragma("unroll") for (int k = 0; k < 2; ++k) \
        acc[ai][bj][m][n] = __builtin_amdgcn_mfma_f32_16x16x32_bf16(Bt[n][k], At[m][k], acc[ai][bj][m][n], 0, 0, 0); __builtin_amdgcn_s_setprio(0); } while (0)
#define PG8_WAIT_V(n) asm volatile("s_waitcnt vmcnt(" #n ")" ::: "memory")
#define PG8_WAIT_L(n) asm volatile("s_waitcnt lgkmcnt(" #n ")" ::: "memory")
#define PG8_BAR __builtin_amdgcn_s_barrier()
#define PG8_SCHED __builtin_amdgcn_sched_barrier(0)
    Unit cur, nxt; int ui = 0;
    if (!S.next(0, cur)) return;
    f32x4 acc[2][2][4][2];
#pragma unroll
    for (int a = 0; a < 2; ++a)
#pragma unroll
        for (int b = 0; b < 2; ++b)
#pragma unroll
            for (int m = 0; m < 4; ++m)
#pragma unroll
                for (int n = 0; n < 2; ++n) acc[a][b][m][n] = (f32x4){0.f, 0.f, 0.f, 0.f};
    bf16x8 At[4][2], B0[2][2], B1[2][2];
    const char* cA = (const char*)g.A + (size_t)cur.pm * tstep; const char* cB = (const char*)g.Bt + (size_t)cur.pn * tstep;
    S.a_ready(cur);
    if constexpr (SP2) {
        PG8_STAGE(PG8_SB(0, 0), cB, voffB); PG8_STAGE(PG8_SB(0, 1), cB + hstep, voffB); PG8_STAGE(PG8_SA(0, 0), cA, voffA); PG8_STAGE(PG8_SA(0, 1), cA + hstep, voffA);
        if (wr == 1) PG8_BAR;
        PG8_WAIT_V(2); PG8_BAR;
        PG8_STAGE(PG8_SB(1, 0), cB + kstep, voffB); PG8_STAGE(PG8_SA(1, 0), cA + kstep, voffA); PG8_STAGE(PG8_SB(1, 1), cB + hstep + kstep, voffB);
        PG8_WAIT_V(6); PG8_BAR;
    } else {
        PG8_STAGE(PG8_SB(0, 0), cB, voffB); PG8_STAGE(PG8_SA(0, 0), cA, voffA); PG8_STAGE(PG8_SB(0, 1), cB + hstep, voffB); PG8_STAGE(PG8_SA(0, 1), cA + hstep, voffA);
        if (wr == 1) PG8_BAR;
        PG8_WAIT_V(4); PG8_BAR;
        PG8_STAGE(PG8_SB(1, 0), cB + kstep, voffB); PG8_STAGE(PG8_SA(1, 0), cA + kstep, voffA); PG8_STAGE(PG8_SB(1, 1), cB + hstep + kstep, voffB);
        PG8_WAIT_V(6); PG8_BAR;
    }
    for (;;) {
        const bool has_next = S.next(ui + 1, nxt);
        const char* nA = has_next ? (const char*)g.A + (size_t)nxt.pm * tstep : cA; const char* nB = has_next ? (const char*)g.Bt + (size_t)nxt.pn * tstep : cB;
        for (int t = 0; t < nt; t += 2) {
            const bool last = (t == nt - 2);
            const char* a1 = cA + (size_t)(t + 1) * kstep;
            const char* a2 = last ? nA : cA + (size_t)(t + 2) * kstep; const char* b2 = last ? nB : cB + (size_t)(t + 2) * kstep;
            const char* a3 = a2 + kstep; const char* b3 = b2 + kstep;
            if (last && has_next) S.a_ready(nxt);
            if constexpr (SP2) {
            PG8_LDB(B0, 0, 0); PG8_LDB(B1, 0, 1); PG8_SCHED; PG8_LDA(At, 0, 0); PG8_STAGE(PG8_SA(1, 1), a1 + hstep, voffA);
            PG8_WAIT_V(8); PG8_WAIT_L(0); PG8_BAR; PG8_MMA(0, 0, At, B0); PG8_MMA(0, 1, At, B1); PG8_BAR; PG8_SCHED;
            PG8_LDA(At, 0, 1); PG8_STAGE(PG8_SB(0, 0), b2, voffB); PG8_STAGE(PG8_SB(0, 1), b2 + hstep, voffB); PG8_STAGE(PG8_SA(0, 0), a2, voffA);
            PG8_WAIT_V(8); PG8_WAIT_L(0); PG8_BAR; PG8_MMA(1, 0, At, B0); PG8_MMA(1, 1, At, B1); PG8_BAR; PG8_SCHED;
            PG8_LDB(B0, 1, 0); PG8_LDB(B1, 1, 1); PG8_SCHED; PG8_LDA(At, 1, 0); PG8_STAGE(PG8_SA(0, 1), a2 + hstep, voffA);
            PG8_WAIT_V(8); PG8_WAIT_L(0); PG8_BAR; PG8_MMA(0, 0, At, B0); PG8_MMA(0, 1, At, B1); PG8_BAR; PG8_SCHED;
            PG8_LDA(At, 1, 1); PG8_STAGE(PG8_SB(1, 0), b3, voffB); PG8_STAGE(PG8_SB(1, 1), b3 + hstep, voffB); PG8_STAGE(PG8_SA(1, 0), a3, voffA);
            PG8_WAIT_V(8); PG8_WAIT_L(0); PG8_BAR; PG8_MMA(1, 0, At, B0); PG8_MMA(1, 1, At, B1); PG8_BAR; PG8_SCHED;
            } else {
            PG8_LDB(B0, 0, 0); PG8_SCHED; PG8_LDA(At, 0, 0); PG8_STAGE(PG8_SA(1, 1), a1 + hstep, voffA);
            PG8_WAIT_L(8); PG8_BAR; PG8_WAIT_L(0); PG8_MMA(0, 0, At, B0); PG8_BAR; PG8_SCHED;
            PG8_LDB(B1, 0, 1); PG8_STAGE(PG8_SB(0, 0), b2, voffB);
            PG8_BAR; PG8_WAIT_L(0); PG8_MMA(0, 1, At, B1); PG8_BAR;
            PG8_LDA(At, 0, 1); PG8_STAGE(PG8_SA(0, 0), a2, voffA);
            PG8_BAR; PG8_WAIT_L(0); PG8_MMA(1, 0, At, B0); PG8_BAR; PG8_SCHED;
            PG8_STAGE(PG8_SB(0, 1), b2 + hstep, voffB);
            PG8_WAIT_V(6); PG8_BAR; PG8_MMA(1, 1, At, B1); PG8_BAR;
            PG8_LDB(B0, 1, 0); PG8_SCHED; PG8_LDA(At, 1, 0); PG8_STAGE(PG8_SA(0, 1), a2 + hstep, voffA);
            PG8_WAIT_L(8); PG8_BAR; PG8_WAIT_L(0); PG8_MMA(0, 0, At, B0); PG8_BAR; PG8_SCHED;
            PG8_LDB(B1, 1, 1); PG8_STAGE(PG8_SB(1, 0), b3, voffB);
            PG8_BAR; PG8_WAIT_L(0); PG8_MMA(0, 1, At, B1); PG8_BAR;
            PG8_LDA(At, 1, 1); PG8_STAGE(PG8_SA(1, 0), a3, voffA);
            PG8_BAR; PG8_WAIT_L(0); PG8_MMA(1, 0, At, B0); PG8_BAR; PG8_SCHED;
            PG8_STAGE(PG8_SB(1, 1), b3 + hstep, voffB);
            PG8_WAIT_V(6); PG8_BAR; PG8_MMA(1, 1, At, B1); PG8_BAR;
            }
        }
        if constexpr (ALIGN_EPI) { if (wr == 0) PG8_BAR; }
        if constexpr (!Epi::AFTER_DRAIN) { E(acc, cur, wr, wc, fr, fq); S.done(cur); }
        if (!has_next) break;
#pragma unroll
        for (int a = 0; a < 2; ++a)
#pragma unroll
            for (int b = 0; b < 2; ++b)
#pragma unroll
                for (int m = 0; m < 4; ++m)
#pragma unroll
                    for (int n = 0; n < 2; ++n) acc[a][b][m][n] = (f32x4){0.f, 0.f, 0.f, 0.f};
        cur = nxt; cA = nA; cB = nB; ++ui;
        if constexpr (ALIGN_EPI) { if (wr == 1) PG8_BAR; }
    }
    PG8_WAIT_V(0);
    if constexpr (!ALIGN_EPI) { if (wr == 0) PG8_BAR; }
    PG8_BAR;
    if constexpr (Epi::AFTER_DRAIN) { E.fused(acc, cur, wr, wc, fr, fq, lds, wid, lane); S.done(cur); }
#undef PG8_SA
#undef PG8_SB
#undef PG8_STAGE
#undef PG8_LDA
#undef PG8_LDB
#undef PG8_MMA
#undef PG8_WAIT_V
#undef PG8_WAIT_L
#undef PG8_BAR
#undef PG8_SCHED
}
}

namespace pg8 {
typedef unsigned u32x2 __attribute__((ext_vector_type(2)));
__device__ __forceinline__ float sigmoidf_(float v) { return 1.0f / (1.0f + __expf(-v)); }

struct EpiSwiglu {
    static constexpr bool PERM = true, AFTER_DRAIN = false;
    bf16_t* H; int ldh;
    __device__ __forceinline__ void operator()(const f32x4 (&acc)[2][2][4][2], const Unit& u, int wr, int wc, int fr, int fq) const {
        const int row0 = u.pm * BM + wr * 64 + fr; const int col0 = u.pn * HALF + wc * 32 + 8 * fq;
#pragma unroll
        for (int ai = 0; ai < 2; ++ai)
#pragma unroll
            for (int m = 0; m < 4; ++m) {
                bf16_t* p = H + (size_t)(row0 + ai * HALF + m * 16) * ldh + col0;
                f32x4 h0, h1;
#pragma unroll
                for (int e = 0; e < 4; ++e) {
                    const float g0 = acc[ai][0][m][0][e], g1 = acc[ai][0][m][1][e];
                    h0[e] = g0 * sigmoidf_(g0) * acc[ai][1][m][0][e];
                    h1[e] = g1 * sigmoidf_(g1) * acc[ai][1][m][1][e];
                }
                u32x4 w; w.x = cvt_pk_bf16(h0[0], h0[1]); w.y = cvt_pk_bf16(h0[2], h0[3]); w.z = cvt_pk_bf16(h1[0], h1[1]); w.w = cvt_pk_bf16(h1[2], h1[3]);
                *(u32x4*)p = w;
            }
    }
};

template <bool RF32> struct EpiZ {
    static constexpr bool PERM = true, AFTER_DRAIN = false;
    const void* R; bf16_t* Z; float alpha, s;
    __device__ __forceinline__ void operator()(const f32x4 (&acc)[2][2][4][2], const Unit& u, int wr, int wc, int fr, int fq) const {
        const int row0 = u.pm * BM + wr * 64 + fr; const int col0 = u.pn * BM + wc * 32 + 8 * fq;
#pragma unroll
        for (int ai = 0; ai < 2; ++ai)
#pragma unroll
            for (int m = 0; m < 4; ++m) {
                const size_t off = (size_t)(row0 + ai * HALF + m * 16) * 2048 + col0;
#pragma unroll
                for (int bj = 0; bj < 2; ++bj) {
                    f32x4 r0, r1;
                    if (RF32) { r0 = *(const f32x4*)((const float*)R + off + bj * HALF); r1 = *(const f32x4*)((const float*)R + off + bj * HALF + 4); }
                    else { const u32x4 rb = *(const u32x4*)((const bf16_t*)R + off + bj * HALF);
                        r0[0] = __uint_as_float(rb.x << 16); r0[1] = __uint_as_float(rb.x & 0xffff0000u); r0[2] = __uint_as_float(rb.y << 16); r0[3] = __uint_as_float(rb.y & 0xffff0000u);
                        r1[0] = __uint_as_float(rb.z << 16); r1[1] = __uint_as_float(rb.z & 0xffff0000u); r1[2] = __uint_as_float(rb.w << 16); r1[3] = __uint_as_float(rb.w & 0xffff0000u); }
                    const f32x4 z0 = r0 * alpha + acc[ai][bj][m][0] * s, z1 = r1 * alpha + acc[ai][bj][m][1] * s;
                    u32x4 w; w.x = cvt_pk_bf16(z0[0], z0[1]); w.y = cvt_pk_bf16(z0[2], z0[3]); w.z = cvt_pk_bf16(z1[0], z1[1]); w.w = cvt_pk_bf16(z1[2], z1[3]);
                    *(u32x4*)(Z + off + bj * HALF) = w;
                }
            }
    }
};

struct EpiStore {
    static constexpr bool PERM = true, AFTER_DRAIN = false;
    bf16_t* O; int ldc; int ncols; float* GT;
    __device__ __forceinline__ void operator()(const f32x4 (&acc)[2][2][4][2], const Unit& u, int wr, int wc, int fr, int fq) const {
        const int row0 = u.pm * BM + wr * 64 + fr; const int colt = u.pn * BM;
        if (colt < ncols) {
            const int col0 = colt + wc * 32 + 8 * fq;
#pragma unroll
            for (int ai = 0; ai < 2; ++ai)
#pragma unroll
                for (int m = 0; m < 4; ++m) {
                    bf16_t* rowp = O + (size_t)(row0 + ai * HALF + m * 16) * ldc + col0;
#pragma unroll
                    for (int bj = 0; bj < 2; ++bj) {
                        const f32x4 v0 = acc[ai][bj][m][0], v1 = acc[ai][bj][m][1];
                        u32x4 w; w.x = cvt_pk_bf16(v0[0], v0[1]); w.y = cvt_pk_bf16(v0[2], v0[3]); w.z = cvt_pk_bf16(v1[0], v1[1]); w.w = cvt_pk_bf16(v1[2], v1[3]);
                        *(u32x4*)(rowp + bj * HALF) = w;
                    }
                }
        } else if (GT != nullptr && wc == 0 && fq < 2) {
#pragma unroll
            for (int ai = 0; ai < 2; ++ai)
#pragma unroll
                for (int m = 0; m < 4; ++m) {
                    float* g = GT + (size_t)(row0 + ai * HALF + m * 16) * 16 + 8 * fq;
                    *(f32x4*)(g) = acc[ai][0][m][0];
                    *(f32x4*)(g + 4) = acc[ai][0][m][1];
                }
        }
    }
};

struct EpiPle {
    static constexpr bool PERM = true, AFTER_DRAIN = false;
    const bf16_t* X; const bf16_t* E; float* OUTF; bf16_t* XBO;
    __device__ __forceinline__ void operator()(const f32x4 (&acc)[2][2][4][2], const Unit& u, int wr, int wc, int fr, int fq) const {
        const int row0 = u.pm * BM + wr * 64 + fr; const int col0 = u.pn * BM + wc * 32 + 8 * fq;
#pragma unroll
        for (int ai = 0; ai < 2; ++ai)
#pragma unroll
            for (int m = 0; m < 4; ++m) {
                const size_t off = (size_t)(row0 + ai * HALF + m * 16) * 2048 + col0;
#pragma unroll
                for (int bj = 0; bj < 2; ++bj) {
                    const size_t o2 = off + bj * HALF;
                    const u32x4 xb = *(const u32x4*)(X + o2), eb = *(const u32x4*)(E + o2);
                    const unsigned xw[4] = {xb.x, xb.y, xb.z, xb.w}, ew[4] = {eb.x, eb.y, eb.z, eb.w};
                    float o[8];
#pragma unroll
                    for (int q = 0; q < 4; ++q) {
                        const float a0 = acc[ai][bj][m][q >> 1][2 * (q & 1)], a1 = acc[ai][bj][m][q >> 1][2 * (q & 1) + 1];
                        o[2 * q] = __uint_as_float(xw[q] << 16) + __uint_as_float(ew[q] << 16) * sigmoidf_(a0);
                        o[2 * q + 1] = __uint_as_float(xw[q] & 0xffff0000u) + __uint_as_float(ew[q] & 0xffff0000u) * sigmoidf_(a1);
                    }
                    if (OUTF != nullptr) { *(f32x4*)(OUTF + o2) = (f32x4){o[0], o[1], o[2], o[3]}; *(f32x4*)(OUTF + o2 + 4) = (f32x4){o[4], o[5], o[6], o[7]}; }
                    if (XBO != nullptr) { u32x4 w; w.x = cvt_pk_bf16(o[0], o[1]); w.y = cvt_pk_bf16(o[2], o[3]); w.z = cvt_pk_bf16(o[4], o[5]); w.w = cvt_pk_bf16(o[6], o[7]); *(u32x4*)(XBO + o2) = w; }
                }
            }
    }
};
}

#define LAS __attribute__((address_space(3)))
using pg8::bf16_t; using pg8::bf16x8; using pg8::f32x4; using pg8::u32x4; using pg8::u32x2;
typedef short s16x4 __attribute__((ext_vector_type(4)));
typedef float f32x16 __attribute__((ext_vector_type(16)));
typedef short v4i16_t __attribute__((ext_vector_type(4)));

constexpr int MT = 16384, SEQ = 8192, DM = 2048, DFF = 5632, NFF2 = 11264, NIN = 6144, UW = 6144, PLE = 256;
constexpr int LDS_BYTES = 147456;
constexpr float ALPHA = 1.4142135623730951f;
constexpr float LOG2E = 1.4426950408889634f;

constexpr size_t SZ_WFI = (size_t)NFF2 * DM * 2, SZ_WFO = (size_t)DM * DFF * 2, SZ_WIN = (size_t)NIN * DM * 2, SZ_WSQ = (size_t)DM * DM * 2, SZ_WPP = (size_t)DM * PLE * 2;
constexpr size_t OFF_WFI = 0;
constexpr size_t OFF_WFO = OFF_WFI + 4 * SZ_WFI;
constexpr size_t OFF_WAB = OFF_WFO + 4 * SZ_WFO;
constexpr size_t OFF_WC = OFF_WAB + SZ_WIN;
constexpr size_t OFF_WOAB = OFF_WC + SZ_WIN;
constexpr size_t OFF_WOC = OFF_WOAB + SZ_WSQ;
constexpr size_t OFF_WPG = OFF_WOC + SZ_WSQ;
constexpr size_t OFF_WPP = OFF_WPG + 2 * SZ_WSQ;
constexpr size_t OFF_XF = OFF_WPP + 2 * SZ_WPP;
constexpr size_t OFF_XB = OFF_XF + (size_t)MT * DM * 4;
constexpr size_t OFF_Z = OFF_XB + (size_t)MT * DM * 2;
constexpr size_t OFF_H = OFF_Z + (size_t)MT * DM * 4;
constexpr size_t OFF_MIX = OFF_H + (size_t)MT * UW * 2;
constexpr size_t OFF_PB = OFF_MIX + (size_t)MT * DM * 2;
constexpr size_t OFF_GT = OFF_PB + (size_t)2 * MT * PLE * 2;
constexpr size_t OFF_QB = OFF_GT + (size_t)MT * 16 * 4;
constexpr size_t OFF_KB = OFF_QB + (size_t)MT * 512 * 2;
constexpr size_t OFF_BC = OFF_KB + (size_t)MT * 512 * 2;
constexpr size_t OFF_IP = OFF_BC + (size_t)MT * 4 * 4;
constexpr size_t OFF_MSC = OFF_IP + (size_t)MT * 4 * 4;
constexpr size_t OFF_NL = OFF_MSC + 3 * 1024 * 4;
constexpr size_t OFF_DC = OFF_NL + (size_t)8 * 128 * 128 * 4;
constexpr size_t OFF_ST = OFF_DC + (size_t)8 * 128 * 256 * 4;
constexpr size_t OFF_CTL = OFF_ST + (size_t)8 * 128 * 512 * 256 * 2;
constexpr size_t WS_NEED = OFF_CTL + 32768;

#define LDS_WAIT() asm volatile("s_waitcnt lgkmcnt(0)" ::: "memory")
__device__ __forceinline__ unsigned f2bf(float f) { unsigned u = __builtin_bit_cast(unsigned, f); return (u + 0x7fffu + ((u >> 16) & 1u)) >> 16; }
__device__ __forceinline__ unsigned pk2(float lo, float hi) { return f2bf(lo) | (f2bf(hi) << 16); }
__device__ __forceinline__ float bf2f(unsigned h) { return __uint_as_float(h << 16); }
__device__ __forceinline__ float bflo(unsigned w) { return __uint_as_float(w << 16); }
__device__ __forceinline__ float bfhi(unsigned w) { return __uint_as_float(w & 0xffff0000u); }
__device__ __forceinline__ float wave_sum(float v) {
#pragma unroll
    for (int o = 1; o < 64; o <<= 1) v += __shfl_xor(v, o);
    return v;
}
__device__ __forceinline__ float logsigmoidf_(float x) { return fminf(x, 0.f) - log1pf(__expf(-fabsf(x))); }
__device__ __forceinline__ s16x4 vtr(const LAS unsigned char* p) { return __builtin_bit_cast(s16x4, __builtin_amdgcn_ds_read_tr16_b64_v4i16((LAS v4i16_t*)p)); }
__device__ __forceinline__ bf16x8 tr8(const LAS unsigned char* p0, const LAS unsigned char* p1) {
    const s16x4 a = vtr(p0), b = vtr(p1); bf16x8 r; r[0] = a[0]; r[1] = a[1]; r[2] = a[2]; r[3] = a[3]; r[4] = b[0]; r[5] = b[1]; r[6] = b[2]; r[7] = b[3]; return r;
}
__device__ __forceinline__ f32x4 mfma16(bf16x8 a, bf16x8 b, f32x4 c) { return __builtin_amdgcn_mfma_f32_16x16x32_bf16(a, b, c, 0, 0, 0); }
__device__ __forceinline__ f32x16 mfma32(bf16x8 a, bf16x8 b, f32x16 c) { return __builtin_amdgcn_mfma_f32_32x32x16_bf16(a, b, c, 0, 0, 0); }
__device__ __forceinline__ bf16x8 ldsv8(const LAS unsigned char* p) { return *(const LAS bf16x8*)p; }

struct Ctx { LAS unsigned char* lds; int tid, lane, wave, G, bid, gw, NGW; };

__device__ __forceinline__ void tr_decode(int it, int nnb, int mode, int& k0, int& n0, int& drow0, float& scale) {
    const int kb = it / nnb, nb = it - kb * nnb; k0 = 64 * kb; n0 = 64 * nb; drow0 = n0; scale = 1.f;
    if (mode == 1) { const int half = n0 >= DFF ? 1 : 0; const int j0 = n0 - half * DFF; drow0 = 256 * (j0 >> 7) + 128 * half + (j0 & 127); }
    if (mode == 2 && n0 < 1024) scale = 0.125f;
}
__device__ __forceinline__ void tr_load(float (&r)[64], const float* __restrict__ W, int N, int k0, int n0, int lane) {
    const int n = n0 + lane; const bool ok = n < N; const float* src = W + (size_t)k0 * N + (ok ? n : 0);
#pragma unroll
    for (int i = 0; i < 64; ++i) { const float v = src[(size_t)i * N]; r[i] = ok ? v : 0.f; }
}
__device__ __forceinline__ void conv_matrix(const Ctx& C, const float* W, int K, int N, int Npad, bf16_t* WT, int mode, int& base) {
    LAS float* scr = (LAS float*)(C.lds + C.wave * 16640);
    const int nnb = Npad / 64, nitems = (K / 64) * nnb, lane = C.lane;
    int first = (C.gw - base) % C.NGW; if (first < 0) first += C.NGW;
    float r[64]; int k0 = 0, n0 = 0, drow0 = 0; float scale = 1.f;
    int it = first;
    if (it < nitems) { tr_decode(it, nnb, mode, k0, n0, drow0, scale); tr_load(r, W, N, k0, n0, lane); }
    while (it < nitems) {
#pragma unroll
        for (int i = 0; i < 64; ++i) scr[i * 65 + lane] = r[i] * scale;
        const int ck0 = k0, cdrow0 = drow0;
        it += C.NGW;
        if (it < nitems) { tr_decode(it, nnb, mode, k0, n0, drow0, scale); tr_load(r, W, N, k0, n0, lane); }
        LDS_WAIT(); asm volatile("" ::: "memory");
        const int c = lane & 7;
#pragma unroll
        for (int j = 0; j < 8; ++j) { const int nn = (lane >> 3) + 8 * j; const LAS float* s = scr + (8 * c) * 65 + nn;
            u32x4 o; o.x = pk2(s[0 * 65], s[1 * 65]); o.y = pk2(s[2 * 65], s[3 * 65]); o.z = pk2(s[4 * 65], s[5 * 65]); o.w = pk2(s[6 * 65], s[7 * 65]);
            *(u32x4*)(WT + (size_t)(cdrow0 + nn) * K + ck0 + 8 * c) = o; }
        LDS_WAIT(); asm volatile("" ::: "memory");
    }
    base = (base + nitems) % C.NGW;
}
__device__ __forceinline__ void cvt_rows(const Ctx& C, const float* src, bf16_t* dst, size_t n4) {
    const size_t stride = (size_t)C.G * 512;
    for (size_t i = (size_t)C.bid * 512 + C.tid; i < n4; i += 4 * stride) {
        f32x4 v[4];
#pragma unroll
        for (int j = 0; j < 4; ++j) if (i + j * stride < n4) v[j] = *(const f32x4*)(src + 4 * (i + j * stride));
#pragma unroll
        for (int j = 0; j < 4; ++j) if (i + j * stride < n4) { u32x2 w; w.x = pk2(v[j][0], v[j][1]); w.y = pk2(v[j][2], v[j][3]); *(u32x2*)(dst + 4 * (i + j * stride)) = w; }
    }
}

template <bool GATES>
__device__ __forceinline__ void ln_phase(const Ctx& C, const bf16_t* Z, const float* g, const float* b, bf16_t* XB, const float* Wsrc, int ldw, int ngate, float* GT) {
    LAS float* WG = (LAS float*)C.lds;
    if (GATES) {
        for (int col = C.tid; col < DM; col += 512) {
            const float* src = Wsrc + (size_t)col * ldw + 6144;
#pragma unroll
            for (int gi = 0; gi < 16; ++gi) WG[gi * DM + col] = (gi < ngate) ? src[gi] : 0.f;
        }
        __syncthreads();
    }
    f32x4 gv[8], bv[8];
#pragma unroll
    for (int j = 0; j < 4; ++j) { gv[2 * j] = *(const f32x4*)(g + 512 * j + 8 * C.lane); gv[2 * j + 1] = *(const f32x4*)(g + 512 * j + 8 * C.lane + 4);
                                  bv[2 * j] = *(const f32x4*)(b + 512 * j + 8 * C.lane); bv[2 * j + 1] = *(const f32x4*)(b + 512 * j + 8 * C.lane + 4); }
    const bool grp = (C.G & 7) == 0; const int nwg_ = grp ? (C.G >> 3) * 8 : C.NGW; const int first_ = grp ? (C.bid >> 3) * 8 + C.wave : C.gw; const int base_ = grp ? 2048 * (C.bid & 7) : 0; const int lim_ = grp ? 2048 : MT;
    for (int lrow = first_; lrow < lim_; lrow += nwg_) {
        const int row = base_ + lrow;
        const bf16_t* z = Z + (size_t)row * DM + 8 * C.lane;
        u32x4 zb[4];
#pragma unroll
        for (int j = 0; j < 4; ++j) zb[j] = *(const u32x4*)(z + 512 * j);
        f32x4 v[8]; float s = 0.f;
#pragma unroll
        for (int j = 0; j < 4; ++j) { v[2 * j] = (f32x4){bflo(zb[j].x), bfhi(zb[j].x), bflo(zb[j].y), bfhi(zb[j].y)}; v[2 * j + 1] = (f32x4){bflo(zb[j].z), bfhi(zb[j].z), bflo(zb[j].w), bfhi(zb[j].w)}; }
#pragma unroll
        for (int j = 0; j < 8; ++j) s += (v[j][0] + v[j][1]) + (v[j][2] + v[j][3]);
        const float mean = wave_sum(s) * (1.f / DM); float s2 = 0.f;
#pragma unroll
        for (int j = 0; j < 8; ++j) { v[j] = v[j] - mean; s2 += (v[j][0] * v[j][0] + v[j][1] * v[j][1]) + (v[j][2] * v[j][2] + v[j][3] * v[j][3]); }
        const float rstd = 1.f / sqrtf(wave_sum(s2) * (1.f / DM) + 1e-5f);
        bf16_t* bo = XB + (size_t)row * DM + 8 * C.lane;
#pragma unroll
        for (int j = 0; j < 4; ++j) { const f32x4 o0 = v[2 * j] * rstd * gv[2 * j] + bv[2 * j], o1 = v[2 * j + 1] * rstd * gv[2 * j + 1] + bv[2 * j + 1];
            u32x4 w; w.x = pg8::cvt_pk_bf16(o0[0], o0[1]); w.y = pg8::cvt_pk_bf16(o0[2], o0[3]); w.z = pg8::cvt_pk_bf16(o1[0], o1[1]); w.w = pg8::cvt_pk_bf16(o1[2], o1[3]); *(u32x4*)(bo + 512 * j) = w;
            if (GATES) { v[2 * j] = o0; v[2 * j + 1] = o1; } }
        if (GATES) {
            float mine = 0.f;
#pragma unroll 4
            for (int gi = 0; gi < 16; ++gi) {
                float s0 = 0.f, s1 = 0.f;
#pragma unroll
                for (int j = 0; j < 4; ++j) { const f32x4 w0 = *(const LAS f32x4*)(WG + gi * DM + 512 * j + 8 * C.lane), w1 = *(const LAS f32x4*)(WG + gi * DM + 512 * j + 8 * C.lane + 4);
                    s0 += (v[2 * j][0] * w0[0] + v[2 * j][1] * w0[1]) + (v[2 * j][2] * w0[2] + v[2 * j][3] * w0[3]);
                    s1 += (v[2 * j + 1][0] * w1[0] + v[2 * j + 1][1] * w1[1]) + (v[2 * j + 1][2] * w1[2] + v[2 * j + 1][3] * w1[3]); }
                const float tot = wave_sum(s0 + s1);
                mine = (C.lane == gi) ? tot : mine;
            }
            if (C.lane < 16) GT[(size_t)row * 16 + C.lane] = mine;
        }
    }
    if (GATES) __syncthreads();
}

__device__ __forceinline__ void m1_phase(const Ctx& C, const bf16_t* U, const float* GT, const float* conv_w, const float* conv_b, const float* b_i, const float* b_f,
                                         bf16_t* QB, bf16_t* KB, float* BC, float* IP, float* MSC) {
    if (C.bid < 8) {
        LAS float* sb = (LAS float*)C.lds; LAS float* su = sb + 128;
        const int bh = C.bid, b = bh >> 2, h = bh & 3;
        {
            const float bi = b_i[h], bf = b_f[h]; const int ln = C.lane;
            float fv[16], iv[16];
#pragma unroll
            for (int k = 0; k < 16; ++k) { const size_t row = (size_t)b * SEQ + (C.wave * 16 + k) * 64 + ln; fv[k] = GT[row * 16 + 4 + h]; iv[k] = GT[row * 16 + h]; }
#pragma unroll
            for (int k = 0; k < 16; ++k) {
                const int c = C.wave * 16 + k; const size_t row = (size_t)b * SEQ + c * 64 + ln;
                float cum = logsigmoidf_(fv[k] + bf);
#pragma unroll
                for (int off = 1; off < 64; off <<= 1) { const float t = __shfl_up(cum, off); if (ln >= off) cum += t; }
                const float ip = iv[k] + bi;
                BC[row * 4 + h] = cum; IP[row * 4 + h] = ip;
                float um = ip - cum;
#pragma unroll
                for (int off = 1; off < 64; off <<= 1) um = fmaxf(um, __shfl_xor(um, off));
                const float bl = __shfl(cum, 63);
                if (ln == 0) { sb[c] = bl; su[c] = um; }
            }
        }
        __syncthreads();
        if (C.tid == 0) {
            float m = 0.f;
#pragma unroll 1
            for (int c = 0; c < 128; ++c) {
                const float bl = sb[c], mn = fmaxf(bl + m, bl + su[c]);
                MSC[bh * 128 + c] = m; MSC[1024 + bh * 128 + c] = mn; MSC[2048 + bh * 128 + c] = __expf(bl + m - mn); m = mn;
            }
        }
        __syncthreads();
    }
    for (size_t i = (size_t)C.bid * 512 + C.tid; i < (size_t)MT * 128; i += (size_t)C.G * 512) {
        const int row = (int)(i >> 7), c0 = (int)(i & 127) * 8, t = row & (SEQ - 1);
        float acc[8];
#pragma unroll
        for (int e = 0; e < 8; ++e) acc[e] = conv_b[c0 + e];
#pragma unroll
        for (int j = 0; j < 4; ++j) {
            const int tt = t - 3 + j;
            if (tt >= 0) {
                const u32x4 xv = *(const u32x4*)(U + (size_t)(row - 3 + j) * UW + 3072 + c0);
                const f32x4 w0 = *(const f32x4*)(conv_w + j * 1024 + c0), w1 = *(const f32x4*)(conv_w + j * 1024 + c0 + 4);
                acc[0] += w0[0] * bflo(xv.x); acc[1] += w0[1] * bfhi(xv.x); acc[2] += w0[2] * bflo(xv.y); acc[3] += w0[3] * bfhi(xv.y);
                acc[4] += w1[0] * bflo(xv.z); acc[5] += w1[1] * bfhi(xv.z); acc[6] += w1[2] * bflo(xv.w); acc[7] += w1[3] * bfhi(xv.w);
            }
        }
        const float sc = (c0 < 512) ? 0.08838834764831845f : 1.f;
#pragma unroll
        for (int e = 0; e < 8; ++e) acc[e] = acc[e] * pg8::sigmoidf_(acc[e]) * sc;
        u32x4 w; w.x = pk2(acc[0], acc[1]); w.y = pk2(acc[2], acc[3]); w.z = pk2(acc[4], acc[5]); w.w = pk2(acc[6], acc[7]);
        if (c0 < 512) *(u32x4*)(QB + (size_t)row * 512 + c0) = w; else *(u32x4*)(KB + (size_t)row * 512 + c0 - 512) = w;
    }
}

__device__ __forceinline__ void mlstm_passA(const Ctx& C, const bf16_t* U, const bf16_t* KB, const float* BC, const float* IP, const float* MSC, bf16_t* ST, float* NL) {
    LAS unsigned char* KW = C.lds; LAS unsigned char* V = C.lds + 17408; LAS float* wk = (LAS float*)(C.lds + 52224);
    const int l = C.lane, g = l >> 4, q = (l & 15) >> 2, p = l & 3, w = C.wave;
    for (int u = C.bid; u < 1024; u += C.G) {
        const int bh = u >> 7, c = u & 127, b = bh >> 2, h = bh & 3; const size_t row0 = (size_t)b * SEQ + c * 64;
        if (C.tid < 64) { const float bl = BC[(row0 + 63) * 4 + h], mn = MSC[1024 + bh * 128 + c]; wk[C.tid] = __expf(bl - BC[(row0 + C.tid) * 4 + h] + IP[(row0 + C.tid) * 4 + h] - mn); }
        __syncthreads();
        { const int s = C.tid >> 3, seg = C.tid & 7; const float ws = wk[s];
          const bf16_t* kp = KB + (row0 + s) * 512 + h * 128 + seg * 16;
#pragma unroll
          for (int i = 0; i < 2; ++i) { const u32x4 kv = *(const u32x4*)(kp + 8 * i); u32x4 o;
              o.x = pk2(bflo(kv.x) * ws, bfhi(kv.x) * ws); o.y = pk2(bflo(kv.y) * ws, bfhi(kv.y) * ws); o.z = pk2(bflo(kv.z) * ws, bfhi(kv.z) * ws); o.w = pk2(bflo(kv.w) * ws, bfhi(kv.w) * ws);
              *(LAS u32x4*)(KW + s * 272 + seg * 32 + 16 * i) = o; }
          const bf16_t* vp = U + (row0 + s) * UW + 4096 + h * 256 + seg * 32;
#pragma unroll
          for (int i = 0; i < 4; ++i) *(LAS u32x4*)(V + s * 544 + seg * 64 + 16 * i) = *(const u32x4*)(vp + 8 * i); }
        __syncthreads();
        f32x4 acc[2][8];
#pragma unroll
        for (int mi = 0; mi < 2; ++mi)
#pragma unroll
            for (int ni = 0; ni < 8; ++ni) acc[mi][ni] = (f32x4){0.f, 0.f, 0.f, 0.f};
#pragma unroll
        for (int ks = 0; ks < 2; ++ks) {
            const int r0 = 32 * ks + 8 * g + q;
            bf16x8 a[2];
#pragma unroll
            for (int mi = 0; mi < 2; ++mi) { const LAS unsigned char* ap = V + r0 * 544 + (32 * w + 16 * mi + 4 * p) * 2; a[mi] = tr8(ap, ap + 4 * 544); }
#pragma unroll
            for (int ni = 0; ni < 8; ++ni) { const LAS unsigned char* bp = KW + r0 * 272 + (16 * ni + 4 * p) * 2; const bf16x8 bb = tr8(bp, bp + 4 * 272);
#pragma unroll
                for (int mi = 0; mi < 2; ++mi) acc[mi][ni] = mfma16(bb, a[mi], acc[mi][ni]); }
        }
        bf16_t* st = ST + ((size_t)(bh * 128 + c) << 15);
#pragma unroll
        for (int mi = 0; mi < 2; ++mi)
#pragma unroll
            for (int ni = 0; ni < 8; ++ni) { u32x2 wv; wv.x = pg8::cvt_pk_bf16(acc[mi][ni][0], acc[mi][ni][1]); wv.y = pg8::cvt_pk_bf16(acc[mi][ni][2], acc[mi][ni][3]);
                *(u32x2*)(st + (32 * w + 16 * mi + (l & 15)) * 128 + 16 * ni + 4 * g) = wv; }
        if (C.tid < 128) { float s = 0.f;
#pragma unroll 4
            for (int t = 0; t < 64; ++t) s += bf2f(*(const LAS unsigned short*)(KW + t * 272 + C.tid * 2)); NL[(size_t)(bh * 128 + c) * 128 + C.tid] = s; }
        __syncthreads();
    }
}

__device__ __forceinline__ void mlstm_scan(const Ctx& C, bf16_t* ST, float* NL, const float* MSC) {
    for (int e2 = C.bid * 512 + C.tid; e2 < 8 * 16384; e2 += C.G * 512) {
        const int bh = e2 >> 14, off = e2 & 16383; float c0 = 0.f, c1 = 0.f;
        unsigned* p = (unsigned*)(ST + ((size_t)(bh * 128) << 15)) + off;
#pragma unroll 1
        for (int cb = 0; cb < 128; cb += 8) {
            unsigned t[8]; float d[8];
#pragma unroll
            for (int i = 0; i < 8; ++i) { t[i] = p[(size_t)(cb + i) << 14]; d[i] = MSC[2048 + bh * 128 + cb + i]; }
#pragma unroll
            for (int i = 0; i < 8; ++i) { p[(size_t)(cb + i) << 14] = pk2(c0, c1); c0 = d[i] * c0 + bflo(t[i]); c1 = d[i] * c1 + bfhi(t[i]); }
        }
    }
    const int gt = C.bid * 512 + C.tid;
    if (gt < 1024) { const int bh = gt >> 7, dk = gt & 127; float n = 0.f;
#pragma unroll 2
        for (int c = 0; c < 128; ++c) { float* p = NL + (size_t)(bh * 128 + c) * 128 + dk; const float t = *p; *p = n; n = MSC[2048 + bh * 128 + c] * n + t; } }
}

__device__ __forceinline__ void mlstm_passC(const Ctx& C, const bf16_t* U, const bf16_t* QB, const bf16_t* KB, const float* BC, const float* IP, const float* MSC,
                                            const bf16_t* ST, const float* NL, const float* mg, bf16_t* MIX) {
    LAS unsigned char* Q = C.lds; LAS unsigned char* K = C.lds + 17408; LAS unsigned char* V = C.lds + 34816; LAS unsigned char* SW = C.lds + 69632;
    LAS float* fu = (LAS float*)(C.lds + 78848); LAS float* fM = fu + 64; LAS float* fw = fu + 128; LAS float* fb = fu + 192; LAS float* finv = fu + 256; LAS float* fn = fu + 320; LAS float* fss = fu + 448;
    const int l = C.lane, g = l >> 4, q = (l & 15) >> 2, p = l & 3, w = C.wave, lr = l & 15;
    for (int u = C.bid; u < 1024; u += C.G) {
        const int bh = u >> 7, c = u & 127, b = bh >> 2, h = bh & 3; const size_t row0 = (size_t)b * SEQ + c * 64;
        const float mprev = MSC[bh * 128 + c];
        if (C.tid < 64) { const float bt = BC[(row0 + C.tid) * 4 + h]; fb[C.tid] = bt; fu[C.tid] = IP[(row0 + C.tid) * 4 + h] - bt; }
        if (C.tid >= 64 && C.tid < 192) fn[C.tid - 64] = NL[(size_t)(bh * 128 + c) * 128 + C.tid - 64];
        { const int s = C.tid >> 3, seg = C.tid & 7;
          const bf16_t* qp = QB + (row0 + s) * 512 + h * 128 + seg * 16; const bf16_t* kp = KB + (row0 + s) * 512 + h * 128 + seg * 16;
#pragma unroll
          for (int i = 0; i < 2; ++i) { *(LAS u32x4*)(Q + s * 272 + seg * 32 + 16 * i) = *(const u32x4*)(qp + 8 * i); *(LAS u32x4*)(K + s * 272 + seg * 32 + 16 * i) = *(const u32x4*)(kp + 8 * i); }
          const bf16_t* vp = U + (row0 + s) * UW + 4096 + h * 256 + seg * 32;
#pragma unroll
          for (int i = 0; i < 4; ++i) *(LAS u32x4*)(V + s * 544 + seg * 64 + 16 * i) = *(const u32x4*)(vp + 8 * i); }
        __syncthreads();
        if (C.tid < 64) { float pm = -3.0e38f;
#pragma unroll 1
            for (int s = 0; s <= C.tid; ++s) pm = fmaxf(pm, fu[s]); const float Mt = fmaxf(mprev, pm); fM[C.tid] = Mt; fw[C.tid] = __expf(mprev - Mt); }
        __syncthreads();
#pragma unroll
        for (int tt = 0; tt < 2; ++tt) {
            const int tile = 2 * w + tt, ti = tile >> 2, si = tile & 3;
            f32x4 s4 = (f32x4){0.f, 0.f, 0.f, 0.f};
            if (si <= ti) {
#pragma unroll
                for (int ks = 0; ks < 4; ++ks) { const bf16x8 a = ldsv8(Q + (16 * ti + lr) * 272 + (32 * ks + 8 * g) * 2), bb = ldsv8(K + (16 * si + lr) * 272 + (32 * ks + 8 * g) * 2); s4 = mfma16(a, bb, s4); }
            }
            const int sidx = 16 * si + lr; const float us = fu[sidx];
#pragma unroll
            for (int j = 0; j < 4; ++j) { const int t = 16 * ti + 4 * g + j; const float wgt = (sidx <= t) ? __expf(us - fM[t]) : 0.f;
                *(LAS unsigned short*)(SW + t * 144 + sidx * 2) = (unsigned short)f2bf(s4[j] * wgt); }
        }
        __syncthreads();
        if (C.tid < 64) { const int t = C.tid; float rs = 0.f, qn = 0.f;
#pragma unroll 4
            for (int s = 0; s < 64; ++s) rs += bf2f(*(const LAS unsigned short*)(SW + t * 144 + s * 2));
#pragma unroll 4
            for (int d = 0; d < 128; ++d) qn += bf2f(*(const LAS unsigned short*)(Q + t * 272 + d * 2)) * fn[d];
            const float den = fw[t] * qn + rs; finv[t] = 1.f / fmaxf(fabsf(den), __expf(-(fb[t] + fM[t]))); }
        f32x4 acc[4][2];
#pragma unroll
        for (int mi = 0; mi < 4; ++mi)
#pragma unroll
            for (int ni = 0; ni < 2; ++ni) acc[mi][ni] = (f32x4){0.f, 0.f, 0.f, 0.f};
        const bf16_t* st = ST + ((size_t)(bh * 128 + c) << 15);
#pragma unroll
        for (int ks = 0; ks < 4; ++ks) {
            bf16x8 bb[2];
#pragma unroll
            for (int ni = 0; ni < 2; ++ni) bb[ni] = *(const bf16x8*)(st + (32 * w + 16 * ni + lr) * 128 + 32 * ks + 8 * g);
#pragma unroll
            for (int mi = 0; mi < 4; ++mi) { const bf16x8 a = ldsv8(Q + (16 * mi + lr) * 272 + (32 * ks + 8 * g) * 2);
#pragma unroll
                for (int ni = 0; ni < 2; ++ni) acc[mi][ni] = mfma16(bb[ni], a, acc[mi][ni]); }
        }
#pragma unroll
        for (int mi = 0; mi < 4; ++mi) { const float wi = fw[16 * mi + lr]; acc[mi][0] = acc[mi][0] * wi; acc[mi][1] = acc[mi][1] * wi; }
#pragma unroll
        for (int ks = 0; ks < 2; ++ks) {
            const int r0 = 32 * ks + 8 * g + q; bf16x8 bb[2];
#pragma unroll
            for (int ni = 0; ni < 2; ++ni) { const LAS unsigned char* bp = V + r0 * 544 + (32 * w + 16 * ni + 4 * p) * 2; bb[ni] = tr8(bp, bp + 4 * 544); }
#pragma unroll
            for (int mi = 0; mi < 4; ++mi) { const bf16x8 a = ldsv8(SW + (16 * mi + lr) * 144 + (32 * ks + 8 * g) * 2);
#pragma unroll
                for (int ni = 0; ni < 2; ++ni) acc[mi][ni] = mfma16(bb[ni], a, acc[mi][ni]); }
        }
        __syncthreads();
#pragma unroll
        for (int mi = 0; mi < 4; ++mi) { const float iv = finv[16 * mi + lr]; acc[mi][0] = acc[mi][0] * iv; acc[mi][1] = acc[mi][1] * iv;
            float ss = 0.f;
#pragma unroll
            for (int ni = 0; ni < 2; ++ni) ss += (acc[mi][ni][0] * acc[mi][ni][0] + acc[mi][ni][1] * acc[mi][ni][1]) + (acc[mi][ni][2] * acc[mi][ni][2] + acc[mi][ni][3] * acc[mi][ni][3]);
            ss += __shfl_xor(ss, 16); ss += __shfl_xor(ss, 32);
            if (g == 0) fss[w * 64 + 16 * mi + lr] = ss; }
        __syncthreads();
#pragma unroll
        for (int mi = 0; mi < 4; ++mi) { const int t = 16 * mi + lr; float tot = 0.f;
#pragma unroll
            for (int ww = 0; ww < 8; ++ww) tot += fss[ww * 64 + t];
            const float r = 1.f / sqrtf(tot * (1.f / 256.f) + 1e-6f);
#pragma unroll
            for (int ni = 0; ni < 2; ++ni) { const int dv = 32 * w + 16 * ni + 4 * g;
                const u32x2 ogb = *(const u32x2*)(U + (row0 + t) * UW + 5120 + h * 256 + dv); const f32x4 gv = *(const f32x4*)(mg + h * 256 + dv);
                const float o0 = acc[mi][ni][0] * r * gv[0] * pg8::sigmoidf_(bflo(ogb.x)), o1 = acc[mi][ni][1] * r * gv[1] * pg8::sigmoidf_(bfhi(ogb.x));
                const float o2 = acc[mi][ni][2] * r * gv[2] * pg8::sigmoidf_(bflo(ogb.y)), o3 = acc[mi][ni][3] * r * gv[3] * pg8::sigmoidf_(bfhi(ogb.y));
                u32x2 wv; wv.x = pg8::cvt_pk_bf16(o0, o1); wv.y = pg8::cvt_pk_bf16(o2, o3);
                *(u32x2*)(MIX + (row0 + t) * DM + 1024 + h * 256 + dv) = wv; } }
        __syncthreads();
    }
}

__device__ __forceinline__ float gla_decay(const Ctx& C, const float* w_a2, const float* b_a, int h, LAS float* A1, LAS float* tot0, LAS unsigned char* QD, LAS unsigned char* KD) {
    const int ch = C.tid & 255, half = C.tid >> 8, t0 = 32 * half;
    float wv[16];
#pragma unroll
    for (int i = 0; i < 16; ++i) wv[i] = w_a2[i * 1024 + h * 256 + ch];
    const float ba = b_a[h * 256 + ch];
    float c[32]; float run = 0.f;
#pragma unroll
    for (int i = 0; i < 32; ++i) {
        const LAS float* ap = A1 + (t0 + i) * 16;
        const f32x4 a0 = *(const LAS f32x4*)(ap), a1 = *(const LAS f32x4*)(ap + 4), a2 = *(const LAS f32x4*)(ap + 8), a3 = *(const LAS f32x4*)(ap + 12);
        float z0 = ba, z1 = 0.f, z2 = 0.f, z3 = 0.f;
#pragma unroll
        for (int j = 0; j < 4; ++j) { z0 += a0[j] * wv[j]; z1 += a1[j] * wv[4 + j]; z2 += a2[j] * wv[8 + j]; z3 += a3[j] * wv[12 + j]; }
        const float z = (z0 + z1) + (z2 + z3);
        run += (fminf(z, 0.f) - __logf(1.f + __expf(-fabsf(z)))) * 0.0625f;
        c[i] = run;
    }
    if (half == 0) tot0[ch] = run;
    __syncthreads();
    const float off = half ? tot0[ch] : 0.f;
#pragma unroll
    for (int i = 0; i < 32; ++i) {
        const float cum = c[i] + off; const int t = t0 + i;
        LAS unsigned short* kp = (LAS unsigned short*)(KD + t * 528 + ch * 2); *kp = (unsigned short)f2bf(bf2f(*kp) * __expf(-cum));
        LAS unsigned short* qp = (LAS unsigned short*)(QD + t * 528 + ch * 2); *qp = (unsigned short)f2bf(bf2f(*qp) * __expf(cum) * 0.0625f);
    }
    return __expf(c[31] + off);
}

__device__ __forceinline__ void gla_passA(const Ctx& C, const bf16_t* U, const float* GT, const float* w_a2, const float* b_a, bf16_t* ST, float* DC, bf16_t* QDG, bf16_t* KDG) {
    LAS unsigned char* QD = C.lds; LAS unsigned char* KD = C.lds + 33792; LAS unsigned char* V = C.lds + 67584;
    LAS float* A1 = (LAS float*)(C.lds + 135168); LAS float* bl = (LAS float*)(C.lds + 139264); LAS float* tot0 = (LAS float*)(C.lds + 140288);
    const int l = C.lane, g = l >> 4, q = (l & 15) >> 2, p = l & 3, w = C.wave, lr = l & 15;
    for (int u = C.bid; u < 1024; u += C.G) {
        const int bh = u >> 7, c = u & 127, b = bh >> 2, h = bh & 3; const size_t row0 = (size_t)b * SEQ + c * 64;
        A1[C.tid] = GT[row0 * 16 + C.tid]; A1[C.tid + 512] = GT[row0 * 16 + C.tid + 512];
        { const int s = C.tid >> 3, seg = C.tid & 7; const bf16_t* vp = U + (row0 + s) * UW + 2048 + h * 512 + seg * 64;
#pragma unroll
          for (int i = 0; i < 8; ++i) *(LAS u32x4*)(V + s * 1056 + seg * 128 + 16 * i) = *(const u32x4*)(vp + 8 * i);
          const bf16_t* qp = U + (row0 + s) * UW + h * 256 + seg * 32;
#pragma unroll
          for (int i = 0; i < 4; ++i) { *(LAS u32x4*)(QD + s * 528 + seg * 64 + 16 * i) = *(const u32x4*)(qp + 8 * i); *(LAS u32x4*)(KD + s * 528 + seg * 64 + 16 * i) = *(const u32x4*)(qp + 1024 + 8 * i); } }
        __syncthreads();
        const float eb = gla_decay(C, w_a2, b_a, h, A1, tot0, QD, KD);
        if (C.tid >= 256) { bl[C.tid - 256] = eb; DC[(size_t)(bh * 128 + c) * 256 + C.tid - 256] = eb; }
        __syncthreads();
        { const int s = C.tid >> 3, seg = C.tid & 7; bf16_t* qg = QDG + (row0 + s) * 1024 + h * 256 + seg * 32; bf16_t* kg = KDG + (row0 + s) * 1024 + h * 256 + seg * 32;
#pragma unroll
          for (int i = 0; i < 4; ++i) { *(u32x4*)(qg + 8 * i) = *(const LAS u32x4*)(QD + s * 528 + seg * 64 + 16 * i); *(u32x4*)(kg + 8 * i) = *(const LAS u32x4*)(KD + s * 528 + seg * 64 + 16 * i); } }
#pragma unroll 1
        for (int dvq = 0; dvq < 4; ++dvq) {
            f32x4 acc[16];
#pragma unroll
            for (int ni = 0; ni < 16; ++ni) acc[ni] = (f32x4){0.f, 0.f, 0.f, 0.f};
#pragma unroll
            for (int ks = 0; ks < 2; ++ks) {
                const int r0 = 32 * ks + 8 * g + q;
                const LAS unsigned char* ap = V + r0 * 1056 + (dvq * 128 + 16 * w + 4 * p) * 2; const bf16x8 a = tr8(ap, ap + 4 * 1056);
#pragma unroll
                for (int ni = 0; ni < 16; ++ni) { const LAS unsigned char* bp = KD + r0 * 528 + (16 * ni + 4 * p) * 2; acc[ni] = mfma16(tr8(bp, bp + 4 * 528), a, acc[ni]); }
            }
            bf16_t* st = ST + ((size_t)(bh * 128 + c) << 17) + (size_t)(dvq * 128 + 16 * w + lr) * 256 + 4 * g;
#pragma unroll
            for (int ni = 0; ni < 16; ++ni) { const f32x4 e4 = *(const LAS f32x4*)(bl + 16 * ni + 4 * g); const f32x4 v4 = acc[ni] * e4;
                u32x2 wv; wv.x = pg8::cvt_pk_bf16(v4[0], v4[1]); wv.y = pg8::cvt_pk_bf16(v4[2], v4[3]); *(u32x2*)(st + 16 * ni) = wv; }
        }
        __syncthreads();
    }
}

__device__ __forceinline__ void gla_scan(const Ctx& C, bf16_t* ST, const float* DC) {
    for (int e8 = C.bid * 512 + C.tid; e8 < 8 * 16384; e8 += C.G * 512) {
        const int bh = e8 >> 14, off = e8 & 16383, dk = (off * 8) & 255;
        float s[8];
#pragma unroll
        for (int i = 0; i < 8; ++i) s[i] = 0.f;
        u32x4* p = (u32x4*)(ST + ((size_t)(bh * 128) << 17)) + off;
#pragma unroll 1
        for (int cb = 0; cb < 128; cb += 4) {
            u32x4 t[4]; f32x4 d0[4], d1[4];
#pragma unroll
            for (int i = 0; i < 4; ++i) { t[i] = p[(size_t)(cb + i) << 14]; const float* d = DC + (size_t)(bh * 128 + cb + i) * 256 + dk; d0[i] = *(const f32x4*)d; d1[i] = *(const f32x4*)(d + 4); }
#pragma unroll
            for (int i = 0; i < 4; ++i) {
                u32x4 o; o.x = pk2(s[0], s[1]); o.y = pk2(s[2], s[3]); o.z = pk2(s[4], s[5]); o.w = pk2(s[6], s[7]); p[(size_t)(cb + i) << 14] = o;
                s[0] = d0[i][0] * s[0] + bflo(t[i].x); s[1] = d0[i][1] * s[1] + bfhi(t[i].x); s[2] = d0[i][2] * s[2] + bflo(t[i].y); s[3] = d0[i][3] * s[3] + bfhi(t[i].y);
                s[4] = d1[i][0] * s[4] + bflo(t[i].z); s[5] = d1[i][1] * s[5] + bfhi(t[i].z); s[6] = d1[i][2] * s[6] + bflo(t[i].w); s[7] = d1[i][3] * s[7] + bfhi(t[i].w);
            }
        }
    }
}

__device__ __forceinline__ void gla_passC(const Ctx& C, const bf16_t* U, const bf16_t* QDG, const bf16_t* KDG, const bf16_t* ST, const float* gg, bf16_t* MIX) {
    LAS unsigned char* QD = C.lds; LAS unsigned char* KD = C.lds + 33792; LAS unsigned char* V = C.lds + 67584; LAS unsigned char* ATT = C.lds + 135168;
    LAS float* fss = (LAS float*)(C.lds + 144384);
    const int l = C.lane, g = l >> 4, q = (l & 15) >> 2, p = l & 3, w = C.wave, lr = l & 15;
    for (int u = C.bid; u < 1024; u += C.G) {
        const int bh = u >> 7, c = u & 127, b = bh >> 2, h = bh & 3; const size_t row0 = (size_t)b * SEQ + c * 64;
        { const int s = C.tid >> 3, seg = C.tid & 7; const bf16_t* vp = U + (row0 + s) * UW + 2048 + h * 512 + seg * 64;
#pragma unroll
          for (int i = 0; i < 8; ++i) *(LAS u32x4*)(V + s * 1056 + seg * 128 + 16 * i) = *(const u32x4*)(vp + 8 * i);
          const bf16_t* qg = QDG + (row0 + s) * 1024 + h * 256 + seg * 32; const bf16_t* kg = KDG + (row0 + s) * 1024 + h * 256 + seg * 32;
#pragma unroll
          for (int i = 0; i < 4; ++i) { *(LAS u32x4*)(QD + s * 528 + seg * 64 + 16 * i) = *(const u32x4*)(qg + 8 * i); *(LAS u32x4*)(KD + s * 528 + seg * 64 + 16 * i) = *(const u32x4*)(kg + 8 * i); } }
        __syncthreads();
#pragma unroll
        for (int tt = 0; tt < 2; ++tt) {
            const int tile = 2 * w + tt, ti = tile >> 2, si = tile & 3;
            f32x4 s4 = (f32x4){0.f, 0.f, 0.f, 0.f};
            if (si <= ti) {
#pragma unroll
                for (int ks = 0; ks < 8; ++ks) { const bf16x8 a = ldsv8(QD + (16 * ti + lr) * 528 + (32 * ks + 8 * g) * 2), bb = ldsv8(KD + (16 * si + lr) * 528 + (32 * ks + 8 * g) * 2); s4 = mfma16(a, bb, s4); }
            }
            const int sidx = 16 * si + lr;
#pragma unroll
            for (int j = 0; j < 4; ++j) { const int t = 16 * ti + 4 * g + j; *(LAS unsigned short*)(ATT + t * 144 + sidx * 2) = (unsigned short)f2bf((sidx <= t) ? s4[j] : 0.f); }
        }
        __syncthreads();
        f32x4 acc[4][4];
#pragma unroll
        for (int mi = 0; mi < 4; ++mi)
#pragma unroll
            for (int ni = 0; ni < 4; ++ni) acc[mi][ni] = (f32x4){0.f, 0.f, 0.f, 0.f};
        const bf16_t* st = ST + ((size_t)(bh * 128 + c) << 17);
#pragma unroll 4
        for (int ks = 0; ks < 8; ++ks) {
            bf16x8 bb[4];
#pragma unroll
            for (int ni = 0; ni < 4; ++ni) bb[ni] = *(const bf16x8*)(st + (size_t)(64 * w + 16 * ni + lr) * 256 + 32 * ks + 8 * g);
#pragma unroll
            for (int mi = 0; mi < 4; ++mi) { const bf16x8 a = ldsv8(QD + (16 * mi + lr) * 528 + (32 * ks + 8 * g) * 2);
#pragma unroll
                for (int ni = 0; ni < 4; ++ni) acc[mi][ni] = mfma16(bb[ni], a, acc[mi][ni]); }
        }
#pragma unroll
        for (int ks = 0; ks < 2; ++ks) {
            const int r0 = 32 * ks + 8 * g + q; bf16x8 bb[4];
#pragma unroll
            for (int ni = 0; ni < 4; ++ni) { const LAS unsigned char* bp = V + r0 * 1056 + (64 * w + 16 * ni + 4 * p) * 2; bb[ni] = tr8(bp, bp + 4 * 1056); }
#pragma unroll
            for (int mi = 0; mi < 4; ++mi) { const bf16x8 a = ldsv8(ATT + (16 * mi + lr) * 144 + (32 * ks + 8 * g) * 2);
#pragma unroll
                for (int ni = 0; ni < 4; ++ni) acc[mi][ni] = mfma16(bb[ni], a, acc[mi][ni]); }
        }
#pragma unroll
        for (int mi = 0; mi < 4; ++mi) { float ss = 0.f;
#pragma unroll
            for (int ni = 0; ni < 4; ++ni) ss += (acc[mi][ni][0] * acc[mi][ni][0] + acc[mi][ni][1] * acc[mi][ni][1]) + (acc[mi][ni][2] * acc[mi][ni][2] + acc[mi][ni][3] * acc[mi][ni][3]);
            ss += __shfl_xor(ss, 16); ss += __shfl_xor(ss, 32);
            if (g == 0) fss[w * 64 + 16 * mi + lr] = ss; }
        __syncthreads();
#pragma unroll
        for (int mi = 0; mi < 4; ++mi) { const int t = 16 * mi + lr; float tot = 0.f;
#pragma unroll
            for (int ww = 0; ww < 8; ++ww) tot += fss[ww * 64 + t];
            const float r = 1.f / sqrtf(tot * (1.f / 512.f) + 1e-6f);
#pragma unroll
            for (int ni = 0; ni < 4; ++ni) { const int dv = 64 * w + 16 * ni + 4 * g;
                const u32x2 rgb = *(const u32x2*)(U + (row0 + t) * UW + 4096 + h * 512 + dv); const f32x4 gv = *(const f32x4*)(gg + h * 512 + dv);
                const float r0 = bflo(rgb.x), r1 = bfhi(rgb.x), r2 = bflo(rgb.y), r3 = bfhi(rgb.y);
                const float o0 = acc[mi][ni][0] * r * gv[0] * r0 * pg8::sigmoidf_(r0), o1 = acc[mi][ni][1] * r * gv[1] * r1 * pg8::sigmoidf_(r1);
                const float o2 = acc[mi][ni][2] * r * gv[2] * r2 * pg8::sigmoidf_(r2), o3 = acc[mi][ni][3] * r * gv[3] * r3 * pg8::sigmoidf_(r3);
                u32x2 wv; wv.x = pg8::cvt_pk_bf16(o0, o1); wv.y = pg8::cvt_pk_bf16(o2, o3);
                *(u32x2*)(MIX + (row0 + t) * DM + h * 512 + dv) = wv; } }
        __syncthreads();
    }
}

__device__ __forceinline__ int crow(int r, int hi) { return (r & 3) + 8 * (r >> 2) + 4 * hi; }
__device__ __forceinline__ void attn_unit(const Ctx& C, const bf16_t* U, const float* rel_bias, const float* dg, float lam, int b, int h, int qb, bf16_t* MIX) {
    LAS unsigned char* KT0 = C.lds; LAS unsigned char* VT0 = C.lds + 2 * 17408; LAS float* tab = (LAS float*)(C.lds + 131072); LAS float* OX = (LAS float*)(C.lds);
    constexpr int KS = 272, VS = 320;
    const int l = C.lane, ql = l & 31, hi = l >> 5, g = l >> 4, qq = (l & 15) >> 2, pp = l & 3, w = C.wave, comp = w >> 2, rw = w & 3;
    const int qpos = qb * 128 + 32 * rw + ql;
    const size_t rowq = (size_t)b * SEQ + qpos;
    __syncthreads();
    if (C.tid < 128) { const int n = C.tid; int bk;
        if (n < 16) bk = n; else { bk = 16 + (int)(__logf((float)n * 0.0625f) / 2.0794415416798357f * 16.f); bk = bk < 31 ? bk : 31; }
        tab[n] = rel_bias[bk * 8 + h] * LOG2E; }
    const float b31 = rel_bias[31 * 8 + h] * LOG2E;
    LAS unsigned char* QT = C.lds + 96256;
    { const int row = C.tid >> 2, part = C.tid & 3; const bf16_t* qsrc = U + ((size_t)b * SEQ + qb * 128 + row) * UW + h * 128 + part * 32;
#pragma unroll
      for (int i = 0; i < 4; ++i) *(LAS u32x4*)(QT + row * 272 + part * 64 + 16 * i) = *(const u32x4*)(qsrc + 8 * i); }
    const LAS unsigned char* qfrag = QT + (32 * rw + ql) * 272 + (comp * 64 + 8 * hi) * 2;
    f32x16 o[4];
#pragma unroll
    for (int mb = 0; mb < 4; ++mb)
#pragma unroll
        for (int r = 0; r < 16; ++r) o[mb][r] = 0.f;
    float mrun = -1.0e30f, lrun = 0.f;
    u32x4 kreg[2], vreg[2];
    const bf16_t* srcb = U + ((size_t)b * SEQ + (C.tid >> 4)) * UW + h * 128 + (C.tid & 15) * 8;
    const int ntiles = 2 * (qb + 1);
#pragma unroll
    for (int i = 0; i < 2; ++i) { kreg[i] = *(const u32x4*)(srcb + (size_t)(32 * i) * UW + 1024); vreg[i] = *(const u32x4*)(srcb + (size_t)(32 * i) * UW + 2048); }
#pragma unroll
    for (int i = 0; i < 2; ++i) { const int key = (C.tid >> 4) + 32 * i, seg = C.tid & 15;
        *(LAS u32x4*)(KT0 + key * KS + seg * 16) = kreg[i]; *(LAS u32x4*)(VT0 + key * VS + seg * 16) = vreg[i]; }
#pragma unroll
    for (int i = 0; i < 2; ++i) { kreg[i] = *(const u32x4*)(srcb + (size_t)(64 + 32 * i) * UW + 1024); vreg[i] = *(const u32x4*)(srcb + (size_t)(64 + 32 * i) * UW + 2048); }
    int vs_cur = 0, vs_prev = 0; const bool rot = comp == 1;
    bf16x8 pb[4];
#pragma unroll
    for (int i = 0; i < 4; ++i) pb[i] = (bf16x8){0, 0, 0, 0, 0, 0, 0, 0};
#define ATT_PV(VSLOT) do { const LAS unsigned char* vb_ = VT0 + (VSLOT) * 20480 + (4 * hi + qq) * VS + (16 * (g & 1) + 4 * pp) * 2; _Pragma("unroll") for (int k2 = 0; k2 < 2; ++k2) _Pragma("unroll") for (int ks = 0; ks < 2; ++ks) { \
        bf16x8 af_[4]; _Pragma("unroll") for (int mb = 0; mb < 4; ++mb) { const LAS unsigned char* ap = vb_ + (32 * k2 + 16 * ks) * VS + 64 * mb; af_[mb] = tr8(ap, ap + 8 * VS); } \
        __builtin_amdgcn_sched_barrier(0); \
        _Pragma("unroll") for (int mb = 0; mb < 4; ++mb) o[mb] = mfma32(af_[mb], pb[2 * k2 + ks], o[mb]); } } while (0)
    for (int kt = 0; kt < ntiles; ++kt) {
        const int kb = kt * 64;
        __syncthreads();
        LAS unsigned char* KT = KT0 + (kt & 1) * 17408; LAS unsigned char* VT = VT0 + vs_cur * 20480;
        const int vs_nxt = vs_cur == 2 ? 0 : vs_cur + 1;
        if (kt + 1 < ntiles) {
            LAS unsigned char* KN = KT0 + ((kt + 1) & 1) * 17408; LAS unsigned char* VN = VT0 + vs_nxt * 20480;
#pragma unroll
            for (int i = 0; i < 2; ++i) { const int key = (C.tid >> 4) + 32 * i, seg = C.tid & 15;
                *(LAS u32x4*)(KN + key * KS + seg * 16) = kreg[i]; *(LAS u32x4*)(VN + key * VS + seg * 16) = vreg[i]; }
            if (kt + 2 < ntiles) {
#pragma unroll
                for (int i = 0; i < 2; ++i) { kreg[i] = *(const u32x4*)(srcb + (size_t)(kb + 128 + 32 * i) * UW + 1024); vreg[i] = *(const u32x4*)(srcb + (size_t)(kb + 128 + 32 * i) * UW + 2048); }
            }
        }
        if (rot && kt > 0) ATT_PV(vs_prev);
        __builtin_amdgcn_sched_barrier(0);
        f32x16 st[2];
#pragma unroll
        for (int k2 = 0; k2 < 2; ++k2) {
#pragma unroll
            for (int r = 0; r < 16; ++r) st[k2][r] = 0.f;
#pragma unroll
            for (int kk = 0; kk < 4; ++kk) st[k2] = mfma32(ldsv8(KT + (32 * k2 + ql) * KS + (comp * 64 + 16 * kk + 8 * hi) * 2), ldsv8(qfrag + 32 * kk), st[k2]);
        }
        __builtin_amdgcn_sched_barrier(0);
        const bool far = (qb * 128 + 32 * rw - (kb + 63)) >= 127;
        float mx = -1.0e30f, cadd;
        if (far) {
#pragma unroll
            for (int k2 = 0; k2 < 2; ++k2)
#pragma unroll
                for (int r = 0; r < 16; r += 2) mx = fmaxf(fmaxf(st[k2][r], st[k2][r + 1]), mx);
            mx = mx * LOG2E + b31; cadd = b31;
        } else {
#pragma unroll
            for (int k2 = 0; k2 < 2; ++k2)
#pragma unroll
                for (int r = 0; r < 16; ++r) { const int rel = qpos - (kb + 32 * k2 + crow(r, hi)); const int ri = rel < 0 ? 0 : (rel > 127 ? 127 : rel);
                    const float t = st[k2][r] * LOG2E + tab[ri]; st[k2][r] = (rel >= 0 ? t : -1.0e30f) * (1.0f / LOG2E); mx = fmaxf(mx, rel >= 0 ? t : -1.0e30f); }
            cadd = 0.f;
        }
        mx = fmaxf(mx, __shfl_xor(mx, 32));
        const float mnew = fmaxf(mrun, mx), alpha = __builtin_amdgcn_exp2f(mrun - mnew);
        const bool grew = mnew > mrun; mrun = mnew;
        const float cst = cadd - mnew;
        float ps = 0.f;
#pragma unroll
        for (int k2 = 0; k2 < 2; ++k2)
#pragma unroll
            for (int r = 0; r < 16; ++r) { const float pv = __builtin_amdgcn_exp2f(__builtin_fmaf(st[k2][r], LOG2E, cst)); st[k2][r] = pv; ps += pv; }
        lrun = lrun * alpha + ps;
        if (__any(grew)) {
#pragma unroll
            for (int mb = 0; mb < 4; ++mb)
#pragma unroll
                for (int r = 0; r < 16; ++r) o[mb][r] *= alpha;
        }
        __builtin_amdgcn_sched_barrier(0);
#pragma unroll
        for (int k2 = 0; k2 < 2; ++k2)
#pragma unroll
            for (int ks = 0; ks < 2; ++ks) { const int r8 = 8 * ks;
                const unsigned w0 = pg8::cvt_pk_bf16(st[k2][r8 + 0], st[k2][r8 + 1]), w1 = pg8::cvt_pk_bf16(st[k2][r8 + 2], st[k2][r8 + 3]), w2 = pg8::cvt_pk_bf16(st[k2][r8 + 4], st[k2][r8 + 5]), w3 = pg8::cvt_pk_bf16(st[k2][r8 + 6], st[k2][r8 + 7]);
                const u32x4 wv = (u32x4){w0, w1, w2, w3}; pb[2 * k2 + ks] = __builtin_bit_cast(bf16x8, wv); }
        __builtin_amdgcn_sched_barrier(0);
        if (!rot) ATT_PV(vs_cur);
        vs_prev = vs_cur; vs_cur = vs_nxt;
    }
    if (rot) ATT_PV(vs_prev);
#undef ATT_PV
    const float ltot = lrun + __shfl_xor(lrun, 32), inv = 1.f / ltot;
    int l2 = C.lane; asm volatile("" : "+v"(l2));
    const int ql_e = l2 & 31, hi_e = l2 >> 5;
    const size_t rowq_e = (size_t)b * SEQ + qb * 128 + 32 * rw + ql_e;
    __syncthreads();
    if (comp == 1) {
#pragma unroll
        for (int mb = 0; mb < 4; ++mb)
#pragma unroll
            for (int r = 0; r < 16; ++r) OX[(rw * 128 + 32 * mb + crow(r, hi_e)) * 32 + ql_e] = o[mb][r] * inv;
    }
    __syncthreads();
    if (comp == 0) {
        float ss = 0.f;
#pragma unroll
        for (int mb = 0; mb < 4; ++mb)
#pragma unroll
            for (int r = 0; r < 16; ++r) { const float y = o[mb][r] * inv - lam * OX[(rw * 128 + 32 * mb + crow(r, hi_e)) * 32 + ql_e]; o[mb][r] = y; ss += y * y; }
        ss += __shfl_xor(ss, 32);
        const float rn = (1.f / sqrtf(ss * (1.f / 128.f) + 1e-6f)) * 0.8f;
#pragma unroll
        for (int mb = 0; mb < 4; ++mb)
#pragma unroll
            for (int r4 = 0; r4 < 4; ++r4) { const int dv = 32 * mb + 8 * r4 + 4 * hi_e; const f32x4 gv = *(const f32x4*)(dg + h * 128 + dv);
                u32x2 wv; wv.x = pk2(o[mb][4 * r4] * rn * gv[0], o[mb][4 * r4 + 1] * rn * gv[1]); wv.y = pk2(o[mb][4 * r4 + 2] * rn * gv[2], o[mb][4 * r4 + 3] * rn * gv[3]);
                *(u32x2*)(MIX + rowq_e * DM + h * 128 + dv) = wv; }
    }
}
__device__ __forceinline__ void attn_phase(const Ctx& C, const bf16_t* U, const float* rel_bias, const float* dg, const float* lq1, const float* lk1, const float* lq2, const float* lk2, bf16_t* MIX) {
    float s1 = 0.f, s2 = 0.f;
#pragma unroll 4
    for (int i = 0; i < 64; ++i) { s1 += lq1[i] * lk1[i]; s2 += lq2[i] * lk2[i]; }
    const float lam = __expf(s1) - __expf(s2) + 0.2f;
    const bool xa = (C.G == 256);
#pragma unroll 1
    for (int k = 0; k < 512; ++k) {
        int pr;
        if (xa) { if (k >= 2) break; pr = (2 * (C.bid & 7) + k) * 32 + (C.bid >> 3); } else { pr = C.bid + k * C.G; if (pr >= 512) break; }
        const int bh = pr >> 5, i = pr & 31, b = bh >> 3, h = bh & 7;
        attn_unit(C, U, rel_bias, dg, lam, b, h, i, MIX);
        attn_unit(C, U, rel_bias, dg, lam, b, h, 63 - i, MIX);
    }
    __syncthreads();
}

struct Args {
    const float* x; const float* p; const float* ln_g; const float* ln_b; const float* w_ffn_in; const float* w_ffn_out; const float* w_in_ab; const float* w_out_ab;
    const float* rel_bias; const float* lq1; const float* lk1; const float* lq2; const float* lk2; const float* diff_norm; const float* conv_w; const float* conv_b;
    const float* b_igate; const float* b_fgate; const float* mlstm_norm; const float* w_in_c; const float* w_alpha2; const float* b_alpha; const float* gla_norm;
    const float* w_out_c; const float* w_ple_proj; const float* w_ple_gate;
    float* out; unsigned char* ws;
    int ph_lo, ph_hi;
};


constexpr int ARGS_OFF = 147200;
enum { A_x = 0, A_p, A_ln_g, A_ln_b, A_w_ffn_in, A_w_ffn_out, A_w_in_ab, A_w_out_ab, A_rel_bias, A_lq1, A_lk1, A_lq2, A_lk2, A_diff_norm, A_conv_w, A_conv_b,
       A_b_igate, A_b_fgate, A_mlstm_norm, A_w_in_c, A_w_alpha2, A_b_alpha, A_gla_norm, A_w_out_c, A_w_ple_proj, A_w_ple_gate, A_out, A_ws };
__device__ __forceinline__ unsigned char* ldarg(LAS unsigned char* lds, int i) {
    volatile LAS unsigned* p = (volatile LAS unsigned*)(lds + ARGS_OFF) + 2 * i;
    const unsigned lo = __builtin_amdgcn_readfirstlane(p[0]), hi = __builtin_amdgcn_readfirstlane(p[1]);
    return (unsigned char*)(__attribute__((address_space(1))) unsigned char*)(((unsigned long long)hi << 32) | lo);
}
#define ARGF(i) ((const float*)ldarg(C.lds, (i)))
#define WSP(T, off) ((T*)(ldarg(C.lds, A_ws) + (off)))


__device__ __forceinline__ void grid_barrier(unsigned* ctr, unsigned target, bool leader) {
    asm volatile("s_waitcnt vmcnt(0) lgkmcnt(0)" ::: "memory");
    __syncthreads();
    if (leader) {
        __builtin_amdgcn_fence(__ATOMIC_RELEASE, "agent");
        asm volatile("s_waitcnt vmcnt(0)" ::: "memory");
        (void)__hip_atomic_fetch_add(ctr, 1u, __ATOMIC_RELAXED, __HIP_MEMORY_SCOPE_AGENT);
        while (__hip_atomic_load(ctr, __ATOMIC_RELAXED, __HIP_MEMORY_SCOPE_AGENT) < target) __builtin_amdgcn_s_sleep(1);
        __builtin_amdgcn_fence(__ATOMIC_ACQUIRE, "agent");
        asm volatile("s_waitcnt vmcnt(0)" ::: "memory");
    }
    __syncthreads();
}

#define XB_TMO      128
#define XB_XCNT(j)  (256  + 64 * (j))
#define XB_XSUB(j)  (1280 + 64 * (j))
#define XB_XGEN(j)  (2304 + 64 * (j))
#define XB_TOP      3328
#define XB_TOPGEN   3392
#define XCD_BAR_WORDS 3456
#define XB_SPIN_CAP (1u << 22)
__device__ __forceinline__ unsigned xb_ld(unsigned* p)              { return __hip_atomic_load(p, __ATOMIC_RELAXED, __HIP_MEMORY_SCOPE_AGENT); }
__device__ __forceinline__ unsigned xb_add(unsigned* p, unsigned v) { return __hip_atomic_fetch_add(p, v, __ATOMIC_RELAXED, __HIP_MEMORY_SCOPE_AGENT); }
__device__ __forceinline__ unsigned xb_xcc_id() { return (unsigned)__builtin_amdgcn_s_getreg((3 << 11) | 20) & 0xFu; }
#define XB_SPIN(cond, bar) do { unsigned _sp = 0; while (cond) { __builtin_amdgcn_s_sleep(1); \
    if ((++_sp & 255u) == 0u) { if (xb_ld(&(bar)[XB_TMO])) break; if (_sp > XB_SPIN_CAP) { atomicAdd(&(bar)[XB_TMO], 1u); break; } } } } while (0)
__device__ __forceinline__ void xcd_barrier_complete(unsigned* bar, unsigned x, unsigned& nloc, unsigned& nx) {
    const unsigned G = gridDim.x;
    unsigned sum, cnt, mine, sp = 0u;
    for (;;) {
        sum = 0u; cnt = 0u; mine = 0u;
#pragma unroll
        for (unsigned j = 0; j < 16; ++j) { const unsigned c = xb_ld(&bar[XB_XCNT(j)]); sum += c; cnt += (c > 0u) ? 1u : 0u; mine = (j == x) ? c : mine; }
        if (sum == G) break;
        __builtin_amdgcn_s_sleep(1);
        if ((++sp & 255u) == 0u) { if (xb_ld(&bar[XB_TMO])) break; if (sp > XB_SPIN_CAP) { atomicAdd(&bar[XB_TMO], 1u); break; } }
    }
    nloc = mine > 0u ? mine : 1u; nx = cnt > 0u ? cnt : 1u;
}
__device__ __forceinline__ void xcd_barrier(unsigned* bar, volatile LAS unsigned* st, bool leader) {
    asm volatile("s_waitcnt vmcnt(0)" ::: "memory");
    __syncthreads();
    if (leader) {
        __builtin_amdgcn_s_waitcnt(0);
        const unsigned x = xb_xcc_id();
        unsigned nloc = st[0], nx = st[1];
        if (nloc == 0u) { xcd_barrier_complete(bar, x, nloc, nx); st[0] = nloc; st[1] = nx; }
        const unsigned old = xb_add(&bar[XB_XSUB(x)], 1u);
        const unsigned gen = old / nloc;
        if (old + 1u == (gen + 1u) * nloc) {
            __builtin_amdgcn_fence(__ATOMIC_RELEASE, "agent");
            asm volatile("s_waitcnt vmcnt(0)" ::: "memory");
            const unsigned og = xb_add(&bar[XB_TOP], 1u);
            const unsigned tg = og / nx;
            if (og + 1u == (tg + 1u) * nx) xb_add(&bar[XB_TOPGEN], 1u);
            else XB_SPIN(xb_ld(&bar[XB_TOPGEN]) == tg, bar);
            __builtin_amdgcn_fence(__ATOMIC_ACQUIRE, "agent");
            xb_add(&bar[XB_XGEN(x)], 1u);
            asm volatile("s_waitcnt vmcnt(0)" ::: "memory");
        } else {
            XB_SPIN(xb_ld(&bar[XB_XGEN(x)]) == gen, bar);
            __builtin_amdgcn_fence(__ATOMIC_ACQUIRE, "agent");
            asm volatile("s_waitcnt vmcnt(0)" ::: "memory");
        }
    }
    __syncthreads();
}

#define GEMM_CALL(EPI, Aptr, Bptr, Nn, Kk, Eobj) do { pg8::Gemm g_{(const bf16_t*)(Aptr), (const bf16_t*)(Bptr), MT, (Nn), (Kk)}; pg8::StaticOrder S_; S_.init(MT, (Nn), C.G, C.bid); \
    pg8::gemm_phase<EPI, pg8::StaticOrder, true, true>(C.lds, g_, S_, Eobj, C.tid); } while (0)

__global__ void __launch_bounds__(512, 2) mega_fwd(Args a) {
    extern __shared__ __attribute__((aligned(16))) unsigned char lds_raw[];
    cg::grid_group grid = cg::this_grid();
    if (threadIdx.x == 0) {
        LAS unsigned long long* t = (LAS unsigned long long*)((LAS unsigned char*)lds_raw + ARGS_OFF);
        t[A_x] = (unsigned long long)a.x; t[A_p] = (unsigned long long)a.p; t[A_ln_g] = (unsigned long long)a.ln_g; t[A_ln_b] = (unsigned long long)a.ln_b;
        t[A_w_ffn_in] = (unsigned long long)a.w_ffn_in; t[A_w_ffn_out] = (unsigned long long)a.w_ffn_out; t[A_w_in_ab] = (unsigned long long)a.w_in_ab; t[A_w_out_ab] = (unsigned long long)a.w_out_ab;
        t[A_rel_bias] = (unsigned long long)a.rel_bias; t[A_lq1] = (unsigned long long)a.lq1; t[A_lk1] = (unsigned long long)a.lk1; t[A_lq2] = (unsigned long long)a.lq2; t[A_lk2] = (unsigned long long)a.lk2;
        t[A_diff_norm] = (unsigned long long)a.diff_norm; t[A_conv_w] = (unsigned long long)a.conv_w; t[A_conv_b] = (unsigned long long)a.conv_b; t[A_b_igate] = (unsigned long long)a.b_igate;
        t[A_b_fgate] = (unsigned long long)a.b_fgate; t[A_mlstm_norm] = (unsigned long long)a.mlstm_norm; t[A_w_in_c] = (unsigned long long)a.w_in_c; t[A_w_alpha2] = (unsigned long long)a.w_alpha2;
        t[A_b_alpha] = (unsigned long long)a.b_alpha; t[A_gla_norm] = (unsigned long long)a.gla_norm; t[A_w_out_c] = (unsigned long long)a.w_out_c; t[A_w_ple_proj] = (unsigned long long)a.w_ple_proj;
        t[A_w_ple_gate] = (unsigned long long)a.w_ple_gate; t[A_out] = (unsigned long long)a.out; t[A_ws] = (unsigned long long)a.ws;
        t[30] = 0ull;
    }
    __syncthreads();
    const int ph_lo = a.ph_lo, ph_hi = a.ph_hi;
    int ph = 0; unsigned nbar = 0, ngb = 0;
    const int wave_s = __builtin_amdgcn_readfirstlane((int)(threadIdx.x >> 6));
#ifndef REPMASK
#define REPMASK 0
#endif
#define PHASE_BEGIN_G(grp) if (ph >= ph_lo && ph < ph_hi) for (int rep_ = 0; rep_ < (((REPMASK >> (grp)) & 1) ? 2 : 1); ++rep_) { Ctx C; { int t_ = wave_s * 64 + (int)__builtin_amdgcn_mbcnt_hi(~0u, __builtin_amdgcn_mbcnt_lo(~0u, 0u)); asm volatile("" : "+v"(t_)); C.lds = (LAS unsigned char*)lds_raw; C.tid = t_; C.lane = t_ & 63; C.wave = __builtin_amdgcn_readfirstlane(t_ >> 6); \
    C.G = gridDim.x; C.bid = blockIdx.x; C.gw = C.bid * 8 + C.wave; C.NGW = C.G * 8; }
#define PHASE_BEGIN PHASE_BEGIN_G(31)
#ifndef SYNCREP
#define SYNCREP 1
#endif
#define PHASE_END_K(GROUPWISE) } ++ph; if (ph > ph_lo && ph < ph_hi) { for (int sr_ = 0; sr_ < SYNCREP; ++sr_) { \
        unsigned* ctl_ = (unsigned*)(ldarg((LAS unsigned char*)lds_raw, A_ws) + OFF_CTL); const bool lead_ = wave_s == 0 && __builtin_amdgcn_mbcnt_hi(~0u, __builtin_amdgcn_mbcnt_lo(~0u, 0u)) == 0u; \
        if ((GROUPWISE) && (gridDim.x & 7u) == 0u) { ++ngb; grid_barrier(ctl_ + 64 * (1 + (blockIdx.x & 7u)), ngb * (gridDim.x >> 3), lead_); } \
        else { xcd_barrier(ctl_ + 1024, (volatile LAS unsigned*)((LAS unsigned char*)lds_raw + ARGS_OFF + 240), lead_); } } }
#define PHASE_END PHASE_END_K(0)
#define PHASE_END_NONE } ++ph;
#define PHASE_END_ROWS PHASE_END_K(0)

    PHASE_BEGIN_G(0)
        if (C.bid == 0) { unsigned* ctl0_ = (unsigned*)(ldarg(C.lds, A_ws) + OFF_CTL); for (int i_ = C.tid; i_ < 1024 + XCD_BAR_WORDS; i_ += 512) ctl0_[i_] = 0u; }
        int base = 0;
        for (int i = 0; i < 4; ++i) conv_matrix(C, ARGF(A_w_ffn_in) + (size_t)i * DM * NFF2, DM, NFF2, NFF2, WSP(bf16_t, OFF_WFI) + (size_t)i * NFF2 * DM, 1, base);
        for (int i = 0; i < 4; ++i) conv_matrix(C, ARGF(A_w_ffn_out) + (size_t)i * DFF * DM, DFF, DM, DM, WSP(bf16_t, OFF_WFO) + (size_t)i * DM * DFF, 0, base);
        conv_matrix(C, ARGF(A_w_in_ab), DM, 6152, NIN, WSP(bf16_t, OFF_WAB), 2, base);
        conv_matrix(C, ARGF(A_w_in_c), DM, 6160, NIN, WSP(bf16_t, OFF_WC), 0, base);
        conv_matrix(C, ARGF(A_w_out_ab), DM, DM, DM, WSP(bf16_t, OFF_WOAB), 0, base);
        conv_matrix(C, ARGF(A_w_out_c), DM, DM, DM, WSP(bf16_t, OFF_WOC), 0, base);
        for (int i = 0; i < 2; ++i) conv_matrix(C, ARGF(A_w_ple_gate) + (size_t)i * DM * DM, DM, DM, DM, WSP(bf16_t, OFF_WPG) + (size_t)i * DM * DM, 0, base);
        for (int i = 0; i < 2; ++i) conv_matrix(C, ARGF(A_w_ple_proj) + (size_t)i * PLE * DM, PLE, DM, DM, WSP(bf16_t, OFF_WPP) + (size_t)i * DM * PLE, 0, base);
        cvt_rows(C, ARGF(A_x), WSP(bf16_t, OFF_XB), (size_t)MT * DM / 4);
        cvt_rows(C, ARGF(A_p), WSP(bf16_t, OFF_PB), (size_t)2 * MT * PLE / 4);
        __syncthreads();
    } ++ph; if (ph > ph_lo && ph < ph_hi) { grid.sync(); if (wave_s == 0 && __builtin_amdgcn_mbcnt_hi(~0u, __builtin_amdgcn_mbcnt_lo(~0u, 0u)) == 0u) (void)xb_add((unsigned*)(ldarg((LAS unsigned char*)lds_raw, A_ws) + OFF_CTL) + 1024 + XB_XCNT(xb_xcc_id()), 1u); }

    { constexpr int L = 0;
        PHASE_BEGIN_G(1) { pg8::EpiSwiglu e{WSP(bf16_t, OFF_H), DFF}; GEMM_CALL(pg8::EpiSwiglu, WSP(bf16_t, (L == 0 ? OFF_XB : OFF_MIX)), WSP(bf16_t, OFF_WFI) + (size_t)(2 * L) * NFF2 * DM, NFF2, DM, e); }
            if (L == 0) { for (int l2 = 0; l2 < 2; ++l2) { pg8::EpiStore e2{WSP(bf16_t, OFF_XF) + (size_t)l2 * MT * DM, DM, DM, nullptr}; GEMM_CALL(pg8::EpiStore, WSP(bf16_t, OFF_PB) + (size_t)l2 * MT * PLE, WSP(bf16_t, OFF_WPP) + (size_t)l2 * DM * PLE, DM, PLE, e2); } } PHASE_END_ROWS
        PHASE_BEGIN_G(1) { if (L == 0) { pg8::EpiZ<true> e{(const void*)ARGF(A_x), WSP(bf16_t, OFF_Z), ALPHA, 0.5f}; GEMM_CALL(pg8::EpiZ<true>, WSP(bf16_t, OFF_H), WSP(bf16_t, OFF_WFO) + (size_t)(2 * L) * DM * DFF, DM, DFF, e); } else { pg8::EpiZ<false> e{(const void*)WSP(bf16_t, OFF_MIX), WSP(bf16_t, OFF_Z), ALPHA, 0.5f}; GEMM_CALL(pg8::EpiZ<false>, WSP(bf16_t, OFF_H), WSP(bf16_t, OFF_WFO) + (size_t)(2 * L) * DM * DFF, DM, DFF, e); } } PHASE_END_ROWS
        PHASE_BEGIN_G(3) ln_phase<true>(C, WSP(bf16_t, OFF_Z), ARGF(A_ln_g) + (size_t)(3 * L) * DM, ARGF(A_ln_b) + (size_t)(3 * L) * DM, WSP(bf16_t, OFF_XB), (L == 0 ? ARGF(A_w_in_ab) : ARGF(A_w_in_c)), (L == 0 ? 6152 : 6160), (L == 0 ? 8 : 16), WSP(float, OFF_GT)); PHASE_END
        PHASE_BEGIN_G(2) { pg8::EpiStore e{WSP(bf16_t, OFF_H), UW, UW, nullptr}; GEMM_CALL(pg8::EpiStore, WSP(bf16_t, OFF_XB), WSP(bf16_t, (L == 0 ? OFF_WAB : OFF_WC)), NIN, DM, e); } PHASE_END
        if (L == 0) {
            PHASE_BEGIN_G(5) m1_phase(C, WSP(bf16_t, OFF_H), WSP(float, OFF_GT), ARGF(A_conv_w), ARGF(A_conv_b), ARGF(A_b_igate), ARGF(A_b_fgate), WSP(bf16_t, OFF_QB), WSP(bf16_t, OFF_KB), WSP(float, OFF_BC), WSP(float, OFF_IP), WSP(float, OFF_MSC)); PHASE_END
            PHASE_BEGIN
                mlstm_passA(C, WSP(bf16_t, OFF_H), WSP(bf16_t, OFF_KB), WSP(float, OFF_BC), WSP(float, OFF_IP), WSP(float, OFF_MSC), WSP(bf16_t, OFF_ST), WSP(float, OFF_NL));
                for (int rep2_ = 0; rep2_ < (((REPMASK >> 4) & 1) ? 2 : 1); ++rep2_)
                attn_phase(C, WSP(bf16_t, OFF_H), ARGF(A_rel_bias), ARGF(A_diff_norm), ARGF(A_lq1), ARGF(A_lk1), ARGF(A_lq2), ARGF(A_lk2), WSP(bf16_t, OFF_MIX));
            PHASE_END
            PHASE_BEGIN mlstm_scan(C, WSP(bf16_t, OFF_ST), WSP(float, OFF_NL), WSP(float, OFF_MSC)); PHASE_END
            PHASE_BEGIN_G(5) mlstm_passC(C, WSP(bf16_t, OFF_H), WSP(bf16_t, OFF_QB), WSP(bf16_t, OFF_KB), WSP(float, OFF_BC), WSP(float, OFF_IP), WSP(float, OFF_MSC), WSP(bf16_t, OFF_ST), WSP(float, OFF_NL), ARGF(A_mlstm_norm), WSP(bf16_t, OFF_MIX)); PHASE_END
        } else {
            PHASE_BEGIN_G(6) gla_passA(C, WSP(bf16_t, OFF_H), WSP(float, OFF_GT), ARGF(A_w_alpha2), ARGF(A_b_alpha), WSP(bf16_t, OFF_ST), WSP(float, OFF_DC), WSP(bf16_t, OFF_Z), WSP(bf16_t, OFF_Z + (size_t)MT * 1024 * 2)); PHASE_END
            PHASE_BEGIN gla_scan(C, WSP(bf16_t, OFF_ST), WSP(float, OFF_DC)); PHASE_END
            PHASE_BEGIN_G(7) gla_passC(C, WSP(bf16_t, OFF_H), WSP(bf16_t, OFF_Z), WSP(bf16_t, OFF_Z + (size_t)MT * 1024 * 2), WSP(bf16_t, OFF_ST), ARGF(A_gla_norm), WSP(bf16_t, OFF_MIX)); PHASE_END
        }
        PHASE_BEGIN_G(1) { pg8::EpiZ<false> e{(const void*)WSP(bf16_t, OFF_XB), WSP(bf16_t, OFF_Z), ALPHA, 1.0f}; GEMM_CALL(pg8::EpiZ<false>, WSP(bf16_t, OFF_MIX), WSP(bf16_t, (L == 0 ? OFF_WOAB : OFF_WOC)), DM, DM, e); } PHASE_END_ROWS
        PHASE_BEGIN_G(3) ln_phase<false>(C, WSP(bf16_t, OFF_Z), ARGF(A_ln_g) + (size_t)(3 * L + 1) * DM, ARGF(A_ln_b) + (size_t)(3 * L + 1) * DM, WSP(bf16_t, OFF_XB), nullptr, 0, 0, nullptr); PHASE_END_ROWS
        PHASE_BEGIN_G(1) { pg8::EpiSwiglu e{WSP(bf16_t, OFF_H), DFF}; GEMM_CALL(pg8::EpiSwiglu, WSP(bf16_t, OFF_XB), WSP(bf16_t, OFF_WFI) + (size_t)(2 * L + 1) * NFF2 * DM, NFF2, DM, e); } PHASE_END_ROWS
        PHASE_BEGIN_G(1) { pg8::EpiZ<false> e{(const void*)WSP(bf16_t, OFF_XB), WSP(bf16_t, OFF_Z), ALPHA, 0.5f}; GEMM_CALL(pg8::EpiZ<false>, WSP(bf16_t, OFF_H), WSP(bf16_t, OFF_WFO) + (size_t)(2 * L + 1) * DM * DFF, DM, DFF, e); } PHASE_END_ROWS
        PHASE_BEGIN_G(3) ln_phase<false>(C, WSP(bf16_t, OFF_Z), ARGF(A_ln_g) + (size_t)(3 * L + 2) * DM, ARGF(A_ln_b) + (size_t)(3 * L + 2) * DM, WSP(bf16_t, OFF_XB), nullptr, 0, 0, nullptr); PHASE_END_ROWS
        PHASE_BEGIN { pg8::EpiPle e{WSP(const bf16_t, OFF_XB), WSP(const bf16_t, OFF_XF) + (size_t)L * MT * DM, (L == 1) ? (float*)ldarg(C.lds, A_out) : (float*)nullptr, (L == 1) ? (bf16_t*)nullptr : WSP(bf16_t, OFF_MIX)}; GEMM_CALL(pg8::EpiPle, WSP(bf16_t, OFF_XB), WSP(bf16_t, OFF_WPG) + (size_t)L * DM * DM, DM, DM, e); } PHASE_END_ROWS
        }
    { constexpr int L = 1;
        PHASE_BEGIN_G(1) { pg8::EpiSwiglu e{WSP(bf16_t, OFF_H), DFF}; GEMM_CALL(pg8::EpiSwiglu, WSP(bf16_t, (L == 0 ? OFF_XB : OFF_MIX)), WSP(bf16_t, OFF_WFI) + (size_t)(2 * L) * NFF2 * DM, NFF2, DM, e); }
            if (L == 0) { for (int l2 = 0; l2 < 2; ++l2) { pg8::EpiStore e2{WSP(bf16_t, OFF_XF) + (size_t)l2 * MT * DM, DM, DM, nullptr}; GEMM_CALL(pg8::EpiStore, WSP(bf16_t, OFF_PB) + (size_t)l2 * MT * PLE, WSP(bf16_t, OFF_WPP) + (size_t)l2 * DM * PLE, DM, PLE, e2); } } PHASE_END_ROWS
        PHASE_BEGIN_G(1) { if (L == 0) { pg8::EpiZ<true> e{(const void*)ARGF(A_x), WSP(bf16_t, OFF_Z), ALPHA, 0.5f}; GEMM_CALL(pg8::EpiZ<true>, WSP(bf16_t, OFF_H), WSP(bf16_t, OFF_WFO) + (size_t)(2 * L) * DM * DFF, DM, DFF, e); } else { pg8::EpiZ<false> e{(const void*)WSP(bf16_t, OFF_MIX), WSP(bf16_t, OFF_Z), ALPHA, 0.5f}; GEMM_CALL(pg8::EpiZ<false>, WSP(bf16_t, OFF_H), WSP(bf16_t, OFF_WFO) + (size_t)(2 * L) * DM * DFF, DM, DFF, e); } } PHASE_END_ROWS
        PHASE_BEGIN_G(3) ln_phase<true>(C, WSP(bf16_t, OFF_Z), ARGF(A_ln_g) + (size_t)(3 * L) * DM, ARGF(A_ln_b) + (size_t)(3 * L) * DM, WSP(bf16_t, OFF_XB), (L == 0 ? ARGF(A_w_in_ab) : ARGF(A_w_in_c)), (L == 0 ? 6152 : 6160), (L == 0 ? 8 : 16), WSP(float, OFF_GT)); PHASE_END
        PHASE_BEGIN_G(2) { pg8::EpiStore e{WSP(bf16_t, OFF_H), UW, UW, nullptr}; GEMM_CALL(pg8::EpiStore, WSP(bf16_t, OFF_XB), WSP(bf16_t, (L == 0 ? OFF_WAB : OFF_WC)), NIN, DM, e); } PHASE_END
        if (L == 0) {
            PHASE_BEGIN_G(5) m1_phase(C, WSP(bf16_t, OFF_H), WSP(float, OFF_GT), ARGF(A_conv_w), ARGF(A_conv_b), ARGF(A_b_igate), ARGF(A_b_fgate), WSP(bf16_t, OFF_QB), WSP(bf16_t, OFF_KB), WSP(float, OFF_BC), WSP(float, OFF_IP), WSP(float, OFF_MSC)); PHASE_END
            PHASE_BEGIN
                mlstm_passA(C, WSP(bf16_t, OFF_H), WSP(bf16_t, OFF_KB), WSP(float, OFF_BC), WSP(float, OFF_IP), WSP(float, OFF_MSC), WSP(bf16_t, OFF_ST), WSP(float, OFF_NL));
                for (int rep2_ = 0; rep2_ < (((REPMASK >> 4) & 1) ? 2 : 1); ++rep2_)
                attn_phase(C, WSP(bf16_t, OFF_H), ARGF(A_rel_bias), ARGF(A_diff_norm), ARGF(A_lq1), ARGF(A_lk1), ARGF(A_lq2), ARGF(A_lk2), WSP(bf16_t, OFF_MIX));
            PHASE_END
            PHASE_BEGIN mlstm_scan(C, WSP(bf16_t, OFF_ST), WSP(float, OFF_NL), WSP(float, OFF_MSC)); PHASE_END
            PHASE_BEGIN_G(5) mlstm_passC(C, WSP(bf16_t, OFF_H), WSP(bf16_t, OFF_QB), WSP(bf16_t, OFF_KB), WSP(float, OFF_BC), WSP(float, OFF_IP), WSP(float, OFF_MSC), WSP(bf16_t, OFF_ST), WSP(float, OFF_NL), ARGF(A_mlstm_norm), WSP(bf16_t, OFF_MIX)); PHASE_END
        } else {
            PHASE_BEGIN_G(6) gla_passA(C, WSP(bf16_t, OFF_H), WSP(float, OFF_GT), ARGF(A_w_alpha2), ARGF(A_b_alpha), WSP(bf16_t, OFF_ST), WSP(float, OFF_DC), WSP(bf16_t, OFF_Z), WSP(bf16_t, OFF_Z + (size_t)MT * 1024 * 2)); PHASE_END
            PHASE_BEGIN gla_scan(C, WSP(bf16_t, OFF_ST), WSP(float, OFF_DC)); PHASE_END
            PHASE_BEGIN_G(7) gla_passC(C, WSP(bf16_t, OFF_H), WSP(bf16_t, OFF_Z), WSP(bf16_t, OFF_Z + (size_t)MT * 1024 * 2), WSP(bf16_t, OFF_ST), ARGF(A_gla_norm), WSP(bf16_t, OFF_MIX)); PHASE_END
        }
        PHASE_BEGIN_G(1) { pg8::EpiZ<false> e{(const void*)WSP(bf16_t, OFF_XB), WSP(bf16_t, OFF_Z), ALPHA, 1.0f}; GEMM_CALL(pg8::EpiZ<false>, WSP(bf16_t, OFF_MIX), WSP(bf16_t, (L == 0 ? OFF_WOAB : OFF_WOC)), DM, DM, e); } PHASE_END_ROWS
        PHASE_BEGIN_G(3) ln_phase<false>(C, WSP(bf16_t, OFF_Z), ARGF(A_ln_g) + (size_t)(3 * L + 1) * DM, ARGF(A_ln_b) + (size_t)(3 * L + 1) * DM, WSP(bf16_t, OFF_XB), nullptr, 0, 0, nullptr); PHASE_END_ROWS
        PHASE_BEGIN_G(1) { pg8::EpiSwiglu e{WSP(bf16_t, OFF_H), DFF}; GEMM_CALL(pg8::EpiSwiglu, WSP(bf16_t, OFF_XB), WSP(bf16_t, OFF_WFI) + (size_t)(2 * L + 1) * NFF2 * DM, NFF2, DM, e); } PHASE_END_ROWS
        PHASE_BEGIN_G(1) { pg8::EpiZ<false> e{(const void*)WSP(bf16_t, OFF_XB), WSP(bf16_t, OFF_Z), ALPHA, 0.5f}; GEMM_CALL(pg8::EpiZ<false>, WSP(bf16_t, OFF_H), WSP(bf16_t, OFF_WFO) + (size_t)(2 * L + 1) * DM * DFF, DM, DFF, e); } PHASE_END_ROWS
        PHASE_BEGIN_G(3) ln_phase<false>(C, WSP(bf16_t, OFF_Z), ARGF(A_ln_g) + (size_t)(3 * L + 2) * DM, ARGF(A_ln_b) + (size_t)(3 * L + 2) * DM, WSP(bf16_t, OFF_XB), nullptr, 0, 0, nullptr); PHASE_END_ROWS
        PHASE_BEGIN { pg8::EpiPle e{WSP(const bf16_t, OFF_XB), WSP(const bf16_t, OFF_XF) + (size_t)L * MT * DM, (L == 1) ? (float*)ldarg(C.lds, A_out) : (float*)nullptr, (L == 1) ? (bf16_t*)nullptr : WSP(bf16_t, OFF_MIX)}; GEMM_CALL(pg8::EpiPle, WSP(bf16_t, OFF_XB), WSP(bf16_t, OFF_WPG) + (size_t)L * DM * DM, DM, DM, e); } PHASE_END_NONE
        }
}

extern "C" void kernel_launch(void* const* d_in, const int* in_sizes, int n_in, void* d_out, int out_size, void* d_ws, size_t ws_size, hipStream_t stream) {
    static int grid = 0;
    if (grid == 0) {
        int dev = 0, cus = 0, per_cu = 0;
        (void)hipGetDevice(&dev); (void)hipDeviceGetAttribute(&cus, hipDeviceAttributeMultiprocessorCount, dev);
        (void)hipFuncSetAttribute((const void*)mega_fwd, hipFuncAttributeMaxDynamicSharedMemorySize, LDS_BYTES);
        (void)hipOccupancyMaxActiveBlocksPerMultiprocessor(&per_cu, (const void*)mega_fwd, 512, LDS_BYTES);
        if (per_cu < 1) per_cu = 1;
        if (cus < 8) cus = 256;
        grid = cus * per_cu;
        if (ws_size < WS_NEED || n_in != 26) { fprintf(stderr, "kernel_launch: ws %zu < %zu or n_in %d != 26\n", ws_size, (size_t)WS_NEED, n_in); }
        (void)hipGetLastError();
    }
    Args a{};
    const float** fp = (const float**)&a;
    for (int i = 0; i < 26; ++i) fp[i] = (const float*)d_in[i];
    a.out = (float*)d_out; a.ws = (unsigned char*)d_ws; a.ph_lo = 0; a.ph_hi = 1000;
    void* args[] = {&a};
    hipError_t e = hipLaunchCooperativeKernel((const void*)mega_fwd, dim3(grid), dim3(512), args, LDS_BYTES, stream);
    if (e != hipSuccess) fprintf(stderr, "cooperative launch failed: %s (grid %d)\n", hipGetErrorString(e), grid);
}
```

```cpp
#include <hip/hip_runtime.h>
#include <hip/hip_cooperative_groups.h>
#include <cstdio>
#include <cstdint>
namespace cg = cooperative_groups;
namespace pg8 {
#define PG8_LAS __attribute__((address_space(3)))
typedef unsigned short bf16_t;
typedef short bf16x8 __attribute__((ext_vector_type(8)));
typedef float f32x4 __attribute__((ext_vector_type(4)));
typedef unsigned u32x4 __attribute__((ext_vector_type(4)));
constexpr int BM = 256, BK = 64, HALF = 128, HTB = HALF * BK * 2  , STAGE_BYTES = 8 * HTB, NXCD = 8, WGM = 8;

__host__ __device__ __forceinline__ int lds_byte(int r, int c) { const int st = (r >> 4) * 2 + (c >> 5), rr = r & 15, cc = c & 31, ob = rr * 64 + cc * 2; return st * 1024 + (ob ^ (((ob >> 9) & 1) << 5)); }
__host__ __device__ __forceinline__ void stage_rc(int b, int& R, int& C) { const int st = b / 1024, sb = b % 1024, swz = sb ^ (((sb >> 9) & 1) << 5); R = (st >> 1) * 16 + swz / 64; C = (st & 1) * 32 + (swz % 64) / 2; }
__host__ __device__ __forceinline__ int perm32(int rho) { const int n = rho >> 4, i = rho & 15; return 8 * (i >> 2) + 4 * n + (i & 3); }

struct Unit { int pm, pn; };
struct Gemm { const bf16_t* A; const bf16_t* Bt; int M, N, K; };

struct StaticOrder {
    int nM, nN, nwg, G, c;
    __host__ __device__ void init(int M, int N, int G_, int c_) { nM = M / BM; nN = N / BM; nwg = nM * nN; G = G_; c = c_; }
    __host__ __device__ bool next(int i, Unit& u) const {
        const long L = (long)i * G + c; if (L >= nwg) return false;
        int wgid = (int)L; { const int q = nwg / NXCD, r = nwg % NXCD, xcd = wgid % NXCD, off = wgid / NXCD; wgid = (xcd < r ? xcd * (q + 1) : r * (q + 1) + (xcd - r) * q) + off; }
        const int nig = WGM * nN, gid = wgid / nig, fm = gid * WGM, gsz = (nM - fm) < WGM ? (nM - fm) : WGM;
        u.pm = fm + ((wgid % nig) % gsz); u.pn = (wgid % nig) / gsz; return true;
    }
    __device__ __forceinline__ void a_ready(const Unit&) const {}
    __device__ __forceinline__ void done(const Unit&) const {}
};

__device__ __forceinline__ unsigned cvt_pk_bf16(float lo, float hi) { unsigned r; asm volatile("v_cvt_pk_bf16_f32 %0, %1, %2" : "=v"(r) : "v"(lo), "v"(hi)); return r; }
typedef float f32x2 __attribute__((ext_vector_type(2)));
template <class Epi, class Sched, bool ALIGN_EPI = false, bool SP2 = false>
__device__ __forceinline__ void gemm_phase(PG8_LAS unsigned char* lds, const Gemm g, const Sched& S, const Epi& E, const int tid_in) {
    const int tid = tid_in, wid = __builtin_amdgcn_readfirstlane(tid >> 6), lane = tid & 63, wr = wid >> 2, wc = wid & 3, fr = lane & 15, fq = lane >> 4;
    const int K = g.K, nt = K / BK;
    unsigned voffA[2], voffB[2];
#pragma unroll
    for (int i = 0; i < 2; ++i) { int R, C; stage_rc(tid * 16 + i * 8192, R, C); const int Rb = Epi::PERM ? ((R & ~31) + perm32(R & 31)) : R;
        voffA[i] = (unsigned)(R * K + C) * 2u; voffB[i] = (unsigned)(Rb * K + C) * 2u; }
    const size_t kstep = (size_t)(BK * 2);
    const size_t hstep = (size_t)HALF * K * 2;
    const size_t tstep = 2 * hstep;
    const unsigned ldsw = (unsigned)wid * 1024u;
    const int aoff = lds_byte(wr * 64 + fr, fq * 8), boff = lds_byte(wc * 32 + fr, fq * 8);
#define PG8_SA(b, h) (((b) * 2 + (h)) * HTB)
#define PG8_SB(b, h) ((4 + (b) * 2 + (h)) * HTB)
#define PG8_STAGE(bufoff, gbase, voff) do { _Pragma("unroll") for (int _i = 0; _i < 2; ++_i) \
        __builtin_amdgcn_global_load_lds((const unsigned*)((const char*)(gbase) + (voff)[_i]), (PG8_LAS unsigned*)(lds + (bufoff) + ldsw + _i * 8192), 16, 0, 0); } while (0)
#define PG8_LDA(dst, b, h) do { _Pragma("unroll") for (int m = 0; m < 4; ++m) _Pragma("unroll") for (int k = 0; k < 2; ++k) dst[m][k] = *(const PG8_LAS bf16x8*)(lds + PG8_SA(b, h) + aoff + m * 2048 + k * 1024); } while (0)
#define PG8_LDB(dst, b, h) do { _Pragma("unroll") for (int n = 0; n < 2; ++n) _Pragma("unroll") for (int k = 0; k < 2; ++k) dst[n][k] = *(const PG8_LAS bf16x8*)(lds + PG8_SB(b, h) + boff + n * 2048 + k * 1024); } while (0)
#define PG8_MMA(ai, bj, At, Bt) do { __builtin_amdgcn_s_setprio(1); _Pragma("unroll") for (int m = 0; m < 4; ++m) _Pragma("unroll") for (int n = 0; n < 2; ++n) _Pragma("unroll") for (int k = 0; k < 2; ++k) \
        acc[ai][bj][m][n] = __builtin_amdgcn_mfma_f32_16x16x32_bf16(Bt[n][k], At[m][k], acc[ai][bj][m][n], 0, 0, 0); __builtin_amdgcn_s_setprio(0); } while (0)
#define PG8_WAIT_V(n) asm volatile("s_waitcnt vmcnt(" #n ")" ::: "memory")
#define PG8_WAIT_L(n) asm volatile("s_waitcnt lgkmcnt(" #n ")" ::: "memory")
#define PG8_BAR __builtin_amdgcn_s_barrier()
#define PG8_SCHED __builtin_amdgcn_sched_barrier(0)
    Unit cur, nxt; int ui = 0;
    if (!S.next(0, cur)) return;
    f32x4 acc[2][2][4][2];
#pragma unroll
    for (int a = 0; a < 2; ++a)
#pragma unroll
        for (int b = 0; b < 2; ++b)
#pragma unroll
            for (int m = 0; m < 4; ++m)
#pragma unroll
                for (int n = 0; n < 2; ++n) acc[a][b][m][n] = (f32x4){0.f, 0.f, 0.f, 0.f};
    bf16x8 At[4][2], B0[2][2], B1[2][2];
    const char* cA = (const char*)g.A + (size_t)cur.pm * tstep; const char* cB = (const char*)g.Bt + (size_t)cur.pn * tstep;
    S.a_ready(cur);
    if constexpr (SP2) {
        PG8_STAGE(PG8_SB(0, 0), cB, voffB); PG8_STAGE(PG8_SB(0, 1), cB + hstep, voffB); PG8_STAGE(PG8_SA(0, 0), cA, voffA); PG8_STAGE(PG8_SA(0, 1), cA + hstep, voffA);
        if (wr == 1) PG8_BAR;
        PG8_WAIT_V(2); PG8_BAR;
        PG8_STAGE(PG8_SB(1, 0), cB + kstep, voffB); PG8_STAGE(PG8_SA(1, 0), cA + kstep, voffA); PG8_STAGE(PG8_SB(1, 1), cB + hstep + kstep, voffB);
        PG8_WAIT_V(6); PG8_BAR;
    } else {
        PG8_STAGE(PG8_SB(0, 0), cB, voffB); PG8_STAGE(PG8_SA(0, 0), cA, voffA); PG8_STAGE(PG8_SB(0, 1), cB + hstep, voffB); PG8_STAGE(PG8_SA(0, 1), cA + hstep, voffA);
        if (wr == 1) PG8_BAR;
        PG8_WAIT_V(4); PG8_BAR;
        PG8_STAGE(PG8_SB(1, 0), cB + kstep, voffB); PG8_STAGE(PG8_SA(1, 0), cA + kstep, voffA); PG8_STAGE(PG8_SB(1, 1), cB + hstep + kstep, voffB);
        PG8_WAIT_V(6); PG8_BAR;
    }
    for (;;) {
        const bool has_next = S.next(ui + 1, nxt);
        const char* nA = has_next ? (const char*)g.A + (size_t)nxt.pm * tstep : cA; const char* nB = has_next ? (const char*)g.Bt + (size_t)nxt.pn * tstep : cB;
        for (int t = 0; t < nt; t += 2) {
            const bool last = (t == nt - 2);
            const char* a1 = cA + (size_t)(t + 1) * kstep;
            const char* a2 = last ? nA : cA + (size_t)(t + 2) * kstep; const char* b2 = last ? nB : cB + (size_t)(t + 2) * kstep;
            const char* a3 = a2 + kstep; const char* b3 = b2 + kstep;
            if (last && has_next) S.a_ready(nxt);
            if constexpr (SP2) {
            PG8_LDB(B0, 0, 0); PG8_LDB(B1, 0, 1); PG8_SCHED; PG8_LDA(At, 0, 0); PG8_STAGE(PG8_SA(1, 1), a1 + hstep, voffA);
            PG8_WAIT_V(8); PG8_WAIT_L(0); PG8_BAR; PG8_MMA(0, 0, At, B0); PG8_MMA(0, 1, At, B1); PG8_BAR; PG8_SCHED;
            PG8_LDA(At, 0, 1); PG8_STAGE(PG8_SB(0, 0), b2, voffB); PG8_STAGE(PG8_SB(0, 1), b2 + hstep, voffB); PG8_STAGE(PG8_SA(0, 0), a2, voffA);
            PG8_WAIT_V(8); PG8_WAIT_L(0); PG8_BAR; PG8_MMA(1, 0, At, B0); PG8_MMA(1, 1, At, B1); PG8_BAR; PG8_SCHED;
            PG8_LDB(B0, 1, 0); PG8_LDB(B1, 1, 1); PG8_SCHED; PG8_LDA(At, 1, 0); PG8_STAGE(PG8_SA(0, 1), a2 + hstep, voffA);
            PG8_WAIT_V(8); PG8_WAIT_L(0); PG8_BAR; PG8_MMA(0, 0, At, B0); PG8_MMA(0, 1, At, B1); PG8_BAR; PG8_SCHED;
            PG8_LDA(At, 1, 1); PG8_STAGE(PG8_SB(1, 0), b3, voffB); PG8_STAGE(PG8_SB(1, 1), b3 + hstep, voffB); PG8_STAGE(PG8_SA(1, 0), a3, voffA);
            PG8_WAIT_V(8); PG8_WAIT_L(0); PG8_BAR; PG8_MMA(1, 0, At, B0); PG8_MMA(1, 1, At, B1); PG8_BAR; PG8_SCHED;
            } else {
            PG8_LDB(B0, 0, 0); PG8_SCHED; PG8_LDA(At, 0, 0); PG8_STAGE(PG8_SA(1, 1), a1 + hstep, voffA);
            PG8_WAIT_L(8); PG8_BAR; PG8_WAIT_L(0); PG8_MMA(0, 0, At, B0); PG8_BAR; PG8_SCHED;
            PG8_LDB(B1, 0, 1); PG8_STAGE(PG8_SB(0, 0), b2, voffB);
            PG8_BAR; PG8_WAIT_L(0); PG8_MMA(0, 1, At, B1); PG8_BAR;
            PG8_LDA(At, 0, 1); PG8_STAGE(PG8_SA(0, 0), a2, voffA);
            PG8_BAR; PG8_WAIT_L(0); PG8_MMA(1, 0, At, B0); PG8_BAR; PG8_SCHED;
            PG8_STAGE(PG8_SB(0, 1), b2 + hstep, voffB);
            PG8_WAIT_V(6); PG8_BAR; PG8_MMA(1, 1, At, B1); PG8_BAR;
            PG8_LDB(B0, 1, 0); PG8_SCHED; PG8_LDA(At, 1, 0); PG8_STAGE(PG8_SA(0, 1), a2 + hstep, voffA);
            PG8_WAIT_L(8); PG8_BAR; PG8_WAIT_L(0); PG8_MMA(0, 0, At, B0); PG8_BAR; PG8_SCHED;
            PG8_LDB(B1, 1, 1); PG8_STAGE(PG8_SB(1, 0), b3, voffB);
            PG8_BAR; PG8_WAIT_L(0); PG8_MMA(0, 1, At, B1); PG8_BAR;
            PG8_LDA(At, 1, 1); PG8_STAGE(PG8_SA(1, 0), a3, voffA);
            PG8_BAR; PG8_WAIT_L(0); PG8_MMA(1, 0, At, B0); PG8_BAR; PG8_SCHED;
            PG8_STAGE(PG8_SB(1, 1), b3 + hstep, voffB);
            PG8_WAIT_V(6); PG8_BAR; PG8_MMA(1, 1, At, B1); PG8_BAR;
            }
        }
        if constexpr (ALIGN_EPI) { if (wr == 0) PG8_BAR; }
        if constexpr (!Epi::AFTER_DRAIN) { E(acc, cur, wr, wc, fr, fq); S.done(cur); }
        if (!has_next) break;
#pragma unroll
        for (int a = 0; a < 2; ++a)
#pragma unroll
            for (int b = 0; b < 2; ++b)
#pragma unroll
                for (int m = 0; m < 4; ++m)
#pragma unroll
                    for (int n = 0; n < 2; ++n) acc[a][b][m][n] = (f32x4){0.f, 0.f, 0.f, 0.f};
        cur = nxt; cA = nA; cB = nB; ++ui;
        if constexpr (ALIGN_EPI) { if (wr == 1) PG8_BAR; }
    }
    PG8_WAIT_V(0);
    if constexpr (!ALIGN_EPI) { if (wr == 0) PG8_BAR; }
    PG8_BAR;
    if constexpr (Epi::AFTER_DRAIN) { E.fused(acc, cur, wr, wc, fr, fq, lds, wid, lane); S.done(cur); }
#undef PG8_SA
#undef PG8_SB
#undef PG8_STAGE
#undef PG8_LDA
#undef PG8_LDB
#undef PG8_MMA
#undef PG8_WAIT_V
#undef PG8_WAIT_L
#undef PG8_BAR
#undef PG8_SCHED
}
}

namespace pg8 {
typedef unsigned u32x2 __attribute__((ext_vector_type(2)));
__device__ __forceinline__ float sigmoidf_(float v) { return __builtin_amdgcn_rcpf(1.0f + __expf(-v)); }

struct EpiSwiglu {
    static constexpr bool PERM = true, AFTER_DRAIN = false;
    bf16_t* H; int ldh;
    __device__ __forceinline__ void operator()(const f32x4 (&acc)[2][2][4][2], const Unit& u, int wr, int wc, int fr, int fq) const {
        const int row0 = u.pm * BM + wr * 64 + fr; const int col0 = u.pn * HALF + wc * 32 + 8 * fq;
#pragma unroll
        for (int ai = 0; ai < 2; ++ai)
#pragma unroll
            for (int m = 0; m < 4; ++m) {
                bf16_t* p = H + (size_t)(row0 + ai * HALF + m * 16) * ldh + col0;
                f32x4 h0, h1;
#pragma unroll
                for (int e = 0; e < 4; ++e) {
                    const float g0 = acc[ai][0][m][0][e], g1 = acc[ai][0][m][1][e];
                    h0[e] = g0 * sigmoidf_(g0) * acc[ai][1][m][0][e];
                    h1[e] = g1 * sigmoidf_(g1) * acc[ai][1][m][1][e];
                }
                u32x4 w; w.x = cvt_pk_bf16(h0[0], h0[1]); w.y = cvt_pk_bf16(h0[2], h0[3]); w.z = cvt_pk_bf16(h1[0], h1[1]); w.w = cvt_pk_bf16(h1[2], h1[3]);
                *(u32x4*)p = w;
            }
    }
};

template <bool RF32> struct EpiZ {
    static constexpr bool PERM = true, AFTER_DRAIN = false;
    const void* R; bf16_t* Z; float alpha, s;
    __device__ __forceinline__ void operator()(const f32x4 (&acc)[2][2][4][2], const Unit& u, int wr, int wc, int fr, int fq) const {
        const int row0 = u.pm * BM + wr * 64 + fr; const int col0 = u.pn * BM + wc * 32 + 8 * fq;
#pragma unroll
        for (int ai = 0; ai < 2; ++ai)
#pragma unroll
            for (int m = 0; m < 4; ++m) {
                const size_t off = (size_t)(row0 + ai * HALF + m * 16) * 2048 + col0;
#pragma unroll
                for (int bj = 0; bj < 2; ++bj) {
                    f32x4 r0, r1;
                    if (RF32) { r0 = *(const f32x4*)((const float*)R + off + bj * HALF); r1 = *(const f32x4*)((const float*)R + off + bj * HALF + 4); }
                    else { const u32x4 rb = *(const u32x4*)((const bf16_t*)R + off + bj * HALF);
                        r0[0] = __uint_as_float(rb.x << 16); r0[1] = __uint_as_float(rb.x & 0xffff0000u); r0[2] = __uint_as_float(rb.y << 16); r0[3] = __uint_as_float(rb.y & 0xffff0000u);
                        r1[0] = __uint_as_float(rb.z << 16); r1[1] = __uint_as_float(rb.z & 0xffff0000u); r1[2] = __uint_as_float(rb.w << 16); r1[3] = __uint_as_float(rb.w & 0xffff0000u); }
                    const f32x4 z0 = r0 * alpha + acc[ai][bj][m][0] * s, z1 = r1 * alpha + acc[ai][bj][m][1] * s;
                    u32x4 w; w.x = cvt_pk_bf16(z0[0], z0[1]); w.y = cvt_pk_bf16(z0[2], z0[3]); w.z = cvt_pk_bf16(z1[0], z1[1]); w.w = cvt_pk_bf16(z1[2], z1[3]);
                    *(u32x4*)(Z + off + bj * HALF) = w;
                }
            }
    }
};

struct EpiStore {
    static constexpr bool PERM = true, AFTER_DRAIN = false;
    bf16_t* O; int ldc; int ncols; float* GT;
    __device__ __forceinline__ void operator()(const f32x4 (&acc)[2][2][4][2], const Unit& u, int wr, int wc, int fr, int fq) const {
        const int row0 = u.pm * BM + wr * 64 + fr; const int colt = u.pn * BM;
        if (colt < ncols) {
            const int col0 = colt + wc * 32 + 8 * fq;
#pragma unroll
            for (int ai = 0; ai < 2; ++ai)
#pragma unroll
                for (int m = 0; m < 4; ++m) {
                    bf16_t* rowp = O + (size_t)(row0 + ai * HALF + m * 16) * ldc + col0;
#pragma unroll
                    for (int bj = 0; bj < 2; ++bj) {
                        const f32x4 v0 = acc[ai][bj][m][0], v1 = acc[ai][bj][m][1];
                        u32x4 w; w.x = cvt_pk_bf16(v0[0], v0[1]); w.y = cvt_pk_bf16(v0[2], v0[3]); w.z = cvt_pk_bf16(v1[0], v1[1]); w.w = cvt_pk_bf16(v1[2], v1[3]);
                        *(u32x4*)(rowp + bj * HALF) = w;
                    }
                }
        } else if (GT != nullptr && wc == 0 && fq < 2) {
#pragma unroll
            for (int ai = 0; ai < 2; ++ai)
#pragma unroll
                for (int m = 0; m < 4; ++m) {
                    float* g = GT + (size_t)(row0 + ai * HALF + m * 16) * 16 + 8 * fq;
                    *(f32x4*)(g) = acc[ai][0][m][0];
                    *(f32x4*)(g + 4) = acc[ai][0][m][1];
                }
        }
    }
};

struct EpiPle {
    static constexpr bool PERM = true, AFTER_DRAIN = false;
    const bf16_t* X; const bf16_t* E; float* OUTF; bf16_t* XBO;
    __device__ __forceinline__ void operator()(const f32x4 (&acc)[2][2][4][2], const Unit& u, int wr, int wc, int fr, int fq) const {
        const int row0 = u.pm * BM + wr * 64 + fr; const int col0 = u.pn * BM + wc * 32 + 8 * fq;
#pragma unroll
        for (int ai = 0; ai < 2; ++ai)
#pragma unroll
            for (int m = 0; m < 4; ++m) {
                const size_t off = (size_t)(row0 + ai * HALF + m * 16) * 2048 + col0;
#pragma unroll
                for (int bj = 0; bj < 2; ++bj) {
                    const size_t o2 = off + bj * HALF;
                    const u32x4 xb = *(const u32x4*)(X + o2), eb = *(const u32x4*)(E + o2);
                    const unsigned xw[4] = {xb.x, xb.y, xb.z, xb.w}, ew[4] = {eb.x, eb.y, eb.z, eb.w};
                    float o[8];
#pragma unroll
                    for (int q = 0; q < 4; ++q) {
                        const float a0 = acc[ai][bj][m][q >> 1][2 * (q & 1)], a1 = acc[ai][bj][m][q >> 1][2 * (q & 1) + 1];
                        o[2 * q] = __uint_as_float(xw[q] << 16) + __uint_as_float(ew[q] << 16) * sigmoidf_(a0);
                        o[2 * q + 1] = __uint_as_float(xw[q] & 0xffff0000u) + __uint_as_float(ew[q] & 0xffff0000u) * sigmoidf_(a1);
                    }
                    if (OUTF != nullptr) { *(f32x4*)(OUTF + o2) = (f32x4){o[0], o[1], o[2], o[3]}; *(f32x4*)(OUTF + o2 + 4) = (f32x4){o[4], o[5], o[6], o[7]}; }
                    if (XBO != nullptr) { u32x4 w; w.x = cvt_pk_bf16(o[0], o[1]); w.y = cvt_pk_bf16(o[2], o[3]); w.z = cvt_pk_bf16(o[4], o[5]); w.w = cvt_pk_bf16(o[6], o[7]); *(u32x4*)(XBO + o2) = w; }
                }
            }
    }
};
}

#define LAS __attribute__((address_space(3)))
using pg8::bf16_t; using pg8::bf16x8; using pg8::f32x4; using pg8::u32x4; using pg8::u32x2;
typedef short s16x4 __attribute__((ext_vector_type(4)));
typedef float f32x16 __attribute__((ext_vector_type(16)));
typedef short v4i16_t __attribute__((ext_vector_type(4)));

constexpr int MT = 16384, SEQ = 8192, DM = 2048, DFF = 5632, NFF2 = 11264, NIN = 6144, UW = 6144, PLE = 256;
constexpr int LDS_BYTES = 147456;
constexpr float ALPHA = 1.4142135623730951f;
constexpr float LOG2E = 1.4426950408889634f;

constexpr size_t SZ_WFI = (size_t)NFF2 * DM * 2, SZ_WFO = (size_t)DM * DFF * 2, SZ_WIN = (size_t)NIN * DM * 2, SZ_WSQ = (size_t)DM * DM * 2, SZ_WPP = (size_t)DM * PLE * 2;
constexpr size_t OFF_WFI = 0;
constexpr size_t OFF_WFO = OFF_WFI + 4 * SZ_WFI;
constexpr size_t OFF_WAB = OFF_WFO + 4 * SZ_WFO;
constexpr size_t OFF_WC = OFF_WAB + SZ_WIN;
constexpr size_t OFF_WOAB = OFF_WC + SZ_WIN;
constexpr size_t OFF_WOC = OFF_WOAB + SZ_WSQ;
constexpr size_t OFF_WPG = OFF_WOC + SZ_WSQ;
constexpr size_t OFF_WPP = OFF_WPG + 2 * SZ_WSQ;
constexpr size_t OFF_XF = OFF_WPP + 2 * SZ_WPP;
constexpr size_t OFF_XB = OFF_XF + (size_t)MT * DM * 4;
constexpr size_t OFF_Z = OFF_XB + (size_t)MT * DM * 2;
constexpr size_t OFF_H = OFF_Z + (size_t)MT * DM * 4;
constexpr size_t OFF_MIX = OFF_H + (size_t)MT * UW * 2;
constexpr size_t OFF_PB = OFF_MIX + (size_t)MT * DM * 2;
constexpr size_t OFF_GT = OFF_PB + (size_t)2 * MT * PLE * 2;
constexpr size_t OFF_QB = OFF_GT + (size_t)MT * 16 * 4;
constexpr size_t OFF_KB = OFF_QB + (size_t)MT * 512 * 2;
constexpr size_t OFF_BC = OFF_KB + (size_t)MT * 512 * 2;
constexpr size_t OFF_IP = OFF_BC + (size_t)MT * 4 * 4;
constexpr size_t OFF_MSC = OFF_IP + (size_t)MT * 4 * 4;
constexpr size_t OFF_NL = OFF_MSC + 3 * 1024 * 4;
constexpr size_t OFF_DC = OFF_NL + (size_t)8 * 128 * 128 * 4;
constexpr size_t OFF_ST = OFF_DC + (size_t)8 * 128 * 256 * 4;
constexpr size_t OFF_CTL = OFF_ST + (size_t)8 * 128 * 512 * 256 * 2;
constexpr size_t WS_NEED = OFF_CTL + 32768;

#define LDS_WAIT() asm volatile("s_waitcnt lgkmcnt(0)" ::: "memory")
__device__ __forceinline__ unsigned f2bf(float f) { unsigned u = __builtin_bit_cast(unsigned, f); return (u + 0x7fffu + ((u >> 16) & 1u)) >> 16; }
__device__ __forceinline__ unsigned pk2(float lo, float hi) { return f2bf(lo) | (f2bf(hi) << 16); }
__device__ __forceinline__ float bf2f(unsigned h) { return __uint_as_float(h << 16); }
__device__ __forceinline__ float bflo(unsigned w) { return __uint_as_float(w << 16); }
__device__ __forceinline__ float bfhi(unsigned w) { return __uint_as_float(w & 0xffff0000u); }
__device__ __forceinline__ float wave_sum(float v) {
#pragma unroll
    for (int o = 1; o < 64; o <<= 1) v += __shfl_xor(v, o);
    return v;
}
__device__ __forceinline__ float logsigmoidf_(float x) { return fminf(x, 0.f) - log1pf(__expf(-fabsf(x))); }
__device__ __forceinline__ s16x4 vtr(const LAS unsigned char* p) { return __builtin_bit_cast(s16x4, __builtin_amdgcn_ds_read_tr16_b64_v4i16((LAS v4i16_t*)p)); }
__device__ __forceinline__ bf16x8 tr8(const LAS unsigned char* p0, const LAS unsigned char* p1) {
    const s16x4 a = vtr(p0), b = vtr(p1); bf16x8 r; r[0] = a[0]; r[1] = a[1]; r[2] = a[2]; r[3] = a[3]; r[4] = b[0]; r[5] = b[1]; r[6] = b[2]; r[7] = b[3]; return r;
}
__device__ __forceinline__ f32x4 mfma16(bf16x8 a, bf16x8 b, f32x4 c) { return __builtin_amdgcn_mfma_f32_16x16x32_bf16(a, b, c, 0, 0, 0); }
__device__ __forceinline__ f32x16 mfma32(bf16x8 a, bf16x8 b, f32x16 c) { return __builtin_amdgcn_mfma_f32_32x32x16_bf16(a, b, c, 0, 0, 0); }
__device__ __forceinline__ bf16x8 ldsv8(const LAS unsigned char* p) { return *(const LAS bf16x8*)p; }

struct Ctx { LAS unsigned char* lds; int tid, lane, wave, G, bid, gw, NGW; };

__device__ __forceinline__ void tr_decode(int it, int nnb, int mode, int& k0, int& n0, int& drow0, float& scale) {
    const int kb = it / nnb, nb = it - kb * nnb; k0 = 64 * kb; n0 = 64 * nb; drow0 = n0; scale = 1.f;
    if (mode == 1) { const int half = n0 >= DFF ? 1 : 0; const int j0 = n0 - half * DFF; drow0 = 256 * (j0 >> 7) + 128 * half + (j0 & 127); }
    if (mode == 2 && n0 < 1024) scale = 0.125f;
}
__device__ __forceinline__ void tr_load(float (&r)[64], const float* __restrict__ W, int N, int k0, int n0, int lane) {
    const int n = n0 + lane; const bool ok = n < N; const float* src = W + (size_t)k0 * N + (ok ? n : 0);
#pragma unroll
    for (int i = 0; i < 64; ++i) { const float v = src[(size_t)i * N]; r[i] = ok ? v : 0.f; }
}
__device__ __forceinline__ void conv_matrix(const Ctx& C, const float* W, int K, int N, int Npad, bf16_t* WT, int mode, int& base) {
    LAS float* scr = (LAS float*)(C.lds + C.wave * 16640);
    const int nnb = Npad / 64, nitems = (K / 64) * nnb, lane = C.lane;
    int first = (C.gw - base) % C.NGW; if (first < 0) first += C.NGW;
    float r[64]; int k0 = 0, n0 = 0, drow0 = 0; float scale = 1.f;
    int it = first;
    if (it < nitems) { tr_decode(it, nnb, mode, k0, n0, drow0, scale); tr_load(r, W, N, k0, n0, lane); }
    while (it < nitems) {
#pragma unroll
        for (int i = 0; i < 64; ++i) scr[i * 65 + lane] = r[i] * scale;
        const int ck0 = k0, cdrow0 = drow0;
        it += C.NGW;
        if (it < nitems) { tr_decode(it, nnb, mode, k0, n0, drow0, scale); tr_load(r, W, N, k0, n0, lane); }
        LDS_WAIT(); asm volatile("" ::: "memory");
        const int c = lane & 7;
#pragma unroll
        for (int j = 0; j < 8; ++j) { const int nn = (lane >> 3) + 8 * j; const LAS float* s = scr + (8 * c) * 65 + nn;
            u32x4 o; o.x = pk2(s[0 * 65], s[1 * 65]); o.y = pk2(s[2 * 65], s[3 * 65]); o.z = pk2(s[4 * 65], s[5 * 65]); o.w = pk2(s[6 * 65], s[7 * 65]);
            *(u32x4*)(WT + (size_t)(cdrow0 + nn) * K + ck0 + 8 * c) = o; }
        LDS_WAIT(); asm volatile("" ::: "memory");
    }
    base = (base + nitems) % C.NGW;
}
__device__ __forceinline__ void cvt_rows(const Ctx& C, const float* src, bf16_t* dst, size_t n4) {
    const size_t stride = (size_t)C.G * 512;
    for (size_t i = (size_t)C.bid * 512 + C.tid; i < n4; i += 4 * stride) {
        f32x4 v[4];
#pragma unroll
        for (int j = 0; j < 4; ++j) if (i + j * stride < n4) v[j] = *(const f32x4*)(src + 4 * (i + j * stride));
#pragma unroll
        for (int j = 0; j < 4; ++j) if (i + j * stride < n4) { u32x2 w; w.x = pk2(v[j][0], v[j][1]); w.y = pk2(v[j][2], v[j][3]); *(u32x2*)(dst + 4 * (i + j * stride)) = w; }
    }
}

template <bool GATES>
__device__ __forceinline__ void ln_phase(const Ctx& C, const bf16_t* Z, const float* g, const float* b, bf16_t* XB, const float* Wsrc, int ldw, int ngate, float* GT) {
    LAS float* WG = (LAS float*)C.lds;
    if (GATES) {
        for (int col = C.tid; col < DM; col += 512) {
            const float* src = Wsrc + (size_t)col * ldw + 6144;
#pragma unroll
            for (int gi = 0; gi < 16; ++gi) WG[gi * DM + col] = (gi < ngate) ? src[gi] : 0.f;
        }
        __syncthreads();
    }
    f32x4 gv[8], bv[8];
#pragma unroll
    for (int j = 0; j < 4; ++j) { gv[2 * j] = *(const f32x4*)(g + 512 * j + 8 * C.lane); gv[2 * j + 1] = *(const f32x4*)(g + 512 * j + 8 * C.lane + 4);
                                  bv[2 * j] = *(const f32x4*)(b + 512 * j + 8 * C.lane); bv[2 * j + 1] = *(const f32x4*)(b + 512 * j + 8 * C.lane + 4); }
    const bool grp = (C.G & 7) == 0; const int nwg_ = grp ? (C.G >> 3) * 8 : C.NGW; const int first_ = grp ? (C.bid >> 3) * 8 + C.wave : C.gw; const int base_ = grp ? 2048 * (C.bid & 7) : 0; const int lim_ = grp ? 2048 : MT;
    for (int lrow = first_; lrow < lim_; lrow += nwg_) {
        const int row = base_ + lrow;
        const bf16_t* z = Z + (size_t)row * DM + 8 * C.lane;
        u32x4 zb[4];
#pragma unroll
        for (int j = 0; j < 4; ++j) zb[j] = *(const u32x4*)(z + 512 * j);
        f32x4 v[8]; float s = 0.f;
#pragma unroll
        for (int j = 0; j < 4; ++j) { v[2 * j] = (f32x4){bflo(zb[j].x), bfhi(zb[j].x), bflo(zb[j].y), bfhi(zb[j].y)}; v[2 * j + 1] = (f32x4){bflo(zb[j].z), bfhi(zb[j].z), bflo(zb[j].w), bfhi(zb[j].w)}; }
#pragma unroll
        for (int j = 0; j < 8; ++j) s += (v[j][0] + v[j][1]) + (v[j][2] + v[j][3]);
        const float mean = wave_sum(s) * (1.f / DM); float s2 = 0.f;
#pragma unroll
        for (int j = 0; j < 8; ++j) { v[j] = v[j] - mean; s2 += (v[j][0] * v[j][0] + v[j][1] * v[j][1]) + (v[j][2] * v[j][2] + v[j][3] * v[j][3]); }
        const float rstd = 1.f / sqrtf(wave_sum(s2) * (1.f / DM) + 1e-5f);
        bf16_t* bo = XB + (size_t)row * DM + 8 * C.lane;
#pragma unroll
        for (int j = 0; j < 4; ++j) { const f32x4 o0 = v[2 * j] * rstd * gv[2 * j] + bv[2 * j], o1 = v[2 * j + 1] * rstd * gv[2 * j + 1] + bv[2 * j + 1];
            u32x4 w; w.x = pg8::cvt_pk_bf16(o0[0], o0[1]); w.y = pg8::cvt_pk_bf16(o0[2], o0[3]); w.z = pg8::cvt_pk_bf16(o1[0], o1[1]); w.w = pg8::cvt_pk_bf16(o1[2], o1[3]); *(u32x4*)(bo + 512 * j) = w;
            if (GATES) { v[2 * j] = o0; v[2 * j + 1] = o1; } }
        if (GATES) {
            float mine = 0.f;
#pragma unroll 4
            for (int gi = 0; gi < 16; ++gi) {
                float s0 = 0.f, s1 = 0.f;
#pragma unroll
                for (int j = 0; j < 4; ++j) { const f32x4 w0 = *(const LAS f32x4*)(WG + gi * DM + 512 * j + 8 * C.lane), w1 = *(const LAS f32x4*)(WG + gi * DM + 512 * j + 8 * C.lane + 4);
                    s0 += (v[2 * j][0] * w0[0] + v[2 * j][1] * w0[1]) + (v[2 * j][2] * w0[2] + v[2 * j][3] * w0[3]);
                    s1 += (v[2 * j + 1][0] * w1[0] + v[2 * j + 1][1] * w1[1]) + (v[2 * j + 1][2] * w1[2] + v[2 * j + 1][3] * w1[3]); }
                const float tot = wave_sum(s0 + s1);
                mine = (C.lane == gi) ? tot : mine;
            }
            if (C.lane < 16) GT[(size_t)row * 16 + C.lane] = mine;
        }
    }
    if (GATES) __syncthreads();
}

__device__ __forceinline__ void m1_phase(const Ctx& C, const bf16_t* U, const float* GT, const float* conv_w, const float* conv_b, const float* b_i, const float* b_f,
                                         bf16_t* QB, bf16_t* KB, float* BC, float* IP, float* MSC) {
    if (C.bid < 8) {
        LAS float* sb = (LAS float*)C.lds; LAS float* su = sb + 128;
        const int bh = C.bid, b = bh >> 2, h = bh & 3;
        {
            const float bi = b_i[h], bf = b_f[h]; const int ln = C.lane;
            float fv[16], iv[16];
#pragma unroll
            for (int k = 0; k < 16; ++k) { const size_t row = (size_t)b * SEQ + (C.wave * 16 + k) * 64 + ln; fv[k] = GT[row * 16 + 4 + h]; iv[k] = GT[row * 16 + h]; }
#pragma unroll
            for (int k = 0; k < 16; ++k) {
                const int c = C.wave * 16 + k; const size_t row = (size_t)b * SEQ + c * 64 + ln;
                float cum = logsigmoidf_(fv[k] + bf);
#pragma unroll
                for (int off = 1; off < 64; off <<= 1) { const float t = __shfl_up(cum, off); if (ln >= off) cum += t; }
                const float ip = iv[k] + bi;
                BC[row * 4 + h] = cum; IP[row * 4 + h] = ip;
                float um = ip - cum;
#pragma unroll
                for (int off = 1; off < 64; off <<= 1) um = fmaxf(um, __shfl_xor(um, off));
                const float bl = __shfl(cum, 63);
                if (ln == 0) { sb[c] = bl; su[c] = um; }
            }
        }
        __syncthreads();
        if (C.tid == 0) {
            float m = 0.f;
#pragma unroll 1
            for (int c = 0; c < 128; ++c) {
                const float bl = sb[c], mn = fmaxf(bl + m, bl + su[c]);
                MSC[bh * 128 + c] = m; MSC[1024 + bh * 128 + c] = mn; MSC[2048 + bh * 128 + c] = __expf(bl + m - mn); m = mn;
            }
        }
        __syncthreads();
    }
    for (size_t i = (size_t)C.bid * 512 + C.tid; i < (size_t)MT * 128; i += (size_t)C.G * 512) {
        const int row = (int)(i >> 7), c0 = (int)(i & 127) * 8, t = row & (SEQ - 1);
        float acc[8];
#pragma unroll
        for (int e = 0; e < 8; ++e) acc[e] = conv_b[c0 + e];
#pragma unroll
        for (int j = 0; j < 4; ++j) {
            const int tt = t - 3 + j;
            if (tt >= 0) {
                const u32x4 xv = *(const u32x4*)(U + (size_t)(row - 3 + j) * UW + 3072 + c0);
                const f32x4 w0 = *(const f32x4*)(conv_w + j * 1024 + c0), w1 = *(const f32x4*)(conv_w + j * 1024 + c0 + 4);
                acc[0] += w0[0] * bflo(xv.x); acc[1] += w0[1] * bfhi(xv.x); acc[2] += w0[2] * bflo(xv.y); acc[3] += w0[3] * bfhi(xv.y);
                acc[4] += w1[0] * bflo(xv.z); acc[5] += w1[1] * bfhi(xv.z); acc[6] += w1[2] * bflo(xv.w); acc[7] += w1[3] * bfhi(xv.w);
            }
        }
        const float sc = (c0 < 512) ? 0.08838834764831845f : 1.f;
#pragma unroll
        for (int e = 0; e < 8; ++e) acc[e] = acc[e] * pg8::sigmoidf_(acc[e]) * sc;
        u32x4 w; w.x = pk2(acc[0], acc[1]); w.y = pk2(acc[2], acc[3]); w.z = pk2(acc[4], acc[5]); w.w = pk2(acc[6], acc[7]);
        if (c0 < 512) *(u32x4*)(QB + (size_t)row * 512 + c0) = w; else *(u32x4*)(KB + (size_t)row * 512 + c0 - 512) = w;
    }
}

__device__ __forceinline__ void mlstm_passA(const Ctx& C, const bf16_t* U, const bf16_t* KB, const float* BC, const float* IP, const float* MSC, bf16_t* ST, float* NL) {
    LAS unsigned char* KW = C.lds; LAS unsigned char* V = C.lds + 17408; LAS float* wk = (LAS float*)(C.lds + 52224);
    const int l = C.lane, g = l >> 4, q = (l & 15) >> 2, p = l & 3, w = C.wave;
    for (int u = C.bid; u < 1024; u += C.G) {
        const int bh = u >> 7, c = u & 127, b = bh >> 2, h = bh & 3; const size_t row0 = (size_t)b * SEQ + c * 64;
        if (C.tid < 64) { const float bl = BC[(row0 + 63) * 4 + h], mn = MSC[1024 + bh * 128 + c]; wk[C.tid] = __expf(bl - BC[(row0 + C.tid) * 4 + h] + IP[(row0 + C.tid) * 4 + h] - mn); }
        __syncthreads();
        { const int s = C.tid >> 3, seg = C.tid & 7; const float ws = wk[s];
          const bf16_t* kp = KB + (row0 + s) * 512 + h * 128 + seg * 16;
#pragma unroll
          for (int i = 0; i < 2; ++i) { const u32x4 kv = *(const u32x4*)(kp + 8 * i); u32x4 o;
              o.x = pk2(bflo(kv.x) * ws, bfhi(kv.x) * ws); o.y = pk2(bflo(kv.y) * ws, bfhi(kv.y) * ws); o.z = pk2(bflo(kv.z) * ws, bfhi(kv.z) * ws); o.w = pk2(bflo(kv.w) * ws, bfhi(kv.w) * ws);
              *(LAS u32x4*)(KW + s * 272 + seg * 32 + 16 * i) = o; }
          const bf16_t* vp = U + (row0 + s) * UW + 4096 + h * 256 + seg * 32;
#pragma unroll
          for (int i = 0; i < 4; ++i) *(LAS u32x4*)(V + s * 544 + seg * 64 + 16 * i) = *(const u32x4*)(vp + 8 * i); }
        __syncthreads();
        f32x4 acc[2][8];
#pragma unroll
        for (int mi = 0; mi < 2; ++mi)
#pragma unroll
            for (int ni = 0; ni < 8; ++ni) acc[mi][ni] = (f32x4){0.f, 0.f, 0.f, 0.f};
#pragma unroll
        for (int ks = 0; ks < 2; ++ks) {
            const int r0 = 32 * ks + 8 * g + q;
            bf16x8 a[2];
#pragma unroll
            for (int mi = 0; mi < 2; ++mi) { const LAS unsigned char* ap = V + r0 * 544 + (32 * w + 16 * mi + 4 * p) * 2; a[mi] = tr8(ap, ap + 4 * 544); }
#pragma unroll
            for (int ni = 0; ni < 8; ++ni) { const LAS unsigned char* bp = KW + r0 * 272 + (16 * ni + 4 * p) * 2; const bf16x8 bb = tr8(bp, bp + 4 * 272);
#pragma unroll
                for (int mi = 0; mi < 2; ++mi) acc[mi][ni] = mfma16(bb, a[mi], acc[mi][ni]); }
        }
        bf16_t* st = ST + ((size_t)(bh * 128 + c) << 15);
#pragma unroll
        for (int mi = 0; mi < 2; ++mi)
#pragma unroll
            for (int ni = 0; ni < 8; ++ni) { u32x2 wv; wv.x = pg8::cvt_pk_bf16(acc[mi][ni][0], acc[mi][ni][1]); wv.y = pg8::cvt_pk_bf16(acc[mi][ni][2], acc[mi][ni][3]);
                *(u32x2*)(st + (32 * w + 16 * mi + (l & 15)) * 128 + 16 * ni + 4 * g) = wv; }
        if (C.tid < 128) { float s = 0.f;
#pragma unroll 4
            for (int t = 0; t < 64; ++t) s += bf2f(*(const LAS unsigned short*)(KW + t * 272 + C.tid * 2)); NL[(size_t)(bh * 128 + c) * 128 + C.tid] = s; }
        __syncthreads();
    }
}

__device__ __forceinline__ void mlstm_scan(const Ctx& C, bf16_t* ST, float* NL, const float* MSC) {
    for (int e2 = C.bid * 512 + C.tid; e2 < 8 * 16384; e2 += C.G * 512) {
        const int bh = e2 >> 14, off = e2 & 16383; float c0 = 0.f, c1 = 0.f;
        unsigned* p = (unsigned*)(ST + ((size_t)(bh * 128) << 15)) + off;
#pragma unroll 1
        for (int cb = 0; cb < 128; cb += 8) {
            unsigned t[8]; float d[8];
#pragma unroll
            for (int i = 0; i < 8; ++i) { t[i] = p[(size_t)(cb + i) << 14]; d[i] = MSC[2048 + bh * 128 + cb + i]; }
#pragma unroll
            for (int i = 0; i < 8; ++i) { p[(size_t)(cb + i) << 14] = pk2(c0, c1); c0 = d[i] * c0 + bflo(t[i]); c1 = d[i] * c1 + bfhi(t[i]); }
        }
    }
    const int gt = C.bid * 512 + C.tid;
    if (gt < 1024) { const int bh = gt >> 7, dk = gt & 127; float n = 0.f;
#pragma unroll 2
        for (int c = 0; c < 128; ++c) { float* p = NL + (size_t)(bh * 128 + c) * 128 + dk; const float t = *p; *p = n; n = MSC[2048 + bh * 128 + c] * n + t; } }
}

__device__ __forceinline__ void mlstm_passC(const Ctx& C, const bf16_t* U, const bf16_t* QB, const bf16_t* KB, const float* BC, const float* IP, const float* MSC,
                                            const bf16_t* ST, const float* NL, const float* mg, bf16_t* MIX) {
    LAS unsigned char* Q = C.lds; LAS unsigned char* K = C.lds + 17408; LAS unsigned char* V = C.lds + 34816; LAS unsigned char* SW = C.lds + 69632;
    LAS float* fu = (LAS float*)(C.lds + 78848); LAS float* fM = fu + 64; LAS float* fw = fu + 128; LAS float* fb = fu + 192; LAS float* finv = fu + 256; LAS float* fn = fu + 320; LAS float* fss = fu + 448;
    const int l = C.lane, g = l >> 4, q = (l & 15) >> 2, p = l & 3, w = C.wave, lr = l & 15;
    for (int u = C.bid; u < 1024; u += C.G) {
        const int bh = u >> 7, c = u & 127, b = bh >> 2, h = bh & 3; const size_t row0 = (size_t)b * SEQ + c * 64;
        const float mprev = MSC[bh * 128 + c];
        if (C.tid < 64) { const float bt = BC[(row0 + C.tid) * 4 + h]; fb[C.tid] = bt; fu[C.tid] = IP[(row0 + C.tid) * 4 + h] - bt; }
        if (C.tid >= 64 && C.tid < 192) fn[C.tid - 64] = NL[(size_t)(bh * 128 + c) * 128 + C.tid - 64];
        { const int s = C.tid >> 3, seg = C.tid & 7;
          const bf16_t* qp = QB + (row0 + s) * 512 + h * 128 + seg * 16; const bf16_t* kp = KB + (row0 + s) * 512 + h * 128 + seg * 16;
#pragma unroll
          for (int i = 0; i < 2; ++i) { *(LAS u32x4*)(Q + s * 272 + seg * 32 + 16 * i) = *(const u32x4*)(qp + 8 * i); *(LAS u32x4*)(K + s * 272 + seg * 32 + 16 * i) = *(const u32x4*)(kp + 8 * i); }
          const bf16_t* vp = U + (row0 + s) * UW + 4096 + h * 256 + seg * 32;
#pragma unroll
          for (int i = 0; i < 4; ++i) *(LAS u32x4*)(V + s * 544 + seg * 64 + 16 * i) = *(const u32x4*)(vp + 8 * i); }
        __syncthreads();
        if (C.tid < 64) { float pm = -3.0e38f;
#pragma unroll 1
            for (int s = 0; s <= C.tid; ++s) pm = fmaxf(pm, fu[s]); const float Mt = fmaxf(mprev, pm); fM[C.tid] = Mt; fw[C.tid] = __expf(mprev - Mt); }
        __syncthreads();
#pragma unroll
        for (int tt = 0; tt < 2; ++tt) {
            const int tile = 2 * w + tt, ti = tile >> 2, si = tile & 3;
            f32x4 s4 = (f32x4){0.f, 0.f, 0.f, 0.f};
            if (si <= ti) {
#pragma unroll
                for (int ks = 0; ks < 4; ++ks) { const bf16x8 a = ldsv8(Q + (16 * ti + lr) * 272 + (32 * ks + 8 * g) * 2), bb = ldsv8(K + (16 * si + lr) * 272 + (32 * ks + 8 * g) * 2); s4 = mfma16(a, bb, s4); }
            }
            const int sidx = 16 * si + lr; const float us = fu[sidx];
#pragma unroll
            for (int j = 0; j < 4; ++j) { const int t = 16 * ti + 4 * g + j; const float wgt = (sidx <= t) ? __expf(us - fM[t]) : 0.f;
                *(LAS unsigned short*)(SW + t * 144 + sidx * 2) = (unsigned short)f2bf(s4[j] * wgt); }
        }
        __syncthreads();
        if (C.tid < 64) { const int t = C.tid; float rs = 0.f, qn = 0.f;
#pragma unroll 4
            for (int s = 0; s < 64; ++s) rs += bf2f(*(const LAS unsigned short*)(SW + t * 144 + s * 2));
#pragma unroll 4
            for (int d = 0; d < 128; ++d) qn += bf2f(*(const LAS unsigned short*)(Q + t * 272 + d * 2)) * fn[d];
            const float den = fw[t] * qn + rs; finv[t] = 1.f / fmaxf(fabsf(den), __expf(-(fb[t] + fM[t]))); }
        f32x4 acc[4][2];
#pragma unroll
        for (int mi = 0; mi < 4; ++mi)
#pragma unroll
            for (int ni = 0; ni < 2; ++ni) acc[mi][ni] = (f32x4){0.f, 0.f, 0.f, 0.f};
        const bf16_t* st = ST + ((size_t)(bh * 128 + c) << 15);
#pragma unroll
        for (int ks = 0; ks < 4; ++ks) {
            bf16x8 bb[2];
#pragma unroll
            for (int ni = 0; ni < 2; ++ni) bb[ni] = *(const bf16x8*)(st + (32 * w + 16 * ni + lr) * 128 + 32 * ks + 8 * g);
#pragma unroll
            for (int mi = 0; mi < 4; ++mi) { const bf16x8 a = ldsv8(Q + (16 * mi + lr) * 272 + (32 * ks + 8 * g) * 2);
#pragma unroll
                for (int ni = 0; ni < 2; ++ni) acc[mi][ni] = mfma16(bb[ni], a, acc[mi][ni]); }
        }
#pragma unroll
        for (int mi = 0; mi < 4; ++mi) { const float wi = fw[16 * mi + lr]; acc[mi][0] = acc[mi][0] * wi; acc[mi][1] = acc[mi][1] * wi; }
#pragma unroll
        for (int ks = 0; ks < 2; ++ks) {
            const int r0 = 32 * ks + 8 * g + q; bf16x8 bb[2];
#pragma unroll
            for (int ni = 0; ni < 2; ++ni) { const LAS unsigned char* bp = V + r0 * 544 + (32 * w + 16 * ni + 4 * p) * 2; bb[ni] = tr8(bp, bp + 4 * 544); }
#pragma unroll
            for (int mi = 0; mi < 4; ++mi) { const bf16x8 a = ldsv8(SW + (16 * mi + lr) * 144 + (32 * ks + 8 * g) * 2);
#pragma unroll
                for (int ni = 0; ni < 2; ++ni) acc[mi][ni] = mfma16(bb[ni], a, acc[mi][ni]); }
        }
        __syncthreads();
#pragma unroll
        for (int mi = 0; mi < 4; ++mi) { const float iv = finv[16 * mi + lr]; acc[mi][0] = acc[mi][0] * iv; acc[mi][1] = acc[mi][1] * iv;
            float ss = 0.f;
#pragma unroll
            for (int ni = 0; ni < 2; ++ni) ss += (acc[mi][ni][0] * acc[mi][ni][0] + acc[mi][ni][1] * acc[mi][ni][1]) + (acc[mi][ni][2] * acc[mi][ni][2] + acc[mi][ni][3] * acc[mi][ni][3]);
            ss += __shfl_xor(ss, 16); ss += __shfl_xor(ss, 32);
            if (g == 0) fss[w * 64 + 16 * mi + lr] = ss; }
        __syncthreads();
#pragma unroll
        for (int mi = 0; mi < 4; ++mi) { const int t = 16 * mi + lr; float tot = 0.f;
#pragma unroll
            for (int ww = 0; ww < 8; ++ww) tot += fss[ww * 64 + t];
            const float r = 1.f / sqrtf(tot * (1.f / 256.f) + 1e-6f);
#pragma unroll
            for (int ni = 0; ni < 2; ++ni) { const int dv = 32 * w + 16 * ni + 4 * g;
                const u32x2 ogb = *(const u32x2*)(U + (row0 + t) * UW + 5120 + h * 256 + dv); const f32x4 gv = *(const f32x4*)(mg + h * 256 + dv);
                const float o0 = acc[mi][ni][0] * r * gv[0] * pg8::sigmoidf_(bflo(ogb.x)), o1 = acc[mi][ni][1] * r * gv[1] * pg8::sigmoidf_(bfhi(ogb.x));
                const float o2 = acc[mi][ni][2] * r * gv[2] * pg8::sigmoidf_(bflo(ogb.y)), o3 = acc[mi][ni][3] * r * gv[3] * pg8::sigmoidf_(bfhi(ogb.y));
                u32x2 wv; wv.x = pg8::cvt_pk_bf16(o0, o1); wv.y = pg8::cvt_pk_bf16(o2, o3);
                *(u32x2*)(MIX + (row0 + t) * DM + 1024 + h * 256 + dv) = wv; } }
        __syncthreads();
    }
}

__device__ __forceinline__ float gla_decay(const Ctx& C, const float* w_a2, const float* b_a, int h, LAS float* A1, LAS float* tot0, LAS unsigned char* QD, LAS unsigned char* KD) {
    const int ch = C.tid & 255, half = C.tid >> 8, t0 = 32 * half;
    float wv[16];
#pragma unroll
    for (int i = 0; i < 16; ++i) wv[i] = w_a2[i * 1024 + h * 256 + ch];
    const float ba = b_a[h * 256 + ch];
    float c[32]; float run = 0.f;
#pragma unroll
    for (int i = 0; i < 32; ++i) {
        const LAS float* ap = A1 + (t0 + i) * 16;
        const f32x4 a0 = *(const LAS f32x4*)(ap), a1 = *(const LAS f32x4*)(ap + 4), a2 = *(const LAS f32x4*)(ap + 8), a3 = *(const LAS f32x4*)(ap + 12);
        float z0 = ba, z1 = 0.f, z2 = 0.f, z3 = 0.f;
#pragma unroll
        for (int j = 0; j < 4; ++j) { z0 += a0[j] * wv[j]; z1 += a1[j] * wv[4 + j]; z2 += a2[j] * wv[8 + j]; z3 += a3[j] * wv[12 + j]; }
        const float z = (z0 + z1) + (z2 + z3);
        run += (fminf(z, 0.f) - __logf(1.f + __expf(-fabsf(z)))) * 0.0625f;
        c[i] = run;
    }
    if (half == 0) tot0[ch] = run;
    __syncthreads();
    const float off = half ? tot0[ch] : 0.f;
#pragma unroll
    for (int i = 0; i < 32; ++i) {
        const float cum = c[i] + off; const int t = t0 + i;
        LAS unsigned short* kp = (LAS unsigned short*)(KD + t * 528 + ch * 2); *kp = (unsigned short)f2bf(bf2f(*kp) * __expf(-cum));
        LAS unsigned short* qp = (LAS unsigned short*)(QD + t * 528 + ch * 2); *qp = (unsigned short)f2bf(bf2f(*qp) * __expf(cum) * 0.0625f);
    }
    return __expf(c[31] + off);
}

__device__ __forceinline__ void gla_passA(const Ctx& C, const bf16_t* U, const float* GT, const float* w_a2, const float* b_a, bf16_t* ST, float* DC, bf16_t* QDG, bf16_t* KDG) {
    LAS unsigned char* QD = C.lds; LAS unsigned char* KD = C.lds + 33792; LAS unsigned char* V = C.lds + 67584;
    LAS float* A1 = (LAS float*)(C.lds + 135168); LAS float* bl = (LAS float*)(C.lds + 139264); LAS float* tot0 = (LAS float*)(C.lds + 140288);
    const int l = C.lane, g = l >> 4, q = (l & 15) >> 2, p = l & 3, w = C.wave, lr = l & 15;
    for (int u = C.bid; u < 1024; u += C.G) {
        const int bh = u >> 7, c = u & 127, b = bh >> 2, h = bh & 3; const size_t row0 = (size_t)b * SEQ + c * 64;
        A1[C.tid] = GT[row0 * 16 + C.tid]; A1[C.tid + 512] = GT[row0 * 16 + C.tid + 512];
        { const int s = C.tid >> 3, seg = C.tid & 7; const bf16_t* vp = U + (row0 + s) * UW + 2048 + h * 512 + seg * 64;
#pragma unroll
          for (int i = 0; i < 8; ++i) *(LAS u32x4*)(V + s * 1056 + seg * 128 + 16 * i) = *(const u32x4*)(vp + 8 * i);
          const bf16_t* qp = U + (row0 + s) * UW + h * 256 + seg * 32;
#pragma unroll
          for (int i = 0; i < 4; ++i) { *(LAS u32x4*)(QD + s * 528 + seg * 64 + 16 * i) = *(const u32x4*)(qp + 8 * i); *(LAS u32x4*)(KD + s * 528 + seg * 64 + 16 * i) = *(const u32x4*)(qp + 1024 + 8 * i); } }
        __syncthreads();
        const float eb = gla_decay(C, w_a2, b_a, h, A1, tot0, QD, KD);
        if (C.tid >= 256) { bl[C.tid - 256] = eb; DC[(size_t)(bh * 128 + c) * 256 + C.tid - 256] = eb; }
        __syncthreads();
        { const int s = C.tid >> 3, seg = C.tid & 7; bf16_t* qg = QDG + (row0 + s) * 1024 + h * 256 + seg * 32; bf16_t* kg = KDG + (row0 + s) * 1024 + h * 256 + seg * 32;
#pragma unroll
          for (int i = 0; i < 4; ++i) { *(u32x4*)(qg + 8 * i) = *(const LAS u32x4*)(QD + s * 528 + seg * 64 + 16 * i); *(u32x4*)(kg + 8 * i) = *(const LAS u32x4*)(KD + s * 528 + seg * 64 + 16 * i); } }
#pragma unroll 1
        for (int dvq = 0; dvq < 4; ++dvq) {
            f32x4 acc[16];
#pragma unroll
            for (int ni = 0; ni < 16; ++ni) acc[ni] = (f32x4){0.f, 0.f, 0.f, 0.f};
#pragma unroll
            for (int ks = 0; ks < 2; ++ks) {
                const int r0 = 32 * ks + 8 * g + q;
                const LAS unsigned char* ap = V + r0 * 1056 + (dvq * 128 + 16 * w + 4 * p) * 2; const bf16x8 a = tr8(ap, ap + 4 * 1056);
#pragma unroll
                for (int ni = 0; ni < 16; ++ni) { const LAS unsigned char* bp = KD + r0 * 528 + (16 * ni + 4 * p) * 2; acc[ni] = mfma16(tr8(bp, bp + 4 * 528), a, acc[ni]); }
            }
            bf16_t* st = ST + ((size_t)(bh * 128 + c) << 17) + (size_t)(dvq * 128 + 16 * w + lr) * 256 + 4 * g;
#pragma unroll
            for (int ni = 0; ni < 16; ++ni) { const f32x4 e4 = *(const LAS f32x4*)(bl + 16 * ni + 4 * g); const f32x4 v4 = acc[ni] * e4;
                u32x2 wv; wv.x = pg8::cvt_pk_bf16(v4[0], v4[1]); wv.y = pg8::cvt_pk_bf16(v4[2], v4[3]); *(u32x2*)(st + 16 * ni) = wv; }
        }
        __syncthreads();
    }
}

__device__ __forceinline__ void gla_scan(const Ctx& C, bf16_t* ST, const float* DC) {
    for (int e8 = C.bid * 512 + C.tid; e8 < 8 * 16384; e8 += C.G * 512) {
        const int bh = e8 >> 14, off = e8 & 16383, dk = (off * 8) & 255;
        float s[8];
#pragma unroll
        for (int i = 0; i < 8; ++i) s[i] = 0.f;
        u32x4* p = (u32x4*)(ST + ((size_t)(bh * 128) << 17)) + off;
#pragma unroll 1
        for (int cb = 0; cb < 128; cb += 4) {
            u32x4 t[4]; f32x4 d0[4], d1[4];
#pragma unroll
            for (int i = 0; i < 4; ++i) { t[i] = p[(size_t)(cb + i) << 14]; const float* d = DC + (size_t)(bh * 128 + cb + i) * 256 + dk; d0[i] = *(const f32x4*)d; d1[i] = *(const f32x4*)(d + 4); }
#pragma unroll
            for (int i = 0; i < 4; ++i) {
                u32x4 o; o.x = pk2(s[0], s[1]); o.y = pk2(s[2], s[3]); o.z = pk2(s[4], s[5]); o.w = pk2(s[6], s[7]); p[(size_t)(cb + i) << 14] = o;
                s[0] = d0[i][0] * s[0] + bflo(t[i].x); s[1] = d0[i][1] * s[1] + bfhi(t[i].x); s[2] = d0[i][2] * s[2] + bflo(t[i].y); s[3] = d0[i][3] * s[3] + bfhi(t[i].y);
                s[4] = d1[i][0] * s[4] + bflo(t[i].z); s[5] = d1[i][1] * s[5] + bfhi(t[i].z); s[6] = d1[i][2] * s[6] + bflo(t[i].w); s[7] = d1[i][3] * s[7] + bfhi(t[i].w);
            }
        }
    }
}

__device__ __forceinline__ void gla_passC(const Ctx& C, const bf16_t* U, const bf16_t* QDG, const bf16_t* KDG, const bf16_t* ST, const float* gg, bf16_t* MIX) {
    LAS unsigned char* QD = C.lds; LAS unsigned char* KD = C.lds + 33792; LAS unsigned char* V = C.lds + 67584; LAS unsigned char* ATT = C.lds + 135168;
    LAS float* fss = (LAS float*)(C.lds + 144384);
    const int l = C.lane, g = l >> 4, q = (l & 15) >> 2, p = l & 3, w = C.wave, lr = l & 15;
    for (int u = C.bid; u < 1024; u += C.G) {
        const int bh = u >> 7, c = u & 127, b = bh >> 2, h = bh & 3; const size_t row0 = (size_t)b * SEQ + c * 64;
        { const int s = C.tid >> 3, seg = C.tid & 7; const bf16_t* vp = U + (row0 + s) * UW + 2048 + h * 512 + seg * 64;
#pragma unroll
          for (int i = 0; i < 8; ++i) *(LAS u32x4*)(V + s * 1056 + seg * 128 + 16 * i) = *(const u32x4*)(vp + 8 * i);
          const bf16_t* qg = QDG + (row0 + s) * 1024 + h * 256 + seg * 32; const bf16_t* kg = KDG + (row0 + s) * 1024 + h * 256 + seg * 32;
#pragma unroll
          for (int i = 0; i < 4; ++i) { *(LAS u32x4*)(QD + s * 528 + seg * 64 + 16 * i) = *(const u32x4*)(qg + 8 * i); *(LAS u32x4*)(KD + s * 528 + seg * 64 + 16 * i) = *(const u32x4*)(kg + 8 * i); } }
        __syncthreads();
#pragma unroll
        for (int tt = 0; tt < 2; ++tt) {
            const int tile = 2 * w + tt, ti = tile >> 2, si = tile & 3;
            f32x4 s4 = (f32x4){0.f, 0.f, 0.f, 0.f};
            if (si <= ti) {
#pragma unroll
                for (int ks = 0; ks < 8; ++ks) { const bf16x8 a = ldsv8(QD + (16 * ti + lr) * 528 + (32 * ks + 8 * g) * 2), bb = ldsv8(KD + (16 * si + lr) * 528 + (32 * ks + 8 * g) * 2); s4 = mfma16(a, bb, s4); }
            }
            const int sidx = 16 * si + lr;
#pragma unroll
            for (int j = 0; j < 4; ++j) { const int t = 16 * ti + 4 * g + j; *(LAS unsigned short*)(ATT + t * 144 + sidx * 2) = (unsigned short)f2bf((sidx <= t) ? s4[j] : 0.f); }
        }
        __syncthreads();
        f32x4 acc[4][4];
#pragma unroll
        for (int mi = 0; mi < 4; ++mi)
#pragma unroll
            for (int ni = 0; ni < 4; ++ni) acc[mi][ni] = (f32x4){0.f, 0.f, 0.f, 0.f};
        const bf16_t* st = ST + ((size_t)(bh * 128 + c) << 17);
#pragma unroll 4
        for (int ks = 0; ks < 8; ++ks) {
            bf16x8 bb[4];
#pragma unroll
            for (int ni = 0; ni < 4; ++ni) bb[ni] = *(const bf16x8*)(st + (size_t)(64 * w + 16 * ni + lr) * 256 + 32 * ks + 8 * g);
#pragma unroll
            for (int mi = 0; mi < 4; ++mi) { const bf16x8 a = ldsv8(QD + (16 * mi + lr) * 528 + (32 * ks + 8 * g) * 2);
#pragma unroll
                for (int ni = 0; ni < 4; ++ni) acc[mi][ni] = mfma16(bb[ni], a, acc[mi][ni]); }
        }
#pragma unroll
        for (int ks = 0; ks < 2; ++ks) {
            const int r0 = 32 * ks + 8 * g + q; bf16x8 bb[4];
#pragma unroll
            for (int ni = 0; ni < 4; ++ni) { const LAS unsigned char* bp = V + r0 * 1056 + (64 * w + 16 * ni + 4 * p) * 2; bb[ni] = tr8(bp, bp + 4 * 1056); }
#pragma unroll
            for (int mi = 0; mi < 4; ++mi) { const bf16x8 a = ldsv8(ATT + (16 * mi + lr) * 144 + (32 * ks + 8 * g) * 2);
#pragma unroll
                for (int ni = 0; ni < 4; ++ni) acc[mi][ni] = mfma16(bb[ni], a, acc[mi][ni]); }
        }
#pragma unroll
        for (int mi = 0; mi < 4; ++mi) { float ss = 0.f;
#pragma unroll
            for (int ni = 0; ni < 4; ++ni) ss += (acc[mi][ni][0] * acc[mi][ni][0] + acc[mi][ni][1] * acc[mi][ni][1]) + (acc[mi][ni][2] * acc[mi][ni][2] + acc[mi][ni][3] * acc[mi][ni][3]);
            ss += __shfl_xor(ss, 16); ss += __shfl_xor(ss, 32);
            if (g == 0) fss[w * 64 + 16 * mi + lr] = ss; }
        __syncthreads();
#pragma unroll
        for (int mi = 0; mi < 4; ++mi) { const int t = 16 * mi + lr; float tot = 0.f;
#pragma unroll
            for (int ww = 0; ww < 8; ++ww) tot += fss[ww * 64 + t];
            const float r = 1.f / sqrtf(tot * (1.f / 512.f) + 1e-6f);
#pragma unroll
            for (int ni = 0; ni < 4; ++ni) { const int dv = 64 * w + 16 * ni + 4 * g;
                const u32x2 rgb = *(const u32x2*)(U + (row0 + t) * UW + 4096 + h * 512 + dv); const f32x4 gv = *(const f32x4*)(gg + h * 512 + dv);
                const float r0 = bflo(rgb.x), r1 = bfhi(rgb.x), r2 = bflo(rgb.y), r3 = bfhi(rgb.y);
                const float o0 = acc[mi][ni][0] * r * gv[0] * r0 * pg8::sigmoidf_(r0), o1 = acc[mi][ni][1] * r * gv[1] * r1 * pg8::sigmoidf_(r1);
                const float o2 = acc[mi][ni][2] * r * gv[2] * r2 * pg8::sigmoidf_(r2), o3 = acc[mi][ni][3] * r * gv[3] * r3 * pg8::sigmoidf_(r3);
                u32x2 wv; wv.x = pg8::cvt_pk_bf16(o0, o1); wv.y = pg8::cvt_pk_bf16(o2, o3);
                *(u32x2*)(MIX + (row0 + t) * DM + h * 512 + dv) = wv; } }
        __syncthreads();
    }
}

__device__ __forceinline__ int crow(int r, int hi) { return (r & 3) + 8 * (r >> 2) + 4 * hi; }
__device__ __forceinline__ void attn_unit(const Ctx& C, const bf16_t* U, const float* rel_bias, const float* dg, float lam, int b, int h, int qb, bf16_t* MIX) {
    LAS unsigned char* KT0 = C.lds; LAS unsigned char* VT0 = C.lds + 2 * 17408; LAS float* tab = (LAS float*)(C.lds + 131072); LAS float* OX = (LAS float*)(C.lds);
    constexpr int KS = 272, VS = 320;
    const int l = C.lane, ql = l & 31, hi = l >> 5, g = l >> 4, qq = (l & 15) >> 2, pp = l & 3, w = C.wave, comp = w >> 2, rw = w & 3;
    const int qpos = qb * 128 + 32 * rw + ql;
    const size_t rowq = (size_t)b * SEQ + qpos;
    __syncthreads();
    if (C.tid < 128) { const int n = C.tid; int bk;
        if (n < 16) bk = n; else { bk = 16 + (int)(__logf((float)n * 0.0625f) / 2.0794415416798357f * 16.f); bk = bk < 31 ? bk : 31; }
        tab[n] = rel_bias[bk * 8 + h] * LOG2E; }
    const float b31 = rel_bias[31 * 8 + h] * LOG2E;
    LAS unsigned char* QT = C.lds + 96256;
    { const int row = C.tid >> 2, part = C.tid & 3; const bf16_t* qsrc = U + ((size_t)b * SEQ + qb * 128 + row) * UW + h * 128 + part * 32;
#pragma unroll
      for (int i = 0; i < 4; ++i) *(LAS u32x4*)(QT + row * 272 + part * 64 + 16 * i) = *(const u32x4*)(qsrc + 8 * i); }
    const LAS unsigned char* qfrag = QT + (32 * rw + ql) * 272 + (comp * 64 + 8 * hi) * 2;
    f32x16 o[4];
#pragma unroll
    for (int mb = 0; mb < 4; ++mb)
#pragma unroll
        for (int r = 0; r < 16; ++r) o[mb][r] = 0.f;
    float mrun = -1.0e30f, lrun = 0.f;
    u32x4 kreg[2], vreg[2];
    const bf16_t* srcb = U + ((size_t)b * SEQ + (C.tid >> 4)) * UW + h * 128 + (C.tid & 15) * 8;
    const int ntiles = 2 * (qb + 1);
#pragma unroll
    for (int i = 0; i < 2; ++i) { kreg[i] = *(const u32x4*)(srcb + (size_t)(32 * i) * UW + 1024); vreg[i] = *(const u32x4*)(srcb + (size_t)(32 * i) * UW + 2048); }
#pragma unroll
    for (int i = 0; i < 2; ++i) { const int key = (C.tid >> 4) + 32 * i, seg = C.tid & 15;
        *(LAS u32x4*)(KT0 + key * KS + seg * 16) = kreg[i]; *(LAS u32x4*)(VT0 + key * VS + seg * 16) = vreg[i]; }
#pragma unroll
    for (int i = 0; i < 2; ++i) { kreg[i] = *(const u32x4*)(srcb + (size_t)(64 + 32 * i) * UW + 1024); vreg[i] = *(const u32x4*)(srcb + (size_t)(64 + 32 * i) * UW + 2048); }
    int vs_cur = 0, vs_prev = 0; const bool rot = comp == 1;
    bf16x8 pb[4];
#pragma unroll
    for (int i = 0; i < 4; ++i) pb[i] = (bf16x8){0, 0, 0, 0, 0, 0, 0, 0};
#define ATT_PV(VSLOT) do { const LAS unsigned char* vb_ = VT0 + (VSLOT) * 20480 + (4 * hi + qq) * VS + (16 * (g & 1) + 4 * pp) * 2; _Pragma("unroll") for (int k2 = 0; k2 < 2; ++k2) _Pragma("unroll") for (int ks = 0; ks < 2; ++ks) { \
        bf16x8 af_[4]; _Pragma("unroll") for (int mb = 0; mb < 4; ++mb) { const LAS unsigned char* ap = vb_ + (32 * k2 + 16 * ks) * VS + 64 * mb; af_[mb] = tr8(ap, ap + 8 * VS); } \
        __builtin_amdgcn_sched_barrier(0); \
        _Pragma("unroll") for (int mb = 0; mb < 4; ++mb) o[mb] = mfma32(af_[mb], pb[2 * k2 + ks], o[mb]); } } while (0)
    for (int kt = 0; kt < ntiles; ++kt) {
        const int kb = kt * 64;
        __syncthreads();
        LAS unsigned char* KT = KT0 + (kt & 1) * 17408; LAS unsigned char* VT = VT0 + vs_cur * 20480;
        const int vs_nxt = vs_cur == 2 ? 0 : vs_cur + 1;
        if (kt + 1 < ntiles) {
            LAS unsigned char* KN = KT0 + ((kt + 1) & 1) * 17408; LAS unsigned char* VN = VT0 + vs_nxt * 20480;
#pragma unroll
            for (int i = 0; i < 2; ++i) { const int key = (C.tid >> 4) + 32 * i, seg = C.tid & 15;
                *(LAS u32x4*)(KN + key * KS + seg * 16) = kreg[i]; *(LAS u32x4*)(VN + key * VS + seg * 16) = vreg[i]; }
            if (kt + 2 < ntiles) {
#pragma unroll
                for (int i = 0; i < 2; ++i) { kreg[i] = *(const u32x4*)(srcb + (size_t)(kb + 128 + 32 * i) * UW + 1024); vreg[i] = *(const u32x4*)(srcb + (size_t)(kb + 128 + 32 * i) * UW + 2048); }
            }
        }
        if (rot && kt > 0) ATT_PV(vs_prev);
        __builtin_amdgcn_sched_barrier(0);
        f32x16 st[2];
#pragma unroll
        for (int k2 = 0; k2 < 2; ++k2) {
#pragma unroll
            for (int r = 0; r < 16; ++r) st[k2][r] = 0.f;
#pragma unroll
            for (int kk = 0; kk < 4; ++kk) st[k2] = mfma32(ldsv8(KT + (32 * k2 + ql) * KS + (comp * 64 + 16 * kk + 8 * hi) * 2), ldsv8(qfrag + 32 * kk), st[k2]);
        }
        __builtin_amdgcn_sched_barrier(0);
        const bool far = (qb * 128 + 32 * rw - (kb + 63)) >= 127;
        float mx = -1.0e30f, cadd;
        if (far) {
#pragma unroll
            for (int k2 = 0; k2 < 2; ++k2)
#pragma unroll
                for (int r = 0; r < 16; r += 2) mx = fmaxf(fmaxf(st[k2][r], st[k2][r + 1]), mx);
            mx = mx * LOG2E + b31; cadd = b31;
        } else {
#pragma unroll
            for (int k2 = 0; k2 < 2; ++k2)
#pragma unroll
                for (int r = 0; r < 16; ++r) { const int rel = qpos - (kb + 32 * k2 + crow(r, hi)); const int ri = rel < 0 ? 0 : (rel > 127 ? 127 : rel);
                    const float t = st[k2][r] * LOG2E + tab[ri]; st[k2][r] = (rel >= 0 ? t : -1.0e30f) * (1.0f / LOG2E); mx = fmaxf(mx, rel >= 0 ? t : -1.0e30f); }
            cadd = 0.f;
        }
        mx = fmaxf(mx, __shfl_xor(mx, 32));
        const float mnew = fmaxf(mrun, mx), alpha = __builtin_amdgcn_exp2f(mrun - mnew);
        const bool grew = mnew > mrun; mrun = mnew;
        const float cst = cadd - mnew;
        float ps = 0.f;
#pragma unroll
        for (int k2 = 0; k2 < 2; ++k2)
#pragma unroll
            for (int r = 0; r < 16; ++r) { const float pv = __builtin_amdgcn_exp2f(__builtin_fmaf(st[k2][r], LOG2E, cst)); st[k2][r] = pv; ps += pv; }
        lrun = lrun * alpha + ps;
        if (__any(grew)) {
#pragma unroll
            for (int mb = 0; mb < 4; ++mb)
#pragma unroll
                for (int r = 0; r < 16; ++r) o[mb][r] *= alpha;
        }
        __builtin_amdgcn_sched_barrier(0);
#pragma unroll
        for (int k2 = 0; k2 < 2; ++k2)
#pragma unroll
            for (int ks = 0; ks < 2; ++ks) { const int r8 = 8 * ks;
                const unsigned w0 = pg8::cvt_pk_bf16(st[k2][r8 + 0], st[k2][r8 + 1]), w1 = pg8::cvt_pk_bf16(st[k2][r8 + 2], st[k2][r8 + 3]), w2 = pg8::cvt_pk_bf16(st[k2][r8 + 4], st[k2][r8 + 5]), w3 = pg8::cvt_pk_bf16(st[k2][r8 + 6], st[k2][r8 + 7]);
                const u32x4 wv = (u32x4){w0, w1, w2, w3}; pb[2 * k2 + ks] = __builtin_bit_cast(bf16x8, wv); }
        __builtin_amdgcn_sched_barrier(0);
        if (!rot) ATT_PV(vs_cur);
        vs_prev = vs_cur; vs_cur = vs_nxt;
    }
    if (rot) ATT_PV(vs_prev);
#undef ATT_PV
    const float ltot = lrun + __shfl_xor(lrun, 32), inv = 1.f / ltot;
    int l2 = C.lane; asm volatile("" : "+v"(l2));
    const int ql_e = l2 & 31, hi_e = l2 >> 5;
    const size_t rowq_e = (size_t)b * SEQ + qb * 128 + 32 * rw + ql_e;
    __syncthreads();
    if (comp == 1) {
#pragma unroll
        for (int mb = 0; mb < 4; ++mb)
#pragma unroll
            for (int r = 0; r < 16; ++r) OX[(rw * 128 + 32 * mb + crow(r, hi_e)) * 32 + ql_e] = o[mb][r] * inv;
    }
    __syncthreads();
    if (comp == 0) {
        float ss = 0.f;
#pragma unroll
        for (int mb = 0; mb < 4; ++mb)
#pragma unroll
            for (int r = 0; r < 16; ++r) { const float y = o[mb][r] * inv - lam * OX[(rw * 128 + 32 * mb + crow(r, hi_e)) * 32 + ql_e]; o[mb][r] = y; ss += y * y; }
        ss += __shfl_xor(ss, 32);
        const float rn = (1.f / sqrtf(ss * (1.f / 128.f) + 1e-6f)) * 0.8f;
#pragma unroll
        for (int mb = 0; mb < 4; ++mb)
#pragma unroll
            for (int r4 = 0; r4 < 4; ++r4) { const int dv = 32 * mb + 8 * r4 + 4 * hi_e; const f32x4 gv = *(const f32x4*)(dg + h * 128 + dv);
                u32x2 wv; wv.x = pk2(o[mb][4 * r4] * rn * gv[0], o[mb][4 * r4 + 1] * rn * gv[1]); wv.y = pk2(o[mb][4 * r4 + 2] * rn * gv[2], o[mb][4 * r4 + 3] * rn * gv[3]);
                *(u32x2*)(MIX + rowq_e * DM + h * 128 + dv) = wv; }
    }
}
__device__ __forceinline__ void attn_phase(const Ctx& C, const bf16_t* U, const float* rel_bias, const float* dg, const float* lq1, const float* lk1, const float* lq2, const float* lk2, bf16_t* MIX) {
    float s1 = 0.f, s2 = 0.f;
#pragma unroll 4
    for (int i = 0; i < 64; ++i) { s1 += lq1[i] * lk1[i]; s2 += lq2[i] * lk2[i]; }
    const float lam = __expf(s1) - __expf(s2) + 0.2f;
    const bool xa = (C.G == 256);
#pragma unroll 1
    for (int k = 0; k < 512; ++k) {
        int pr;
        if (xa) { if (k >= 2) break; pr = (2 * (C.bid & 7) + k) * 32 + (C.bid >> 3); } else { pr = C.bid + k * C.G; if (pr >= 512) break; }
        const int bh = pr >> 5, i = pr & 31, b = bh >> 3, h = bh & 7;
        attn_unit(C, U, rel_bias, dg, lam, b, h, i, MIX);
        attn_unit(C, U, rel_bias, dg, lam, b, h, 63 - i, MIX);
    }
    __syncthreads();
}

struct Args {
    const float* x; const float* p; const float* ln_g; const float* ln_b; const float* w_ffn_in; const float* w_ffn_out; const float* w_in_ab; const float* w_out_ab;
    const float* rel_bias; const float* lq1; const float* lk1; const float* lq2; const float* lk2; const float* diff_norm; const float* conv_w; const float* conv_b;
    const float* b_igate; const float* b_fgate; const float* mlstm_norm; const float* w_in_c; const float* w_alpha2; const float* b_alpha; const float* gla_norm;
    const float* w_out_c; const float* w_ple_proj; const float* w_ple_gate;
    float* out; unsigned char* ws;
    int ph_lo, ph_hi;
};


constexpr int ARGS_OFF = 147200;
enum { A_x = 0, A_p, A_ln_g, A_ln_b, A_w_ffn_in, A_w_ffn_out, A_w_in_ab, A_w_out_ab, A_rel_bias, A_lq1, A_lk1, A_lq2, A_lk2, A_diff_norm, A_conv_w, A_conv_b,
       A_b_igate, A_b_fgate, A_mlstm_norm, A_w_in_c, A_w_alpha2, A_b_alpha, A_gla_norm, A_w_out_c, A_w_ple_proj, A_w_ple_gate, A_out, A_ws };
__device__ __forceinline__ unsigned char* ldarg(LAS unsigned char* lds, int i) {
    volatile LAS unsigned* p = (volatile LAS unsigned*)(lds + ARGS_OFF) + 2 * i;
    const unsigned lo = __builtin_amdgcn_readfirstlane(p[0]), hi = __builtin_amdgcn_readfirstlane(p[1]);
    return (unsigned char*)(__attribute__((address_space(1))) unsigned char*)(((unsigned long long)hi << 32) | lo);
}
#define ARGF(i) ((const float*)ldarg(C.lds, (i)))
#define WSP(T, off) ((T*)(ldarg(C.lds, A_ws) + (off)))


__device__ __forceinline__ void grid_barrier(unsigned* ctr, unsigned target, bool leader) {
    asm volatile("s_waitcnt vmcnt(0) lgkmcnt(0)" ::: "memory");
    __syncthreads();
    if (leader) {
        __builtin_amdgcn_fence(__ATOMIC_RELEASE, "agent");
        asm volatile("s_waitcnt vmcnt(0)" ::: "memory");
        (void)__hip_atomic_fetch_add(ctr, 1u, __ATOMIC_RELAXED, __HIP_MEMORY_SCOPE_AGENT);
        while (__hip_atomic_load(ctr, __ATOMIC_RELAXED, __HIP_MEMORY_SCOPE_AGENT) < target) __builtin_amdgcn_s_sleep(1);
        __builtin_amdgcn_fence(__ATOMIC_ACQUIRE, "agent");
        asm volatile("s_waitcnt vmcnt(0)" ::: "memory");
    }
    __syncthreads();
}

#define XB_TMO      128
#define XB_XCNT(j)  (256  + 64 * (j))
#define XB_XSUB(j)  (1280 + 64 * (j))
#define XB_XGEN(j)  (2304 + 64 * (j))
#define XB_TOP      3328
#define XB_TOPGEN   3392
#define XCD_BAR_WORDS 3456
#define XB_SPIN_CAP (1u << 22)
__device__ __forceinline__ unsigned xb_ld(unsigned* p)              { return __hip_atomic_load(p, __ATOMIC_RELAXED, __HIP_MEMORY_SCOPE_AGENT); }
__device__ __forceinline__ unsigned xb_add(unsigned* p, unsigned v) { return __hip_atomic_fetch_add(p, v, __ATOMIC_RELAXED, __HIP_MEMORY_SCOPE_AGENT); }
__device__ __forceinline__ unsigned xb_xcc_id() { return (unsigned)__builtin_amdgcn_s_getreg((3 << 11) | 20) & 0xFu; }
#define XB_SPIN(cond, bar) do { unsigned _sp = 0; while (cond) { __builtin_amdgcn_s_sleep(1); \
    if ((++_sp & 255u) == 0u) { if (xb_ld(&(bar)[XB_TMO])) break; if (_sp > XB_SPIN_CAP) { atomicAdd(&(bar)[XB_TMO], 1u); break; } } } } while (0)
__device__ __forceinline__ void xcd_barrier_complete(unsigned* bar, unsigned x, unsigned& nloc, unsigned& nx) {
    const unsigned G = gridDim.x;
    unsigned sum, cnt, mine, sp = 0u;
    for (;;) {
        sum = 0u; cnt = 0u; mine = 0u;
#pragma unroll
        for (unsigned j = 0; j < 16; ++j) { const unsigned c = xb_ld(&bar[XB_XCNT(j)]); sum += c; cnt += (c > 0u) ? 1u : 0u; mine = (j == x) ? c : mine; }
        if (sum == G) break;
        __builtin_amdgcn_s_sleep(1);
        if ((++sp & 255u) == 0u) { if (xb_ld(&bar[XB_TMO])) break; if (sp > XB_SPIN_CAP) { atomicAdd(&bar[XB_TMO], 1u); break; } }
    }
    nloc = mine > 0u ? mine : 1u; nx = cnt > 0u ? cnt : 1u;
}
__device__ __forceinline__ void xcd_barrier(unsigned* bar, volatile LAS unsigned* st, bool leader) {
    asm volatile("s_waitcnt vmcnt(0)" ::: "memory");
    __syncthreads();
    if (leader) {
        __builtin_amdgcn_s_waitcnt(0);
        const unsigned x = xb_xcc_id();
        unsigned nloc = st[0], nx = st[1];
        if (nloc == 0u) { xcd_barrier_complete(bar, x, nloc, nx); st[0] = nloc; st[1] = nx; }
        const unsigned old = xb_add(&bar[XB_XSUB(x)], 1u);
        const unsigned gen = old / nloc;
        if (old + 1u == (gen + 1u) * nloc) {
            __builtin_amdgcn_fence(__ATOMIC_RELEASE, "agent");
            asm volatile("s_waitcnt vmcnt(0)" ::: "memory");
            const unsigned og = xb_add(&bar[XB_TOP], 1u);
            const unsigned tg = og / nx;
            if (og + 1u == (tg + 1u) * nx) xb_add(&bar[XB_TOPGEN], 1u);
            else XB_SPIN(xb_ld(&bar[XB_TOPGEN]) == tg, bar);
            __builtin_amdgcn_fence(__ATOMIC_ACQUIRE, "agent");
            xb_add(&bar[XB_XGEN(x)], 1u);
            asm volatile("s_waitcnt vmcnt(0)" ::: "memory");
        } else {
            XB_SPIN(xb_ld(&bar[XB_XGEN(x)]) == gen, bar);
            __builtin_amdgcn_fence(__ATOMIC_ACQUIRE, "agent");
            asm volatile("s_waitcnt vmcnt(0)" ::: "memory");
        }
    }
    __syncthreads();
}

#define GEMM_CALL(EPI, Aptr, Bptr, Nn, Kk, Eobj) do { pg8::Gemm g_{(const bf16_t*)(Aptr), (const bf16_t*)(Bptr), MT, (Nn), (Kk)}; pg8::StaticOrder S_; S_.init(MT, (Nn), C.G, C.bid); \
    pg8::gemm_phase<EPI, pg8::StaticOrder, true, true>(C.lds, g_, S_, Eobj, C.tid); } while (0)

__global__ void __launch_bounds__(512, 2) mega_fwd(Args a) {
    extern __shared__ __attribute__((aligned(16))) unsigned char lds_raw[];
    cg::grid_group grid = cg::this_grid();
    if (threadIdx.x == 0) {
        LAS unsigned long long* t = (LAS unsigned long long*)((LAS unsigned char*)lds_raw + ARGS_OFF);
        t[A_x] = (unsigned long long)a.x; t[A_p] = (unsigned long long)a.p; t[A_ln_g] = (unsigned long long)a.ln_g; t[A_ln_b] = (unsigned long long)a.ln_b;
        t[A_w_ffn_in] = (unsigned long long)a.w_ffn_in; t[A_w_ffn_out] = (unsigned long long)a.w_ffn_out; t[A_w_in_ab] = (unsigned long long)a.w_in_ab; t[A_w_out_ab] = (unsigned long long)a.w_out_ab;
        t[A_rel_bias] = (unsigned long long)a.rel_bias; t[A_lq1] = (unsigned long long)a.lq1; t[A_lk1] = (unsigned long long)a.lk1; t[A_lq2] = (unsigned long long)a.lq2; t[A_lk2] = (unsigned long long)a.lk2;
        t[A_diff_norm] = (unsigned long long)a.diff_norm; t[A_conv_w] = (unsigned long long)a.conv_w; t[A_conv_b] = (unsigned long long)a.conv_b; t[A_b_igate] = (unsigned long long)a.b_igate;
        t[A_b_fgate] = (unsigned long long)a.b_fgate; t[A_mlstm_norm] = (unsigned long long)a.mlstm_norm; t[A_w_in_c] = (unsigned long long)a.w_in_c; t[A_w_alpha2] = (unsigned long long)a.w_alpha2;
        t[A_b_alpha] = (unsigned long long)a.b_alpha; t[A_gla_norm] = (unsigned long long)a.gla_norm; t[A_w_out_c] = (unsigned long long)a.w_out_c; t[A_w_ple_proj] = (unsigned long long)a.w_ple_proj;
        t[A_w_ple_gate] = (unsigned long long)a.w_ple_gate; t[A_out] = (unsigned long long)a.out; t[A_ws] = (unsigned long long)a.ws;
        t[30] = 0ull;
    }
    __syncthreads();
    const int ph_lo = a.ph_lo, ph_hi = a.ph_hi;
    int ph = 0; unsigned nbar = 0, ngb = 0;
    const int wave_s = __builtin_amdgcn_readfirstlane((int)(threadIdx.x >> 6));
#ifndef REPMASK
#define REPMASK 0
#endif
#define PHASE_BEGIN_G(grp) if (ph >= ph_lo && ph < ph_hi) for (int rep_ = 0; rep_ < (((REPMASK >> (grp)) & 1) ? 2 : 1); ++rep_) { Ctx C; { int t_ = wave_s * 64 + (int)__builtin_amdgcn_mbcnt_hi(~0u, __builtin_amdgcn_mbcnt_lo(~0u, 0u)); asm volatile("" : "+v"(t_)); C.lds = (LAS unsigned char*)lds_raw; C.tid = t_; C.lane = t_ & 63; C.wave = __builtin_amdgcn_readfirstlane(t_ >> 6); \
    C.G = gridDim.x; C.bid = blockIdx.x; C.gw = C.bid * 8 + C.wave; C.NGW = C.G * 8; }
#define PHASE_BEGIN PHASE_BEGIN_G(31)
#ifndef SYNCREP
#define SYNCREP 1
#endif
#define PHASE_END_K(GROUPWISE) } ++ph; if (ph > ph_lo && ph < ph_hi) { for (int sr_ = 0; sr_ < SYNCREP; ++sr_) { \
        unsigned* ctl_ = (unsigned*)(ldarg((LAS unsigned char*)lds_raw, A_ws) + OFF_CTL); const bool lead_ = wave_s == 0 && __builtin_amdgcn_mbcnt_hi(~0u, __builtin_amdgcn_mbcnt_lo(~0u, 0u)) == 0u; \
        if ((GROUPWISE) && (gridDim.x & 7u) == 0u) { ++ngb; grid_barrier(ctl_ + 64 * (1 + (blockIdx.x & 7u)), ngb * (gridDim.x >> 3), lead_); } \
        else { xcd_barrier(ctl_ + 1024, (volatile LAS unsigned*)((LAS unsigned char*)lds_raw + ARGS_OFF + 240), lead_); } } }
#define PHASE_END PHASE_END_K(0)
#define PHASE_END_NONE } ++ph;
#define PHASE_END_ROWS PHASE_END_K(0)

    PHASE_BEGIN_G(0)
        if (C.bid == 0) { unsigned* ctl0_ = (unsigned*)(ldarg(C.lds, A_ws) + OFF_CTL); for (int i_ = C.tid; i_ < 1024 + XCD_BAR_WORDS; i_ += 512) ctl0_[i_] = 0u; }
        int base = 0;
        for (int i = 0; i < 4; ++i) conv_matrix(C, ARGF(A_w_ffn_in) + (size_t)i * DM * NFF2, DM, NFF2, NFF2, WSP(bf16_t, OFF_WFI) + (size_t)i * NFF2 * DM, 1, base);
        for (int i = 0; i < 4; ++i) conv_matrix(C, ARGF(A_w_ffn_out) + (size_t)i * DFF * DM, DFF, DM, DM, WSP(bf16_t, OFF_WFO) + (size_t)i * DM * DFF, 0, base);
        conv_matrix(C, ARGF(A_w_in_ab), DM, 6152, NIN, WSP(bf16_t, OFF_WAB), 2, base);
        conv_matrix(C, ARGF(A_w_in_c), DM, 6160, NIN, WSP(bf16_t, OFF_WC), 0, base);
        conv_matrix(C, ARGF(A_w_out_ab), DM, DM, DM, WSP(bf16_t, OFF_WOAB), 0, base);
        conv_matrix(C, ARGF(A_w_out_c), DM, DM, DM, WSP(bf16_t, OFF_WOC), 0, base);
        for (int i = 0; i < 2; ++i) conv_matrix(C, ARGF(A_w_ple_gate) + (size_t)i * DM * DM, DM, DM, DM, WSP(bf16_t, OFF_WPG) + (size_t)i * DM * DM, 0, base);
        for (int i = 0; i < 2; ++i) conv_matrix(C, ARGF(A_w_ple_proj) + (size_t)i * PLE * DM, PLE, DM, DM, WSP(bf16_t, OFF_WPP) + (size_t)i * DM * PLE, 0, base);
        cvt_rows(C, ARGF(A_x), WSP(bf16_t, OFF_XB), (size_t)MT * DM / 4);
        cvt_rows(C, ARGF(A_p), WSP(bf16_t, OFF_PB), (size_t)2 * MT * PLE / 4);
        __syncthreads();
    } ++ph; if (ph > ph_lo && ph < ph_hi) { grid.sync(); if (wave_s == 0 && __builtin_amdgcn_mbcnt_hi(~0u, __builtin_amdgcn_mbcnt_lo(~0u, 0u)) == 0u) (void)xb_add((unsigned*)(ldarg((LAS unsigned char*)lds_raw, A_ws) + OFF_CTL) + 1024 + XB_XCNT(xb_xcc_id()), 1u); }

    { constexpr int L = 0;
        PHASE_BEGIN_G(1) { pg8::EpiSwiglu e{WSP(bf16_t, OFF_H), DFF}; GEMM_CALL(pg8::EpiSwiglu, WSP(bf16_t, (L == 0 ? OFF_XB : OFF_MIX)), WSP(bf16_t, OFF_WFI) + (size_t)(2 * L) * NFF2 * DM, NFF2, DM, e); }
            if (L == 0) { for (int l2 = 0; l2 < 2; ++l2) { pg8::EpiStore e2{WSP(bf16_t, OFF_XF) + (size_t)l2 * MT * DM, DM, DM, nullptr}; GEMM_CALL(pg8::EpiStore, WSP(bf16_t, OFF_PB) + (size_t)l2 * MT * PLE, WSP(bf16_t, OFF_WPP) + (size_t)l2 * DM * PLE, DM, PLE, e2); } } PHASE_END_ROWS
        PHASE_BEGIN_G(1) { if (L == 0) { pg8::EpiZ<true> e{(const void*)ARGF(A_x), WSP(bf16_t, OFF_Z), ALPHA, 0.5f}; GEMM_CALL(pg8::EpiZ<true>, WSP(bf16_t, OFF_H), WSP(bf16_t, OFF_WFO) + (size_t)(2 * L) * DM * DFF, DM, DFF, e); } else { pg8::EpiZ<false> e{(const void*)WSP(bf16_t, OFF_MIX), WSP(bf16_t, OFF_Z), ALPHA, 0.5f}; GEMM_CALL(pg8::EpiZ<false>, WSP(bf16_t, OFF_H), WSP(bf16_t, OFF_WFO) + (size_t)(2 * L) * DM * DFF, DM, DFF, e); } } PHASE_END_ROWS
        PHASE_BEGIN_G(3) ln_phase<true>(C, WSP(bf16_t, OFF_Z), ARGF(A_ln_g) + (size_t)(3 * L) * DM, ARGF(A_ln_b) + (size_t)(3 * L) * DM, WSP(bf16_t, OFF_XB), (L == 0 ? ARGF(A_w_in_ab) : ARGF(A_w_in_c)), (L == 0 ? 6152 : 6160), (L == 0 ? 8 : 16), WSP(float, OFF_GT)); PHASE_END
        PHASE_BEGIN_G(2) { pg8::EpiStore e{WSP(bf16_t, OFF_H), UW, UW, nullptr}; GEMM_CALL(pg8::EpiStore, WSP(bf16_t, OFF_XB), WSP(bf16_t, (L == 0 ? OFF_WAB : OFF_WC)), NIN, DM, e); } PHASE_END
        if (L == 0) {
            PHASE_BEGIN_G(5) m1_phase(C, WSP(bf16_t, OFF_H), WSP(float, OFF_GT), ARGF(A_conv_w), ARGF(A_conv_b), ARGF(A_b_igate), ARGF(A_b_fgate), WSP(bf16_t, OFF_QB), WSP(bf16_t, OFF_KB), WSP(float, OFF_BC), WSP(float, OFF_IP), WSP(float, OFF_MSC)); PHASE_END
            PHASE_BEGIN
                mlstm_passA(C, WSP(bf16_t, OFF_H), WSP(bf16_t, OFF_KB), WSP(float, OFF_BC), WSP(float, OFF_IP), WSP(float, OFF_MSC), WSP(bf16_t, OFF_ST), WSP(float, OFF_NL));
                for (int rep2_ = 0; rep2_ < (((REPMASK >> 4) & 1) ? 2 : 1); ++rep2_)
                attn_phase(C, WSP(bf16_t, OFF_H), ARGF(A_rel_bias), ARGF(A_diff_norm), ARGF(A_lq1), ARGF(A_lk1), ARGF(A_lq2), ARGF(A_lk2), WSP(bf16_t, OFF_MIX));
            PHASE_END
            PHASE_BEGIN mlstm_scan(C, WSP(bf16_t, OFF_ST), WSP(float, OFF_NL), WSP(float, OFF_MSC)); PHASE_END
            PHASE_BEGIN_G(5) mlstm_passC(C, WSP(bf16_t, OFF_H), WSP(bf16_t, OFF_QB), WSP(bf16_t, OFF_KB), WSP(float, OFF_BC), WSP(float, OFF_IP), WSP(float, OFF_MSC), WSP(bf16_t, OFF_ST), WSP(float, OFF_NL), ARGF(A_mlstm_norm), WSP(bf16_t, OFF_MIX)); PHASE_END
        } else {
            PHASE_BEGIN_G(6) gla_passA(C, WSP(bf16_t, OFF_H), WSP(float, OFF_GT), ARGF(A_w_alpha2), ARGF(A_b_alpha), WSP(bf16_t, OFF_ST), WSP(float, OFF_DC), WSP(bf16_t, OFF_Z), WSP(bf16_t, OFF_Z + (size_t)MT * 1024 * 2)); PHASE_END
            PHASE_BEGIN gla_scan(C, WSP(bf16_t, OFF_ST), WSP(float, OFF_DC)); PHASE_END
            PHASE_BEGIN_G(7) gla_passC(C, WSP(bf16_t, OFF_H), WSP(bf16_t, OFF_Z), WSP(bf16_t, OFF_Z + (size_t)MT * 1024 * 2), WSP(bf16_t, OFF_ST), ARGF(A_gla_norm), WSP(bf16_t, OFF_MIX)); PHASE_END
        }
        PHASE_BEGIN_G(1) { pg8::EpiZ<false> e{(const void*)WSP(bf16_t, OFF_XB), WSP(bf16_t, OFF_Z), ALPHA, 1.0f}; GEMM_CALL(pg8::EpiZ<false>, WSP(bf16_t, OFF_MIX), WSP(bf16_t, (L == 0 ? OFF_WOAB : OFF_WOC)), DM, DM, e); } PHASE_END_ROWS
        PHASE_BEGIN_G(3) ln_phase<false>(C, WSP(bf16_t, OFF_Z), ARGF(A_ln_g) + (size_t)(3 * L + 1) * DM, ARGF(A_ln_b) + (size_t)(3 * L + 1) * DM, WSP(bf16_t, OFF_XB), nullptr, 0, 0, nullptr); PHASE_END_ROWS
        PHASE_BEGIN_G(1) { pg8::EpiSwiglu e{WSP(bf16_t, OFF_H), DFF}; GEMM_CALL(pg8::EpiSwiglu, WSP(bf16_t, OFF_XB), WSP(bf16_t, OFF_WFI) + (size_t)(2 * L + 1) * NFF2 * DM, NFF2, DM, e); } PHASE_END_ROWS
        PHASE_BEGIN_G(1) { pg8::EpiZ<false> e{(const void*)WSP(bf16_t, OFF_XB), WSP(bf16_t, OFF_Z), ALPHA, 0.5f}; GEMM_CALL(pg8::EpiZ<false>, WSP(bf16_t, OFF_H), WSP(bf16_t, OFF_WFO) + (size_t)(2 * L + 1) * DM * DFF, DM, DFF, e); } PHASE_END_ROWS
        PHASE_BEGIN_G(3) ln_phase<false>(C, WSP(bf16_t, OFF_Z), ARGF(A_ln_g) + (size_t)(3 * L + 2) * DM, ARGF(A_ln_b) + (size_t)(3 * L + 2) * DM, WSP(bf16_t, OFF_XB), nullptr, 0, 0, nullptr); PHASE_END_ROWS
        PHASE_BEGIN { pg8::EpiPle e{WSP(const bf16_t, OFF_XB), WSP(const bf16_t, OFF_XF) + (size_t)L * MT * DM, (L == 1) ? (float*)ldarg(C.lds, A_out) : (float*)nullptr, (L == 1) ? (bf16_t*)nullptr : WSP(bf16_t, OFF_MIX)}; GEMM_CALL(pg8::EpiPle, WSP(bf16_t, OFF_XB), WSP(bf16_t, OFF_WPG) + (size_t)L * DM * DM, DM, DM, e); } PHASE_END_ROWS
        }
    { constexpr int L = 1;
        PHASE_BEGIN_G(1) { pg8::EpiSwiglu e{WSP(bf16_t, OFF_H), DFF}; GEMM_CALL(pg8::EpiSwiglu, WSP(bf16_t, (L == 0 ? OFF_XB : OFF_MIX)), WSP(bf16_t, OFF_WFI) + (size_t)(2 * L) * NFF2 * DM, NFF2, DM, e); }
            if (L == 0) { for (int l2 = 0; l2 < 2; ++l2) { pg8::EpiStore e2{WSP(bf16_t, OFF_XF) + (size_t)l2 * MT * DM, DM, DM, nullptr}; GEMM_CALL(pg8::EpiStore, WSP(bf16_t, OFF_PB) + (size_t)l2 * MT * PLE, WSP(bf16_t, OFF_WPP) + (size_t)l2 * DM * PLE, DM, PLE, e2); } } PHASE_END_ROWS
        PHASE_BEGIN_G(1) { if (L == 0) { pg8::EpiZ<true> e{(const void*)ARGF(A_x), WSP(bf16_t, OFF_Z), ALPHA, 0.5f}; GEMM_CALL(pg8::EpiZ<true>, WSP(bf16_t, OFF_H), WSP(bf16_t, OFF_WFO) + (size_t)(2 * L) * DM * DFF, DM, DFF, e); } else { pg8::EpiZ<false> e{(const void*)WSP(bf16_t, OFF_MIX), WSP(bf16_t, OFF_Z), ALPHA, 0.5f}; GEMM_CALL(pg8::EpiZ<false>, WSP(bf16_t, OFF_H), WSP(bf16_t, OFF_WFO) + (size_t)(2 * L) * DM * DFF, DM, DFF, e); } } PHASE_END_ROWS
        PHASE_BEGIN_G(3) ln_phase<true>(C, WSP(bf16_t, OFF_Z), ARGF(A_ln_g) + (size_t)(3 * L) * DM, ARGF(A_ln_b) + (size_t)(3 * L) * DM, WSP(bf16_t, OFF_XB), (L == 0 ? ARGF(A_w_in_ab) : ARGF(A_w_in_c)), (L == 0 ? 6152 : 6160), (L == 0 ? 8 : 16), WSP(float, OFF_GT)); PHASE_END
        PHASE_BEGIN_G(2) { pg8::EpiStore e{WSP(bf16_t, OFF_H), UW, UW, nullptr}; GEMM_CALL(pg8::EpiStore, WSP(bf16_t, OFF_XB), WSP(bf16_t, (L == 0 ? OFF_WAB : OFF_WC)), NIN, DM, e); } PHASE_END
        if (L == 0) {
            PHASE_BEGIN_G(5) m1_phase(C, WSP(bf16_t, OFF_H), WSP(float, OFF_GT), ARGF(A_conv_w), ARGF(A_conv_b), ARGF(A_b_igate), ARGF(A_b_fgate), WSP(bf16_t, OFF_QB), WSP(bf16_t, OFF_KB), WSP(float, OFF_BC), WSP(float, OFF_IP), WSP(float, OFF_MSC)); PHASE_END
            PHASE_BEGIN
                mlstm_passA(C, WSP(bf16_t, OFF_H), WSP(bf16_t, OFF_KB), WSP(float, OFF_BC), WSP(float, OFF_IP), WSP(float, OFF_MSC), WSP(bf16_t, OFF_ST), WSP(float, OFF_NL));
                for (int rep2_ = 0; rep2_ < (((REPMASK >> 4) & 1) ? 2 : 1); ++rep2_)
                attn_phase(C, WSP(bf16_t, OFF_H), ARGF(A_rel_bias), ARGF(A_diff_norm), ARGF(A_lq1), ARGF(A_lk1), ARGF(A_lq2), ARGF(A_lk2), WSP(bf16_t, OFF_MIX));
            PHASE_END
            PHASE_BEGIN mlstm_scan(C, WSP(bf16_t, OFF_ST), WSP(float, OFF_NL), WSP(float, OFF_MSC)); PHASE_END
            PHASE_BEGIN_G(5) mlstm_passC(C, WSP(bf16_t, OFF_H), WSP(bf16_t, OFF_QB), WSP(bf16_t, OFF_KB), WSP(float, OFF_BC), WSP(float, OFF_IP), WSP(float, OFF_MSC), WSP(bf16_t, OFF_ST), WSP(float, OFF_NL), ARGF(A_mlstm_norm), WSP(bf16_t, OFF_MIX)); PHASE_END
        } else {
            PHASE_BEGIN_G(6) gla_passA(C, WSP(bf16_t, OFF_H), WSP(float, OFF_GT), ARGF(A_w_alpha2), ARGF(A_b_alpha), WSP(bf16_t, OFF_ST), WSP(float, OFF_DC), WSP(bf16_t, OFF_Z), WSP(bf16_t, OFF_Z + (size_t)MT * 1024 * 2)); PHASE_END
            PHASE_BEGIN gla_scan(C, WSP(bf16_t, OFF_ST), WSP(float, OFF_DC)); PHASE_END
            PHASE_BEGIN_G(7) gla_passC(C, WSP(bf16_t, OFF_H), WSP(bf16_t, OFF_Z), WSP(bf16_t, OFF_Z + (size_t)MT * 1024 * 2), WSP(bf16_t, OFF_ST), ARGF(A_gla_norm), WSP(bf16_t, OFF_MIX)); PHASE_END
        }
        PHASE_BEGIN_G(1) { pg8::EpiZ<false> e{(const void*)WSP(bf16_t, OFF_XB), WSP(bf16_t, OFF_Z), ALPHA, 1.0f}; GEMM_CALL(pg8::EpiZ<false>, WSP(bf16_t, OFF_MIX), WSP(bf16_t, (L == 0 ? OFF_WOAB : OFF_WOC)), DM, DM, e); } PHASE_END_ROWS
        PHASE_BEGIN_G(3) ln_phase<false>(C, WSP(bf16_t, OFF_Z), ARGF(A_ln_g) + (size_t)(3 * L + 1) * DM, ARGF(A_ln_b) + (size_t)(3 * L + 1) * DM, WSP(bf16_t, OFF_XB), nullptr, 0, 0, nullptr); PHASE_END_ROWS
        PHASE_BEGIN_G(1) { pg8::EpiSwiglu e{WSP(bf16_t, OFF_H), DFF}; GEMM_CALL(pg8::EpiSwiglu, WSP(bf16_t, OFF_XB), WSP(bf16_t, OFF_WFI) + (size_t)(2 * L + 1) * NFF2 * DM, NFF2, DM, e); } PHASE_END_ROWS
        PHASE_BEGIN_G(1) { pg8::EpiZ<false> e{(const void*)WSP(bf16_t, OFF_XB), WSP(bf16_t, OFF_Z), ALPHA, 0.5f}; GEMM_CALL(pg8::EpiZ<false>, WSP(bf16_t, OFF_H), WSP(bf16_t, OFF_WFO) + (size_t)(2 * L + 1) * DM * DFF, DM, DFF, e); } PHASE_END_ROWS
        PHASE_BEGIN_G(3) ln_phase<false>(C, WSP(bf16_t, OFF_Z), ARGF(A_ln_g) + (size_t)(3 * L + 2) * DM, ARGF(A_ln_b) + (size_t)(3 * L + 2) * DM, WSP(bf16_t, OFF_XB), nullptr, 0, 0, nullptr); PHASE_END_ROWS
        PHASE_BEGIN { pg8::EpiPle e{WSP(const bf16_t, OFF_XB), WSP(const bf16_t, OFF_XF) + (size_t)L * MT * DM, (L == 1) ? (float*)ldarg(C.lds, A_out) : (float*)nullptr, (L == 1) ? (bf16_t*)nullptr : WSP(bf16_t, OFF_MIX)}; GEMM_CALL(pg8::EpiPle, WSP(bf16_t, OFF_XB), WSP(bf16_t, OFF_WPG) + (size_t)L * DM * DM, DM, DM, e); } PHASE_END_NONE
        }
}

extern "C" void kernel_launch(void* const* d_in, const int* in_sizes, int n_in, void* d_out, int out_size, void* d_ws, size_t ws_size, hipStream_t stream) {
    static int grid = 0;
    if (grid == 0) {
        int dev = 0, cus = 0, per_cu = 0;
        (void)hipGetDevice(&dev); (void)hipDeviceGetAttribute(&cus, hipDeviceAttributeMultiprocessorCount, dev);
        (void)hipFuncSetAttribute((const void*)mega_fwd, hipFuncAttributeMaxDynamicSharedMemorySize, LDS_BYTES);
        (void)hipOccupancyMaxActiveBlocksPerMultiprocessor(&per_cu, (const void*)mega_fwd, 512, LDS_BYTES);
        if (per_cu < 1) per_cu = 1;
        if (cus < 8) cus = 256;
        grid = cus * per_cu;
        if (ws_size < WS_NEED || n_in != 26) { fprintf(stderr, "kernel_launch: ws %zu < %zu or n_in %d != 26\n", ws_size, (size_t)WS_NEED, n_in); }
        (void)hipGetLastError();
    }
    Args a{};
    const float** fp = (const float**)&a;
    for (int i = 0; i < 26; ++i) fp[i] = (const float*)d_in[i];
    a.out = (float*)d_out; a.ws = (unsigned char*)d_ws; a.ph_lo = 0; a.ph_hi = 1000;
    void* args[] = {&a};
    hipError_t e = hipLaunchCooperativeKernel((const void*)mega_fwd, dim3(grid), dim3(512), args, LDS_BYTES, stream);
    if (e != hipSuccess) fprintf(stderr, "cooperative launch failed: %s (grid %d)\n", hipGetErrorString(e), grid);
}
```

```cpp
#include <hip/hip_runtime.h>
#include <hip/hip_cooperative_groups.h>
#include <cstdio>
#include <cstdint>
namespace cg = cooperative_groups;
namespace pg8 {
#define PG8_LAS __attribute__((address_space(3)))
typedef unsigned short bf16_t;
typedef short bf16x8 __attribute__((ext_vector_type(8)));
typedef float f32x4 __attribute__((ext_vector_type(4)));
typedef unsigned u32x4 __attribute__((ext_vector_type(4)));
constexpr int BM = 256, BK = 64, HALF = 128, HTB = HALF * BK * 2  , STAGE_BYTES = 8 * HTB, NXCD = 8, WGM = 8;

__host__ __device__ __forceinline__ int lds_byte(int r, int c) { const int st = (r >> 4) * 2 + (c >> 5), rr = r & 15, cc = c & 31, ob = rr * 64 + cc * 2; return st * 1024 + (ob ^ (((ob >> 9) & 1) << 5)); }
__host__ __device__ __forceinline__ void stage_rc(int b, int& R, int& C) { const int st = b / 1024, sb = b % 1024, swz = sb ^ (((sb >> 9) & 1) << 5); R = (st >> 1) * 16 + swz / 64; C = (st & 1) * 32 + (swz % 64) / 2; }
__host__ __device__ __forceinline__ int perm32(int rho) { const int n = rho >> 4, i = rho & 15; return 8 * (i >> 2) + 4 * n + (i & 3); }

struct Unit { int pm, pn; };
struct Gemm { const bf16_t* A; const bf16_t* Bt; int M, N, K; };

struct StaticOrder {
    int nM, nN, nwg, G, c;
    __host__ __device__ void init(int M, int N, int G_, int c_) { nM = M / BM; nN = N / BM; nwg = nM * nN; G = G_; c = c_; }
    __host__ __device__ bool next(int i, Unit& u) const {
        const long L = (long)i * G + c; if (L >= nwg) return false;
        int wgid = (int)L; { const int q = nwg / NXCD, r = nwg % NXCD, xcd = wgid % NXCD, off = wgid / NXCD; wgid = (xcd < r ? xcd * (q + 1) : r * (q + 1) + (xcd - r) * q) + off; }
        const int nig = WGM * nN, gid = wgid / nig, fm = gid * WGM, gsz = (nM - fm) < WGM ? (nM - fm) : WGM;
        u.pm = fm + ((wgid % nig) % gsz); u.pn = (wgid % nig) / gsz; return true;
    }
    __device__ __forceinline__ void a_ready(const Unit&) const {}
    __device__ __forceinline__ void done(const Unit&) const {}
};

__device__ __forceinline__ unsigned cvt_pk_bf16(float lo, float hi) { unsigned r; asm volatile("v_cvt_pk_bf16_f32 %0, %1, %2" : "=v"(r) : "v"(lo), "v"(hi)); return r; }
typedef float f32x2 __attribute__((ext_vector_type(2)));
template <class Epi, class Sched, bool ALIGN_EPI = false, bool SP2 = false>
__device__ __forceinline__ void gemm_phase(PG8_LAS unsigned char* lds, const Gemm g, const Sched& S, const Epi& E, const int tid_in) {
    const int tid = tid_in, wid = __builtin_amdgcn_readfirstlane(tid >> 6), lane = tid & 63, wr = wid >> 2, wc = wid & 3, fr = lane & 15, fq = lane >> 4;
    const int K = g.K, nt = K / BK;
    unsigned voffA[2], voffB[2];
#pragma unroll
    for (int i = 0; i < 2; ++i) { int R, C; stage_rc(tid * 16 + i * 8192, R, C); const int Rb = Epi::PERM ? ((R & ~31) + perm32(R & 31)) : R;
        voffA[i] = (unsigned)(R * K + C) * 2u; voffB[i] = (unsigned)(Rb * K + C) * 2u; }
    const size_t kstep = (size_t)(BK * 2);
    const size_t hstep = (size_t)HALF * K * 2;
    const size_t tstep = 2 * hstep;
    const unsigned ldsw = (unsigned)wid * 1024u;
    const int aoff = lds_byte(wr * 64 + fr, fq * 8), boff = lds_byte(wc * 32 + fr, fq * 8);
#define PG8_SA(b, h) (((b) * 2 + (h)) * HTB)
#define PG8_SB(b, h) ((4 + (b) * 2 + (h)) * HTB)
#define PG8_STAGE(bufoff, gbase, voff) do { _Pragma("unroll") for (int _i = 0; _i < 2; ++_i) \
        __builtin_amdgcn_global_load_lds((const unsigned*)((const char*)(gbase) + (voff)[_i]), (PG8_LAS unsigned*)(lds + (bufoff) + ldsw + _i * 8192), 16, 0, 0); } while (0)
#define PG8_LDA(dst, b, h) do { _Pragma("unroll") for (int m = 0; m < 4; ++m) _Pragma("unroll") for (int k = 0; k < 2; ++k) dst[m][k] = *(const PG8_LAS bf16x8*)(lds + PG8_SA(b, h) + aoff + m * 2048 + k * 1024); } while (0)
#define PG8_LDB(dst, b, h) do { _Pragma("unroll") for (int n = 0; n < 2; ++n) _Pragma("unroll") for (int k = 0; k < 2; ++k) dst[n][k] = *(const PG8_LAS bf16x8*)(lds + PG8_SB(b, h) + boff + n * 2048 + k * 1024); } while (0)
#define PG8_MMA(ai, bj, At, Bt) do { __builtin_amdgcn_s_setprio(1); _Pragma("unroll") for (int m = 0; m < 4; ++m) _Pragma("unroll") for (int n = 0; n < 2; ++n) _Pragma("unroll") for (int k = 0; k < 2; ++k) \
        acc[ai][bj][m][n] = __builtin_amdgcn_mfma_f32_16x16x32_bf16(Bt[n][k], At[m][k], acc[ai][bj][m][n], 0, 0, 0); __builtin_amdgcn_s_setprio(0); } while (0)
#define PG8_WAIT_V(n) asm volatile("s_waitcnt vmcnt(" #n ")" ::: "memory")
#define PG8_WAIT_L(n) asm volatile("s_waitcnt lgkmcnt(" #n ")" ::: "memory")
#define PG8_BAR __builtin_amdgcn_s_barrier()
#define PG8_SCHED __builtin_amdgcn_sched_barrier(0)
    Unit cur, nxt; int ui = 0;
    if (!S.next(0, cur)) return;
    f32x4 acc[2][2][4][2];
#pragma unroll
    for (int a = 0; a < 2; ++a)
#pragma unroll
        for (int b = 0; b < 2; ++b)
#pragma unroll
            for (int m = 0; m < 4; ++m)
#pragma unroll
                for (int n = 0; n < 2; ++n) acc[a][b][m][n] = (f32x4){0.f, 0.f, 0.f, 0.f};
    bf16x8 At[4][2], B0[2][2], B1[2][2];
    const char* cA = (const char*)g.A + (size_t)cur.pm * tstep; const char* cB = (const char*)g.Bt + (size_t)cur.pn * tstep;
    S.a_ready(cur);
    if constexpr (SP2) {
        PG8_STAGE(PG8_SB(0, 0), cB, voffB); PG8_STAGE(PG8_SB(0, 1), cB + hstep, voffB); PG8_STAGE(PG8_SA(0, 0), cA, voffA); PG8_STAGE(PG8_SA(0, 1), cA + hstep, voffA);
        if (wr == 1) PG8_BAR;
        PG8_WAIT_V(2); PG8_BAR;
        PG8_STAGE(PG8_SB(1, 0), cB + kstep, voffB); PG8_STAGE(PG8_SA(1, 0), cA + kstep, voffA); PG8_STAGE(PG8_SB(1, 1), cB + hstep + kstep, voffB);
        PG8_WAIT_V(6); PG8_BAR;
    } else {
        PG8_STAGE(PG8_SB(0, 0), cB, voffB); PG8_STAGE(PG8_SA(0, 0), cA, voffA); PG8_STAGE(PG8_SB(0, 1), cB + hstep, voffB); PG8_STAGE(PG8_SA(0, 1), cA + hstep, voffA);
        if (wr == 1) PG8_BAR;
        PG8_WAIT_V(4); PG8_BAR;
        PG8_STAGE(PG8_SB(1, 0), cB + kstep, voffB); PG8_STAGE(PG8_SA(1, 0), cA + kstep, voffA); PG8_STAGE(PG8_SB(1, 1), cB + hstep + kstep, voffB);
        PG8_WAIT_V(6); PG8_BAR;
    }
    for (;;) {
        const bool has_next = S.next(ui + 1, nxt);
        const char* nA = has_next ? (const char*)g.A + (size_t)nxt.pm * tstep : cA; const char* nB = has_next ? (const char*)g.Bt + (size_t)nxt.pn * tstep : cB;
        for (int t = 0; t < nt; t += 2) {
            const bool last = (t == nt - 2);
            const char* a1 = cA + (size_t)(t + 1) * kstep;
            const char* a2 = last ? nA : cA + (size_t)(t + 2) * kstep; const char* b2 = last ? nB : cB + (size_t)(t + 2) * kstep;
            const char* a3 = a2 + kstep; const char* b3 = b2 + kstep;
            if (last && has_next) S.a_ready(nxt);
            if constexpr (SP2) {
            PG8_LDB(B0, 0, 0); PG8_LDB(B1, 0, 1); PG8_SCHED; PG8_LDA(At, 0, 0); PG8_STAGE(PG8_SA(1, 1), a1 + hstep, voffA);
            PG8_WAIT_V(8); PG8_WAIT_L(0); PG8_BAR; PG8_MMA(0, 0, At, B0); PG8_MMA(0, 1, At, B1); PG8_BAR; PG8_SCHED;
            PG8_LDA(At, 0, 1); PG8_STAGE(PG8_SB(0, 0), b2, voffB); PG8_STAGE(PG8_SB(0, 1), b2 + hstep, voffB); PG8_STAGE(PG8_SA(0, 0), a2, voffA);
            PG8_WAIT_V(8); PG8_WAIT_L(0); PG8_BAR; PG8_MMA(1, 0, At, B0); PG8_MMA(1, 1, At, B1); PG8_BAR; PG8_SCHED;
            PG8_LDB(B0, 1, 0); PG8_LDB(B1, 1, 1); PG8_SCHED; PG8_LDA(At, 1, 0); PG8_STAGE(PG8_SA(0, 1), a2 + hstep, voffA);
            PG8_WAIT_V(8); PG8_WAIT_L(0); PG8_BAR; PG8_MMA(0, 0, At, B0); PG8_MMA(0, 1, At, B1); PG8_BAR; PG8_SCHED;
            PG8_LDA(At, 1, 1); PG8_STAGE(PG8_SB(1, 0), b3, voffB); PG8_STAGE(PG8_SB(1, 1), b3 + hstep, voffB); PG8_STAGE(PG8_SA(1, 0), a3, voffA);
            PG8_WAIT_V(8); PG8_WAIT_L(0); PG8_BAR; PG8_MMA(1, 0, At, B0); PG8_MMA(1, 1, At, B1); PG8_BAR; PG8_SCHED;
            } else {
            PG8_LDB(B0, 0, 0); PG8_SCHED; PG8_LDA(At, 0, 0); PG8_STAGE(PG8_SA(1, 1), a1 + hstep, voffA);
            PG8_WAIT_L(8); PG8_BAR; PG8_WAIT_L(0); PG8_MMA(0, 0, At, B0); PG8_BAR; PG8_SCHED;
            PG8_LDB(B1, 0, 1); PG8_STAGE(PG8_SB(0, 0), b2, voffB);
            PG8_BAR; PG8_WAIT_L(0); PG8_MMA(0, 1, At, B1); PG8_BAR;
            PG8_LDA(At, 0, 1); PG8_STAGE(PG8_SA(0, 0), a2, voffA);
            PG8_BAR; PG8_WAIT_L(0); PG8_MMA(1, 0, At, B0); PG8_BAR; PG8_SCHED;
            PG8_STAGE(PG8_SB(0, 1), b2 + hstep, voffB);
            PG8_WAIT_V(6); PG8_BAR; PG8_MMA(1, 1, At, B1); PG8_BAR;
            PG8_LDB(B0, 1, 0); PG8_SCHED; PG8_LDA(At, 1, 0); PG8_STAGE(PG8_SA(0, 1), a2 + hstep, voffA);
            PG8_WAIT_L(8); PG8_BAR; PG8_WAIT_L(0); PG8_MMA(0, 0, At, B0); PG8_BAR; PG8_SCHED;
            PG8_LDB(B1, 1, 1); PG8_STAGE(PG8_SB(1, 0), b3, voffB);
            PG8_BAR; PG8_WAIT_L(0); PG8_MMA(0, 1, At, B1); PG8_BAR;
            PG8_LDA(At, 1, 1); PG8_STAGE(PG8_SA(1, 0), a3, voffA);
            PG8_BAR; PG8_WAIT_L(0); PG8_MMA(1, 0, At, B0); PG8_BAR; PG8_SCHED;
            PG8_STAGE(PG8_SB(1, 1), b3 + hstep, voffB);
            PG8_WAIT_V(6); PG8_BAR; PG8_MMA(1, 1, At, B1); PG8_BAR;
            }
        }
        if constexpr (ALIGN_EPI) { if (wr == 0) PG8_BAR; }
        if constexpr (!Epi::AFTER_DRAIN) { E(acc, cur, wr, wc, fr, fq); S.done(cur); }
        if (!has_next) break;
#pragma unroll
        for (int a = 0; a < 2; ++a)
#pragma unroll
            for (int b = 0; b < 2; ++b)
#pragma unroll
                for (int m = 0; m < 4; ++m)
#pragma unroll
                    for (int n = 0; n < 2; ++n) acc[a][b][m][n] = (f32x4){0.f, 0.f, 0.f, 0.f};
        cur = nxt; cA = nA; cB = nB; ++ui;
        if constexpr (ALIGN_EPI) { if (wr == 1) PG8_BAR; }
    }
    PG8_WAIT_V(0);
    if constexpr (!ALIGN_EPI) { if (wr == 0) PG8_BAR; }
    PG8_BAR;
    if constexpr (Epi::AFTER_DRAIN) { E.fused(acc, cur, wr, wc, fr, fq, lds, wid, lane); S.done(cur); }
#undef PG8_SA
#undef PG8_SB
#undef PG8_STAGE
#undef PG8_LDA
#undef PG8_LDB
#undef PG8_MMA
#undef PG8_WAIT_V
#undef PG8_WAIT_L
#undef PG8_BAR
#undef PG8_SCHED
}
}

namespace pg8 {
typedef unsigned u32x2 __attribute__((ext_vector_type(2)));
__device__ __forceinline__ float sigmoidf_(float v) { return __builtin_amdgcn_rcpf(1.0f + __expf(-v)); }

struct EpiSwiglu {
    static constexpr bool PERM = true, AFTER_DRAIN = false;
    bf16_t* H; int ldh;
    __device__ __forceinline__ void operator()(const f32x4 (&acc)[2][2][4][2], const Unit& u, int wr, int wc, int fr, int fq) const {
        const int row0 = u.pm * BM + wr * 64 + fr; const int col0 = u.pn * HALF + wc * 32 + 8 * fq;
#pragma unroll
        for (int ai = 0; ai < 2; ++ai)
#pragma unroll
            for (int m = 0; m < 4; ++m) {
                bf16_t* p = H + (size_t)(row0 + ai * HALF + m * 16) * ldh + col0;
                f32x4 h0, h1;
#pragma unroll
                for (int e = 0; e < 4; ++e) {
                    const float g0 = acc[ai][0][m][0][e], g1 = acc[ai][0][m][1][e];
                    h0[e] = g0 * sigmoidf_(g0) * acc[ai][1][m][0][e];
                    h1[e] = g1 * sigmoidf_(g1) * acc[ai][1][m][1][e];
                }
                u32x4 w; w.x = cvt_pk_bf16(h0[0], h0[1]); w.y = cvt_pk_bf16(h0[2], h0[3]); w.z = cvt_pk_bf16(h1[0], h1[1]); w.w = cvt_pk_bf16(h1[2], h1[3]);
                *(u32x4*)p = w;
            }
    }
};

template <bool RF32> struct EpiZ {
    static constexpr bool PERM = true, AFTER_DRAIN = false;
    const void* R; bf16_t* Z; float alpha, s;
    __device__ __forceinline__ void operator()(const f32x4 (&acc)[2][2][4][2], const Unit& u, int wr, int wc, int fr, int fq) const {
        const int row0 = u.pm * BM + wr * 64 + fr; const int col0 = u.pn * BM + wc * 32 + 8 * fq;
#pragma unroll
        for (int ai = 0; ai < 2; ++ai)
#pragma unroll
            for (int m = 0; m < 4; ++m) {
                const size_t off = (size_t)(row0 + ai * HALF + m * 16) * 2048 + col0;
#pragma unroll
                for (int bj = 0; bj < 2; ++bj) {
                    f32x4 r0, r1;
                    if (RF32) { r0 = *(const f32x4*)((const float*)R + off + bj * HALF); r1 = *(const f32x4*)((const float*)R + off + bj * HALF + 4); }
                    else { const u32x4 rb = *(const u32x4*)((const bf16_t*)R + off + bj * HALF);
                        r0[0] = __uint_as_float(rb.x << 16); r0[1] = __uint_as_float(rb.x & 0xffff0000u); r0[2] = __uint_as_float(rb.y << 16); r0[3] = __uint_as_float(rb.y & 0xffff0000u);
                        r1[0] = __uint_as_float(rb.z << 16); r1[1] = __uint_as_float(rb.z & 0xffff0000u); r1[2] = __uint_as_float(rb.w << 16); r1[3] = __uint_as_float(rb.w & 0xffff0000u); }
                    const f32x4 z0 = r0 * alpha + acc[ai][bj][m][0] * s, z1 = r1 * alpha + acc[ai][bj][m][1] * s;
                    u32x4 w; w.x = cvt_pk_bf16(z0[0], z0[1]); w.y = cvt_pk_bf16(z0[2], z0[3]); w.z = cvt_pk_bf16(z1[0], z1[1]); w.w = cvt_pk_bf16(z1[2], z1[3]);
                    *(u32x4*)(Z + off + bj * HALF) = w;
                }
            }
    }
};

struct EpiStore {
    static constexpr bool PERM = true, AFTER_DRAIN = false;
    bf16_t* O; int ldc; int ncols; float* GT;
    __device__ __forceinline__ void operator()(const f32x4 (&acc)[2][2][4][2], const Unit& u, int wr, int wc, int fr, int fq) const {
        const int row0 = u.pm * BM + wr * 64 + fr; const int colt = u.pn * BM;
        if (colt < ncols) {
            const int col0 = colt + wc * 32 + 8 * fq;
#pragma unroll
            for (int ai = 0; ai < 2; ++ai)
#pragma unroll
                for (int m = 0; m < 4; ++m) {
                    bf16_t* rowp = O + (size_t)(row0 + ai * HALF + m * 16) * ldc + col0;
#pragma unroll
                    for (int bj = 0; bj < 2; ++bj) {
                        const f32x4 v0 = acc[ai][bj][m][0], v1 = acc[ai][bj][m][1];
                        u32x4 w; w.x = cvt_pk_bf16(v0[0], v0[1]); w.y = cvt_pk_bf16(v0[2], v0[3]); w.z = cvt_pk_bf16(v1[0], v1[1]); w.w = cvt_pk_bf16(v1[2], v1[3]);
                        *(u32x4*)(rowp + bj * HALF) = w;
                    }
                }
        } else if (GT != nullptr && wc == 0 && fq < 2) {
#pragma unroll
            for (int ai = 0; ai < 2; ++ai)
#pragma unroll
                for (int m = 0; m < 4; ++m) {
                    float* g = GT + (size_t)(row0 + ai * HALF + m * 16) * 16 + 8 * fq;
                    *(f32x4*)(g) = acc[ai][0][m][0];
                    *(f32x4*)(g + 4) = acc[ai][0][m][1];
                }
        }
    }
};

struct EpiPle {
    static constexpr bool PERM = true, AFTER_DRAIN = false;
    const bf16_t* X; const bf16_t* E; float* OUTF; bf16_t* XBO;
    __device__ __forceinline__ void operator()(const f32x4 (&acc)[2][2][4][2], const Unit& u, int wr, int wc, int fr, int fq) const {
        const int row0 = u.pm * BM + wr * 64 + fr; const int col0 = u.pn * BM + wc * 32 + 8 * fq;
#pragma unroll
        for (int ai = 0; ai < 2; ++ai)
#pragma unroll
            for (int m = 0; m < 4; ++m) {
                const size_t off = (size_t)(row0 + ai * HALF + m * 16) * 2048 + col0;
#pragma unroll
                for (int bj = 0; bj < 2; ++bj) {
                    const size_t o2 = off + bj * HALF;
                    const u32x4 xb = *(const u32x4*)(X + o2), eb = *(const u32x4*)(E + o2);
                    const unsigned xw[4] = {xb.x, xb.y, xb.z, xb.w}, ew[4] = {eb.x, eb.y, eb.z, eb.w};
                    float o[8];
#pragma unroll
                    for (int q = 0; q < 4; ++q) {
                        const float a0 = acc[ai][bj][m][q >> 1][2 * (q & 1)], a1 = acc[ai][bj][m][q >> 1][2 * (q & 1) + 1];
                        o[2 * q] = __uint_as_float(xw[q] << 16) + __uint_as_float(ew[q] << 16) * sigmoidf_(a0);
                        o[2 * q + 1] = __uint_as_float(xw[q] & 0xffff0000u) + __uint_as_float(ew[q] & 0xffff0000u) * sigmoidf_(a1);
                    }
                    if (OUTF != nullptr) { *(f32x4*)(OUTF + o2) = (f32x4){o[0], o[1], o[2], o[3]}; *(f32x4*)(OUTF + o2 + 4) = (f32x4){o[4], o[5], o[6], o[7]}; }
                    if (XBO != nullptr) { u32x4 w; w.x = cvt_pk_bf16(o[0], o[1]); w.y = cvt_pk_bf16(o[2], o[3]); w.z = cvt_pk_bf16(o[4], o[5]); w.w = cvt_pk_bf16(o[6], o[7]); *(u32x4*)(XBO + o2) = w; }
                }
            }
    }
};
}

#define LAS __attribute__((address_space(3)))
using pg8::bf16_t; using pg8::bf16x8; using pg8::f32x4; using pg8::u32x4; using pg8::u32x2;
typedef short s16x4 __attribute__((ext_vector_type(4)));
typedef float f32x16 __attribute__((ext_vector_type(16)));
typedef short v4i16_t __attribute__((ext_vector_type(4)));

constexpr int MT = 16384, SEQ = 8192, DM = 2048, DFF = 5632, NFF2 = 11264, NIN = 6144, UW = 6144, PLE = 256;
constexpr int LDS_BYTES = 147456;
constexpr float ALPHA = 1.4142135623730951f;
constexpr float LOG2E = 1.4426950408889634f;

constexpr size_t SZ_WFI = (size_t)NFF2 * DM * 2, SZ_WFO = (size_t)DM * DFF * 2, SZ_WIN = (size_t)NIN * DM * 2, SZ_WSQ = (size_t)DM * DM * 2, SZ_WPP = (size_t)DM * PLE * 2;
constexpr size_t OFF_WFI = 0;
constexpr size_t OFF_WFO = OFF_WFI + 4 * SZ_WFI;
constexpr size_t OFF_WAB = OFF_WFO + 4 * SZ_WFO;
constexpr size_t OFF_WC = OFF_WAB + SZ_WIN;
constexpr size_t OFF_WOAB = OFF_WC + SZ_WIN;
constexpr size_t OFF_WOC = OFF_WOAB + SZ_WSQ;
constexpr size_t OFF_WPG = OFF_WOC + SZ_WSQ;
constexpr size_t OFF_WPP = OFF_WPG + 2 * SZ_WSQ;
constexpr size_t OFF_XF = OFF_WPP + 2 * SZ_WPP;
constexpr size_t OFF_XB = OFF_XF + (size_t)MT * DM * 4;
constexpr size_t OFF_Z = OFF_XB + (size_t)MT * DM * 2;
constexpr size_t OFF_H = OFF_Z + (size_t)MT * DM * 4;
constexpr size_t OFF_MIX = OFF_H + (size_t)MT * UW * 2;
constexpr size_t OFF_PB = OFF_MIX + (size_t)MT * DM * 2;
constexpr size_t OFF_GT = OFF_PB + (size_t)2 * MT * PLE * 2;
constexpr size_t OFF_QB = OFF_GT + (size_t)MT * 16 * 4;
constexpr size_t OFF_KB = OFF_QB + (size_t)MT * 512 * 2;
constexpr size_t OFF_BC = OFF_KB + (size_t)MT * 512 * 2;
constexpr size_t OFF_IP = OFF_BC + (size_t)MT * 4 * 4;
constexpr size_t OFF_MSC = OFF_IP + (size_t)MT * 4 * 4;
constexpr size_t OFF_NL = OFF_MSC + 3 * 1024 * 4;
constexpr size_t OFF_DC = OFF_NL + (size_t)8 * 128 * 128 * 4;
constexpr size_t OFF_ST = OFF_DC + (size_t)8 * 128 * 256 * 4;
constexpr size_t OFF_CTL = OFF_ST + (size_t)8 * 128 * 512 * 256 * 2;
constexpr size_t WS_NEED = OFF_CTL + 32768;

#define LDS_WAIT() asm volatile("s_waitcnt lgkmcnt(0)" ::: "memory")
__device__ __forceinline__ unsigned f2bf(float f) { unsigned u = __builtin_bit_cast(unsigned, f); return (u + 0x7fffu + ((u >> 16) & 1u)) >> 16; }
__device__ __forceinline__ unsigned pk2(float lo, float hi) { return f2bf(lo) | (f2bf(hi) << 16); }
__device__ __forceinline__ float bf2f(unsigned h) { return __uint_as_float(h << 16); }
__device__ __forceinline__ float bflo(unsigned w) { return __uint_as_float(w << 16); }
__device__ __forceinline__ float bfhi(unsigned w) { return __uint_as_float(w & 0xffff0000u); }
__device__ __forceinline__ float wave_sum(float v) {
#pragma unroll
    for (int o = 1; o < 64; o <<= 1) v += __shfl_xor(v, o);
    return v;
}
__device__ __forceinline__ float logsigmoidf_(float x) { return fminf(x, 0.f) - log1pf(__expf(-fabsf(x))); }
__device__ __forceinline__ s16x4 vtr(const LAS unsigned char* p) { return __builtin_bit_cast(s16x4, __builtin_amdgcn_ds_read_tr16_b64_v4i16((LAS v4i16_t*)p)); }
__device__ __forceinline__ bf16x8 tr8(const LAS unsigned char* p0, const LAS unsigned char* p1) {
    const s16x4 a = vtr(p0), b = vtr(p1); bf16x8 r; r[0] = a[0]; r[1] = a[1]; r[2] = a[2]; r[3] = a[3]; r[4] = b[0]; r[5] = b[1]; r[6] = b[2]; r[7] = b[3]; return r;
}
__device__ __forceinline__ f32x4 mfma16(bf16x8 a, bf16x8 b, f32x4 c) { return __builtin_amdgcn_mfma_f32_16x16x32_bf16(a, b, c, 0, 0, 0); }
__device__ __forceinline__ f32x16 mfma32(bf16x8 a, bf16x8 b, f32x16 c) { return __builtin_amdgcn_mfma_f32_32x32x16_bf16(a, b, c, 0, 0, 0); }
__device__ __forceinline__ bf16x8 ldsv8(const LAS unsigned char* p) { return *(const LAS bf16x8*)p; }

struct Ctx { LAS unsigned char* lds; int tid, lane, wave, G, bid, gw, NGW; };

__device__ __forceinline__ void tr_decode(int it, int nnb, int mode, int& k0, int& n0, int& drow0, float& scale) {
    const int kb = it / nnb, nb = it - kb * nnb; k0 = 64 * kb; n0 = 64 * nb; drow0 = n0; scale = 1.f;
    if (mode == 1) { const int half = n0 >= DFF ? 1 : 0; const int j0 = n0 - half * DFF; drow0 = 256 * (j0 >> 7) + 128 * half + (j0 & 127); }
    if (mode == 2 && n0 < 1024) scale = 0.125f;
}
__device__ __forceinline__ void tr_load(float (&r)[64], const float* __restrict__ W, int N, int k0, int n0, int lane) {
    const int n = n0 + lane; const bool ok = n < N; const float* src = W + (size_t)k0 * N + (ok ? n : 0);
#pragma unroll
    for (int i = 0; i < 64; ++i) { const float v = src[(size_t)i * N]; r[i] = ok ? v : 0.f; }
}
__device__ __forceinline__ void conv_matrix(const Ctx& C, const float* W, int K, int N, int Npad, bf16_t* WT, int mode, int& base) {
    LAS float* scr = (LAS float*)(C.lds + C.wave * 16640);
    const int nnb = Npad / 64, nitems = (K / 64) * nnb, lane = C.lane;
    int first = (C.gw - base) % C.NGW; if (first < 0) first += C.NGW;
    float r[64]; int k0 = 0, n0 = 0, drow0 = 0; float scale = 1.f;
    int it = first;
    if (it < nitems) { tr_decode(it, nnb, mode, k0, n0, drow0, scale); tr_load(r, W, N, k0, n0, lane); }
    while (it < nitems) {
#pragma unroll
        for (int i = 0; i < 64; ++i) scr[i * 65 + lane] = r[i] * scale;
        const int ck0 = k0, cdrow0 = drow0;
        it += C.NGW;
        if (it < nitems) { tr_decode(it, nnb, mode, k0, n0, drow0, scale); tr_load(r, W, N, k0, n0, lane); }
        LDS_WAIT(); asm volatile("" ::: "memory");
        const int c = lane & 7;
#pragma unroll
        for (int j = 0; j < 8; ++j) { const int nn = (lane >> 3) + 8 * j; const LAS float* s = scr + (8 * c) * 65 + nn;
            u32x4 o; o.x = pk2(s[0 * 65], s[1 * 65]); o.y = pk2(s[2 * 65], s[3 * 65]); o.z = pk2(s[4 * 65], s[5 * 65]); o.w = pk2(s[6 * 65], s[7 * 65]);
            *(u32x4*)(WT + (size_t)(cdrow0 + nn) * K + ck0 + 8 * c) = o; }
        LDS_WAIT(); asm volatile("" ::: "memory");
    }
    base = (base + nitems) % C.NGW;
}
__device__ __forceinline__ void cvt_rows(const Ctx& C, const float* src, bf16_t* dst, size_t n4) {
    const size_t stride = (size_t)C.G * 512;
    for (size_t i = (size_t)C.bid * 512 + C.tid; i < n4; i += 4 * stride) {
        f32x4 v[4];
#pragma unroll
        for (int j = 0; j < 4; ++j) if (i + j * stride < n4) v[j] = *(const f32x4*)(src + 4 * (i + j * stride));
#pragma unroll
        for (int j = 0; j < 4; ++j) if (i + j * stride < n4) { u32x2 w; w.x = pk2(v[j][0], v[j][1]); w.y = pk2(v[j][2], v[j][3]); *(u32x2*)(dst + 4 * (i + j * stride)) = w; }
    }
}

template <int NG>
__device__ __forceinline__ void ln_phase(const Ctx& C, const bf16_t* Z, const float* g, const float* b, bf16_t* XB, const float* Wsrc, int ldw, int ngate, float* GT) {
    constexpr bool GATES = NG > 0;
    LAS float* WG = (LAS float*)C.lds;
    if (GATES) {
        for (int col = C.tid; col < DM; col += 512) {
            const float* src = Wsrc + (size_t)col * ldw + 6144;
#pragma unroll
            for (int gi = 0; gi < (NG > 0 ? NG : 1); ++gi) WG[gi * DM + col] = (gi < ngate) ? src[gi] : 0.f;
        }
        __syncthreads();
    }
    f32x4 gv[8], bv[8];
#pragma unroll
    for (int j = 0; j < 4; ++j) { gv[2 * j] = *(const f32x4*)(g + 512 * j + 8 * C.lane); gv[2 * j + 1] = *(const f32x4*)(g + 512 * j + 8 * C.lane + 4);
                                  bv[2 * j] = *(const f32x4*)(b + 512 * j + 8 * C.lane); bv[2 * j + 1] = *(const f32x4*)(b + 512 * j + 8 * C.lane + 4); }
    const bool grp = (C.G & 7) == 0; const int nwg_ = grp ? (C.G >> 3) * 8 : C.NGW; const int first_ = grp ? (C.bid >> 3) * 8 + C.wave : C.gw; const int base_ = grp ? 2048 * (C.bid & 7) : 0; const int lim_ = grp ? 2048 : MT;
    for (int lrow = first_; lrow < lim_; lrow += nwg_) {
        const int row = base_ + lrow;
        const bf16_t* z = Z + (size_t)row * DM + 8 * C.lane;
        u32x4 zb[4];
#pragma unroll
        for (int j = 0; j < 4; ++j) zb[j] = *(const u32x4*)(z + 512 * j);
        f32x4 v[8]; float s = 0.f;
#pragma unroll
        for (int j = 0; j < 4; ++j) { v[2 * j] = (f32x4){bflo(zb[j].x), bfhi(zb[j].x), bflo(zb[j].y), bfhi(zb[j].y)}; v[2 * j + 1] = (f32x4){bflo(zb[j].z), bfhi(zb[j].z), bflo(zb[j].w), bfhi(zb[j].w)}; }
#pragma unroll
        for (int j = 0; j < 8; ++j) s += (v[j][0] + v[j][1]) + (v[j][2] + v[j][3]);
        const float mean = wave_sum(s) * (1.f / DM); float s2 = 0.f;
#pragma unroll
        for (int j = 0; j < 8; ++j) { v[j] = v[j] - mean; s2 += (v[j][0] * v[j][0] + v[j][1] * v[j][1]) + (v[j][2] * v[j][2] + v[j][3] * v[j][3]); }
        const float rstd = 1.f / sqrtf(wave_sum(s2) * (1.f / DM) + 1e-5f);
        bf16_t* bo = XB + (size_t)row * DM + 8 * C.lane;
#pragma unroll
        for (int j = 0; j < 4; ++j) { const f32x4 o0 = v[2 * j] * rstd * gv[2 * j] + bv[2 * j], o1 = v[2 * j + 1] * rstd * gv[2 * j + 1] + bv[2 * j + 1];
            u32x4 w; w.x = pg8::cvt_pk_bf16(o0[0], o0[1]); w.y = pg8::cvt_pk_bf16(o0[2], o0[3]); w.z = pg8::cvt_pk_bf16(o1[0], o1[1]); w.w = pg8::cvt_pk_bf16(o1[2], o1[3]); *(u32x4*)(bo + 512 * j) = w;
            if (GATES) { v[2 * j] = o0; v[2 * j + 1] = o1; } }
        if (GATES) {
            float mine = 0.f;
#pragma unroll 4
            for (int gi = 0; gi < (NG > 0 ? NG : 1); ++gi) {
                float s0 = 0.f, s1 = 0.f;
#pragma unroll
                for (int j = 0; j < 4; ++j) { const f32x4 w0 = *(const LAS f32x4*)(WG + gi * DM + 512 * j + 8 * C.lane), w1 = *(const LAS f32x4*)(WG + gi * DM + 512 * j + 8 * C.lane + 4);
                    s0 += (v[2 * j][0] * w0[0] + v[2 * j][1] * w0[1]) + (v[2 * j][2] * w0[2] + v[2 * j][3] * w0[3]);
                    s1 += (v[2 * j + 1][0] * w1[0] + v[2 * j + 1][1] * w1[1]) + (v[2 * j + 1][2] * w1[2] + v[2 * j + 1][3] * w1[3]); }
                const float tot = wave_sum(s0 + s1);
                mine = (C.lane == gi) ? tot : mine;
            }
            if (C.lane < NG) GT[(size_t)row * 16 + C.lane] = mine;
        }
    }
    if (GATES) __syncthreads();
}

__device__ __forceinline__ void m1_phase(const Ctx& C, const bf16_t* U, const float* GT, const float* conv_w, const float* conv_b, const float* b_i, const float* b_f,
                                         bf16_t* QB, bf16_t* KB, float* BC, float* IP, float* MSC) {
    if (C.bid < 8) {
        LAS float* sb = (LAS float*)C.lds; LAS float* su = sb + 128;
        const int bh = C.bid, b = bh >> 2, h = bh & 3;
        {
            const float bi = b_i[h], bf = b_f[h]; const int ln = C.lane;
            float fv[16], iv[16];
#pragma unroll
            for (int k = 0; k < 16; ++k) { const size_t row = (size_t)b * SEQ + (C.wave * 16 + k) * 64 + ln; fv[k] = GT[row * 16 + 4 + h]; iv[k] = GT[row * 16 + h]; }
#pragma unroll
            for (int k = 0; k < 16; ++k) {
                const int c = C.wave * 16 + k; const size_t row = (size_t)b * SEQ + c * 64 + ln;
                float cum = logsigmoidf_(fv[k] + bf);
#pragma unroll
                for (int off = 1; off < 64; off <<= 1) { const float t = __shfl_up(cum, off); if (ln >= off) cum += t; }
                const float ip = iv[k] + bi;
                BC[row * 4 + h] = cum; IP[row * 4 + h] = ip;
                float um = ip - cum;
#pragma unroll
                for (int off = 1; off < 64; off <<= 1) um = fmaxf(um, __shfl_xor(um, off));
                const float bl = __shfl(cum, 63);
                if (ln == 0) { sb[c] = bl; su[c] = um; }
            }
        }
        __syncthreads();
        if (C.tid == 0) {
            float m = 0.f;
#pragma unroll 1
            for (int c = 0; c < 128; ++c) {
                const float bl = sb[c], mn = fmaxf(bl + m, bl + su[c]);
                MSC[bh * 128 + c] = m; MSC[1024 + bh * 128 + c] = mn; MSC[2048 + bh * 128 + c] = __expf(bl + m - mn); m = mn;
            }
        }
        __syncthreads();
    }
    {
        const int c0 = (int)(((size_t)C.bid * 512 + C.tid) & 127) * 8;
        f32x4 w0[4], w1[4];
#pragma unroll
        for (int j = 0; j < 4; ++j) { w0[j] = *(const f32x4*)(conv_w + j * 1024 + c0); w1[j] = *(const f32x4*)(conv_w + j * 1024 + c0 + 4); }
        const f32x4 cb0 = *(const f32x4*)(conv_b + c0), cb1 = *(const f32x4*)(conv_b + c0 + 4);
        const float sc = (c0 < 512) ? 0.08838834764831845f : 1.f;
        for (size_t i = (size_t)C.bid * 512 + C.tid; i < (size_t)MT * 128; i += (size_t)C.G * 512) {
            const int row = (int)(i >> 7), t = row & (SEQ - 1);
            float acc[8] = {cb0[0], cb0[1], cb0[2], cb0[3], cb1[0], cb1[1], cb1[2], cb1[3]};
#pragma unroll
            for (int j = 0; j < 4; ++j) {
                const int tt = t - 3 + j;
                if (tt >= 0) {
                    const u32x4 xv = *(const u32x4*)(U + (size_t)(row - 3 + j) * UW + 3072 + c0);
                    acc[0] += w0[j][0] * bflo(xv.x); acc[1] += w0[j][1] * bfhi(xv.x); acc[2] += w0[j][2] * bflo(xv.y); acc[3] += w0[j][3] * bfhi(xv.y);
                    acc[4] += w1[j][0] * bflo(xv.z); acc[5] += w1[j][1] * bfhi(xv.z); acc[6] += w1[j][2] * bflo(xv.w); acc[7] += w1[j][3] * bfhi(xv.w);
                }
            }
#pragma unroll
            for (int e = 0; e < 8; ++e) acc[e] = acc[e] * pg8::sigmoidf_(acc[e]) * sc;
            u32x4 w; w.x = pk2(acc[0], acc[1]); w.y = pk2(acc[2], acc[3]); w.z = pk2(acc[4], acc[5]); w.w = pk2(acc[6], acc[7]);
            if (c0 < 512) *(u32x4*)(QB + (size_t)row * 512 + c0) = w; else *(u32x4*)(KB + (size_t)row * 512 + c0 - 512) = w;
        }
    }
}

__device__ __forceinline__ void mlstm_passA(const Ctx& C, const bf16_t* U, const bf16_t* KB, const float* BC, const float* IP, const float* MSC, bf16_t* ST, float* NL) {
    LAS unsigned char* KW = C.lds; LAS unsigned char* V = C.lds + 17408; LAS float* wk = (LAS float*)(C.lds + 52224);
    const int l = C.lane, g = l >> 4, q = (l & 15) >> 2, p = l & 3, w = C.wave;
    for (int u = C.bid; u < 1024; u += C.G) {
        const int bh = u >> 7, c = u & 127, b = bh >> 2, h = bh & 3; const size_t row0 = (size_t)b * SEQ + c * 64;
        if (C.tid < 64) { const float bl = BC[(row0 + 63) * 4 + h], mn = MSC[1024 + bh * 128 + c]; wk[C.tid] = __expf(bl - BC[(row0 + C.tid) * 4 + h] + IP[(row0 + C.tid) * 4 + h] - mn); }
        __syncthreads();
        { const int s = C.tid >> 3, seg = C.tid & 7; const float ws = wk[s];
          const bf16_t* kp = KB + (row0 + s) * 512 + h * 128 + seg * 16;
#pragma unroll
          for (int i = 0; i < 2; ++i) { const u32x4 kv = *(const u32x4*)(kp + 8 * i); u32x4 o;
              o.x = pk2(bflo(kv.x) * ws, bfhi(kv.x) * ws); o.y = pk2(bflo(kv.y) * ws, bfhi(kv.y) * ws); o.z = pk2(bflo(kv.z) * ws, bfhi(kv.z) * ws); o.w = pk2(bflo(kv.w) * ws, bfhi(kv.w) * ws);
              *(LAS u32x4*)(KW + s * 272 + seg * 32 + 16 * i) = o; }
          const bf16_t* vp = U + (row0 + s) * UW + 4096 + h * 256 + seg * 32;
#pragma unroll
          for (int i = 0; i < 4; ++i) *(LAS u32x4*)(V + s * 544 + seg * 64 + 16 * i) = *(const u32x4*)(vp + 8 * i); }
        __syncthreads();
        f32x4 acc[2][8];
#pragma unroll
        for (int mi = 0; mi < 2; ++mi)
#pragma unroll
            for (int ni = 0; ni < 8; ++ni) acc[mi][ni] = (f32x4){0.f, 0.f, 0.f, 0.f};
#pragma unroll
        for (int ks = 0; ks < 2; ++ks) {
            const int r0 = 32 * ks + 8 * g + q;
            bf16x8 a[2];
#pragma unroll
            for (int mi = 0; mi < 2; ++mi) { const LAS unsigned char* ap = V + r0 * 544 + (32 * w + 16 * mi + 4 * p) * 2; a[mi] = tr8(ap, ap + 4 * 544); }
#pragma unroll
            for (int ni = 0; ni < 8; ++ni) { const LAS unsigned char* bp = KW + r0 * 272 + (16 * ni + 4 * p) * 2; const bf16x8 bb = tr8(bp, bp + 4 * 272);
#pragma unroll
                for (int mi = 0; mi < 2; ++mi) acc[mi][ni] = mfma16(bb, a[mi], acc[mi][ni]); }
        }
        bf16_t* st = ST + ((size_t)(bh * 128 + c) << 15);
#pragma unroll
        for (int mi = 0; mi < 2; ++mi)
#pragma unroll
            for (int ni = 0; ni < 8; ++ni) { u32x2 wv; wv.x = pg8::cvt_pk_bf16(acc[mi][ni][0], acc[mi][ni][1]); wv.y = pg8::cvt_pk_bf16(acc[mi][ni][2], acc[mi][ni][3]);
                *(u32x2*)(st + (32 * w + 16 * mi + (l & 15)) * 128 + 16 * ni + 4 * g) = wv; }
        if (C.tid < 128) { float s = 0.f;
#pragma unroll 4
            for (int t = 0; t < 64; ++t) s += bf2f(*(const LAS unsigned short*)(KW + t * 272 + C.tid * 2)); NL[(size_t)(bh * 128 + c) * 128 + C.tid] = s; }
        __syncthreads();
    }
}

__device__ __forceinline__ void mlstm_scan(const Ctx& C, bf16_t* ST, float* NL, const float* MSC) {
    for (int e2 = C.bid * 512 + C.tid; e2 < 8 * 16384; e2 += C.G * 512) {
        const int bh = e2 >> 14, off = e2 & 16383; float c0 = 0.f, c1 = 0.f;
        unsigned* p = (unsigned*)(ST + ((size_t)(bh * 128) << 15)) + off;
#pragma unroll 1
        for (int cb = 0; cb < 128; cb += 8) {
            unsigned t[8]; float d[8];
#pragma unroll
            for (int i = 0; i < 8; ++i) { t[i] = p[(size_t)(cb + i) << 14]; d[i] = MSC[2048 + bh * 128 + cb + i]; }
#pragma unroll
            for (int i = 0; i < 8; ++i) { p[(size_t)(cb + i) << 14] = pk2(c0, c1); c0 = d[i] * c0 + bflo(t[i]); c1 = d[i] * c1 + bfhi(t[i]); }
        }
    }
    const int gt = C.bid * 512 + C.tid;
    if (gt < 1024) { const int bh = gt >> 7, dk = gt & 127; float n = 0.f;
#pragma unroll 2
        for (int c = 0; c < 128; ++c) { float* p = NL + (size_t)(bh * 128 + c) * 128 + dk; const float t = *p; *p = n; n = MSC[2048 + bh * 128 + c] * n + t; } }
}

__device__ __forceinline__ void mlstm_passC(const Ctx& C, const bf16_t* U, const bf16_t* QB, const bf16_t* KB, const float* BC, const float* IP, const float* MSC,
                                            const bf16_t* ST, const float* NL, const float* mg, bf16_t* MIX) {
    LAS unsigned char* Q = C.lds; LAS unsigned char* K = C.lds + 17408; LAS unsigned char* V = C.lds + 34816; LAS unsigned char* SW = C.lds + 69632;
    LAS float* fu = (LAS float*)(C.lds + 78848); LAS float* fM = fu + 64; LAS float* fw = fu + 128; LAS float* fb = fu + 192; LAS float* finv = fu + 256; LAS float* fn = fu + 320; LAS float* fss = fu + 448;
    const int l = C.lane, g = l >> 4, q = (l & 15) >> 2, p = l & 3, w = C.wave, lr = l & 15;
    for (int u = C.bid; u < 1024; u += C.G) {
        const int bh = u >> 7, c = u & 127, b = bh >> 2, h = bh & 3; const size_t row0 = (size_t)b * SEQ + c * 64;
        const float mprev = MSC[bh * 128 + c];
        if (C.tid < 64) { const float bt = BC[(row0 + C.tid) * 4 + h]; fb[C.tid] = bt; fu[C.tid] = IP[(row0 + C.tid) * 4 + h] - bt; }
        if (C.tid >= 64 && C.tid < 192) fn[C.tid - 64] = NL[(size_t)(bh * 128 + c) * 128 + C.tid - 64];
        { const int s = C.tid >> 3, seg = C.tid & 7;
          const bf16_t* qp = QB + (row0 + s) * 512 + h * 128 + seg * 16; const bf16_t* kp = KB + (row0 + s) * 512 + h * 128 + seg * 16;
#pragma unroll
          for (int i = 0; i < 2; ++i) { *(LAS u32x4*)(Q + s * 272 + seg * 32 + 16 * i) = *(const u32x4*)(qp + 8 * i); *(LAS u32x4*)(K + s * 272 + seg * 32 + 16 * i) = *(const u32x4*)(kp + 8 * i); }
          const bf16_t* vp = U + (row0 + s) * UW + 4096 + h * 256 + seg * 32;
#pragma unroll
          for (int i = 0; i < 4; ++i) *(LAS u32x4*)(V + s * 544 + seg * 64 + 16 * i) = *(const u32x4*)(vp + 8 * i); }
        __syncthreads();
        if (C.tid < 64) { float pm = -3.0e38f;
#pragma unroll 1
            for (int s = 0; s <= C.tid; ++s) pm = fmaxf(pm, fu[s]); const float Mt = fmaxf(mprev, pm); fM[C.tid] = Mt; fw[C.tid] = __expf(mprev - Mt); }
        __syncthreads();
#pragma unroll
        for (int tt = 0; tt < 2; ++tt) {
            const int tile = 2 * w + tt, ti = tile >> 2, si = tile & 3;
            f32x4 s4 = (f32x4){0.f, 0.f, 0.f, 0.f};
            if (si <= ti) {
#pragma unroll
                for (int ks = 0; ks < 4; ++ks) { const bf16x8 a = ldsv8(Q + (16 * ti + lr) * 272 + (32 * ks + 8 * g) * 2), bb = ldsv8(K + (16 * si + lr) * 272 + (32 * ks + 8 * g) * 2); s4 = mfma16(a, bb, s4); }
            }
            const int sidx = 16 * si + lr; const float us = fu[sidx];
#pragma unroll
            for (int j = 0; j < 4; ++j) { const int t = 16 * ti + 4 * g + j; const float wgt = (sidx <= t) ? __expf(us - fM[t]) : 0.f;
                *(LAS unsigned short*)(SW + t * 144 + sidx * 2) = (unsigned short)f2bf(s4[j] * wgt); }
        }
        __syncthreads();
        if (C.tid < 64) { const int t = C.tid; float rs = 0.f, qn = 0.f;
#pragma unroll 4
            for (int s = 0; s < 64; ++s) rs += bf2f(*(const LAS unsigned short*)(SW + t * 144 + s * 2));
#pragma unroll 4
            for (int d = 0; d < 128; ++d) qn += bf2f(*(const LAS unsigned short*)(Q + t * 272 + d * 2)) * fn[d];
            const float den = fw[t] * qn + rs; finv[t] = 1.f / fmaxf(fabsf(den), __expf(-(fb[t] + fM[t]))); }
        f32x4 acc[4][2];
#pragma unroll
        for (int mi = 0; mi < 4; ++mi)
#pragma unroll
            for (int ni = 0; ni < 2; ++ni) acc[mi][ni] = (f32x4){0.f, 0.f, 0.f, 0.f};
        const bf16_t* st = ST + ((size_t)(bh * 128 + c) << 15);
#pragma unroll
        for (int ks = 0; ks < 4; ++ks) {
            bf16x8 bb[2];
#pragma unroll
            for (int ni = 0; ni < 2; ++ni) bb[ni] = *(const bf16x8*)(st + (32 * w + 16 * ni + lr) * 128 + 32 * ks + 8 * g);
#pragma unroll
            for (int mi = 0; mi < 4; ++mi) { const bf16x8 a = ldsv8(Q + (16 * mi + lr) * 272 + (32 * ks + 8 * g) * 2);
#pragma unroll
                for (int ni = 0; ni < 2; ++ni) acc[mi][ni] = mfma16(bb[ni], a, acc[mi][ni]); }
        }
#pragma unroll
        for (int mi = 0; mi < 4; ++mi) { const float wi = fw[16 * mi + lr]; acc[mi][0] = acc[mi][0] * wi; acc[mi][1] = acc[mi][1] * wi; }
#pragma unroll
        for (int ks = 0; ks < 2; ++ks) {
            const int r0 = 32 * ks + 8 * g + q; bf16x8 bb[2];
#pragma unroll
            for (int ni = 0; ni < 2; ++ni) { const LAS unsigned char* bp = V + r0 * 544 + (32 * w + 16 * ni + 4 * p) * 2; bb[ni] = tr8(bp, bp + 4 * 544); }
#pragma unroll
            for (int mi = 0; mi < 4; ++mi) { const bf16x8 a = ldsv8(SW + (16 * mi + lr) * 144 + (32 * ks + 8 * g) * 2);
#pragma unroll
                for (int ni = 0; ni < 2; ++ni) acc[mi][ni] = mfma16(bb[ni], a, acc[mi][ni]); }
        }
        __syncthreads();
#pragma unroll
        for (int mi = 0; mi < 4; ++mi) { const float iv = finv[16 * mi + lr]; acc[mi][0] = acc[mi][0] * iv; acc[mi][1] = acc[mi][1] * iv;
            float ss = 0.f;
#pragma unroll
            for (int ni = 0; ni < 2; ++ni) ss += (acc[mi][ni][0] * acc[mi][ni][0] + acc[mi][ni][1] * acc[mi][ni][1]) + (acc[mi][ni][2] * acc[mi][ni][2] + acc[mi][ni][3] * acc[mi][ni][3]);
            ss += __shfl_xor(ss, 16); ss += __shfl_xor(ss, 32);
            if (g == 0) fss[w * 64 + 16 * mi + lr] = ss; }
        __syncthreads();
#pragma unroll
        for (int mi = 0; mi < 4; ++mi) { const int t = 16 * mi + lr; float tot = 0.f;
#pragma unroll
            for (int ww = 0; ww < 8; ++ww) tot += fss[ww * 64 + t];
            const float r = 1.f / sqrtf(tot * (1.f / 256.f) + 1e-6f);
#pragma unroll
            for (int ni = 0; ni < 2; ++ni) { const int dv = 32 * w + 16 * ni + 4 * g;
                const u32x2 ogb = *(const u32x2*)(U + (row0 + t) * UW + 5120 + h * 256 + dv); const f32x4 gv = *(const f32x4*)(mg + h * 256 + dv);
                const float o0 = acc[mi][ni][0] * r * gv[0] * pg8::sigmoidf_(bflo(ogb.x)), o1 = acc[mi][ni][1] * r * gv[1] * pg8::sigmoidf_(bfhi(ogb.x));
                const float o2 = acc[mi][ni][2] * r * gv[2] * pg8::sigmoidf_(bflo(ogb.y)), o3 = acc[mi][ni][3] * r * gv[3] * pg8::sigmoidf_(bfhi(ogb.y));
                u32x2 wv; wv.x = pg8::cvt_pk_bf16(o0, o1); wv.y = pg8::cvt_pk_bf16(o2, o3);
                *(u32x2*)(MIX + (row0 + t) * DM + 1024 + h * 256 + dv) = wv; } }
        __syncthreads();
    }
}

__device__ __forceinline__ float gla_decay(const Ctx& C, const float* w_a2, const float* b_a, int h, LAS float* A1, LAS float* tot0, LAS unsigned char* QD, LAS unsigned char* KD) {
    const int ch = C.tid & 255, half = C.tid >> 8, t0 = 32 * half;
    float wv[16];
#pragma unroll
    for (int i = 0; i < 16; ++i) wv[i] = w_a2[i * 1024 + h * 256 + ch];
    const float ba = b_a[h * 256 + ch];
    float c[32]; float run = 0.f;
#pragma unroll
    for (int i = 0; i < 32; ++i) {
        const LAS float* ap = A1 + (t0 + i) * 16;
        const f32x4 a0 = *(const LAS f32x4*)(ap), a1 = *(const LAS f32x4*)(ap + 4), a2 = *(const LAS f32x4*)(ap + 8), a3 = *(const LAS f32x4*)(ap + 12);
        float z0 = ba, z1 = 0.f, z2 = 0.f, z3 = 0.f;
#pragma unroll
        for (int j = 0; j < 4; ++j) { z0 += a0[j] * wv[j]; z1 += a1[j] * wv[4 + j]; z2 += a2[j] * wv[8 + j]; z3 += a3[j] * wv[12 + j]; }
        const float z = (z0 + z1) + (z2 + z3);
        run += (fminf(z, 0.f) - __logf(1.f + __expf(-fabsf(z)))) * 0.0625f;
        c[i] = run;
    }
    if (half == 0) tot0[ch] = run;
    __syncthreads();
    const float off = half ? tot0[ch] : 0.f;
#pragma unroll
    for (int i = 0; i < 32; ++i) {
        const float cum = c[i] + off; const int t = t0 + i;
        LAS unsigned short* kp = (LAS unsigned short*)(KD + t * 528 + ch * 2); *kp = (unsigned short)f2bf(bf2f(*kp) * __expf(-cum));
        LAS unsigned short* qp = (LAS unsigned short*)(QD + t * 528 + ch * 2); *qp = (unsigned short)f2bf(bf2f(*qp) * __expf(cum) * 0.0625f);
    }
    return __expf(c[31] + off);
}

__device__ __forceinline__ void gla_passA(const Ctx& C, const bf16_t* U, const float* GT, const float* w_a2, const float* b_a, bf16_t* ST, float* DC, bf16_t* QDG, bf16_t* KDG) {
    LAS unsigned char* QD = C.lds; LAS unsigned char* KD = C.lds + 33792; LAS unsigned char* V = C.lds + 67584;
    LAS float* A1 = (LAS float*)(C.lds + 135168); LAS float* bl = (LAS float*)(C.lds + 139264); LAS float* tot0 = (LAS float*)(C.lds + 140288);
    const int l = C.lane, g = l >> 4, q = (l & 15) >> 2, p = l & 3, w = C.wave, lr = l & 15;
    for (int u = C.bid; u < 1024; u += C.G) {
        const int bh = u >> 7, c = u & 127, b = bh >> 2, h = bh & 3; const size_t row0 = (size_t)b * SEQ + c * 64;
        A1[C.tid] = GT[row0 * 16 + C.tid]; A1[C.tid + 512] = GT[row0 * 16 + C.tid + 512];
        { const int s = C.tid >> 3, seg = C.tid & 7; const bf16_t* vp = U + (row0 + s) * UW + 2048 + h * 512 + seg * 64;
#pragma unroll
          for (int i = 0; i < 8; ++i) *(LAS u32x4*)(V + s * 1056 + seg * 128 + 16 * i) = *(const u32x4*)(vp + 8 * i);
          const bf16_t* qp = U + (row0 + s) * UW + h * 256 + seg * 32;
#pragma unroll
          for (int i = 0; i < 4; ++i) { *(LAS u32x4*)(QD + s * 528 + seg * 64 + 16 * i) = *(const u32x4*)(qp + 8 * i); *(LAS u32x4*)(KD + s * 528 + seg * 64 + 16 * i) = *(const u32x4*)(qp + 1024 + 8 * i); } }
        __syncthreads();
        const float eb = gla_decay(C, w_a2, b_a, h, A1, tot0, QD, KD);
        if (C.tid >= 256) { bl[C.tid - 256] = eb; DC[(size_t)(bh * 128 + c) * 256 + C.tid - 256] = eb; }
        __syncthreads();
        { const int s = C.tid >> 3, seg = C.tid & 7; bf16_t* qg = QDG + (row0 + s) * 1024 + h * 256 + seg * 32; bf16_t* kg = KDG + (row0 + s) * 1024 + h * 256 + seg * 32;
#pragma unroll
          for (int i = 0; i < 4; ++i) { *(u32x4*)(qg + 8 * i) = *(const LAS u32x4*)(QD + s * 528 + seg * 64 + 16 * i); *(u32x4*)(kg + 8 * i) = *(const LAS u32x4*)(KD + s * 528 + seg * 64 + 16 * i); } }
#pragma unroll 1
        for (int dvq = 0; dvq < 4; ++dvq) {
            f32x4 acc[16];
#pragma unroll
            for (int ni = 0; ni < 16; ++ni) acc[ni] = (f32x4){0.f, 0.f, 0.f, 0.f};
#pragma unroll
            for (int ks = 0; ks < 2; ++ks) {
                const int r0 = 32 * ks + 8 * g + q;
                const LAS unsigned char* ap = V + r0 * 1056 + (dvq * 128 + 16 * w + 4 * p) * 2; const bf16x8 a = tr8(ap, ap + 4 * 1056);
#pragma unroll
                for (int ni = 0; ni < 16; ++ni) { const LAS unsigned char* bp = KD + r0 * 528 + (16 * ni + 4 * p) * 2; acc[ni] = mfma16(tr8(bp, bp + 4 * 528), a, acc[ni]); }
            }
            bf16_t* st = ST + ((size_t)(bh * 128 + c) << 17) + (size_t)(dvq * 128 + 16 * w + lr) * 256 + 4 * g;
#pragma unroll
            for (int ni = 0; ni < 16; ++ni) { const f32x4 e4 = *(const LAS f32x4*)(bl + 16 * ni + 4 * g); const f32x4 v4 = acc[ni] * e4;
                u32x2 wv; wv.x = pg8::cvt_pk_bf16(v4[0], v4[1]); wv.y = pg8::cvt_pk_bf16(v4[2], v4[3]); *(u32x2*)(st + 16 * ni) = wv; }
        }
        __syncthreads();
    }
}

__device__ __forceinline__ void gla_scan(const Ctx& C, bf16_t* ST, const float* DC) {
    for (int e8 = C.bid * 512 + C.tid; e8 < 8 * 16384; e8 += C.G * 512) {
        const int bh = e8 >> 14, off = e8 & 16383, dk = (off * 8) & 255;
        float s[8];
#pragma unroll
        for (int i = 0; i < 8; ++i) s[i] = 0.f;
        u32x4* p = (u32x4*)(ST + ((size_t)(bh * 128) << 17)) + off;
#pragma unroll 1
        for (int cb = 0; cb < 128; cb += 4) {
            u32x4 t[4]; f32x4 d0[4], d1[4];
#pragma unroll
            for (int i = 0; i < 4; ++i) { t[i] = p[(size_t)(cb + i) << 14]; const float* d = DC + (size_t)(bh * 128 + cb + i) * 256 + dk; d0[i] = *(const f32x4*)d; d1[i] = *(const f32x4*)(d + 4); }
#pragma unroll
            for (int i = 0; i < 4; ++i) {
                u32x4 o; o.x = pk2(s[0], s[1]); o.y = pk2(s[2], s[3]); o.z = pk2(s[4], s[5]); o.w = pk2(s[6], s[7]); p[(size_t)(cb + i) << 14] = o;
                s[0] = d0[i][0] * s[0] + bflo(t[i].x); s[1] = d0[i][1] * s[1] + bfhi(t[i].x); s[2] = d0[i][2] * s[2] + bflo(t[i].y); s[3] = d0[i][3] * s[3] + bfhi(t[i].y);
                s[4] = d1[i][0] * s[4] + bflo(t[i].z); s[5] = d1[i][1] * s[5] + bfhi(t[i].z); s[6] = d1[i][2] * s[6] + bflo(t[i].w); s[7] = d1[i][3] * s[7] + bfhi(t[i].w);
            }
        }
    }
}

__device__ __forceinline__ void gla_passC(const Ctx& C, const bf16_t* U, const bf16_t* QDG, const bf16_t* KDG, const bf16_t* ST, const float* gg, bf16_t* MIX) {
    LAS unsigned char* QD = C.lds; LAS unsigned char* KD = C.lds + 33792; LAS unsigned char* V = C.lds + 67584; LAS unsigned char* ATT = C.lds + 135168;
    LAS float* fss = (LAS float*)(C.lds + 144384);
    const int l = C.lane, g = l >> 4, q = (l & 15) >> 2, p = l & 3, w = C.wave, lr = l & 15;
    for (int u = C.bid; u < 1024; u += C.G) {
        const int bh = u >> 7, c = u & 127, b = bh >> 2, h = bh & 3; const size_t row0 = (size_t)b * SEQ + c * 64;
        { const int s = C.tid >> 3, seg = C.tid & 7; const bf16_t* vp = U + (row0 + s) * UW + 2048 + h * 512 + seg * 64;
#pragma unroll
          for (int i = 0; i < 8; ++i) *(LAS u32x4*)(V + s * 1056 + seg * 128 + 16 * i) = *(const u32x4*)(vp + 8 * i);
          const bf16_t* qg = QDG + (row0 + s) * 1024 + h * 256 + seg * 32; const bf16_t* kg = KDG + (row0 + s) * 1024 + h * 256 + seg * 32;
#pragma unroll
          for (int i = 0; i < 4; ++i) { *(LAS u32x4*)(QD + s * 528 + seg * 64 + 16 * i) = *(const u32x4*)(qg + 8 * i); *(LAS u32x4*)(KD + s * 528 + seg * 64 + 16 * i) = *(const u32x4*)(kg + 8 * i); } }
        __syncthreads();
#pragma unroll
        for (int tt = 0; tt < 2; ++tt) {
            const int tile = 2 * w + tt, ti = tile >> 2, si = tile & 3;
            f32x4 s4 = (f32x4){0.f, 0.f, 0.f, 0.f};
            if (si <= ti) {
#pragma unroll
                for (int ks = 0; ks < 8; ++ks) { const bf16x8 a = ldsv8(QD + (16 * ti + lr) * 528 + (32 * ks + 8 * g) * 2), bb = ldsv8(KD + (16 * si + lr) * 528 + (32 * ks + 8 * g) * 2); s4 = mfma16(a, bb, s4); }
            }
            const int sidx = 16 * si + lr;
#pragma unroll
            for (int j = 0; j < 4; ++j) { const int t = 16 * ti + 4 * g + j; *(LAS unsigned short*)(ATT + t * 144 + sidx * 2) = (unsigned short)f2bf((sidx <= t) ? s4[j] : 0.f); }
        }
        __syncthreads();
        f32x4 acc[4][4];
#pragma unroll
        for (int mi = 0; mi < 4; ++mi)
#pragma unroll
            for (int ni = 0; ni < 4; ++ni) acc[mi][ni] = (f32x4){0.f, 0.f, 0.f, 0.f};
        const bf16_t* st = ST + ((size_t)(bh * 128 + c) << 17);
#pragma unroll 4
        for (int ks = 0; ks < 8; ++ks) {
            bf16x8 bb[4];
#pragma unroll
            for (int ni = 0; ni < 4; ++ni) bb[ni] = *(const bf16x8*)(st + (size_t)(64 * w + 16 * ni + lr) * 256 + 32 * ks + 8 * g);
#pragma unroll
            for (int mi = 0; mi < 4; ++mi) { const bf16x8 a = ldsv8(QD + (16 * mi + lr) * 528 + (32 * ks + 8 * g) * 2);
#pragma unroll
                for (int ni = 0; ni < 4; ++ni) acc[mi][ni] = mfma16(bb[ni], a, acc[mi][ni]); }
        }
#pragma unroll
        for (int ks = 0; ks < 2; ++ks) {
            const int r0 = 32 * ks + 8 * g + q; bf16x8 bb[4];
#pragma unroll
            for (int ni = 0; ni < 4; ++ni) { const LAS unsigned char* bp = V + r0 * 1056 + (64 * w + 16 * ni + 4 * p) * 2; bb[ni] = tr8(bp, bp + 4 * 1056); }
#pragma unroll
            for (int mi = 0; mi < 4; ++mi) { const bf16x8 a = ldsv8(ATT + (16 * mi + lr) * 144 + (32 * ks + 8 * g) * 2);
#pragma unroll
                for (int ni = 0; ni < 4; ++ni) acc[mi][ni] = mfma16(bb[ni], a, acc[mi][ni]); }
        }
#pragma unroll
        for (int mi = 0; mi < 4; ++mi) { float ss = 0.f;
#pragma unroll
            for (int ni = 0; ni < 4; ++ni) ss += (acc[mi][ni][0] * acc[mi][ni][0] + acc[mi][ni][1] * acc[mi][ni][1]) + (acc[mi][ni][2] * acc[mi][ni][2] + acc[mi][ni][3] * acc[mi][ni][3]);
            ss += __shfl_xor(ss, 16); ss += __shfl_xor(ss, 32);
            if (g == 0) fss[w * 64 + 16 * mi + lr] = ss; }
        __syncthreads();
#pragma unroll
        for (int mi = 0; mi < 4; ++mi) { const int t = 16 * mi + lr; float tot = 0.f;
#pragma unroll
            for (int ww = 0; ww < 8; ++ww) tot += fss[ww * 64 + t];
            const float r = 1.f / sqrtf(tot * (1.f / 512.f) + 1e-6f);
#pragma unroll
            for (int ni = 0; ni < 4; ++ni) { const int dv = 64 * w + 16 * ni + 4 * g;
                const u32x2 rgb = *(const u32x2*)(U + (row0 + t) * UW + 4096 + h * 512 + dv); const f32x4 gv = *(const f32x4*)(gg + h * 512 + dv);
                const float r0 = bflo(rgb.x), r1 = bfhi(rgb.x), r2 = bflo(rgb.y), r3 = bfhi(rgb.y);
                const float o0 = acc[mi][ni][0] * r * gv[0] * r0 * pg8::sigmoidf_(r0), o1 = acc[mi][ni][1] * r * gv[1] * r1 * pg8::sigmoidf_(r1);
                const float o2 = acc[mi][ni][2] * r * gv[2] * r2 * pg8::sigmoidf_(r2), o3 = acc[mi][ni][3] * r * gv[3] * r3 * pg8::sigmoidf_(r3);
                u32x2 wv; wv.x = pg8::cvt_pk_bf16(o0, o1); wv.y = pg8::cvt_pk_bf16(o2, o3);
                *(u32x2*)(MIX + (row0 + t) * DM + h * 512 + dv) = wv; } }
        __syncthreads();
    }
}

__device__ __forceinline__ int crow(int r, int hi) { return (r & 3) + 8 * (r >> 2) + 4 * hi; }
__device__ __forceinline__ void attn_unit(const Ctx& C, const bf16_t* U, const float* rel_bias, const float* dg, float lam, int b, int h, int qb, bf16_t* MIX) {
    LAS unsigned char* KT0 = C.lds; LAS unsigned char* VT0 = C.lds + 2 * 17408; LAS float* tab = (LAS float*)(C.lds + 131072); LAS float* OX = (LAS float*)(C.lds);
    constexpr int KS = 272, VS = 320;
    const int l = C.lane, ql = l & 31, hi = l >> 5, g = l >> 4, qq = (l & 15) >> 2, pp = l & 3, w = C.wave, comp = w >> 2, rw = w & 3;
    const int qpos = qb * 128 + 32 * rw + ql;
    const size_t rowq = (size_t)b * SEQ + qpos;
    __syncthreads();
    if (C.tid < 128) { const int n = C.tid; int bk;
        if (n < 16) bk = n; else { bk = 16 + (int)(__logf((float)n * 0.0625f) / 2.0794415416798357f * 16.f); bk = bk < 31 ? bk : 31; }
        tab[n] = rel_bias[bk * 8 + h] * LOG2E; }
    const float b31 = rel_bias[31 * 8 + h] * LOG2E;
    LAS unsigned char* QT = C.lds + 96256;
    { const int row = C.tid >> 2, part = C.tid & 3; const bf16_t* qsrc = U + ((size_t)b * SEQ + qb * 128 + row) * UW + h * 128 + part * 32;
#pragma unroll
      for (int i = 0; i < 4; ++i) *(LAS u32x4*)(QT + row * 272 + part * 64 + 16 * i) = *(const u32x4*)(qsrc + 8 * i); }
    const LAS unsigned char* qfrag = QT + (32 * rw + ql) * 272 + (comp * 64 + 8 * hi) * 2;
    f32x16 o[4];
#pragma unroll
    for (int mb = 0; mb < 4; ++mb)
#pragma unroll
        for (int r = 0; r < 16; ++r) o[mb][r] = 0.f;
    float mrun = -1.0e30f, lrun = 0.f;
    u32x4 kreg[2], vreg[2];
    const bf16_t* srcb = U + ((size_t)b * SEQ + (C.tid >> 4)) * UW + h * 128 + (C.tid & 15) * 8;
    const int ntiles = 2 * (qb + 1);
#pragma unroll
    for (int i = 0; i < 2; ++i) { kreg[i] = *(const u32x4*)(srcb + (size_t)(32 * i) * UW + 1024); vreg[i] = *(const u32x4*)(srcb + (size_t)(32 * i) * UW + 2048); }
#pragma unroll
    for (int i = 0; i < 2; ++i) { const int key = (C.tid >> 4) + 32 * i, seg = C.tid & 15;
        *(LAS u32x4*)(KT0 + key * KS + seg * 16) = kreg[i]; *(LAS u32x4*)(VT0 + key * VS + seg * 16) = vreg[i]; }
#pragma unroll
    for (int i = 0; i < 2; ++i) { kreg[i] = *(const u32x4*)(srcb + (size_t)(64 + 32 * i) * UW + 1024); vreg[i] = *(const u32x4*)(srcb + (size_t)(64 + 32 * i) * UW + 2048); }
    int vs_cur = 0, vs_prev = 0; const bool rot = comp == 1;
    bf16x8 pb[4];
#pragma unroll
    for (int i = 0; i < 4; ++i) pb[i] = (bf16x8){0, 0, 0, 0, 0, 0, 0, 0};
#define ATT_PV(VSLOT) do { const LAS unsigned char* vb_ = VT0 + (VSLOT) * 20480 + (4 * hi + qq) * VS + (16 * (g & 1) + 4 * pp) * 2; _Pragma("unroll") for (int k2 = 0; k2 < 2; ++k2) _Pragma("unroll") for (int ks = 0; ks < 2; ++ks) { \
        bf16x8 af_[4]; _Pragma("unroll") for (int mb = 0; mb < 4; ++mb) { const LAS unsigned char* ap = vb_ + (32 * k2 + 16 * ks) * VS + 64 * mb; af_[mb] = tr8(ap, ap + 8 * VS); } \
        __builtin_amdgcn_sched_barrier(0); \
        _Pragma("unroll") for (int mb = 0; mb < 4; ++mb) o[mb] = mfma32(af_[mb], pb[2 * k2 + ks], o[mb]); } } while (0)
    for (int kt = 0; kt < ntiles; ++kt) {
        const int kb = kt * 64;
        __syncthreads();
        LAS unsigned char* KT = KT0 + (kt & 1) * 17408; LAS unsigned char* VT = VT0 + vs_cur * 20480;
        const int vs_nxt = vs_cur == 2 ? 0 : vs_cur + 1;
        if (kt + 1 < ntiles) {
            LAS unsigned char* KN = KT0 + ((kt + 1) & 1) * 17408; LAS unsigned char* VN = VT0 + vs_nxt * 20480;
#pragma unroll
            for (int i = 0; i < 2; ++i) { const int key = (C.tid >> 4) + 32 * i, seg = C.tid & 15;
                *(LAS u32x4*)(KN + key * KS + seg * 16) = kreg[i]; *(LAS u32x4*)(VN + key * VS + seg * 16) = vreg[i]; }
            if (kt + 2 < ntiles) {
#pragma unroll
                for (int i = 0; i < 2; ++i) { kreg[i] = *(const u32x4*)(srcb + (size_t)(kb + 128 + 32 * i) * UW + 1024); vreg[i] = *(const u32x4*)(srcb + (size_t)(kb + 128 + 32 * i) * UW + 2048); }
            }
        }
        if (rot && kt > 0) ATT_PV(vs_prev);
        __builtin_amdgcn_sched_barrier(0);
        f32x16 st[2];
#pragma unroll
        for (int k2 = 0; k2 < 2; ++k2) {
#pragma unroll
            for (int r = 0; r < 16; ++r) st[k2][r] = 0.f;
#pragma unroll
            for (int kk = 0; kk < 4; ++kk) st[k2] = mfma32(ldsv8(KT + (32 * k2 + ql) * KS + (comp * 64 + 16 * kk + 8 * hi) * 2), ldsv8(qfrag + 32 * kk), st[k2]);
        }
        __builtin_amdgcn_sched_barrier(0);
        const bool far = (qb * 128 + 32 * rw - (kb + 63)) >= 127;
        float mx = -1.0e30f, cadd;
        if (far) {
#pragma unroll
            for (int k2 = 0; k2 < 2; ++k2)
#pragma unroll
                for (int r = 0; r < 16; r += 2) mx = fmaxf(fmaxf(st[k2][r], st[k2][r + 1]), mx);
            mx = mx * LOG2E + b31; cadd = b31;
        } else {
#pragma unroll
            for (int k2 = 0; k2 < 2; ++k2)
#pragma unroll
                for (int r = 0; r < 16; ++r) { const int rel = qpos - (kb + 32 * k2 + crow(r, hi)); const int ri = rel < 0 ? 0 : (rel > 127 ? 127 : rel);
                    const float t = st[k2][r] * LOG2E + tab[ri]; st[k2][r] = (rel >= 0 ? t : -1.0e30f) * (1.0f / LOG2E); mx = fmaxf(mx, rel >= 0 ? t : -1.0e30f); }
            cadd = 0.f;
        }
        mx = fmaxf(mx, __shfl_xor(mx, 32));
        const float mnew = fmaxf(mrun, mx), alpha = __builtin_amdgcn_exp2f(mrun - mnew);
        const bool grew = mnew > mrun; mrun = mnew;
        const float cst = cadd - mnew;
        float ps = 0.f;
#pragma unroll
        for (int k2 = 0; k2 < 2; ++k2)
#pragma unroll
            for (int r = 0; r < 16; ++r) { const float pv = __builtin_amdgcn_exp2f(__builtin_fmaf(st[k2][r], LOG2E, cst)); st[k2][r] = pv; ps += pv; }
        lrun = lrun * alpha + ps;
        if (__any(grew)) {
#pragma unroll
            for (int mb = 0; mb < 4; ++mb)
#pragma unroll
                for (int r = 0; r < 16; ++r) o[mb][r] *= alpha;
        }
        __builtin_amdgcn_sched_barrier(0);
#pragma unroll
        for (int k2 = 0; k2 < 2; ++k2)
#pragma unroll
            for (int ks = 0; ks < 2; ++ks) { const int r8 = 8 * ks;
                const unsigned w0 = pg8::cvt_pk_bf16(st[k2][r8 + 0], st[k2][r8 + 1]), w1 = pg8::cvt_pk_bf16(st[k2][r8 + 2], st[k2][r8 + 3]), w2 = pg8::cvt_pk_bf16(st[k2][r8 + 4], st[k2][r8 + 5]), w3 = pg8::cvt_pk_bf16(st[k2][r8 + 6], st[k2][r8 + 7]);
                const u32x4 wv = (u32x4){w0, w1, w2, w3}; pb[2 * k2 + ks] = __builtin_bit_cast(bf16x8, wv); }
        __builtin_amdgcn_sched_barrier(0);
        if (!rot) ATT_PV(vs_cur);
        vs_prev = vs_cur; vs_cur = vs_nxt;
    }
    if (rot) ATT_PV(vs_prev);
#undef ATT_PV
    const float ltot = lrun + __shfl_xor(lrun, 32), inv = 1.f / ltot;
    int l2 = C.lane; asm volatile("" : "+v"(l2));
    const int ql_e = l2 & 31, hi_e = l2 >> 5;
    const size_t rowq_e = (size_t)b * SEQ + qb * 128 + 32 * rw + ql_e;
    __syncthreads();
    if (comp == 1) {
#pragma unroll
        for (int mb = 0; mb < 4; ++mb)
#pragma unroll
            for (int r = 0; r < 16; ++r) OX[(rw * 128 + 32 * mb + crow(r, hi_e)) * 32 + ql_e] = o[mb][r] * inv;
    }
    __syncthreads();
    if (comp == 0) {
        float ss = 0.f;
#pragma unroll
        for (int mb = 0; mb < 4; ++mb)
#pragma unroll
            for (int r = 0; r < 16; ++r) { const float y = o[mb][r] * inv - lam * OX[(rw * 128 + 32 * mb + crow(r, hi_e)) * 32 + ql_e]; o[mb][r] = y; ss += y * y; }
        ss += __shfl_xor(ss, 32);
        const float rn = (1.f / sqrtf(ss * (1.f / 128.f) + 1e-6f)) * 0.8f;
#pragma unroll
        for (int mb = 0; mb < 4; ++mb)
#pragma unroll
            for (int r4 = 0; r4 < 4; ++r4) { const int dv = 32 * mb + 8 * r4 + 4 * hi_e; const f32x4 gv = *(const f32x4*)(dg + h * 128 + dv);
                u32x2 wv; wv.x = pk2(o[mb][4 * r4] * rn * gv[0], o[mb][4 * r4 + 1] * rn * gv[1]); wv.y = pk2(o[mb][4 * r4 + 2] * rn * gv[2], o[mb][4 * r4 + 3] * rn * gv[3]);
                *(u32x2*)(MIX + rowq_e * DM + h * 128 + dv) = wv; }
    }
}
__device__ __forceinline__ void attn_phase(const Ctx& C, const bf16_t* U, const float* rel_bias, const float* dg, const float* lq1, const float* lk1, const float* lq2, const float* lk2, bf16_t* MIX) {
    float s1 = 0.f, s2 = 0.f;
#pragma unroll 4
    for (int i = 0; i < 64; ++i) { s1 += lq1[i] * lk1[i]; s2 += lq2[i] * lk2[i]; }
    const float lam = __expf(s1) - __expf(s2) + 0.2f;
    const bool xa = (C.G == 256);
#pragma unroll 1
    for (int k = 0; k < 512; ++k) {
        int pr;
        if (xa) { if (k >= 2) break; pr = (2 * (C.bid & 7) + k) * 32 + (C.bid >> 3); } else { pr = C.bid + k * C.G; if (pr >= 512) break; }
        const int bh = pr >> 5, i = pr & 31, b = bh >> 3, h = bh & 7;
        attn_unit(C, U, rel_bias, dg, lam, b, h, i, MIX);
        attn_unit(C, U, rel_bias, dg, lam, b, h, 63 - i, MIX);
    }
    __syncthreads();
}

struct Args {
    const float* x; const float* p; const float* ln_g; const float* ln_b; const float* w_ffn_in; const float* w_ffn_out; const float* w_in_ab; const float* w_out_ab;
    const float* rel_bias; const float* lq1; const float* lk1; const float* lq2; const float* lk2; const float* diff_norm; const float* conv_w; const float* conv_b;
    const float* b_igate; const float* b_fgate; const float* mlstm_norm; const float* w_in_c; const float* w_alpha2; const float* b_alpha; const float* gla_norm;
    const float* w_out_c; const float* w_ple_proj; const float* w_ple_gate;
    float* out; unsigned char* ws;
    int ph_lo, ph_hi;
};


constexpr int ARGS_OFF = 147200;
enum { A_x = 0, A_p, A_ln_g, A_ln_b, A_w_ffn_in, A_w_ffn_out, A_w_in_ab, A_w_out_ab, A_rel_bias, A_lq1, A_lk1, A_lq2, A_lk2, A_diff_norm, A_conv_w, A_conv_b,
       A_b_igate, A_b_fgate, A_mlstm_norm, A_w_in_c, A_w_alpha2, A_b_alpha, A_gla_norm, A_w_out_c, A_w_ple_proj, A_w_ple_gate, A_out, A_ws };
__device__ __forceinline__ unsigned char* ldarg(LAS unsigned char* lds, int i) {
    volatile LAS unsigned* p = (volatile LAS unsigned*)(lds + ARGS_OFF) + 2 * i;
    const unsigned lo = __builtin_amdgcn_readfirstlane(p[0]), hi = __builtin_amdgcn_readfirstlane(p[1]);
    return (unsigned char*)(__attribute__((address_space(1))) unsigned char*)(((unsigned long long)hi << 32) | lo);
}
#define ARGF(i) ((const float*)ldarg(C.lds, (i)))
#define WSP(T, off) ((T*)(ldarg(C.lds, A_ws) + (off)))


__device__ __forceinline__ void grid_barrier(unsigned* ctr, unsigned target, bool leader) {
    asm volatile("s_waitcnt vmcnt(0) lgkmcnt(0)" ::: "memory");
    __syncthreads();
    if (leader) {
        __builtin_amdgcn_fence(__ATOMIC_RELEASE, "agent");
        asm volatile("s_waitcnt vmcnt(0)" ::: "memory");
        (void)__hip_atomic_fetch_add(ctr, 1u, __ATOMIC_RELAXED, __HIP_MEMORY_SCOPE_AGENT);
        while (__hip_atomic_load(ctr, __ATOMIC_RELAXED, __HIP_MEMORY_SCOPE_AGENT) < target) __builtin_amdgcn_s_sleep(1);
        __builtin_amdgcn_fence(__ATOMIC_ACQUIRE, "agent");
        asm volatile("s_waitcnt vmcnt(0)" ::: "memory");
    }
    __syncthreads();
}

#define XB_TMO      128
#define XB_XCNT(j)  (256  + 64 * (j))
#define XB_XSUB(j)  (1280 + 64 * (j))
#define XB_XGEN(j)  (2304 + 64 * (j))
#define XB_TOP      3328
#define XB_TOPGEN   3392
#define XCD_BAR_WORDS 3456
#define XB_SPIN_CAP (1u << 22)
__device__ __forceinline__ unsigned xb_ld(unsigned* p)              { return __hip_atomic_load(p, __ATOMIC_RELAXED, __HIP_MEMORY_SCOPE_AGENT); }
__device__ __forceinline__ unsigned xb_add(unsigned* p, unsigned v) { return __hip_atomic_fetch_add(p, v, __ATOMIC_RELAXED, __HIP_MEMORY_SCOPE_AGENT); }
__device__ __forceinline__ unsigned xb_xcc_id() { return (unsigned)__builtin_amdgcn_s_getreg((3 << 11) | 20) & 0xFu; }
#define XB_SPIN(cond, bar) do { unsigned _sp = 0; while (cond) { __builtin_amdgcn_s_sleep(1); \
    if ((++_sp & 255u) == 0u) { if (xb_ld(&(bar)[XB_TMO])) break; if (_sp > XB_SPIN_CAP) { atomicAdd(&(bar)[XB_TMO], 1u); break; } } } } while (0)
__device__ __forceinline__ void xcd_barrier_complete(unsigned* bar, unsigned x, unsigned& nloc, unsigned& nx) {
    const unsigned G = gridDim.x;
    unsigned sum, cnt, mine, sp = 0u;
    for (;;) {
        sum = 0u; cnt = 0u; mine = 0u;
#pragma unroll
        for (unsigned j = 0; j < 16; ++j) { const unsigned c = xb_ld(&bar[XB_XCNT(j)]); sum += c; cnt += (c > 0u) ? 1u : 0u; mine = (j == x) ? c : mine; }
        if (sum == G) break;
        __builtin_amdgcn_s_sleep(1);
        if ((++sp & 255u) == 0u) { if (xb_ld(&bar[XB_TMO])) break; if (sp > XB_SPIN_CAP) { atomicAdd(&bar[XB_TMO], 1u); break; } }
    }
    nloc = mine > 0u ? mine : 1u; nx = cnt > 0u ? cnt : 1u;
}
__device__ __forceinline__ void xcd_barrier(unsigned* bar, volatile LAS unsigned* st, bool leader) {
    asm volatile("s_waitcnt vmcnt(0)" ::: "memory");
    __syncthreads();
    if (leader) {
        __builtin_amdgcn_s_waitcnt(0);
        const unsigned x = xb_xcc_id();
        unsigned nloc = st[0], nx = st[1];
        if (nloc == 0u) { xcd_barrier_complete(bar, x, nloc, nx); st[0] = nloc; st[1] = nx; }
        const unsigned old = xb_add(&bar[XB_XSUB(x)], 1u);
        const unsigned gen = old / nloc;
        if (old + 1u == (gen + 1u) * nloc) {
            __builtin_amdgcn_fence(__ATOMIC_RELEASE, "agent");
            asm volatile("s_waitcnt vmcnt(0)" ::: "memory");
            const unsigned og = xb_add(&bar[XB_TOP], 1u);
            const unsigned tg = og / nx;
            if (og + 1u == (tg + 1u) * nx) xb_add(&bar[XB_TOPGEN], 1u);
            else XB_SPIN(xb_ld(&bar[XB_TOPGEN]) == tg, bar);
            __builtin_amdgcn_fence(__ATOMIC_ACQUIRE, "agent");
            xb_add(&bar[XB_XGEN(x)], 1u);
            asm volatile("s_waitcnt vmcnt(0)" ::: "memory");
        } else {
            XB_SPIN(xb_ld(&bar[XB_XGEN(x)]) == gen, bar);
            __builtin_amdgcn_fence(__ATOMIC_ACQUIRE, "agent");
            asm volatile("s_waitcnt vmcnt(0)" ::: "memory");
        }
    }
    __syncthreads();
}

#define GEMM_CALL(EPI, Aptr, Bptr, Nn, Kk, Eobj) do { pg8::Gemm g_{(const bf16_t*)(Aptr), (const bf16_t*)(Bptr), MT, (Nn), (Kk)}; pg8::StaticOrder S_; S_.init(MT, (Nn), C.G, C.bid); \
    pg8::gemm_phase<EPI, pg8::StaticOrder, true, true>(C.lds, g_, S_, Eobj, C.tid); } while (0)

__global__ void __launch_bounds__(512, 2) mega_fwd(Args a) {
    extern __shared__ __attribute__((aligned(16))) unsigned char lds_raw[];
    cg::grid_group grid = cg::this_grid();
    if (threadIdx.x == 0) {
        LAS unsigned long long* t = (LAS unsigned long long*)((LAS unsigned char*)lds_raw + ARGS_OFF);
        t[A_x] = (unsigned long long)a.x; t[A_p] = (unsigned long long)a.p; t[A_ln_g] = (unsigned long long)a.ln_g; t[A_ln_b] = (unsigned long long)a.ln_b;
        t[A_w_ffn_in] = (unsigned long long)a.w_ffn_in; t[A_w_ffn_out] = (unsigned long long)a.w_ffn_out; t[A_w_in_ab] = (unsigned long long)a.w_in_ab; t[A_w_out_ab] = (unsigned long long)a.w_out_ab;
        t[A_rel_bias] = (unsigned long long)a.rel_bias; t[A_lq1] = (unsigned long long)a.lq1; t[A_lk1] = (unsigned long long)a.lk1; t[A_lq2] = (unsigned long long)a.lq2; t[A_lk2] = (unsigned long long)a.lk2;
        t[A_diff_norm] = (unsigned long long)a.diff_norm; t[A_conv_w] = (unsigned long long)a.conv_w; t[A_conv_b] = (unsigned long long)a.conv_b; t[A_b_igate] = (unsigned long long)a.b_igate;
        t[A_b_fgate] = (unsigned long long)a.b_fgate; t[A_mlstm_norm] = (unsigned long long)a.mlstm_norm; t[A_w_in_c] = (unsigned long long)a.w_in_c; t[A_w_alpha2] = (unsigned long long)a.w_alpha2;
        t[A_b_alpha] = (unsigned long long)a.b_alpha; t[A_gla_norm] = (unsigned long long)a.gla_norm; t[A_w_out_c] = (unsigned long long)a.w_out_c; t[A_w_ple_proj] = (unsigned long long)a.w_ple_proj;
        t[A_w_ple_gate] = (unsigned long long)a.w_ple_gate; t[A_out] = (unsigned long long)a.out; t[A_ws] = (unsigned long long)a.ws;
        t[30] = 0ull;
    }
    __syncthreads();
    const int ph_lo = a.ph_lo, ph_hi = a.ph_hi;
    int ph = 0; unsigned nbar = 0, ngb = 0;
    const int wave_s = __builtin_amdgcn_readfirstlane((int)(threadIdx.x >> 6));
#ifndef REPMASK
#define REPMASK 0
#endif
#define PHASE_BEGIN_G(grp) if (ph >= ph_lo && ph < ph_hi) for (int rep_ = 0; rep_ < (((REPMASK >> (grp)) & 1) ? 2 : 1); ++rep_) { Ctx C; { int t_ = wave_s * 64 + (int)__builtin_amdgcn_mbcnt_hi(~0u, __builtin_amdgcn_mbcnt_lo(~0u, 0u)); asm volatile("" : "+v"(t_)); C.lds = (LAS unsigned char*)lds_raw; C.tid = t_; C.lane = t_ & 63; C.wave = __builtin_amdgcn_readfirstlane(t_ >> 6); \
    C.G = gridDim.x; C.bid = blockIdx.x; C.gw = C.bid * 8 + C.wave; C.NGW = C.G * 8; }
#define PHASE_BEGIN PHASE_BEGIN_G(31)
#ifndef SYNCREP
#define SYNCREP 1
#endif
#define PHASE_END_K(GROUPWISE) } ++ph; if (ph > ph_lo && ph < ph_hi) { for (int sr_ = 0; sr_ < SYNCREP; ++sr_) { \
        unsigned* ctl_ = (unsigned*)(ldarg((LAS unsigned char*)lds_raw, A_ws) + OFF_CTL); const bool lead_ = wave_s == 0 && __builtin_amdgcn_mbcnt_hi(~0u, __builtin_amdgcn_mbcnt_lo(~0u, 0u)) == 0u; \
        if ((GROUPWISE) && (gridDim.x & 7u) == 0u) { ++ngb; grid_barrier(ctl_ + 64 * (1 + (blockIdx.x & 7u)), ngb * (gridDim.x >> 3), lead_); } \
        else { xcd_barrier(ctl_ + 1024, (volatile LAS unsigned*)((LAS unsigned char*)lds_raw + ARGS_OFF + 240), lead_); } } }
#define PHASE_END PHASE_END_K(0)
#define PHASE_END_NONE } ++ph;
#define PHASE_END_ROWS PHASE_END_K(0)

    PHASE_BEGIN_G(0)
        if (C.bid == 0) { unsigned* ctl0_ = (unsigned*)(ldarg(C.lds, A_ws) + OFF_CTL); for (int i_ = C.tid; i_ < 1024 + XCD_BAR_WORDS; i_ += 512) ctl0_[i_] = 0u; }
        int base = 0;
        for (int i = 0; i < 4; ++i) conv_matrix(C, ARGF(A_w_ffn_in) + (size_t)i * DM * NFF2, DM, NFF2, NFF2, WSP(bf16_t, OFF_WFI) + (size_t)i * NFF2 * DM, 1, base);
        for (int i = 0; i < 4; ++i) conv_matrix(C, ARGF(A_w_ffn_out) + (size_t)i * DFF * DM, DFF, DM, DM, WSP(bf16_t, OFF_WFO) + (size_t)i * DM * DFF, 0, base);
        conv_matrix(C, ARGF(A_w_in_ab), DM, 6152, NIN, WSP(bf16_t, OFF_WAB), 2, base);
        conv_matrix(C, ARGF(A_w_in_c), DM, 6160, NIN, WSP(bf16_t, OFF_WC), 0, base);
        conv_matrix(C, ARGF(A_w_out_ab), DM, DM, DM, WSP(bf16_t, OFF_WOAB), 0, base);
        conv_matrix(C, ARGF(A_w_out_c), DM, DM, DM, WSP(bf16_t, OFF_WOC), 0, base);
        for (int i = 0; i < 2; ++i) conv_matrix(C, ARGF(A_w_ple_gate) + (size_t)i * DM * DM, DM, DM, DM, WSP(bf16_t, OFF_WPG) + (size_t)i * DM * DM, 0, base);
        for (int i = 0; i < 2; ++i) conv_matrix(C, ARGF(A_w_ple_proj) + (size_t)i * PLE * DM, PLE, DM, DM, WSP(bf16_t, OFF_WPP) + (size_t)i * DM * PLE, 0, base);
        cvt_rows(C, ARGF(A_x), WSP(bf16_t, OFF_XB), (size_t)MT * DM / 4);
        cvt_rows(C, ARGF(A_p), WSP(bf16_t, OFF_PB), (size_t)2 * MT * PLE / 4);
        __syncthreads();
    } ++ph; if (ph > ph_lo && ph < ph_hi) { grid.sync(); if (wave_s == 0 && __builtin_amdgcn_mbcnt_hi(~0u, __builtin_amdgcn_mbcnt_lo(~0u, 0u)) == 0u) (void)xb_add((unsigned*)(ldarg((LAS unsigned char*)lds_raw, A_ws) + OFF_CTL) + 1024 + XB_XCNT(xb_xcc_id()), 1u); }

    { constexpr int L = 0;
        PHASE_BEGIN_G(1) { pg8::EpiSwiglu e{WSP(bf16_t, OFF_H), DFF}; GEMM_CALL(pg8::EpiSwiglu, WSP(bf16_t, (L == 0 ? OFF_XB : OFF_MIX)), WSP(bf16_t, OFF_WFI) + (size_t)(2 * L) * NFF2 * DM, NFF2, DM, e); }
            if (L == 0) { for (int l2 = 0; l2 < 2; ++l2) { pg8::EpiStore e2{WSP(bf16_t, OFF_XF) + (size_t)l2 * MT * DM, DM, DM, nullptr}; GEMM_CALL(pg8::EpiStore, WSP(bf16_t, OFF_PB) + (size_t)l2 * MT * PLE, WSP(bf16_t, OFF_WPP) + (size_t)l2 * DM * PLE, DM, PLE, e2); } } PHASE_END_ROWS
        PHASE_BEGIN_G(1) { if (L == 0) { pg8::EpiZ<true> e{(const void*)ARGF(A_x), WSP(bf16_t, OFF_Z), ALPHA, 0.5f}; GEMM_CALL(pg8::EpiZ<true>, WSP(bf16_t, OFF_H), WSP(bf16_t, OFF_WFO) + (size_t)(2 * L) * DM * DFF, DM, DFF, e); } else { pg8::EpiZ<false> e{(const void*)WSP(bf16_t, OFF_MIX), WSP(bf16_t, OFF_Z), ALPHA, 0.5f}; GEMM_CALL(pg8::EpiZ<false>, WSP(bf16_t, OFF_H), WSP(bf16_t, OFF_WFO) + (size_t)(2 * L) * DM * DFF, DM, DFF, e); } } PHASE_END_ROWS
        PHASE_BEGIN_G(3) ln_phase<(L == 0 ? 8 : 16)>(C, WSP(bf16_t, OFF_Z), ARGF(A_ln_g) + (size_t)(3 * L) * DM, ARGF(A_ln_b) + (size_t)(3 * L) * DM, WSP(bf16_t, OFF_XB), (L == 0 ? ARGF(A_w_in_ab) : ARGF(A_w_in_c)), (L == 0 ? 6152 : 6160), (L == 0 ? 8 : 16), WSP(float, OFF_GT)); PHASE_END
        PHASE_BEGIN_G(2) { pg8::EpiStore e{WSP(bf16_t, OFF_H), UW, UW, nullptr}; GEMM_CALL(pg8::EpiStore, WSP(bf16_t, OFF_XB), WSP(bf16_t, (L == 0 ? OFF_WAB : OFF_WC)), NIN, DM, e); } PHASE_END
        if (L == 0) {
            PHASE_BEGIN_G(5) m1_phase(C, WSP(bf16_t, OFF_H), WSP(float, OFF_GT), ARGF(A_conv_w), ARGF(A_conv_b), ARGF(A_b_igate), ARGF(A_b_fgate), WSP(bf16_t, OFF_QB), WSP(bf16_t, OFF_KB), WSP(float, OFF_BC), WSP(float, OFF_IP), WSP(float, OFF_MSC)); PHASE_END
            PHASE_BEGIN
                mlstm_passA(C, WSP(bf16_t, OFF_H), WSP(bf16_t, OFF_KB), WSP(float, OFF_BC), WSP(float, OFF_IP), WSP(float, OFF_MSC), WSP(bf16_t, OFF_ST), WSP(float, OFF_NL));
                for (int rep2_ = 0; rep2_ < (((REPMASK >> 4) & 1) ? 2 : 1); ++rep2_)
                attn_phase(C, WSP(bf16_t, OFF_H), ARGF(A_rel_bias), ARGF(A_diff_norm), ARGF(A_lq1), ARGF(A_lk1), ARGF(A_lq2), ARGF(A_lk2), WSP(bf16_t, OFF_MIX));
            PHASE_END
            PHASE_BEGIN mlstm_scan(C, WSP(bf16_t, OFF_ST), WSP(float, OFF_NL), WSP(float, OFF_MSC)); PHASE_END
            PHASE_BEGIN_G(5) mlstm_passC(C, WSP(bf16_t, OFF_H), WSP(bf16_t, OFF_QB), WSP(bf16_t, OFF_KB), WSP(float, OFF_BC), WSP(float, OFF_IP), WSP(float, OFF_MSC), WSP(bf16_t, OFF_ST), WSP(float, OFF_NL), ARGF(A_mlstm_norm), WSP(bf16_t, OFF_MIX)); PHASE_END
        } else {
            PHASE_BEGIN_G(6) gla_passA(C, WSP(bf16_t, OFF_H), WSP(float, OFF_GT), ARGF(A_w_alpha2), ARGF(A_b_alpha), WSP(bf16_t, OFF_ST), WSP(float, OFF_DC), WSP(bf16_t, OFF_Z), WSP(bf16_t, OFF_Z + (size_t)MT * 1024 * 2)); PHASE_END
            PHASE_BEGIN gla_scan(C, WSP(bf16_t, OFF_ST), WSP(float, OFF_DC)); PHASE_END
            PHASE_BEGIN_G(7) gla_passC(C, WSP(bf16_t, OFF_H), WSP(bf16_t, OFF_Z), WSP(bf16_t, OFF_Z + (size_t)MT * 1024 * 2), WSP(bf16_t, OFF_ST), ARGF(A_gla_norm), WSP(bf16_t, OFF_MIX)); PHASE_END
        }
        PHASE_BEGIN_G(1) { pg8::EpiZ<false> e{(const void*)WSP(bf16_t, OFF_XB), WSP(bf16_t, OFF_Z), ALPHA, 1.0f}; GEMM_CALL(pg8::EpiZ<false>, WSP(bf16_t, OFF_MIX), WSP(bf16_t, (L == 0 ? OFF_WOAB : OFF_WOC)), DM, DM, e); } PHASE_END_ROWS
        PHASE_BEGIN_G(3) ln_phase<0>(C, WSP(bf16_t, OFF_Z), ARGF(A_ln_g) + (size_t)(3 * L + 1) * DM, ARGF(A_ln_b) + (size_t)(3 * L + 1) * DM, WSP(bf16_t, OFF_XB), nullptr, 0, 0, nullptr); PHASE_END_ROWS
        PHASE_BEGIN_G(1) { pg8::EpiSwiglu e{WSP(bf16_t, OFF_H), DFF}; GEMM_CALL(pg8::EpiSwiglu, WSP(bf16_t, OFF_XB), WSP(bf16_t, OFF_WFI) + (size_t)(2 * L + 1) * NFF2 * DM, NFF2, DM, e); } PHASE_END_ROWS
        PHASE_BEGIN_G(1) { pg8::EpiZ<false> e{(const void*)WSP(bf16_t, OFF_XB), WSP(bf16_t, OFF_Z), ALPHA, 0.5f}; GEMM_CALL(pg8::EpiZ<false>, WSP(bf16_t, OFF_H), WSP(bf16_t, OFF_WFO) + (size_t)(2 * L + 1) * DM * DFF, DM, DFF, e); } PHASE_END_ROWS
        PHASE_BEGIN_G(3) ln_phase<0>(C, WSP(bf16_t, OFF_Z), ARGF(A_ln_g) + (size_t)(3 * L + 2) * DM, ARGF(A_ln_b) + (size_t)(3 * L + 2) * DM, WSP(bf16_t, OFF_XB), nullptr, 0, 0, nullptr); PHASE_END_ROWS
        PHASE_BEGIN { pg8::EpiPle e{WSP(const bf16_t, OFF_XB), WSP(const bf16_t, OFF_XF) + (size_t)L * MT * DM, (L == 1) ? (float*)ldarg(C.lds, A_out) : (float*)nullptr, (L == 1) ? (bf16_t*)nullptr : WSP(bf16_t, OFF_MIX)}; GEMM_CALL(pg8::EpiPle, WSP(bf16_t, OFF_XB), WSP(bf16_t, OFF_WPG) + (size_t)L * DM * DM, DM, DM, e); } PHASE_END_ROWS
        }
    { constexpr int L = 1;
        PHASE_BEGIN_G(1) { pg8::EpiSwiglu e{WSP(bf16_t, OFF_H), DFF}; GEMM_CALL(pg8::EpiSwiglu, WSP(bf16_t, (L == 0 ? OFF_XB : OFF_MIX)), WSP(bf16_t, OFF_WFI) + (size_t)(2 * L) * NFF2 * DM, NFF2, DM, e); }
            if (L == 0) { for (int l2 = 0; l2 < 2; ++l2) { pg8::EpiStore e2{WSP(bf16_t, OFF_XF) + (size_t)l2 * MT * DM, DM, DM, nullptr}; GEMM_CALL(pg8::EpiStore, WSP(bf16_t, OFF_PB) + (size_t)l2 * MT * PLE, WSP(bf16_t, OFF_WPP) + (size_t)l2 * DM * PLE, DM, PLE, e2); } } PHASE_END_ROWS
        PHASE_BEGIN_G(1) { if (L == 0) { pg8::EpiZ<true> e{(const void*)ARGF(A_x), WSP(bf16_t, OFF_Z), ALPHA, 0.5f}; GEMM_CALL(pg8::EpiZ<true>, WSP(bf16_t, OFF_H), WSP(bf16_t, OFF_WFO) + (size_t)(2 * L) * DM * DFF, DM, DFF, e); } else { pg8::EpiZ<false> e{(const void*)WSP(bf16_t, OFF_MIX), WSP(bf16_t, OFF_Z), ALPHA, 0.5f}; GEMM_CALL(pg8::EpiZ<false>, WSP(bf16_t, OFF_H), WSP(bf16_t, OFF_WFO) + (size_t)(2 * L) * DM * DFF, DM, DFF, e); } } PHASE_END_ROWS
        PHASE_BEGIN_G(3) ln_phase<(L == 0 ? 8 : 16)>(C, WSP(bf16_t, OFF_Z), ARGF(A_ln_g) + (size_t)(3 * L) * DM, ARGF(A_ln_b) + (size_t)(3 * L) * DM, WSP(bf16_t, OFF_XB), (L == 0 ? ARGF(A_w_in_ab) : ARGF(A_w_in_c)), (L == 0 ? 6152 : 6160), (L == 0 ? 8 : 16), WSP(float, OFF_GT)); PHASE_END
        PHASE_BEGIN_G(2) { pg8::EpiStore e{WSP(bf16_t, OFF_H), UW, UW, nullptr}; GEMM_CALL(pg8::EpiStore, WSP(bf16_t, OFF_XB), WSP(bf16_t, (L == 0 ? OFF_WAB : OFF_WC)), NIN, DM, e); } PHASE_END
        if (L == 0) {
            PHASE_BEGIN_G(5) m1_phase(C, WSP(bf16_t, OFF_H), WSP(float, OFF_GT), ARGF(A_conv_w), ARGF(A_conv_b), ARGF(A_b_igate), ARGF(A_b_fgate), WSP(bf16_t, OFF_QB), WSP(bf16_t, OFF_KB), WSP(float, OFF_BC), WSP(float, OFF_IP), WSP(float, OFF_MSC)); PHASE_END
            PHASE_BEGIN
                mlstm_passA(C, WSP(bf16_t, OFF_H), WSP(bf16_t, OFF_KB), WSP(float, OFF_BC), WSP(float, OFF_IP), WSP(float, OFF_MSC), WSP(bf16_t, OFF_ST), WSP(float, OFF_NL));
                for (int rep2_ = 0; rep2_ < (((REPMASK >> 4) & 1) ? 2 : 1); ++rep2_)
                attn_phase(C, WSP(bf16_t, OFF_H), ARGF(A_rel_bias), ARGF(A_diff_norm), ARGF(A_lq1), ARGF(A_lk1), ARGF(A_lq2), ARGF(A_lk2), WSP(bf16_t, OFF_MIX));
            PHASE_END
            PHASE_BEGIN mlstm_scan(C, WSP(bf16_t, OFF_ST), WSP(float, OFF_NL), WSP(float, OFF_MSC)); PHASE_END
            PHASE_BEGIN_G(5) mlstm_passC(C, WSP(bf16_t, OFF_H), WSP(bf16_t, OFF_QB), WSP(bf16_t, OFF_KB), WSP(float, OFF_BC), WSP(float, OFF_IP), WSP(float, OFF_MSC), WSP(bf16_t, OFF_ST), WSP(float, OFF_NL), ARGF(A_mlstm_norm), WSP(bf16_t, OFF_MIX)); PHASE_END
        } else {
            PHASE_BEGIN_G(6) gla_passA(C, WSP(bf16_t, OFF_H), WSP(float, OFF_GT), ARGF(A_w_alpha2), ARGF(A_b_alpha), WSP(bf16_t, OFF_ST), WSP(float, OFF_DC), WSP(bf16_t, OFF_Z), WSP(bf16_t, OFF_Z + (size_t)MT * 1024 * 2)); PHASE_END
            PHASE_BEGIN gla_scan(C, WSP(bf16_t, OFF_ST), WSP(float, OFF_DC)); PHASE_END
            PHASE_BEGIN_G(7) gla_passC(C, WSP(bf16_t, OFF_H), WSP(bf16_t, OFF_Z), WSP(bf16_t, OFF_Z + (size_t)MT * 1024 * 2), WSP(bf16_t, OFF_ST), ARGF(A_gla_norm), WSP(bf16_t, OFF_MIX)); PHASE_END
        }
        PHASE_BEGIN_G(1) { pg8::EpiZ<false> e{(const void*)WSP(bf16_t, OFF_XB), WSP(bf16_t, OFF_Z), ALPHA, 1.0f}; GEMM_CALL(pg8::EpiZ<false>, WSP(bf16_t, OFF_MIX), WSP(bf16_t, (L == 0 ? OFF_WOAB : OFF_WOC)), DM, DM, e); } PHASE_END_ROWS
        PHASE_BEGIN_G(3) ln_phase<0>(C, WSP(bf16_t, OFF_Z), ARGF(A_ln_g) + (size_t)(3 * L + 1) * DM, ARGF(A_ln_b) + (size_t)(3 * L + 1) * DM, WSP(bf16_t, OFF_XB), nullptr, 0, 0, nullptr); PHASE_END_ROWS
        PHASE_BEGIN_G(1) { pg8::EpiSwiglu e{WSP(bf16_t, OFF_H), DFF}; GEMM_CALL(pg8::EpiSwiglu, WSP(bf16_t, OFF_XB), WSP(bf16_t, OFF_WFI) + (size_t)(2 * L + 1) * NFF2 * DM, NFF2, DM, e); } PHASE_END_ROWS
        PHASE_BEGIN_G(1) { pg8::EpiZ<false> e{(const void*)WSP(bf16_t, OFF_XB), WSP(bf16_t, OFF_Z), ALPHA, 0.5f}; GEMM_CALL(pg8::EpiZ<false>, WSP(bf16_t, OFF_H), WSP(bf16_t, OFF_WFO) + (size_t)(2 * L + 1) * DM * DFF, DM, DFF, e); } PHASE_END_ROWS
        PHASE_BEGIN_G(3) ln_phase<0>(C, WSP(bf16_t, OFF_Z), ARGF(A_ln_g) + (size_t)(3 * L + 2) * DM, ARGF(A_ln_b) + (size_t)(3 * L + 2) * DM, WSP(bf16_t, OFF_XB), nullptr, 0, 0, nullptr); PHASE_END_ROWS
        PHASE_BEGIN { pg8::EpiPle e{WSP(const bf16_t, OFF_XB), WSP(const bf16_t, OFF_XF) + (size_t)L * MT * DM, (L == 1) ? (float*)ldarg(C.lds, A_out) : (float*)nullptr, (L == 1) ? (bf16_t*)nullptr : WSP(bf16_t, OFF_MIX)}; GEMM_CALL(pg8::EpiPle, WSP(bf16_t, OFF_XB), WSP(bf16_t, OFF_WPG) + (size_t)L * DM * DM, DM, DM, e); } PHASE_END_NONE
        }
}

extern "C" void kernel_launch(void* const* d_in, const int* in_sizes, int n_in, void* d_out, int out_size, void* d_ws, size_t ws_size, hipStream_t stream) {
    static int grid = 0;
    if (grid == 0) {
        int dev = 0, cus = 0, per_cu = 0;
        (void)hipGetDevice(&dev); (void)hipDeviceGetAttribute(&cus, hipDeviceAttributeMultiprocessorCount, dev);
        (void)hipFuncSetAttribute((const void*)mega_fwd, hipFuncAttributeMaxDynamicSharedMemorySize, LDS_BYTES);
        (void)hipOccupancyMaxActiveBlocksPerMultiprocessor(&per_cu, (const void*)mega_fwd, 512, LDS_BYTES);
        if (per_cu < 1) per_cu = 1;
        if (cus < 8) cus = 256;
        grid = cus * per_cu;
        if (ws_size < WS_NEED || n_in != 26) { fprintf(stderr, "kernel_launch: ws %zu < %zu or n_in %d != 26\n", ws_size, (size_t)WS_NEED, n_in); }
        (void)hipGetLastError();
    }
    Args a{};
    const float** fp = (const float**)&a;
    for (int i = 0; i < 26; ++i) fp[i] = (const float*)d_in[i];
    a.out = (float*)d_out; a.ws = (unsigned char*)d_ws; a.ph_lo = 0; a.ph_hi = 1000;
    void* args[] = {&a};
    hipError_t e = hipLaunchCooperativeKernel((const void*)mega_fwd, dim3(grid), dim3(512), args, LDS_BYTES, stream);
    if (e != hipSuccess) fprintf(stderr, "cooperative launch failed: %s (grid %d)\n", hipGetErrorString(e), grid);
}
```

```cpp
#include <hip/hip_runtime.h>
#include <hip/hip_cooperative_groups.h>
#include <cstdio>
#include <cstdint>
namespace cg = cooperative_groups;
namespace pg8 {
#define PG8_LAS __attribute__((address_space(3)))
typedef unsigned short bf16_t;
typedef short bf16x8 __attribute__((ext_vector_type(8)));
typedef float f32x4 __attribute__((ext_vector_type(4)));
typedef unsigned u32x4 __attribute__((ext_vector_type(4)));
constexpr int BM = 256, BK = 64, HALF = 128, HTB = HALF * BK * 2  , STAGE_BYTES = 8 * HTB, NXCD = 8, WGM = 8;

__host__ __device__ __forceinline__ int lds_byte(int r, int c) { const int st = (r >> 4) * 2 + (c >> 5), rr = r & 15, cc = c & 31, ob = rr * 64 + cc * 2; return st * 1024 + (ob ^ (((ob >> 9) & 1) << 5)); }
__host__ __device__ __forceinline__ void stage_rc(int b, int& R, int& C) { const int st = b / 1024, sb = b % 1024, swz = sb ^ (((sb >> 9) & 1) << 5); R = (st >> 1) * 16 + swz / 64; C = (st & 1) * 32 + (swz % 64) / 2; }
__host__ __device__ __forceinline__ int perm32(int rho) { const int n = rho >> 4, i = rho & 15; return 8 * (i >> 2) + 4 * n + (i & 3); }

struct Unit { int pm, pn; };
struct Gemm { const bf16_t* A; const bf16_t* Bt; int M, N, K; };

struct StaticOrder {
    int nM, nN, nwg, G, c;
    __host__ __device__ void init(int M, int N, int G_, int c_) { nM = M / BM; nN = N / BM; nwg = nM * nN; G = G_; c = c_; }
    __host__ __device__ bool next(int i, Unit& u) const {
        const long L = (long)i * G + c; if (L >= nwg) return false;
        int wgid = (int)L; { const int q = nwg / NXCD, r = nwg % NXCD, xcd = wgid % NXCD, off = wgid / NXCD; wgid = (xcd < r ? xcd * (q + 1) : r * (q + 1) + (xcd - r) * q) + off; }
        const int nig = WGM * nN, gid = wgid / nig, fm = gid * WGM, gsz = (nM - fm) < WGM ? (nM - fm) : WGM;
        u.pm = fm + ((wgid % nig) % gsz); u.pn = (wgid % nig) / gsz; return true;
    }
    __device__ __forceinline__ void a_ready(const Unit&) const {}
    __device__ __forceinline__ void done(const Unit&) const {}
};

__device__ __forceinline__ unsigned cvt_pk_bf16(float lo, float hi) { unsigned r; asm volatile("v_cvt_pk_bf16_f32 %0, %1, %2" : "=v"(r) : "v"(lo), "v"(hi)); return r; }
typedef float f32x2 __attribute__((ext_vector_type(2)));
template <class Epi, class Sched, bool ALIGN_EPI = false, bool SP2 = false>
__device__ __forceinline__ void gemm_phase(PG8_LAS unsigned char* lds, const Gemm g, const Sched& S, const Epi& E, const int tid_in) {
    const int tid = tid_in, wid = __builtin_amdgcn_readfirstlane(tid >> 6), lane = tid & 63, wr = wid >> 2, wc = wid & 3, fr = lane & 15, fq = lane >> 4;
    const int K = g.K, nt = K / BK;
    unsigned voffA[2], voffB[2];
#pragma unroll
    for (int i = 0; i < 2; ++i) { int R, C; stage_rc(tid * 16 + i * 8192, R, C); const int Rb = Epi::PERM ? ((R & ~31) + perm32(R & 31)) : R;
        voffA[i] = (unsigned)(R * K + C) * 2u; voffB[i] = (unsigned)(Rb * K + C) * 2u; }
    const size_t kstep = (size_t)(BK * 2);
    const size_t hstep = (size_t)HALF * K * 2;
    const size_t tstep = 2 * hstep;
    const unsigned ldsw = (unsigned)wid * 1024u;
    const int aoff = lds_byte(wr * 64 + fr, fq * 8), boff = lds_byte(wc * 32 + fr, fq * 8);
#define PG8_SA(b, h) (((b) * 2 + (h)) * HTB)
#define PG8_SB(b, h) ((4 + (b) * 2 + (h)) * HTB)
#define PG8_STAGE(bufoff, gbase, voff) do { _Pragma("unroll") for (int _i = 0; _i < 2; ++_i) \
        __builtin_amdgcn_global_load_lds((const unsigned*)((const char*)(gbase) + (voff)[_i]), (PG8_LAS unsigned*)(lds + (bufoff) + ldsw + _i * 8192), 16, 0, 0); } while (0)
#define PG8_LDA(dst, b, h) do { _Pragma("unroll") for (int m = 0; m < 4; ++m) _Pragma("unroll") for (int k = 0; k < 2; ++k) dst[m][k] = *(const PG8_LAS bf16x8*)(lds + PG8_SA(b, h) + aoff + m * 2048 + k * 1024); } while (0)
#define PG8_LDB(dst, b, h) do { _Pragma("unroll") for (int n = 0; n < 2; ++n) _Pragma("unroll") for (int k = 0; k < 2; ++k) dst[n][k] = *(const PG8_LAS bf16x8*)(lds + PG8_SB(b, h) + boff + n * 2048 + k * 1024); } while (0)
#define PG8_MMA(ai, bj, At, Bt) do { __builtin_amdgcn_s_setprio(1); _Pragma("unroll") for (int m = 0; m < 4; ++m) _Pragma("unroll") for (int n = 0; n < 2; ++n) _Pragma("unroll") for (int k = 0; k < 2; ++k) \
        acc[ai][bj][m][n] = __builtin_amdgcn_mfma_f32_16x16x32_bf16(Bt[n][k], At[m][k], acc[ai][bj][m][n], 0, 0, 0); __builtin_amdgcn_s_setprio(0); } while (0)
#define PG8_WAIT_V(n) asm volatile("s_waitcnt vmcnt(" #n ")" ::: "memory")
#define PG8_WAIT_L(n) asm volatile("s_waitcnt lgkmcnt(" #n ")" ::: "memory")
#define PG8_BAR __builtin_amdgcn_s_barrier()
#define PG8_SCHED __builtin_amdgcn_sched_barrier(0)
    Unit cur, nxt; int ui = 0;
    if (!S.next(0, cur)) return;
    f32x4 acc[2][2][4][2];
#pragma unroll
    for (int a = 0; a < 2; ++a)
#pragma unroll
        for (int b = 0; b < 2; ++b)
#pragma unroll
            for (int m = 0; m < 4; ++m)
#pragma unroll
                for (int n = 0; n < 2; ++n) acc[a][b][m][n] = (f32x4){0.f, 0.f, 0.f, 0.f};
    bf16x8 At[4][2], B0[2][2], B1[2][2];
    const char* cA = (const char*)g.A + (size_t)cur.pm * tstep; const char* cB = (const char*)g.Bt + (size_t)cur.pn * tstep;
    S.a_ready(cur);
    if constexpr (SP2) {
        PG8_STAGE(PG8_SB(0, 0), cB, voffB); PG8_STAGE(PG8_SB(0, 1), cB + hstep, voffB); PG8_STAGE(PG8_SA(0, 0), cA, voffA); PG8_STAGE(PG8_SA(0, 1), cA + hstep, voffA);
        if (wr == 1) PG8_BAR;
        PG8_WAIT_V(2); PG8_BAR;
        PG8_STAGE(PG8_SB(1, 0), cB + kstep, voffB); PG8_STAGE(PG8_SA(1, 0), cA + kstep, voffA); PG8_STAGE(PG8_SB(1, 1), cB + hstep + kstep, voffB);
        PG8_WAIT_V(6); PG8_BAR;
    } else {
        PG8_STAGE(PG8_SB(0, 0), cB, voffB); PG8_STAGE(PG8_SA(0, 0), cA, voffA); PG8_STAGE(PG8_SB(0, 1), cB + hstep, voffB); PG8_STAGE(PG8_SA(0, 1), cA + hstep, voffA);
        if (wr == 1) PG8_BAR;
        PG8_WAIT_V(4); PG8_BAR;
        PG8_STAGE(PG8_SB(1, 0), cB + kstep, voffB); PG8_STAGE(PG8_SA(1, 0), cA + kstep, voffA); PG8_STAGE(PG8_SB(1, 1), cB + hstep + kstep, voffB);
        PG8_WAIT_V(6); PG8_BAR;
    }
    for (;;) {
        const bool has_next = S.next(ui + 1, nxt);
        const char* nA = has_next ? (const char*)g.A + (size_t)nxt.pm * tstep : cA; const char* nB = has_next ? (const char*)g.Bt + (size_t)nxt.pn * tstep : cB;
        for (int t = 0; t < nt; t += 2) {
            const bool last = (t == nt - 2);
            const char* a1 = cA + (size_t)(t + 1) * kstep;
            const char* a2 = last ? nA : cA + (size_t)(t + 2) * kstep; const char* b2 = last ? nB : cB + (size_t)(t + 2) * kstep;
            const char* a3 = a2 + kstep; const char* b3 = b2 + kstep;
            if (last && has_next) S.a_ready(nxt);
            if constexpr (SP2) {
            PG8_LDB(B0, 0, 0); PG8_LDB(B1, 0, 1); PG8_SCHED; PG8_LDA(At, 0, 0); PG8_STAGE(PG8_SA(1, 1), a1 + hstep, voffA);
            PG8_WAIT_V(8); PG8_WAIT_L(0); PG8_BAR; PG8_MMA(0, 0, At, B0); PG8_MMA(0, 1, At, B1); PG8_BAR; PG8_SCHED;
            PG8_LDA(At, 0, 1); PG8_STAGE(PG8_SB(0, 0), b2, voffB); PG8_STAGE(PG8_SB(0, 1), b2 + hstep, voffB); PG8_STAGE(PG8_SA(0, 0), a2, voffA);
            PG8_WAIT_V(8); PG8_WAIT_L(0); PG8_BAR; PG8_MMA(1, 0, At, B0); PG8_MMA(1, 1, At, B1); PG8_BAR; PG8_SCHED;
            PG8_LDB(B0, 1, 0); PG8_LDB(B1, 1, 1); PG8_SCHED; PG8_LDA(At, 1, 0); PG8_STAGE(PG8_SA(0, 1), a2 + hstep, voffA);
            PG8_WAIT_V(8); PG8_WAIT_L(0); PG8_BAR; PG8_MMA(0, 0, At, B0); PG8_MMA(0, 1, At, B1); PG8_BAR; PG8_SCHED;
            PG8_LDA(At, 1, 1); PG8_STAGE(PG8_SB(1, 0), b3, voffB); PG8_STAGE(PG8_SB(1, 1), b3 + hstep, voffB); PG8_STAGE(PG8_SA(1, 0), a3, voffA);
            PG8_WAIT_V(8); PG8_WAIT_L(0); PG8_BAR; PG8_MMA(1, 0, At, B0); PG8_MMA(1, 1, At, B1); PG8_BAR; PG8_SCHED;
            } else {
            PG8_LDB(B0, 0, 0); PG8_SCHED; PG8_LDA(At, 0, 0); PG8_STAGE(PG8_SA(1, 1), a1 + hstep, voffA);
            PG8_WAIT_L(8); PG8_BAR; PG8_WAIT_L(0); PG8_MMA(0, 0, At, B0); PG8_BAR; PG8_SCHED;
            PG8_LDB(B1, 0, 1); PG8_STAGE(PG8_SB(0, 0), b2, voffB);
            PG8_BAR; PG8_WAIT_L(0); PG8_MMA(0, 1, At, B1); PG8_BAR;
            PG8_LDA(At, 0, 1); PG8_STAGE(PG8_SA(0, 0), a2, voffA);
            PG8_BAR; PG8_WAIT_L(0); PG8_MMA(1, 0, At, B0); PG8_BAR; PG8_SCHED;
            PG8_STAGE(PG8_SB(0, 1), b2 + hstep, voffB);
            PG8_WAIT_V(6); PG8_BAR; PG8_MMA(1, 1, At, B1); PG8_BAR;
            PG8_LDB(B0, 1, 0); PG8_SCHED; PG8_LDA(At, 1, 0); PG8_STAGE(PG8_SA(0, 1), a2 + hstep, voffA);
            PG8_WAIT_L(8); PG8_BAR; PG8_WAIT_L(0); PG8_MMA(0, 0, At, B0); PG8_BAR; PG8_SCHED;
            PG8_LDB(B1, 1, 1); PG8_STAGE(PG8_SB(1, 0), b3, voffB);
            PG8_BAR; PG8_WAIT_L(0); PG8_MMA(0, 1, At, B1); PG8_BAR;
            PG8_LDA(At, 1, 1); PG8_STAGE(PG8_SA(1, 0), a3, voffA);
            PG8_BAR; PG8_WAIT_L(0); PG8_MMA(1, 0, At, B0); PG8_BAR; PG8_SCHED;
            PG8_STAGE(PG8_SB(1, 1), b3 + hstep, voffB);
            PG8_WAIT_V(6); PG8_BAR; PG8_MMA(1, 1, At, B1); PG8_BAR;
            }
        }
        if constexpr (ALIGN_EPI) { if (wr == 0) PG8_BAR; }
        if constexpr (!Epi::AFTER_DRAIN) { E(acc, cur, wr, wc, fr, fq); S.done(cur); }
        if (!has_next) break;
#pragma unroll
        for (int a = 0; a < 2; ++a)
#pragma unroll
            for (int b = 0; b < 2; ++b)
#pragma unroll
                for (int m = 0; m < 4; ++m)
#pragma unroll
                    for (int n = 0; n < 2; ++n) acc[a][b][m][n] = (f32x4){0.f, 0.f, 0.f, 0.f};
        cur = nxt; cA = nA; cB = nB; ++ui;
        if constexpr (ALIGN_EPI) { if (wr == 1) PG8_BAR; }
    }
    PG8_WAIT_V(0);
    if constexpr (!ALIGN_EPI) { if (wr == 0) PG8_BAR; }
    PG8_BAR;
    if constexpr (Epi::AFTER_DRAIN) { E.fused(acc, cur, wr, wc, fr, fq, lds, wid, lane); S.done(cur); }
#undef PG8_SA
#undef PG8_SB
#undef PG8_STAGE
#undef PG8_LDA
#undef PG8_LDB
#undef PG8_MMA
#undef PG8_WAIT_V
#undef PG8_WAIT_L
#undef PG8_BAR
#undef PG8_SCHED
}
}

namespace pg8 {
typedef unsigned u32x2 __attribute__((ext_vector_type(2)));
__device__ __forceinline__ float sigmoidf_(float v) { return __builtin_amdgcn_rcpf(1.0f + __expf(-v)); }

struct EpiSwiglu {
    static constexpr bool PERM = true, AFTER_DRAIN = false;
    bf16_t* H; int ldh;
    __device__ __forceinline__ void operator()(const f32x4 (&acc)[2][2][4][2], const Unit& u, int wr, int wc, int fr, int fq) const {
        const int row0 = u.pm * BM + wr * 64 + fr; const int col0 = u.pn * HALF + wc * 32 + 8 * fq;
#pragma unroll
        for (int ai = 0; ai < 2; ++ai)
#pragma unroll
            for (int m = 0; m < 4; ++m) {
                bf16_t* p = H + (size_t)(row0 + ai * HALF + m * 16) * ldh + col0;
                f32x4 h0, h1;
#pragma unroll
                for (int e = 0; e < 4; ++e) {
                    const float g0 = acc[ai][0][m][0][e], g1 = acc[ai][0][m][1][e];
                    h0[e] = g0 * sigmoidf_(g0) * acc[ai][1][m][0][e];
                    h1[e] = g1 * sigmoidf_(g1) * acc[ai][1][m][1][e];
                }
                u32x4 w; w.x = cvt_pk_bf16(h0[0], h0[1]); w.y = cvt_pk_bf16(h0[2], h0[3]); w.z = cvt_pk_bf16(h1[0], h1[1]); w.w = cvt_pk_bf16(h1[2], h1[3]);
                *(u32x4*)p = w;
            }
    }
};

template <bool RF32> struct EpiZ {
    static constexpr bool PERM = true, AFTER_DRAIN = false;
    const void* R; bf16_t* Z; float alpha, s;
    __device__ __forceinline__ void operator()(const f32x4 (&acc)[2][2][4][2], const Unit& u, int wr, int wc, int fr, int fq) const {
        const int row0 = u.pm * BM + wr * 64 + fr; const int col0 = u.pn * BM + wc * 32 + 8 * fq;
#pragma unroll
        for (int ai = 0; ai < 2; ++ai)
#pragma unroll
            for (int m = 0; m < 4; ++m) {
                const size_t off = (size_t)(row0 + ai * HALF + m * 16) * 2048 + col0;
#pragma unroll
                for (int bj = 0; bj < 2; ++bj) {
                    f32x4 r0, r1;
                    if (RF32) { r0 = *(const f32x4*)((const float*)R + off + bj * HALF); r1 = *(const f32x4*)((const float*)R + off + bj * HALF + 4); }
                    else { const u32x4 rb = *(const u32x4*)((const bf16_t*)R + off + bj * HALF);
                        r0[0] = __uint_as_float(rb.x << 16); r0[1] = __uint_as_float(rb.x & 0xffff0000u); r0[2] = __uint_as_float(rb.y << 16); r0[3] = __uint_as_float(rb.y & 0xffff0000u);
                        r1[0] = __uint_as_float(rb.z << 16); r1[1] = __uint_as_float(rb.z & 0xffff0000u); r1[2] = __uint_as_float(rb.w << 16); r1[3] = __uint_as_float(rb.w & 0xffff0000u); }
                    const f32x4 z0 = r0 * alpha + acc[ai][bj][m][0] * s, z1 = r1 * alpha + acc[ai][bj][m][1] * s;
                    u32x4 w; w.x = cvt_pk_bf16(z0[0], z0[1]); w.y = cvt_pk_bf16(z0[2], z0[3]); w.z = cvt_pk_bf16(z1[0], z1[1]); w.w = cvt_pk_bf16(z1[2], z1[3]);
                    *(u32x4*)(Z + off + bj * HALF) = w;
                }
            }
    }
};

struct EpiStore {
    static constexpr bool PERM = true, AFTER_DRAIN = false;
    bf16_t* O; int ldc; int ncols; float* GT;
    __device__ __forceinline__ void operator()(const f32x4 (&acc)[2][2][4][2], const Unit& u, int wr, int wc, int fr, int fq) const {
        const int row0 = u.pm * BM + wr * 64 + fr; const int colt = u.pn * BM;
        if (colt < ncols) {
            const int col0 = colt + wc * 32 + 8 * fq;
#pragma unroll
            for (int ai = 0; ai < 2; ++ai)
#pragma unroll
                for (int m = 0; m < 4; ++m) {
                    bf16_t* rowp = O + (size_t)(row0 + ai * HALF + m * 16) * ldc + col0;
#pragma unroll
                    for (int bj = 0; bj < 2; ++bj) {
                        const f32x4 v0 = acc[ai][bj][m][0], v1 = acc[ai][bj][m][1];
                        u32x4 w; w.x = cvt_pk_bf16(v0[0], v0[1]); w.y = cvt_pk_bf16(v0[2], v0[3]); w.z = cvt_pk_bf16(v1[0], v1[1]); w.w = cvt_pk_bf16(v1[2], v1[3]);
                        *(u32x4*)(rowp + bj * HALF) = w;
                    }
                }
        } else if (GT != nullptr && wc == 0 && fq < 2) {
#pragma unroll
            for (int ai = 0; ai < 2; ++ai)
#pragma unroll
                for (int m = 0; m < 4; ++m) {
                    float* g = GT + (size_t)(row0 + ai * HALF + m * 16) * 16 + 8 * fq;
                    *(f32x4*)(g) = acc[ai][0][m][0];
                    *(f32x4*)(g + 4) = acc[ai][0][m][1];
                }
        }
    }
};

struct EpiPle {
    static constexpr bool PERM = true, AFTER_DRAIN = false;
    const bf16_t* X; const bf16_t* E; float* OUTF; bf16_t* XBO;
    __device__ __forceinline__ void operator()(const f32x4 (&acc)[2][2][4][2], const Unit& u, int wr, int wc, int fr, int fq) const {
        const int row0 = u.pm * BM + wr * 64 + fr; const int col0 = u.pn * BM + wc * 32 + 8 * fq;
#pragma unroll
        for (int ai = 0; ai < 2; ++ai)
#pragma unroll
            for (int m = 0; m < 4; ++m) {
                const size_t off = (size_t)(row0 + ai * HALF + m * 16) * 2048 + col0;
#pragma unroll
                for (int bj = 0; bj < 2; ++bj) {
                    const size_t o2 = off + bj * HALF;
                    const u32x4 xb = *(const u32x4*)(X + o2), eb = *(const u32x4*)(E + o2);
                    const unsigned xw[4] = {xb.x, xb.y, xb.z, xb.w}, ew[4] = {eb.x, eb.y, eb.z, eb.w};
                    float o[8];
#pragma unroll
                    for (int q = 0; q < 4; ++q) {
                        const float a0 = acc[ai][bj][m][q >> 1][2 * (q & 1)], a1 = acc[ai][bj][m][q >> 1][2 * (q & 1) + 1];
                        o[2 * q] = __uint_as_float(xw[q] << 16) + __uint_as_float(ew[q] << 16) * sigmoidf_(a0);
                        o[2 * q + 1] = __uint_as_float(xw[q] & 0xffff0000u) + __uint_as_float(ew[q] & 0xffff0000u) * sigmoidf_(a1);
                    }
                    if (OUTF != nullptr) { *(f32x4*)(OUTF + o2) = (f32x4){o[0], o[1], o[2], o[3]}; *(f32x4*)(OUTF + o2 + 4) = (f32x4){o[4], o[5], o[6], o[7]}; }
                    if (XBO != nullptr) { u32x4 w; w.x = cvt_pk_bf16(o[0], o[1]); w.y = cvt_pk_bf16(o[2], o[3]); w.z = cvt_pk_bf16(o[4], o[5]); w.w = cvt_pk_bf16(o[6], o[7]); *(u32x4*)(XBO + o2) = w; }
                }
            }
    }
};
}

#define LAS __attribute__((address_space(3)))
using pg8::bf16_t; using pg8::bf16x8; using pg8::f32x4; using pg8::u32x4; using pg8::u32x2;
typedef short s16x4 __attribute__((ext_vector_type(4)));
typedef float f32x16 __attribute__((ext_vector_type(16)));
typedef short v4i16_t __attribute__((ext_vector_type(4)));

constexpr int MT = 16384, SEQ = 8192, DM = 2048, DFF = 5632, NFF2 = 11264, NIN = 6144, UW = 6144, PLE = 256;
constexpr int LDS_BYTES = 147456;
constexpr float ALPHA = 1.4142135623730951f;
constexpr float LOG2E = 1.4426950408889634f;

constexpr size_t SZ_WFI = (size_t)NFF2 * DM * 2, SZ_WFO = (size_t)DM * DFF * 2, SZ_WIN = (size_t)NIN * DM * 2, SZ_WSQ = (size_t)DM * DM * 2, SZ_WPP = (size_t)DM * PLE * 2;
constexpr size_t OFF_WFI = 0;
constexpr size_t OFF_WFO = OFF_WFI + 4 * SZ_WFI;
constexpr size_t OFF_WAB = OFF_WFO + 4 * SZ_WFO;
constexpr size_t OFF_WC = OFF_WAB + SZ_WIN;
constexpr size_t OFF_WOAB = OFF_WC + SZ_WIN;
constexpr size_t OFF_WOC = OFF_WOAB + SZ_WSQ;
constexpr size_t OFF_WPG = OFF_WOC + SZ_WSQ;
constexpr size_t OFF_WPP = OFF_WPG + 2 * SZ_WSQ;
constexpr size_t OFF_XF = OFF_WPP + 2 * SZ_WPP;
constexpr size_t OFF_XB = OFF_XF + (size_t)MT * DM * 4;
constexpr size_t OFF_Z = OFF_XB + (size_t)MT * DM * 2;
constexpr size_t OFF_H = OFF_Z + (size_t)MT * DM * 4;
constexpr size_t OFF_MIX = OFF_H + (size_t)MT * UW * 2;
constexpr size_t OFF_PB = OFF_MIX + (size_t)MT * DM * 2;
constexpr size_t OFF_GT = OFF_PB + (size_t)2 * MT * PLE * 2;
constexpr size_t OFF_QB = OFF_GT + (size_t)MT * 16 * 4;
constexpr size_t OFF_KB = OFF_QB + (size_t)MT * 512 * 2;
constexpr size_t OFF_BC = OFF_KB + (size_t)MT * 512 * 2;
constexpr size_t OFF_IP = OFF_BC + (size_t)MT * 4 * 4;
constexpr size_t OFF_MSC = OFF_IP + (size_t)MT * 4 * 4;
constexpr size_t OFF_NL = OFF_MSC + 3 * 1024 * 4;
constexpr size_t OFF_DC = OFF_NL + (size_t)8 * 128 * 128 * 4;
constexpr size_t OFF_ST = OFF_DC + (size_t)8 * 128 * 256 * 4;
constexpr size_t OFF_CTL = OFF_ST + (size_t)8 * 128 * 512 * 256 * 2;
constexpr size_t WS_NEED = OFF_CTL + 32768;

#define LDS_WAIT() asm volatile("s_waitcnt lgkmcnt(0)" ::: "memory")
__device__ __forceinline__ unsigned f2bf(float f) { unsigned u = __builtin_bit_cast(unsigned, f); return (u + 0x7fffu + ((u >> 16) & 1u)) >> 16; }
__device__ __forceinline__ unsigned pk2(float lo, float hi) { return f2bf(lo) | (f2bf(hi) << 16); }
__device__ __forceinline__ float bf2f(unsigned h) { return __uint_as_float(h << 16); }
__device__ __forceinline__ float bflo(unsigned w) { return __uint_as_float(w << 16); }
__device__ __forceinline__ float bfhi(unsigned w) { return __uint_as_float(w & 0xffff0000u); }
__device__ __forceinline__ float wave_sum(float v) {
#pragma unroll
    for (int o = 1; o < 64; o <<= 1) v += __shfl_xor(v, o);
    return v;
}
__device__ __forceinline__ float logsigmoidf_(float x) { return fminf(x, 0.f) - __logf(1.f + __expf(-fabsf(x))); }
__device__ __forceinline__ s16x4 vtr(const LAS unsigned char* p) { return __builtin_bit_cast(s16x4, __builtin_amdgcn_ds_read_tr16_b64_v4i16((LAS v4i16_t*)p)); }
__device__ __forceinline__ bf16x8 tr8(const LAS unsigned char* p0, const LAS unsigned char* p1) {
    const s16x4 a = vtr(p0), b = vtr(p1); bf16x8 r; r[0] = a[0]; r[1] = a[1]; r[2] = a[2]; r[3] = a[3]; r[4] = b[0]; r[5] = b[1]; r[6] = b[2]; r[7] = b[3]; return r;
}
__device__ __forceinline__ f32x4 mfma16(bf16x8 a, bf16x8 b, f32x4 c) { return __builtin_amdgcn_mfma_f32_16x16x32_bf16(a, b, c, 0, 0, 0); }
__device__ __forceinline__ f32x16 mfma32(bf16x8 a, bf16x8 b, f32x16 c) { return __builtin_amdgcn_mfma_f32_32x32x16_bf16(a, b, c, 0, 0, 0); }
__device__ __forceinline__ bf16x8 ldsv8(const LAS unsigned char* p) { return *(const LAS bf16x8*)p; }

struct Ctx { LAS unsigned char* lds; int tid, lane, wave, G, bid, gw, NGW; };

__device__ __forceinline__ void tr_decode(int it, int nnb, int mode, int& k0, int& n0, int& drow0, float& scale) {
    const int kb = it / nnb, nb = it - kb * nnb; k0 = 64 * kb; n0 = 64 * nb; drow0 = n0; scale = 1.f;
    if (mode == 1) { const int half = n0 >= DFF ? 1 : 0; const int j0 = n0 - half * DFF; drow0 = 256 * (j0 >> 7) + 128 * half + (j0 & 127); }
    if (mode == 2 && n0 < 1024) scale = 0.125f;
}
__device__ __forceinline__ void tr_load(float (&r)[64], const float* __restrict__ W, int N, int k0, int n0, int lane) {
    const int n = n0 + lane; const bool ok = n < N; const float* src = W + (size_t)k0 * N + (ok ? n : 0);
#pragma unroll
    for (int i = 0; i < 64; ++i) { const float v = src[(size_t)i * N]; r[i] = ok ? v : 0.f; }
}
__device__ __forceinline__ void conv_matrix(const Ctx& C, const float* W, int K, int N, int Npad, bf16_t* WT, int mode, int& base) {
    LAS float* scr = (LAS float*)(C.lds + C.wave * 16640);
    const int nnb = Npad / 64, nitems = (K / 64) * nnb, lane = C.lane;
    int first = (C.gw - base) % C.NGW; if (first < 0) first += C.NGW;
    float r[64]; int k0 = 0, n0 = 0, drow0 = 0; float scale = 1.f;
    int it = first;
    if (it < nitems) { tr_decode(it, nnb, mode, k0, n0, drow0, scale); tr_load(r, W, N, k0, n0, lane); }
    while (it < nitems) {
#pragma unroll
        for (int i = 0; i < 64; ++i) scr[i * 65 + lane] = r[i] * scale;
        const int ck0 = k0, cdrow0 = drow0;
        it += C.NGW;
        if (it < nitems) { tr_decode(it, nnb, mode, k0, n0, drow0, scale); tr_load(r, W, N, k0, n0, lane); }
        LDS_WAIT(); asm volatile("" ::: "memory");
        const int c = lane & 7;
#pragma unroll
        for (int j = 0; j < 8; ++j) { const int nn = (lane >> 3) + 8 * j; const LAS float* s = scr + (8 * c) * 65 + nn;
            u32x4 o; o.x = pk2(s[0 * 65], s[1 * 65]); o.y = pk2(s[2 * 65], s[3 * 65]); o.z = pk2(s[4 * 65], s[5 * 65]); o.w = pk2(s[6 * 65], s[7 * 65]);
            *(u32x4*)(WT + (size_t)(cdrow0 + nn) * K + ck0 + 8 * c) = o; }
        LDS_WAIT(); asm volatile("" ::: "memory");
    }
    base = (base + nitems) % C.NGW;
}
__device__ __forceinline__ void cvt_rows(const Ctx& C, const float* src, bf16_t* dst, size_t n4) {
    const size_t stride = (size_t)C.G * 512;
    for (size_t i = (size_t)C.bid * 512 + C.tid; i < n4; i += 4 * stride) {
        f32x4 v[4];
#pragma unroll
        for (int j = 0; j < 4; ++j) if (i + j * stride < n4) v[j] = *(const f32x4*)(src + 4 * (i + j * stride));
#pragma unroll
        for (int j = 0; j < 4; ++j) if (i + j * stride < n4) { u32x2 w; w.x = pk2(v[j][0], v[j][1]); w.y = pk2(v[j][2], v[j][3]); *(u32x2*)(dst + 4 * (i + j * stride)) = w; }
    }
}

template <int NG>
__device__ __forceinline__ void ln_phase(const Ctx& C, const bf16_t* Z, const float* g, const float* b, bf16_t* XB, const float* Wsrc, int ldw, int ngate, float* GT) {
    constexpr bool GATES = NG > 0;
    LAS float* WG = (LAS float*)C.lds;
    if (GATES) {
        for (int col = C.tid; col < DM; col += 512) {
            const float* src = Wsrc + (size_t)col * ldw + 6144;
#pragma unroll
            for (int gi = 0; gi < (NG > 0 ? NG : 1); ++gi) WG[gi * DM + col] = (gi < ngate) ? src[gi] : 0.f;
        }
        __syncthreads();
    }
    f32x4 gv[8], bv[8];
#pragma unroll
    for (int j = 0; j < 4; ++j) { gv[2 * j] = *(const f32x4*)(g + 512 * j + 8 * C.lane); gv[2 * j + 1] = *(const f32x4*)(g + 512 * j + 8 * C.lane + 4);
                                  bv[2 * j] = *(const f32x4*)(b + 512 * j + 8 * C.lane); bv[2 * j + 1] = *(const f32x4*)(b + 512 * j + 8 * C.lane + 4); }
    const bool grp = (C.G & 7) == 0; const int nwg_ = grp ? (C.G >> 3) * 8 : C.NGW; const int first_ = grp ? (C.bid >> 3) * 8 + C.wave : C.gw; const int base_ = grp ? 2048 * (C.bid & 7) : 0; const int lim_ = grp ? 2048 : MT;
    for (int lrow = first_; lrow < lim_; lrow += nwg_) {
        const int row = base_ + lrow;
        const bf16_t* z = Z + (size_t)row * DM + 8 * C.lane;
        u32x4 zb[4];
#pragma unroll
        for (int j = 0; j < 4; ++j) zb[j] = *(const u32x4*)(z + 512 * j);
        f32x4 v[8]; float s = 0.f;
#pragma unroll
        for (int j = 0; j < 4; ++j) { v[2 * j] = (f32x4){bflo(zb[j].x), bfhi(zb[j].x), bflo(zb[j].y), bfhi(zb[j].y)}; v[2 * j + 1] = (f32x4){bflo(zb[j].z), bfhi(zb[j].z), bflo(zb[j].w), bfhi(zb[j].w)}; }
#pragma unroll
        for (int j = 0; j < 8; ++j) s += (v[j][0] + v[j][1]) + (v[j][2] + v[j][3]);
        const float mean = wave_sum(s) * (1.f / DM); float s2 = 0.f;
#pragma unroll
        for (int j = 0; j < 8; ++j) { v[j] = v[j] - mean; s2 += (v[j][0] * v[j][0] + v[j][1] * v[j][1]) + (v[j][2] * v[j][2] + v[j][3] * v[j][3]); }
        const float rstd = __builtin_amdgcn_rsqf(wave_sum(s2) * (1.f / DM) + 1e-5f);
        bf16_t* bo = XB + (size_t)row * DM + 8 * C.lane;
#pragma unroll
        for (int j = 0; j < 4; ++j) { const f32x4 o0 = v[2 * j] * rstd * gv[2 * j] + bv[2 * j], o1 = v[2 * j + 1] * rstd * gv[2 * j + 1] + bv[2 * j + 1];
            u32x4 w; w.x = pg8::cvt_pk_bf16(o0[0], o0[1]); w.y = pg8::cvt_pk_bf16(o0[2], o0[3]); w.z = pg8::cvt_pk_bf16(o1[0], o1[1]); w.w = pg8::cvt_pk_bf16(o1[2], o1[3]); *(u32x4*)(bo + 512 * j) = w;
            if (GATES) { v[2 * j] = o0; v[2 * j + 1] = o1; } }
        if (GATES) {
            float mine = 0.f;
#pragma unroll 4
            for (int gi = 0; gi < (NG > 0 ? NG : 1); ++gi) {
                float s0 = 0.f, s1 = 0.f;
#pragma unroll
                for (int j = 0; j < 4; ++j) { const f32x4 w0 = *(const LAS f32x4*)(WG + gi * DM + 512 * j + 8 * C.lane), w1 = *(const LAS f32x4*)(WG + gi * DM + 512 * j + 8 * C.lane + 4);
                    s0 += (v[2 * j][0] * w0[0] + v[2 * j][1] * w0[1]) + (v[2 * j][2] * w0[2] + v[2 * j][3] * w0[3]);
                    s1 += (v[2 * j + 1][0] * w1[0] + v[2 * j + 1][1] * w1[1]) + (v[2 * j + 1][2] * w1[2] + v[2 * j + 1][3] * w1[3]); }
                const float tot = wave_sum(s0 + s1);
                mine = (C.lane == gi) ? tot : mine;
            }
            if (C.lane < NG) GT[(size_t)row * 16 + C.lane] = mine;
        }
    }
    if (GATES) __syncthreads();
}

__device__ __forceinline__ void m1_phase(const Ctx& C, const bf16_t* U, const float* GT, const float* conv_w, const float* conv_b, const float* b_i, const float* b_f,
                                         bf16_t* QB, bf16_t* KB, float* BC, float* IP, float* MSC) {
    if (C.bid < 8) {
        LAS float* sb = (LAS float*)C.lds; LAS float* su = sb + 128;
        const int bh = C.bid, b = bh >> 2, h = bh & 3;
        {
            const float bi = b_i[h], bf = b_f[h]; const int ln = C.lane;
            float fv[16], iv[16];
#pragma unroll
            for (int k = 0; k < 16; ++k) { const size_t row = (size_t)b * SEQ + (C.wave * 16 + k) * 64 + ln; fv[k] = GT[row * 16 + 4 + h]; iv[k] = GT[row * 16 + h]; }
#pragma unroll
            for (int k = 0; k < 16; ++k) {
                const int c = C.wave * 16 + k; const size_t row = (size_t)b * SEQ + c * 64 + ln;
                float cum = logsigmoidf_(fv[k] + bf);
#pragma unroll
                for (int off = 1; off < 64; off <<= 1) { const float t = __shfl_up(cum, off); if (ln >= off) cum += t; }
                const float ip = iv[k] + bi;
                BC[row * 4 + h] = cum; IP[row * 4 + h] = ip;
                float um = ip - cum;
#pragma unroll
                for (int off = 1; off < 64; off <<= 1) um = fmaxf(um, __shfl_xor(um, off));
                const float bl = __shfl(cum, 63);
                if (ln == 0) { sb[c] = bl; su[c] = um; }
            }
        }
        __syncthreads();
        if (C.tid == 0) {
            float m = 0.f;
#pragma unroll 1
            for (int c = 0; c < 128; ++c) {
                const float bl = sb[c], mn = fmaxf(bl + m, bl + su[c]);
                MSC[bh * 128 + c] = m; MSC[1024 + bh * 128 + c] = mn; MSC[2048 + bh * 128 + c] = __expf(bl + m - mn); m = mn;
            }
        }
        __syncthreads();
    }
    {
        const int c0 = (int)(((size_t)C.bid * 512 + C.tid) & 127) * 8;
        f32x4 w0[4], w1[4];
#pragma unroll
        for (int j = 0; j < 4; ++j) { w0[j] = *(const f32x4*)(conv_w + j * 1024 + c0); w1[j] = *(const f32x4*)(conv_w + j * 1024 + c0 + 4); }
        const f32x4 cb0 = *(const f32x4*)(conv_b + c0), cb1 = *(const f32x4*)(conv_b + c0 + 4);
        const float sc = (c0 < 512) ? 0.08838834764831845f : 1.f;
        for (size_t i = (size_t)C.bid * 512 + C.tid; i < (size_t)MT * 128; i += (size_t)C.G * 512) {
            const int row = (int)(i >> 7), t = row & (SEQ - 1);
            float acc[8] = {cb0[0], cb0[1], cb0[2], cb0[3], cb1[0], cb1[1], cb1[2], cb1[3]};
#pragma unroll
            for (int j = 0; j < 4; ++j) {
                const int tt = t - 3 + j;
                if (tt >= 0) {
                    const u32x4 xv = *(const u32x4*)(U + (size_t)(row - 3 + j) * UW + 3072 + c0);
                    acc[0] += w0[j][0] * bflo(xv.x); acc[1] += w0[j][1] * bfhi(xv.x); acc[2] += w0[j][2] * bflo(xv.y); acc[3] += w0[j][3] * bfhi(xv.y);
                    acc[4] += w1[j][0] * bflo(xv.z); acc[5] += w1[j][1] * bfhi(xv.z); acc[6] += w1[j][2] * bflo(xv.w); acc[7] += w1[j][3] * bfhi(xv.w);
                }
            }
#pragma unroll
            for (int e = 0; e < 8; ++e) acc[e] = acc[e] * pg8::sigmoidf_(acc[e]) * sc;
            u32x4 w; w.x = pk2(acc[0], acc[1]); w.y = pk2(acc[2], acc[3]); w.z = pk2(acc[4], acc[5]); w.w = pk2(acc[6], acc[7]);
            if (c0 < 512) *(u32x4*)(QB + (size_t)row * 512 + c0) = w; else *(u32x4*)(KB + (size_t)row * 512 + c0 - 512) = w;
        }
    }
}

__device__ __forceinline__ void mlstm_passA(const Ctx& C, const bf16_t* U, const bf16_t* KB, const float* BC, const float* IP, const float* MSC, bf16_t* ST, float* NL) {
    LAS unsigned char* KW = C.lds; LAS unsigned char* V = C.lds + 17408; LAS float* wk = (LAS float*)(C.lds + 52224);
    const int l = C.lane, g = l >> 4, q = (l & 15) >> 2, p = l & 3, w = C.wave;
    for (int u = C.bid; u < 1024; u += C.G) {
        const int bh = u >> 7, c = u & 127, b = bh >> 2, h = bh & 3; const size_t row0 = (size_t)b * SEQ + c * 64;
        if (C.tid < 64) { const float bl = BC[(row0 + 63) * 4 + h], mn = MSC[1024 + bh * 128 + c]; wk[C.tid] = __expf(bl - BC[(row0 + C.tid) * 4 + h] + IP[(row0 + C.tid) * 4 + h] - mn); }
        __syncthreads();
        { const int s = C.tid >> 3, seg = C.tid & 7; const float ws = wk[s];
          const bf16_t* kp = KB + (row0 + s) * 512 + h * 128 + seg * 16;
#pragma unroll
          for (int i = 0; i < 2; ++i) { const u32x4 kv = *(const u32x4*)(kp + 8 * i); u32x4 o;
              o.x = pk2(bflo(kv.x) * ws, bfhi(kv.x) * ws); o.y = pk2(bflo(kv.y) * ws, bfhi(kv.y) * ws); o.z = pk2(bflo(kv.z) * ws, bfhi(kv.z) * ws); o.w = pk2(bflo(kv.w) * ws, bfhi(kv.w) * ws);
              *(LAS u32x4*)(KW + s * 272 + seg * 32 + 16 * i) = o; }
          const bf16_t* vp = U + (row0 + s) * UW + 4096 + h * 256 + seg * 32;
#pragma unroll
          for (int i = 0; i < 4; ++i) *(LAS u32x4*)(V + s * 544 + seg * 64 + 16 * i) = *(const u32x4*)(vp + 8 * i); }
        __syncthreads();
        f32x4 acc[2][8];
#pragma unroll
        for (int mi = 0; mi < 2; ++mi)
#pragma unroll
            for (int ni = 0; ni < 8; ++ni) acc[mi][ni] = (f32x4){0.f, 0.f, 0.f, 0.f};
#pragma unroll
        for (int ks = 0; ks < 2; ++ks) {
            const int r0 = 32 * ks + 8 * g + q;
            bf16x8 a[2];
#pragma unroll
            for (int mi = 0; mi < 2; ++mi) { const LAS unsigned char* ap = V + r0 * 544 + (32 * w + 16 * mi + 4 * p) * 2; a[mi] = tr8(ap, ap + 4 * 544); }
#pragma unroll
            for (int ni = 0; ni < 8; ++ni) { const LAS unsigned char* bp = KW + r0 * 272 + (16 * ni + 4 * p) * 2; const bf16x8 bb = tr8(bp, bp + 4 * 272);
#pragma unroll
                for (int mi = 0; mi < 2; ++mi) acc[mi][ni] = mfma16(bb, a[mi], acc[mi][ni]); }
        }
        bf16_t* st = ST + ((size_t)(bh * 128 + c) << 15);
#pragma unroll
        for (int mi = 0; mi < 2; ++mi)
#pragma unroll
            for (int ni = 0; ni < 8; ++ni) { u32x2 wv; wv.x = pg8::cvt_pk_bf16(acc[mi][ni][0], acc[mi][ni][1]); wv.y = pg8::cvt_pk_bf16(acc[mi][ni][2], acc[mi][ni][3]);
                *(u32x2*)(st + (32 * w + 16 * mi + (l & 15)) * 128 + 16 * ni + 4 * g) = wv; }
        if (C.tid < 128) { float s = 0.f;
#pragma unroll 4
            for (int t = 0; t < 64; ++t) s += bf2f(*(const LAS unsigned short*)(KW + t * 272 + C.tid * 2)); NL[(size_t)(bh * 128 + c) * 128 + C.tid] = s; }
        __syncthreads();
    }
}

__device__ __forceinline__ void mlstm_scan(const Ctx& C, bf16_t* ST, float* NL, const float* MSC) {
    for (int e2 = C.bid * 512 + C.tid; e2 < 8 * 16384; e2 += C.G * 512) {
        const int bh = e2 >> 14, off = e2 & 16383; float c0 = 0.f, c1 = 0.f;
        unsigned* p = (unsigned*)(ST + ((size_t)(bh * 128) << 15)) + off;
#pragma unroll 1
        for (int cb = 0; cb < 128; cb += 8) {
            unsigned t[8]; float d[8];
#pragma unroll
            for (int i = 0; i < 8; ++i) { t[i] = p[(size_t)(cb + i) << 14]; d[i] = MSC[2048 + bh * 128 + cb + i]; }
#pragma unroll
            for (int i = 0; i < 8; ++i) { p[(size_t)(cb + i) << 14] = pk2(c0, c1); c0 = d[i] * c0 + bflo(t[i]); c1 = d[i] * c1 + bfhi(t[i]); }
        }
    }
    const int gt = C.bid * 512 + C.tid;
    if (gt < 1024) { const int bh = gt >> 7, dk = gt & 127; float n = 0.f;
#pragma unroll 2
        for (int c = 0; c < 128; ++c) { float* p = NL + (size_t)(bh * 128 + c) * 128 + dk; const float t = *p; *p = n; n = MSC[2048 + bh * 128 + c] * n + t; } }
}

__device__ __forceinline__ void mlstm_passC(const Ctx& C, const bf16_t* U, const bf16_t* QB, const bf16_t* KB, const float* BC, const float* IP, const float* MSC,
                                            const bf16_t* ST, const float* NL, const float* mg, bf16_t* MIX) {
    LAS unsigned char* Q = C.lds; LAS unsigned char* K = C.lds + 17408; LAS unsigned char* V = C.lds + 34816; LAS unsigned char* SW = C.lds + 69632;
    LAS float* fu = (LAS float*)(C.lds + 78848); LAS float* fM = fu + 64; LAS float* fw = fu + 128; LAS float* fb = fu + 192; LAS float* finv = fu + 256; LAS float* fn = fu + 320; LAS float* fss = fu + 448;
    const int l = C.lane, g = l >> 4, q = (l & 15) >> 2, p = l & 3, w = C.wave, lr = l & 15;
    for (int u = C.bid; u < 1024; u += C.G) {
        const int bh = u >> 7, c = u & 127, b = bh >> 2, h = bh & 3; const size_t row0 = (size_t)b * SEQ + c * 64;
        const float mprev = MSC[bh * 128 + c];
        if (C.tid < 64) { const float bt = BC[(row0 + C.tid) * 4 + h]; fb[C.tid] = bt; fu[C.tid] = IP[(row0 + C.tid) * 4 + h] - bt; }
        if (C.tid >= 64 && C.tid < 192) fn[C.tid - 64] = NL[(size_t)(bh * 128 + c) * 128 + C.tid - 64];
        { const int s = C.tid >> 3, seg = C.tid & 7;
          const bf16_t* qp = QB + (row0 + s) * 512 + h * 128 + seg * 16; const bf16_t* kp = KB + (row0 + s) * 512 + h * 128 + seg * 16;
#pragma unroll
          for (int i = 0; i < 2; ++i) { *(LAS u32x4*)(Q + s * 272 + seg * 32 + 16 * i) = *(const u32x4*)(qp + 8 * i); *(LAS u32x4*)(K + s * 272 + seg * 32 + 16 * i) = *(const u32x4*)(kp + 8 * i); }
          const bf16_t* vp = U + (row0 + s) * UW + 4096 + h * 256 + seg * 32;
#pragma unroll
          for (int i = 0; i < 4; ++i) *(LAS u32x4*)(V + s * 544 + seg * 64 + 16 * i) = *(const u32x4*)(vp + 8 * i); }
        __syncthreads();
        if (C.tid < 64) { float pm = -3.0e38f;
#pragma unroll 1
            for (int s = 0; s <= C.tid; ++s) pm = fmaxf(pm, fu[s]); const float Mt = fmaxf(mprev, pm); fM[C.tid] = Mt; fw[C.tid] = __expf(mprev - Mt); }
        __syncthreads();
#pragma unroll
        for (int tt = 0; tt < 2; ++tt) {
            const int tile = 2 * w + tt, ti = tile >> 2, si = tile & 3;
            f32x4 s4 = (f32x4){0.f, 0.f, 0.f, 0.f};
            if (si <= ti) {
#pragma unroll
                for (int ks = 0; ks < 4; ++ks) { const bf16x8 a = ldsv8(Q + (16 * ti + lr) * 272 + (32 * ks + 8 * g) * 2), bb = ldsv8(K + (16 * si + lr) * 272 + (32 * ks + 8 * g) * 2); s4 = mfma16(a, bb, s4); }
            }
            const int sidx = 16 * si + lr; const float us = fu[sidx];
#pragma unroll
            for (int j = 0; j < 4; ++j) { const int t = 16 * ti + 4 * g + j; const float wgt = (sidx <= t) ? __expf(us - fM[t]) : 0.f;
                *(LAS unsigned short*)(SW + t * 144 + sidx * 2) = (unsigned short)f2bf(s4[j] * wgt); }
        }
        __syncthreads();
        if (C.tid < 64) { const int t = C.tid; float rs = 0.f, qn = 0.f;
#pragma unroll 4
            for (int s = 0; s < 64; ++s) rs += bf2f(*(const LAS unsigned short*)(SW + t * 144 + s * 2));
#pragma unroll 4
            for (int d = 0; d < 128; ++d) qn += bf2f(*(const LAS unsigned short*)(Q + t * 272 + d * 2)) * fn[d];
            const float den = fw[t] * qn + rs; finv[t] = __builtin_amdgcn_rcpf(fmaxf(fabsf(den), __expf(-(fb[t] + fM[t])))); }
        f32x4 acc[4][2];
#pragma unroll
        for (int mi = 0; mi < 4; ++mi)
#pragma unroll
            for (int ni = 0; ni < 2; ++ni) acc[mi][ni] = (f32x4){0.f, 0.f, 0.f, 0.f};
        const bf16_t* st = ST + ((size_t)(bh * 128 + c) << 15);
#pragma unroll
        for (int ks = 0; ks < 4; ++ks) {
            bf16x8 bb[2];
#pragma unroll
            for (int ni = 0; ni < 2; ++ni) bb[ni] = *(const bf16x8*)(st + (32 * w + 16 * ni + lr) * 128 + 32 * ks + 8 * g);
#pragma unroll
            for (int mi = 0; mi < 4; ++mi) { const bf16x8 a = ldsv8(Q + (16 * mi + lr) * 272 + (32 * ks + 8 * g) * 2);
#pragma unroll
                for (int ni = 0; ni < 2; ++ni) acc[mi][ni] = mfma16(bb[ni], a, acc[mi][ni]); }
        }
#pragma unroll
        for (int mi = 0; mi < 4; ++mi) { const float wi = fw[16 * mi + lr]; acc[mi][0] = acc[mi][0] * wi; acc[mi][1] = acc[mi][1] * wi; }
#pragma unroll
        for (int ks = 0; ks < 2; ++ks) {
            const int r0 = 32 * ks + 8 * g + q; bf16x8 bb[2];
#pragma unroll
            for (int ni = 0; ni < 2; ++ni) { const LAS unsigned char* bp = V + r0 * 544 + (32 * w + 16 * ni + 4 * p) * 2; bb[ni] = tr8(bp, bp + 4 * 544); }
#pragma unroll
            for (int mi = 0; mi < 4; ++mi) { const bf16x8 a = ldsv8(SW + (16 * mi + lr) * 144 + (32 * ks + 8 * g) * 2);
#pragma unroll
                for (int ni = 0; ni < 2; ++ni) acc[mi][ni] = mfma16(bb[ni], a, acc[mi][ni]); }
        }
        __syncthreads();
#pragma unroll
        for (int mi = 0; mi < 4; ++mi) { const float iv = finv[16 * mi + lr]; acc[mi][0] = acc[mi][0] * iv; acc[mi][1] = acc[mi][1] * iv;
            float ss = 0.f;
#pragma unroll
            for (int ni = 0; ni < 2; ++ni) ss += (acc[mi][ni][0] * acc[mi][ni][0] + acc[mi][ni][1] * acc[mi][ni][1]) + (acc[mi][ni][2] * acc[mi][ni][2] + acc[mi][ni][3] * acc[mi][ni][3]);
            ss += __shfl_xor(ss, 16); ss += __shfl_xor(ss, 32);
            if (g == 0) fss[w * 64 + 16 * mi + lr] = ss; }
        __syncthreads();
#pragma unroll
        for (int mi = 0; mi < 4; ++mi) { const int t = 16 * mi + lr; float tot = 0.f;
#pragma unroll
            for (int ww = 0; ww < 8; ++ww) tot += fss[ww * 64 + t];
            const float r = __builtin_amdgcn_rsqf(tot * (1.f / 256.f) + 1e-6f);
#pragma unroll
            for (int ni = 0; ni < 2; ++ni) { const int dv = 32 * w + 16 * ni + 4 * g;
                const u32x2 ogb = *(const u32x2*)(U + (row0 + t) * UW + 5120 + h * 256 + dv); const f32x4 gv = *(const f32x4*)(mg + h * 256 + dv);
                const float o0 = acc[mi][ni][0] * r * gv[0] * pg8::sigmoidf_(bflo(ogb.x)), o1 = acc[mi][ni][1] * r * gv[1] * pg8::sigmoidf_(bfhi(ogb.x));
                const float o2 = acc[mi][ni][2] * r * gv[2] * pg8::sigmoidf_(bflo(ogb.y)), o3 = acc[mi][ni][3] * r * gv[3] * pg8::sigmoidf_(bfhi(ogb.y));
                u32x2 wv; wv.x = pg8::cvt_pk_bf16(o0, o1); wv.y = pg8::cvt_pk_bf16(o2, o3);
                *(u32x2*)(MIX + (row0 + t) * DM + 1024 + h * 256 + dv) = wv; } }
        __syncthreads();
    }
}

__device__ __forceinline__ float gla_decay(const Ctx& C, const float* w_a2, const float* b_a, int h, LAS float* A1, LAS float* tot0, LAS unsigned char* QD, LAS unsigned char* KD) {
    const int ch = C.tid & 255, half = C.tid >> 8, t0 = 32 * half;
    float wv[16];
#pragma unroll
    for (int i = 0; i < 16; ++i) wv[i] = w_a2[i * 1024 + h * 256 + ch];
    const float ba = b_a[h * 256 + ch];
    float c[32]; float run = 0.f;
#pragma unroll
    for (int i = 0; i < 32; ++i) {
        const LAS float* ap = A1 + (t0 + i) * 16;
        const f32x4 a0 = *(const LAS f32x4*)(ap), a1 = *(const LAS f32x4*)(ap + 4), a2 = *(const LAS f32x4*)(ap + 8), a3 = *(const LAS f32x4*)(ap + 12);
        float z0 = ba, z1 = 0.f, z2 = 0.f, z3 = 0.f;
#pragma unroll
        for (int j = 0; j < 4; ++j) { z0 += a0[j] * wv[j]; z1 += a1[j] * wv[4 + j]; z2 += a2[j] * wv[8 + j]; z3 += a3[j] * wv[12 + j]; }
        const float z = (z0 + z1) + (z2 + z3);
        run += (fminf(z, 0.f) - __logf(1.f + __expf(-fabsf(z)))) * 0.0625f;
        c[i] = run;
    }
    if (half == 0) tot0[ch] = run;
    __syncthreads();
    const float off = half ? tot0[ch] : 0.f;
#pragma unroll
    for (int i = 0; i < 32; ++i) {
        const float cum = c[i] + off; const int t = t0 + i;
        LAS unsigned short* kp = (LAS unsigned short*)(KD + t * 528 + ch * 2); *kp = (unsigned short)f2bf(bf2f(*kp) * __expf(-cum));
        LAS unsigned short* qp = (LAS unsigned short*)(QD + t * 528 + ch * 2); *qp = (unsigned short)f2bf(bf2f(*qp) * __expf(cum) * 0.0625f);
    }
    return __expf(c[31] + off);
}

__device__ __forceinline__ void gla_passA(const Ctx& C, const bf16_t* U, const float* GT, const float* w_a2, const float* b_a, bf16_t* ST, float* DC, bf16_t* QDG, bf16_t* KDG) {
    LAS unsigned char* QD = C.lds; LAS unsigned char* KD = C.lds + 33792; LAS unsigned char* V = C.lds + 67584;
    LAS float* A1 = (LAS float*)(C.lds + 135168); LAS float* bl = (LAS float*)(C.lds + 139264); LAS float* tot0 = (LAS float*)(C.lds + 140288);
    const int l = C.lane, g = l >> 4, q = (l & 15) >> 2, p = l & 3, w = C.wave, lr = l & 15;
    for (int u = C.bid; u < 1024; u += C.G) {
        const int bh = u >> 7, c = u & 127, b = bh >> 2, h = bh & 3; const size_t row0 = (size_t)b * SEQ + c * 64;
        A1[C.tid] = GT[row0 * 16 + C.tid]; A1[C.tid + 512] = GT[row0 * 16 + C.tid + 512];
        { const int s = C.tid >> 3, seg = C.tid & 7; const bf16_t* vp = U + (row0 + s) * UW + 2048 + h * 512 + seg * 64;
#pragma unroll
          for (int i = 0; i < 8; ++i) *(LAS u32x4*)(V + s * 1056 + seg * 128 + 16 * i) = *(const u32x4*)(vp + 8 * i);
          const bf16_t* qp = U + (row0 + s) * UW + h * 256 + seg * 32;
#pragma unroll
          for (int i = 0; i < 4; ++i) { *(LAS u32x4*)(QD + s * 528 + seg * 64 + 16 * i) = *(const u32x4*)(qp + 8 * i); *(LAS u32x4*)(KD + s * 528 + seg * 64 + 16 * i) = *(const u32x4*)(qp + 1024 + 8 * i); } }
        __syncthreads();
        const float eb = gla_decay(C, w_a2, b_a, h, A1, tot0, QD, KD);
        if (C.tid >= 256) { bl[C.tid - 256] = eb; DC[(size_t)(bh * 128 + c) * 256 + C.tid - 256] = eb; }
        __syncthreads();
        { const int s = C.tid >> 3, seg = C.tid & 7; bf16_t* qg = QDG + (row0 + s) * 1024 + h * 256 + seg * 32; bf16_t* kg = KDG + (row0 + s) * 1024 + h * 256 + seg * 32;
#pragma unroll
          for (int i = 0; i < 4; ++i) { *(u32x4*)(qg + 8 * i) = *(const LAS u32x4*)(QD + s * 528 + seg * 64 + 16 * i); *(u32x4*)(kg + 8 * i) = *(const LAS u32x4*)(KD + s * 528 + seg * 64 + 16 * i); } }
#pragma unroll 1
        for (int dvq = 0; dvq < 4; ++dvq) {
            f32x4 acc[16];
#pragma unroll
            for (int ni = 0; ni < 16; ++ni) acc[ni] = (f32x4){0.f, 0.f, 0.f, 0.f};
#pragma unroll
            for (int ks = 0; ks < 2; ++ks) {
                const int r0 = 32 * ks + 8 * g + q;
                const LAS unsigned char* ap = V + r0 * 1056 + (dvq * 128 + 16 * w + 4 * p) * 2; const bf16x8 a = tr8(ap, ap + 4 * 1056);
#pragma unroll
                for (int ni = 0; ni < 16; ++ni) { const LAS unsigned char* bp = KD + r0 * 528 + (16 * ni + 4 * p) * 2; acc[ni] = mfma16(tr8(bp, bp + 4 * 528), a, acc[ni]); }
            }
            bf16_t* st = ST + ((size_t)(bh * 128 + c) << 17) + (size_t)(dvq * 128 + 16 * w + lr) * 256 + 4 * g;
#pragma unroll
            for (int ni = 0; ni < 16; ++ni) { const f32x4 e4 = *(const LAS f32x4*)(bl + 16 * ni + 4 * g); const f32x4 v4 = acc[ni] * e4;
                u32x2 wv; wv.x = pg8::cvt_pk_bf16(v4[0], v4[1]); wv.y = pg8::cvt_pk_bf16(v4[2], v4[3]); *(u32x2*)(st + 16 * ni) = wv; }
        }
        __syncthreads();
    }
}

__device__ __forceinline__ void gla_scan(const Ctx& C, bf16_t* ST, const float* DC) {
    for (int e8 = C.bid * 512 + C.tid; e8 < 8 * 16384; e8 += C.G * 512) {
        const int bh = e8 >> 14, off = e8 & 16383, dk = (off * 8) & 255;
        float s[8];
#pragma unroll
        for (int i = 0; i < 8; ++i) s[i] = 0.f;
        u32x4* p = (u32x4*)(ST + ((size_t)(bh * 128) << 17)) + off;
#pragma unroll 1
        for (int cb = 0; cb < 128; cb += 4) {
            u32x4 t[4]; f32x4 d0[4], d1[4];
#pragma unroll
            for (int i = 0; i < 4; ++i) { t[i] = p[(size_t)(cb + i) << 14]; const float* d = DC + (size_t)(bh * 128 + cb + i) * 256 + dk; d0[i] = *(const f32x4*)d; d1[i] = *(const f32x4*)(d + 4); }
#pragma unroll
            for (int i = 0; i < 4; ++i) {
                u32x4 o; o.x = pk2(s[0], s[1]); o.y = pk2(s[2], s[3]); o.z = pk2(s[4], s[5]); o.w = pk2(s[6], s[7]); p[(size_t)(cb + i) << 14] = o;
                s[0] = d0[i][0] * s[0] + bflo(t[i].x); s[1] = d0[i][1] * s[1] + bfhi(t[i].x); s[2] = d0[i][2] * s[2] + bflo(t[i].y); s[3] = d0[i][3] * s[3] + bfhi(t[i].y);
                s[4] = d1[i][0] * s[4] + bflo(t[i].z); s[5] = d1[i][1] * s[5] + bfhi(t[i].z); s[6] = d1[i][2] * s[6] + bflo(t[i].w); s[7] = d1[i][3] * s[7] + bfhi(t[i].w);
            }
        }
    }
}

__device__ __forceinline__ void gla_passC(const Ctx& C, const bf16_t* U, const bf16_t* QDG, const bf16_t* KDG, const bf16_t* ST, const float* gg, bf16_t* MIX) {
    LAS unsigned char* QD = C.lds; LAS unsigned char* KD = C.lds + 33792; LAS unsigned char* V = C.lds + 67584; LAS unsigned char* ATT = C.lds + 135168;
    LAS float* fss = (LAS float*)(C.lds + 144384);
    const int l = C.lane, g = l >> 4, q = (l & 15) >> 2, p = l & 3, w = C.wave, lr = l & 15;
    for (int u = C.bid; u < 1024; u += C.G) {
        const int bh = u >> 7, c = u & 127, b = bh >> 2, h = bh & 3; const size_t row0 = (size_t)b * SEQ + c * 64;
        { const int s = C.tid >> 3, seg = C.tid & 7; const bf16_t* vp = U + (row0 + s) * UW + 2048 + h * 512 + seg * 64;
#pragma unroll
          for (int i = 0; i < 8; ++i) *(LAS u32x4*)(V + s * 1056 + seg * 128 + 16 * i) = *(const u32x4*)(vp + 8 * i);
          const bf16_t* qg = QDG + (row0 + s) * 1024 + h * 256 + seg * 32; const bf16_t* kg = KDG + (row0 + s) * 1024 + h * 256 + seg * 32;
#pragma unroll
          for (int i = 0; i < 4; ++i) { *(LAS u32x4*)(QD + s * 528 + seg * 64 + 16 * i) = *(const u32x4*)(qg + 8 * i); *(LAS u32x4*)(KD + s * 528 + seg * 64 + 16 * i) = *(const u32x4*)(kg + 8 * i); } }
        __syncthreads();
#pragma unroll
        for (int tt = 0; tt < 2; ++tt) {
            const int tile = 2 * w + tt, ti = tile >> 2, si = tile & 3;
            f32x4 s4 = (f32x4){0.f, 0.f, 0.f, 0.f};
            if (si <= ti) {
#pragma unroll
                for (int ks = 0; ks < 8; ++ks) { const bf16x8 a = ldsv8(QD + (16 * ti + lr) * 528 + (32 * ks + 8 * g) * 2), bb = ldsv8(KD + (16 * si + lr) * 528 + (32 * ks + 8 * g) * 2); s4 = mfma16(a, bb, s4); }
            }
            const int sidx = 16 * si + lr;
#pragma unroll
            for (int j = 0; j < 4; ++j) { const int t = 16 * ti + 4 * g + j; *(LAS unsigned short*)(ATT + t * 144 + sidx * 2) = (unsigned short)f2bf((sidx <= t) ? s4[j] : 0.f); }
        }
        __syncthreads();
        f32x4 acc[4][4];
#pragma unroll
        for (int mi = 0; mi < 4; ++mi)
#pragma unroll
            for (int ni = 0; ni < 4; ++ni) acc[mi][ni] = (f32x4){0.f, 0.f, 0.f, 0.f};
        const bf16_t* st = ST + ((size_t)(bh * 128 + c) << 17);
#pragma unroll 4
        for (int ks = 0; ks < 8; ++ks) {
            bf16x8 bb[4];
#pragma unroll
            for (int ni = 0; ni < 4; ++ni) bb[ni] = *(const bf16x8*)(st + (size_t)(64 * w + 16 * ni + lr) * 256 + 32 * ks + 8 * g);
#pragma unroll
            for (int mi = 0; mi < 4; ++mi) { const bf16x8 a = ldsv8(QD + (16 * mi + lr) * 528 + (32 * ks + 8 * g) * 2);
#pragma unroll
                for (int ni = 0; ni < 4; ++ni) acc[mi][ni] = mfma16(bb[ni], a, acc[mi][ni]); }
        }
#pragma unroll
        for (int ks = 0; ks < 2; ++ks) {
            const int r0 = 32 * ks + 8 * g + q; bf16x8 bb[4];
#pragma unroll
            for (int ni = 0; ni < 4; ++ni) { const LAS unsigned char* bp = V + r0 * 1056 + (64 * w + 16 * ni + 4 * p) * 2; bb[ni] = tr8(bp, bp + 4 * 1056); }
#pragma unroll
            for (int mi = 0; mi < 4; ++mi) { const bf16x8 a = ldsv8(ATT + (16 * mi + lr) * 144 + (32 * ks + 8 * g) * 2);
#pragma unroll
                for (int ni = 0; ni < 4; ++ni) acc[mi][ni] = mfma16(bb[ni], a, acc[mi][ni]); }
        }
#pragma unroll
        for (int mi = 0; mi < 4; ++mi) { float ss = 0.f;
#pragma unroll
            for (int ni = 0; ni < 4; ++ni) ss += (acc[mi][ni][0] * acc[mi][ni][0] + acc[mi][ni][1] * acc[mi][ni][1]) + (acc[mi][ni][2] * acc[mi][ni][2] + acc[mi][ni][3] * acc[mi][ni][3]);
            ss += __shfl_xor(ss, 16); ss += __shfl_xor(ss, 32);
            if (g == 0) fss[w * 64 + 16 * mi + lr] = ss; }
        __syncthreads();
#pragma unroll
        for (int mi = 0; mi < 4; ++mi) { const int t = 16 * mi + lr; float tot = 0.f;
#pragma unroll
            for (int ww = 0; ww < 8; ++ww) tot += fss[ww * 64 + t];
            const float r = __builtin_amdgcn_rsqf(tot * (1.f / 512.f) + 1e-6f);
#pragma unroll
            for (int ni = 0; ni < 4; ++ni) { const int dv = 64 * w + 16 * ni + 4 * g;
                const u32x2 rgb = *(const u32x2*)(U + (row0 + t) * UW + 4096 + h * 512 + dv); const f32x4 gv = *(const f32x4*)(gg + h * 512 + dv);
                const float r0 = bflo(rgb.x), r1 = bfhi(rgb.x), r2 = bflo(rgb.y), r3 = bfhi(rgb.y);
                const float o0 = acc[mi][ni][0] * r * gv[0] * r0 * pg8::sigmoidf_(r0), o1 = acc[mi][ni][1] * r * gv[1] * r1 * pg8::sigmoidf_(r1);
                const float o2 = acc[mi][ni][2] * r * gv[2] * r2 * pg8::sigmoidf_(r2), o3 = acc[mi][ni][3] * r * gv[3] * r3 * pg8::sigmoidf_(r3);
                u32x2 wv; wv.x = pg8::cvt_pk_bf16(o0, o1); wv.y = pg8::cvt_pk_bf16(o2, o3);
                *(u32x2*)(MIX + (row0 + t) * DM + h * 512 + dv) = wv; } }
        __syncthreads();
    }
}

__device__ __forceinline__ int crow(int r, int hi) { return (r & 3) + 8 * (r >> 2) + 4 * hi; }
__device__ __forceinline__ void attn_unit(const Ctx& C, const bf16_t* U, const float* rel_bias, const float* dg, float lam, int b, int h, int qb, bf16_t* MIX) {
    LAS unsigned char* KT0 = C.lds; LAS unsigned char* VT0 = C.lds + 2 * 17408; LAS float* tab = (LAS float*)(C.lds + 131072); LAS float* OX = (LAS float*)(C.lds);
    constexpr int KS = 272, VS = 320;
    const int l = C.lane, ql = l & 31, hi = l >> 5, g = l >> 4, qq = (l & 15) >> 2, pp = l & 3, w = C.wave, comp = w >> 2, rw = w & 3;
    const int qpos = qb * 128 + 32 * rw + ql;
    const size_t rowq = (size_t)b * SEQ + qpos;
    __syncthreads();
    if (C.tid < 128) { const int n = C.tid; int bk;
        if (n < 16) bk = n; else { bk = 16 + (int)(__logf((float)n * 0.0625f) / 2.0794415416798357f * 16.f); bk = bk < 31 ? bk : 31; }
        tab[n] = rel_bias[bk * 8 + h] * LOG2E; }
    const float b31 = rel_bias[31 * 8 + h] * LOG2E;
    LAS unsigned char* QT = C.lds + 96256;
    { const int row = C.tid >> 2, part = C.tid & 3; const bf16_t* qsrc = U + ((size_t)b * SEQ + qb * 128 + row) * UW + h * 128 + part * 32;
#pragma unroll
      for (int i = 0; i < 4; ++i) *(LAS u32x4*)(QT + row * 272 + part * 64 + 16 * i) = *(const u32x4*)(qsrc + 8 * i); }
    const LAS unsigned char* qfrag = QT + (32 * rw + ql) * 272 + (comp * 64 + 8 * hi) * 2;
    f32x16 o[4];
#pragma unroll
    for (int mb = 0; mb < 4; ++mb)
#pragma unroll
        for (int r = 0; r < 16; ++r) o[mb][r] = 0.f;
    float mrun = -1.0e30f, lrun = 0.f;
    u32x4 kreg[2], vreg[2];
    const bf16_t* srcb = U + ((size_t)b * SEQ + (C.tid >> 4)) * UW + h * 128 + (C.tid & 15) * 8;
    const int ntiles = 2 * (qb + 1);
#pragma unroll
    for (int i = 0; i < 2; ++i) { kreg[i] = *(const u32x4*)(srcb + (size_t)(32 * i) * UW + 1024); vreg[i] = *(const u32x4*)(srcb + (size_t)(32 * i) * UW + 2048); }
#pragma unroll
    for (int i = 0; i < 2; ++i) { const int key = (C.tid >> 4) + 32 * i, seg = C.tid & 15;
        *(LAS u32x4*)(KT0 + key * KS + seg * 16) = kreg[i]; *(LAS u32x4*)(VT0 + key * VS + seg * 16) = vreg[i]; }
#pragma unroll
    for (int i = 0; i < 2; ++i) { kreg[i] = *(const u32x4*)(srcb + (size_t)(64 + 32 * i) * UW + 1024); vreg[i] = *(const u32x4*)(srcb + (size_t)(64 + 32 * i) * UW + 2048); }
    int vs_cur = 0, vs_prev = 0; const bool rot = comp == 1;
    bf16x8 pb[4];
#pragma unroll
    for (int i = 0; i < 4; ++i) pb[i] = (bf16x8){0, 0, 0, 0, 0, 0, 0, 0};
#define ATT_PV(VSLOT) do { const LAS unsigned char* vb_ = VT0 + (VSLOT) * 20480 + (4 * hi + qq) * VS + (16 * (g & 1) + 4 * pp) * 2; _Pragma("unroll") for (int k2 = 0; k2 < 2; ++k2) _Pragma("unroll") for (int ks = 0; ks < 2; ++ks) { \
        bf16x8 af_[4]; _Pragma("unroll") for (int mb = 0; mb < 4; ++mb) { const LAS unsigned char* ap = vb_ + (32 * k2 + 16 * ks) * VS + 64 * mb; af_[mb] = tr8(ap, ap + 8 * VS); } \
        __builtin_amdgcn_sched_barrier(0); \
        _Pragma("unroll") for (int mb = 0; mb < 4; ++mb) o[mb] = mfma32(af_[mb], pb[2 * k2 + ks], o[mb]); } } while (0)
    for (int kt = 0; kt < ntiles; ++kt) {
        const int kb = kt * 64;
        __syncthreads();
        LAS unsigned char* KT = KT0 + (kt & 1) * 17408; LAS unsigned char* VT = VT0 + vs_cur * 20480;
        const int vs_nxt = vs_cur == 2 ? 0 : vs_cur + 1;
        if (kt + 1 < ntiles) {
            LAS unsigned char* KN = KT0 + ((kt + 1) & 1) * 17408; LAS unsigned char* VN = VT0 + vs_nxt * 20480;
#pragma unroll
            for (int i = 0; i < 2; ++i) { const int key = (C.tid >> 4) + 32 * i, seg = C.tid & 15;
                *(LAS u32x4*)(KN + key * KS + seg * 16) = kreg[i]; *(LAS u32x4*)(VN + key * VS + seg * 16) = vreg[i]; }
            if (kt + 2 < ntiles) {
#pragma unroll
                for (int i = 0; i < 2; ++i) { kreg[i] = *(const u32x4*)(srcb + (size_t)(kb + 128 + 32 * i) * UW + 1024); vreg[i] = *(const u32x4*)(srcb + (size_t)(kb + 128 + 32 * i) * UW + 2048); }
            }
        }
        if (rot && kt > 0) ATT_PV(vs_prev);
        __builtin_amdgcn_sched_barrier(0);
        f32x16 st[2];
#pragma unroll
        for (int k2 = 0; k2 < 2; ++k2) {
#pragma unroll
            for (int r = 0; r < 16; ++r) st[k2][r] = 0.f;
#pragma unroll
            for (int kk = 0; kk < 4; ++kk) st[k2] = mfma32(ldsv8(KT + (32 * k2 + ql) * KS + (comp * 64 + 16 * kk + 8 * hi) * 2), ldsv8(qfrag + 32 * kk), st[k2]);
        }
        __builtin_amdgcn_sched_barrier(0);
        const bool far = (qb * 128 + 32 * rw - (kb + 63)) >= 127;
        float mx = -1.0e30f, cadd;
        if (far) {
#pragma unroll
            for (int k2 = 0; k2 < 2; ++k2)
#pragma unroll
                for (int r = 0; r < 16; r += 2) mx = fmaxf(fmaxf(st[k2][r], st[k2][r + 1]), mx);
            mx = mx * LOG2E + b31; cadd = b31;
        } else {
#pragma unroll
            for (int k2 = 0; k2 < 2; ++k2)
#pragma unroll
                for (int r = 0; r < 16; ++r) { const int rel = qpos - (kb + 32 * k2 + crow(r, hi)); const int ri = rel < 0 ? 0 : (rel > 127 ? 127 : rel);
                    const float t = st[k2][r] * LOG2E + tab[ri]; st[k2][r] = (rel >= 0 ? t : -1.0e30f) * (1.0f / LOG2E); mx = fmaxf(mx, rel >= 0 ? t : -1.0e30f); }
            cadd = 0.f;
        }
        mx = fmaxf(mx, __shfl_xor(mx, 32));
        const float mnew = fmaxf(mrun, mx), alpha = __builtin_amdgcn_exp2f(mrun - mnew);
        const bool grew = mnew > mrun; mrun = mnew;
        const float cst = cadd - mnew;
        float ps = 0.f;
#pragma unroll
        for (int k2 = 0; k2 < 2; ++k2)
#pragma unroll
            for (int r = 0; r < 16; ++r) { const float pv = __builtin_amdgcn_exp2f(__builtin_fmaf(st[k2][r], LOG2E, cst)); st[k2][r] = pv; ps += pv; }
        lrun = lrun * alpha + ps;
        if (__any(grew)) {
#pragma unroll
            for (int mb = 0; mb < 4; ++mb)
#pragma unroll
                for (int r = 0; r < 16; ++r) o[mb][r] *= alpha;
        }
        __builtin_amdgcn_sched_barrier(0);
#pragma unroll
        for (int k2 = 0; k2 < 2; ++k2)
#pragma unroll
            for (int ks = 0; ks < 2; ++ks) { const int r8 = 8 * ks;
                const unsigned w0 = pg8::cvt_pk_bf16(st[k2][r8 + 0], st[k2][r8 + 1]), w1 = pg8::cvt_pk_bf16(st[k2][r8 + 2], st[k2][r8 + 3]), w2 = pg8::cvt_pk_bf16(st[k2][r8 + 4], st[k2][r8 + 5]), w3 = pg8::cvt_pk_bf16(st[k2][r8 + 6], st[k2][r8 + 7]);
                const u32x4 wv = (u32x4){w0, w1, w2, w3}; pb[2 * k2 + ks] = __builtin_bit_cast(bf16x8, wv); }
        __builtin_amdgcn_sched_barrier(0);
        if (!rot) ATT_PV(vs_cur);
        vs_prev = vs_cur; vs_cur = vs_nxt;
    }
    if (rot) ATT_PV(vs_prev);
#undef ATT_PV
    const float ltot = lrun + __shfl_xor(lrun, 32), inv = __builtin_amdgcn_rcpf(ltot);
    int l2 = C.lane; asm volatile("" : "+v"(l2));
    const int ql_e = l2 & 31, hi_e = l2 >> 5;
    const size_t rowq_e = (size_t)b * SEQ + qb * 128 + 32 * rw + ql_e;
    __syncthreads();
    if (comp == 1) {
#pragma unroll
        for (int mb = 0; mb < 4; ++mb)
#pragma unroll
            for (int r = 0; r < 16; ++r) OX[(rw * 128 + 32 * mb + crow(r, hi_e)) * 32 + ql_e] = o[mb][r] * inv;
    }
    __syncthreads();
    if (comp == 0) {
        float ss = 0.f;
#pragma unroll
        for (int mb = 0; mb < 4; ++mb)
#pragma unroll
            for (int r = 0; r < 16; ++r) { const float y = o[mb][r] * inv - lam * OX[(rw * 128 + 32 * mb + crow(r, hi_e)) * 32 + ql_e]; o[mb][r] = y; ss += y * y; }
        ss += __shfl_xor(ss, 32);
        const float rn = __builtin_amdgcn_rsqf(ss * (1.f / 128.f) + 1e-6f) * 0.8f;
#pragma unroll
        for (int mb = 0; mb < 4; ++mb)
#pragma unroll
            for (int r4 = 0; r4 < 4; ++r4) { const int dv = 32 * mb + 8 * r4 + 4 * hi_e; const f32x4 gv = *(const f32x4*)(dg + h * 128 + dv);
                u32x2 wv; wv.x = pk2(o[mb][4 * r4] * rn * gv[0], o[mb][4 * r4 + 1] * rn * gv[1]); wv.y = pk2(o[mb][4 * r4 + 2] * rn * gv[2], o[mb][4 * r4 + 3] * rn * gv[3]);
                *(u32x2*)(MIX + rowq_e * DM + h * 128 + dv) = wv; }
    }
}
__device__ __forceinline__ void attn_phase(const Ctx& C, const bf16_t* U, const float* rel_bias, const float* dg, const float* lq1, const float* lk1, const float* lq2, const float* lk2, bf16_t* MIX) {
    float s1 = 0.f, s2 = 0.f;
#pragma unroll 4
    for (int i = 0; i < 64; ++i) { s1 += lq1[i] * lk1[i]; s2 += lq2[i] * lk2[i]; }
    const float lam = __expf(s1) - __expf(s2) + 0.2f;
    const bool xa = (C.G == 256);
#pragma unroll 1
    for (int k = 0; k < 512; ++k) {
        int pr;
        if (xa) { if (k >= 2) break; pr = (2 * (C.bid & 7) + k) * 32 + (C.bid >> 3); } else { pr = C.bid + k * C.G; if (pr >= 512) break; }
        const int bh = pr >> 5, i = pr & 31, b = bh >> 3, h = bh & 7;
        attn_unit(C, U, rel_bias, dg, lam, b, h, i, MIX);
        attn_unit(C, U, rel_bias, dg, lam, b, h, 63 - i, MIX);
    }
    __syncthreads();
}

struct Args {
    const float* x; const float* p; const float* ln_g; const float* ln_b; const float* w_ffn_in; const float* w_ffn_out; const float* w_in_ab; const float* w_out_ab;
    const float* rel_bias; const float* lq1; const float* lk1; const float* lq2; const float* lk2; const float* diff_norm; const float* conv_w; const float* conv_b;
    const float* b_igate; const float* b_fgate; const float* mlstm_norm; const float* w_in_c; const float* w_alpha2; const float* b_alpha; const float* gla_norm;
    const float* w_out_c; const float* w_ple_proj; const float* w_ple_gate;
    float* out; unsigned char* ws;
    int ph_lo, ph_hi;
};


constexpr int ARGS_OFF = 147200;
enum { A_x = 0, A_p, A_ln_g, A_ln_b, A_w_ffn_in, A_w_ffn_out, A_w_in_ab, A_w_out_ab, A_rel_bias, A_lq1, A_lk1, A_lq2, A_lk2, A_diff_norm, A_conv_w, A_conv_b,
       A_b_igate, A_b_fgate, A_mlstm_norm, A_w_in_c, A_w_alpha2, A_b_alpha, A_gla_norm, A_w_out_c, A_w_ple_proj, A_w_ple_gate, A_out, A_ws };
__device__ __forceinline__ unsigned char* ldarg(LAS unsigned char* lds, int i) {
    volatile LAS unsigned* p = (volatile LAS unsigned*)(lds + ARGS_OFF) + 2 * i;
    const unsigned lo = __builtin_amdgcn_readfirstlane(p[0]), hi = __builtin_amdgcn_readfirstlane(p[1]);
    return (unsigned char*)(__attribute__((address_space(1))) unsigned char*)(((unsigned long long)hi << 32) | lo);
}
#define ARGF(i) ((const float*)ldarg(C.lds, (i)))
#define WSP(T, off) ((T*)(ldarg(C.lds, A_ws) + (off)))


__device__ __forceinline__ void grid_barrier(unsigned* ctr, unsigned target, bool leader) {
    asm volatile("s_waitcnt vmcnt(0) lgkmcnt(0)" ::: "memory");
    __syncthreads();
    if (leader) {
        __builtin_amdgcn_fence(__ATOMIC_RELEASE, "agent");
        asm volatile("s_waitcnt vmcnt(0)" ::: "memory");
        (void)__hip_atomic_fetch_add(ctr, 1u, __ATOMIC_RELAXED, __HIP_MEMORY_SCOPE_AGENT);
        while (__hip_atomic_load(ctr, __ATOMIC_RELAXED, __HIP_MEMORY_SCOPE_AGENT) < target) __builtin_amdgcn_s_sleep(1);
        __builtin_amdgcn_fence(__ATOMIC_ACQUIRE, "agent");
        asm volatile("s_waitcnt vmcnt(0)" ::: "memory");
    }
    __syncthreads();
}

#define XB_TMO      128
#define XB_XCNT(j)  (256  + 64 * (j))
#define XB_XSUB(j)  (1280 + 64 * (j))
#define XB_XGEN(j)  (2304 + 64 * (j))
#define XB_TOP      3328
#define XB_TOPGEN   3392
#define XCD_BAR_WORDS 3456
#define XB_SPIN_CAP (1u << 22)
__device__ __forceinline__ unsigned xb_ld(unsigned* p)              { return __hip_atomic_load(p, __ATOMIC_RELAXED, __HIP_MEMORY_SCOPE_AGENT); }
__device__ __forceinline__ unsigned xb_add(unsigned* p, unsigned v) { return __hip_atomic_fetch_add(p, v, __ATOMIC_RELAXED, __HIP_MEMORY_SCOPE_AGENT); }
__device__ __forceinline__ unsigned xb_xcc_id() { return (unsigned)__builtin_amdgcn_s_getreg((3 << 11) | 20) & 0xFu; }
#define XB_SPIN(cond, bar) do { unsigned _sp = 0; while (cond) { __builtin_amdgcn_s_sleep(1); \
    if ((++_sp & 255u) == 0u) { if (xb_ld(&(bar)[XB_TMO])) break; if (_sp > XB_SPIN_CAP) { atomicAdd(&(bar)[XB_TMO], 1u); break; } } } } while (0)
__device__ __forceinline__ void xcd_barrier_complete(unsigned* bar, unsigned x, unsigned& nloc, unsigned& nx) {
    const unsigned G = gridDim.x;
    unsigned sum, cnt, mine, sp = 0u;
    for (;;) {
        sum = 0u; cnt = 0u; mine = 0u;
#pragma unroll
        for (unsigned j = 0; j < 16; ++j) { const unsigned c = xb_ld(&bar[XB_XCNT(j)]); sum += c; cnt += (c > 0u) ? 1u : 0u; mine = (j == x) ? c : mine; }
        if (sum == G) break;
        __builtin_amdgcn_s_sleep(1);
        if ((++sp & 255u) == 0u) { if (xb_ld(&bar[XB_TMO])) break; if (sp > XB_SPIN_CAP) { atomicAdd(&bar[XB_TMO], 1u); break; } }
    }
    nloc = mine > 0u ? mine : 1u; nx = cnt > 0u ? cnt : 1u;
}
__device__ __forceinline__ void xcd_barrier(unsigned* bar, volatile LAS unsigned* st, bool leader) {
    asm volatile("s_waitcnt vmcnt(0)" ::: "memory");
    __syncthreads();
    if (leader) {
        __builtin_amdgcn_s_waitcnt(0);
        const unsigned x = xb_xcc_id();
        unsigned nloc = st[0], nx = st[1];
        if (nloc == 0u) { xcd_barrier_complete(bar, x, nloc, nx); st[0] = nloc; st[1] = nx; }
        const unsigned old = xb_add(&bar[XB_XSUB(x)], 1u);
        const unsigned gen = old / nloc;
        if (old + 1u == (gen + 1u) * nloc) {
            __builtin_amdgcn_fence(__ATOMIC_RELEASE, "agent");
            asm volatile("s_waitcnt vmcnt(0)" ::: "memory");
            const unsigned og = xb_add(&bar[XB_TOP], 1u);
            const unsigned tg = og / nx;
            if (og + 1u == (tg + 1u) * nx) xb_add(&bar[XB_TOPGEN], 1u);
            else XB_SPIN(xb_ld(&bar[XB_TOPGEN]) == tg, bar);
            __builtin_amdgcn_fence(__ATOMIC_ACQUIRE, "agent");
            xb_add(&bar[XB_XGEN(x)], 1u);
            asm volatile("s_waitcnt vmcnt(0)" ::: "memory");
        } else {
            XB_SPIN(xb_ld(&bar[XB_XGEN(x)]) == gen, bar);
            __builtin_amdgcn_fence(__ATOMIC_ACQUIRE, "agent");
            asm volatile("s_waitcnt vmcnt(0)" ::: "memory");
        }
    }
    __syncthreads();
}

#define GEMM_CALL(EPI, Aptr, Bptr, Nn, Kk, Eobj) do { pg8::Gemm g_{(const bf16_t*)(Aptr), (const bf16_t*)(Bptr), MT, (Nn), (Kk)}; pg8::StaticOrder S_; S_.init(MT, (Nn), C.G, C.bid); \
    pg8::gemm_phase<EPI, pg8::StaticOrder, true, true>(C.lds, g_, S_, Eobj, C.tid); } while (0)

__global__ void __launch_bounds__(512, 2) mega_fwd(Args a) {
    extern __shared__ __attribute__((aligned(16))) unsigned char lds_raw[];
    cg::grid_group grid = cg::this_grid();
    if (threadIdx.x == 0) {
        LAS unsigned long long* t = (LAS unsigned long long*)((LAS unsigned char*)lds_raw + ARGS_OFF);
        t[A_x] = (unsigned long long)a.x; t[A_p] = (unsigned long long)a.p; t[A_ln_g] = (unsigned long long)a.ln_g; t[A_ln_b] = (unsigned long long)a.ln_b;
        t[A_w_ffn_in] = (unsigned long long)a.w_ffn_in; t[A_w_ffn_out] = (unsigned long long)a.w_ffn_out; t[A_w_in_ab] = (unsigned long long)a.w_in_ab; t[A_w_out_ab] = (unsigned long long)a.w_out_ab;
        t[A_rel_bias] = (unsigned long long)a.rel_bias; t[A_lq1] = (unsigned long long)a.lq1; t[A_lk1] = (unsigned long long)a.lk1; t[A_lq2] = (unsigned long long)a.lq2; t[A_lk2] = (unsigned long long)a.lk2;
        t[A_diff_norm] = (unsigned long long)a.diff_norm; t[A_conv_w] = (unsigned long long)a.conv_w; t[A_conv_b] = (unsigned long long)a.conv_b; t[A_b_igate] = (unsigned long long)a.b_igate;
        t[A_b_fgate] = (unsigned long long)a.b_fgate; t[A_mlstm_norm] = (unsigned long long)a.mlstm_norm; t[A_w_in_c] = (unsigned long long)a.w_in_c; t[A_w_alpha2] = (unsigned long long)a.w_alpha2;
        t[A_b_alpha] = (unsigned long long)a.b_alpha; t[A_gla_norm] = (unsigned long long)a.gla_norm; t[A_w_out_c] = (unsigned long long)a.w_out_c; t[A_w_ple_proj] = (unsigned long long)a.w_ple_proj;
        t[A_w_ple_gate] = (unsigned long long)a.w_ple_gate; t[A_out] = (unsigned long long)a.out; t[A_ws] = (unsigned long long)a.ws;
        t[30] = 0ull;
    }
    __syncthreads();
    const int ph_lo = a.ph_lo, ph_hi = a.ph_hi;
    int ph = 0; unsigned nbar = 0, ngb = 0;
    const int wave_s = __builtin_amdgcn_readfirstlane((int)(threadIdx.x >> 6));
#ifndef REPMASK
#define REPMASK 0
#endif
#define PHASE_BEGIN_G(grp) if (ph >= ph_lo && ph < ph_hi) for (int rep_ = 0; rep_ < (((REPMASK >> (grp)) & 1) ? 2 : 1); ++rep_) { Ctx C; { int t_ = wave_s * 64 + (int)__builtin_amdgcn_mbcnt_hi(~0u, __builtin_amdgcn_mbcnt_lo(~0u, 0u)); asm volatile("" : "+v"(t_)); C.lds = (LAS unsigned char*)lds_raw; C.tid = t_; C.lane = t_ & 63; C.wave = __builtin_amdgcn_readfirstlane(t_ >> 6); \
    C.G = gridDim.x; C.bid = blockIdx.x; C.gw = C.bid * 8 + C.wave; C.NGW = C.G * 8; }
#define PHASE_BEGIN PHASE_BEGIN_G(31)
#ifndef SYNCREP
#define SYNCREP 1
#endif
#define PHASE_END_K(GROUPWISE) } ++ph; if (ph > ph_lo && ph < ph_hi) { for (int sr_ = 0; sr_ < SYNCREP; ++sr_) { \
        unsigned* ctl_ = (unsigned*)(ldarg((LAS unsigned char*)lds_raw, A_ws) + OFF_CTL); const bool lead_ = wave_s == 0 && __builtin_amdgcn_mbcnt_hi(~0u, __builtin_amdgcn_mbcnt_lo(~0u, 0u)) == 0u; \
        if ((GROUPWISE) && (gridDim.x & 7u) == 0u) { ++ngb; grid_barrier(ctl_ + 64 * (1 + (blockIdx.x & 7u)), ngb * (gridDim.x >> 3), lead_); } \
        else { xcd_barrier(ctl_ + 1024, (volatile LAS unsigned*)((LAS unsigned char*)lds_raw + ARGS_OFF + 240), lead_); } } }
#define PHASE_END PHASE_END_K(0)
#define PHASE_END_NONE } ++ph;
#define PHASE_END_ROWS PHASE_END_K(0)

    PHASE_BEGIN_G(0)
        if (C.bid == 0) { unsigned* ctl0_ = (unsigned*)(ldarg(C.lds, A_ws) + OFF_CTL); for (int i_ = C.tid; i_ < 1024 + XCD_BAR_WORDS; i_ += 512) ctl0_[i_] = 0u; }
        int base = 0;
        for (int i = 0; i < 4; ++i) conv_matrix(C, ARGF(A_w_ffn_in) + (size_t)i * DM * NFF2, DM, NFF2, NFF2, WSP(bf16_t, OFF_WFI) + (size_t)i * NFF2 * DM, 1, base);
        for (int i = 0; i < 4; ++i) conv_matrix(C, ARGF(A_w_ffn_out) + (size_t)i * DFF * DM, DFF, DM, DM, WSP(bf16_t, OFF_WFO) + (size_t)i * DM * DFF, 0, base);
        conv_matrix(C, ARGF(A_w_in_ab), DM, 6152, NIN, WSP(bf16_t, OFF_WAB), 2, base);
        conv_matrix(C, ARGF(A_w_in_c), DM, 6160, NIN, WSP(bf16_t, OFF_WC), 0, base);
        conv_matrix(C, ARGF(A_w_out_ab), DM, DM, DM, WSP(bf16_t, OFF_WOAB), 0, base);
        conv_matrix(C, ARGF(A_w_out_c), DM, DM, DM, WSP(bf16_t, OFF_WOC), 0, base);
        for (int i = 0; i < 2; ++i) conv_matrix(C, ARGF(A_w_ple_gate) + (size_t)i * DM * DM, DM, DM, DM, WSP(bf16_t, OFF_WPG) + (size_t)i * DM * DM, 0, base);
        for (int i = 0; i < 2; ++i) conv_matrix(C, ARGF(A_w_ple_proj) + (size_t)i * PLE * DM, PLE, DM, DM, WSP(bf16_t, OFF_WPP) + (size_t)i * DM * PLE, 0, base);
        cvt_rows(C, ARGF(A_x), WSP(bf16_t, OFF_XB), (size_t)MT * DM / 4);
        cvt_rows(C, ARGF(A_p), WSP(bf16_t, OFF_PB), (size_t)2 * MT * PLE / 4);
        __syncthreads();
    } ++ph; if (ph > ph_lo && ph < ph_hi) { grid.sync(); if (wave_s == 0 && __builtin_amdgcn_mbcnt_hi(~0u, __builtin_amdgcn_mbcnt_lo(~0u, 0u)) == 0u) (void)xb_add((unsigned*)(ldarg((LAS unsigned char*)lds_raw, A_ws) + OFF_CTL) + 1024 + XB_XCNT(xb_xcc_id()), 1u); }

    { constexpr int L = 0;
        PHASE_BEGIN_G(1) { pg8::EpiSwiglu e{WSP(bf16_t, OFF_H), DFF}; GEMM_CALL(pg8::EpiSwiglu, WSP(bf16_t, (L == 0 ? OFF_XB : OFF_MIX)), WSP(bf16_t, OFF_WFI) + (size_t)(2 * L) * NFF2 * DM, NFF2, DM, e); }
            if (L == 0) { for (int l2 = 0; l2 < 2; ++l2) { pg8::EpiStore e2{WSP(bf16_t, OFF_XF) + (size_t)l2 * MT * DM, DM, DM, nullptr}; GEMM_CALL(pg8::EpiStore, WSP(bf16_t, OFF_PB) + (size_t)l2 * MT * PLE, WSP(bf16_t, OFF_WPP) + (size_t)l2 * DM * PLE, DM, PLE, e2); } } PHASE_END_ROWS
        PHASE_BEGIN_G(1) { if (L == 0) { pg8::EpiZ<true> e{(const void*)ARGF(A_x), WSP(bf16_t, OFF_Z), ALPHA, 0.5f}; GEMM_CALL(pg8::EpiZ<true>, WSP(bf16_t, OFF_H), WSP(bf16_t, OFF_WFO) + (size_t)(2 * L) * DM * DFF, DM, DFF, e); } else { pg8::EpiZ<false> e{(const void*)WSP(bf16_t, OFF_MIX), WSP(bf16_t, OFF_Z), ALPHA, 0.5f}; GEMM_CALL(pg8::EpiZ<false>, WSP(bf16_t, OFF_H), WSP(bf16_t, OFF_WFO) + (size_t)(2 * L) * DM * DFF, DM, DFF, e); } } PHASE_END_ROWS
        PHASE_BEGIN_G(3) ln_phase<(L == 0 ? 8 : 16)>(C, WSP(bf16_t, OFF_Z), ARGF(A_ln_g) + (size_t)(3 * L) * DM, ARGF(A_ln_b) + (size_t)(3 * L) * DM, WSP(bf16_t, OFF_XB), (L == 0 ? ARGF(A_w_in_ab) : ARGF(A_w_in_c)), (L == 0 ? 6152 : 6160), (L == 0 ? 8 : 16), WSP(float, OFF_GT)); PHASE_END
        PHASE_BEGIN_G(2) { pg8::EpiStore e{WSP(bf16_t, OFF_H), UW, UW, nullptr}; GEMM_CALL(pg8::EpiStore, WSP(bf16_t, OFF_XB), WSP(bf16_t, (L == 0 ? OFF_WAB : OFF_WC)), NIN, DM, e); } PHASE_END
        if (L == 0) {
            PHASE_BEGIN_G(5) m1_phase(C, WSP(bf16_t, OFF_H), WSP(float, OFF_GT), ARGF(A_conv_w), ARGF(A_conv_b), ARGF(A_b_igate), ARGF(A_b_fgate), WSP(bf16_t, OFF_QB), WSP(bf16_t, OFF_KB), WSP(float, OFF_BC), WSP(float, OFF_IP), WSP(float, OFF_MSC)); PHASE_END
            PHASE_BEGIN
                mlstm_passA(C, WSP(bf16_t, OFF_H), WSP(bf16_t, OFF_KB), WSP(float, OFF_BC), WSP(float, OFF_IP), WSP(float, OFF_MSC), WSP(bf16_t, OFF_ST), WSP(float, OFF_NL));
                for (int rep2_ = 0; rep2_ < (((REPMASK >> 4) & 1) ? 2 : 1); ++rep2_)
                attn_phase(C, WSP(bf16_t, OFF_H), ARGF(A_rel_bias), ARGF(A_diff_norm), ARGF(A_lq1), ARGF(A_lk1), ARGF(A_lq2), ARGF(A_lk2), WSP(bf16_t, OFF_MIX));
            PHASE_END
            PHASE_BEGIN mlstm_scan(C, WSP(bf16_t, OFF_ST), WSP(float, OFF_NL), WSP(float, OFF_MSC)); PHASE_END
            PHASE_BEGIN_G(5) mlstm_passC(C, WSP(bf16_t, OFF_H), WSP(bf16_t, OFF_QB), WSP(bf16_t, OFF_KB), WSP(float, OFF_BC), WSP(float, OFF_IP), WSP(float, OFF_MSC), WSP(bf16_t, OFF_ST), WSP(float, OFF_NL), ARGF(A_mlstm_norm), WSP(bf16_t, OFF_MIX)); PHASE_END
        } else {
            PHASE_BEGIN_G(6) gla_passA(C, WSP(bf16_t, OFF_H), WSP(float, OFF_GT), ARGF(A_w_alpha2), ARGF(A_b_alpha), WSP(bf16_t, OFF_ST), WSP(float, OFF_DC), WSP(bf16_t, OFF_Z), WSP(bf16_t, OFF_Z + (size_t)MT * 1024 * 2)); PHASE_END
            PHASE_BEGIN gla_scan(C, WSP(bf16_t, OFF_ST), WSP(float, OFF_DC)); PHASE_END
            PHASE_BEGIN_G(7) gla_passC(C, WSP(bf16_t, OFF_H), WSP(bf16_t, OFF_Z), WSP(bf16_t, OFF_Z + (size_t)MT * 1024 * 2), WSP(bf16_t, OFF_ST), ARGF(A_gla_norm), WSP(bf16_t, OFF_MIX)); PHASE_END
        }
        PHASE_BEGIN_G(1) { pg8::EpiZ<false> e{(const void*)WSP(bf16_t, OFF_XB), WSP(bf16_t, OFF_Z), ALPHA, 1.0f}; GEMM_CALL(pg8::EpiZ<false>, WSP(bf16_t, OFF_MIX), WSP(bf16_t, (L == 0 ? OFF_WOAB : OFF_WOC)), DM, DM, e); } PHASE_END_ROWS
        PHASE_BEGIN_G(3) ln_phase<0>(C, WSP(bf16_t, OFF_Z), ARGF(A_ln_g) + (size_t)(3 * L + 1) * DM, ARGF(A_ln_b) + (size_t)(3 * L + 1) * DM, WSP(bf16_t, OFF_XB), nullptr, 0, 0, nullptr); PHASE_END_ROWS
        PHASE_BEGIN_G(1) { pg8::EpiSwiglu e{WSP(bf16_t, OFF_H), DFF}; GEMM_CALL(pg8::EpiSwiglu, WSP(bf16_t, OFF_XB), WSP(bf16_t, OFF_WFI) + (size_t)(2 * L + 1) * NFF2 * DM, NFF2, DM, e); } PHASE_END_ROWS
        PHASE_BEGIN_G(1) { pg8::EpiZ<false> e{(const void*)WSP(bf16_t, OFF_XB), WSP(bf16_t, OFF_Z), ALPHA, 0.5f}; GEMM_CALL(pg8::EpiZ<false>, WSP(bf16_t, OFF_H), WSP(bf16_t, OFF_WFO) + (size_t)(2 * L + 1) * DM * DFF, DM, DFF, e); } PHASE_END_ROWS
        PHASE_BEGIN_G(3) ln_phase<0>(C, WSP(bf16_t, OFF_Z), ARGF(A_ln_g) + (size_t)(3 * L + 2) * DM, ARGF(A_ln_b) + (size_t)(3 * L + 2) * DM, WSP(bf16_t, OFF_XB), nullptr, 0, 0, nullptr); PHASE_END_ROWS
        PHASE_BEGIN { pg8::EpiPle e{WSP(const bf16_t, OFF_XB), WSP(const bf16_t, OFF_XF) + (size_t)L * MT * DM, (L == 1) ? (float*)ldarg(C.lds, A_out) : (float*)nullptr, (L == 1) ? (bf16_t*)nullptr : WSP(bf16_t, OFF_MIX)}; GEMM_CALL(pg8::EpiPle, WSP(bf16_t, OFF_XB), WSP(bf16_t, OFF_WPG) + (size_t)L * DM * DM, DM, DM, e); } PHASE_END_ROWS
        }
    { constexpr int L = 1;
        PHASE_BEGIN_G(1) { pg8::EpiSwiglu e{WSP(bf16_t, OFF_H), DFF}; GEMM_CALL(pg8::EpiSwiglu, WSP(bf16_t, (L == 0 ? OFF_XB : OFF_MIX)), WSP(bf16_t, OFF_WFI) + (size_t)(2 * L) * NFF2 * DM, NFF2, DM, e); }
            if (L == 0) { for (int l2 = 0; l2 < 2; ++l2) { pg8::EpiStore e2{WSP(bf16_t, OFF_XF) + (size_t)l2 * MT * DM, DM, DM, nullptr}; GEMM_CALL(pg8::EpiStore, WSP(bf16_t, OFF_PB) + (size_t)l2 * MT * PLE, WSP(bf16_t, OFF_WPP) + (size_t)l2 * DM * PLE, DM, PLE, e2); } } PHASE_END_ROWS
        PHASE_BEGIN_G(1) { if (L == 0) { pg8::EpiZ<true> e{(const void*)ARGF(A_x), WSP(bf16_t, OFF_Z), ALPHA, 0.5f}; GEMM_CALL(pg8::EpiZ<true>, WSP(bf16_t, OFF_H), WSP(bf16_t, OFF_WFO) + (size_t)(2 * L) * DM * DFF, DM, DFF, e); } else { pg8::EpiZ<false> e{(const void*)WSP(bf16_t, OFF_MIX), WSP(bf16_t, OFF_Z), ALPHA, 0.5f}; GEMM_CALL(pg8::EpiZ<false>, WSP(bf16_t, OFF_H), WSP(bf16_t, OFF_WFO) + (size_t)(2 * L) * DM * DFF, DM, DFF, e); } } PHASE_END_ROWS
        PHASE_BEGIN_G(3) ln_phase<(L == 0 ? 8 : 16)>(C, WSP(bf16_t, OFF_Z), ARGF(A_ln_g) + (size_t)(3 * L) * DM, ARGF(A_ln_b) + (size_t)(3 * L) * DM, WSP(bf16_t, OFF_XB), (L == 0 ? ARGF(A_w_in_ab) : ARGF(A_w_in_c)), (L == 0 ? 6152 : 6160), (L == 0 ? 8 : 16), WSP(float, OFF_GT)); PHASE_END
        PHASE_BEGIN_G(2) { pg8::EpiStore e{WSP(bf16_t, OFF_H), UW, UW, nullptr}; GEMM_CALL(pg8::EpiStore, WSP(bf16_t, OFF_XB), WSP(bf16_t, (L == 0 ? OFF_WAB : OFF_WC)), NIN, DM, e); } PHASE_END
        if (L == 0) {
            PHASE_BEGIN_G(5) m1_phase(C, WSP(bf16_t, OFF_H), WSP(float, OFF_GT), ARGF(A_conv_w), ARGF(A_conv_b), ARGF(A_b_igate), ARGF(A_b_fgate), WSP(bf16_t, OFF_QB), WSP(bf16_t, OFF_KB), WSP(float, OFF_BC), WSP(float, OFF_IP), WSP(float, OFF_MSC)); PHASE_END
            PHASE_BEGIN
                mlstm_passA(C, WSP(bf16_t, OFF_H), WSP(bf16_t, OFF_KB), WSP(float, OFF_BC), WSP(float, OFF_IP), WSP(float, OFF_MSC), WSP(bf16_t, OFF_ST), WSP(float, OFF_NL));
                for (int rep2_ = 0; rep2_ < (((REPMASK >> 4) & 1) ? 2 : 1); ++rep2_)
                attn_phase(C, WSP(bf16_t, OFF_H), ARGF(A_rel_bias), ARGF(A_diff_norm), ARGF(A_lq1), ARGF(A_lk1), ARGF(A_lq2), ARGF(A_lk2), WSP(bf16_t, OFF_MIX));
            PHASE_END
            PHASE_BEGIN mlstm_scan(C, WSP(bf16_t, OFF_ST), WSP(float, OFF_NL), WSP(float, OFF_MSC)); PHASE_END
            PHASE_BEGIN_G(5) mlstm_passC(C, WSP(bf16_t, OFF_H), WSP(bf16_t, OFF_QB), WSP(bf16_t, OFF_KB), WSP(float, OFF_BC), WSP(float, OFF_IP), WSP(float, OFF_MSC), WSP(bf16_t, OFF_ST), WSP(float, OFF_NL), ARGF(A_mlstm_norm), WSP(bf16_t, OFF_MIX)); PHASE_END
        } else {
            PHASE_BEGIN_G(6) gla_passA(C, WSP(bf16_t, OFF_H), WSP(float, OFF_GT), ARGF(A_w_alpha2), ARGF(A_b_alpha), WSP(bf16_t, OFF_ST), WSP(float, OFF_DC), WSP(bf16_t, OFF_Z), WSP(bf16_t, OFF_Z + (size_t)MT * 1024 * 2)); PHASE_END
            PHASE_BEGIN gla_scan(C, WSP(bf16_t, OFF_ST), WSP(float, OFF_DC)); PHASE_END
            PHASE_BEGIN_G(7) gla_passC(C, WSP(bf16_t, OFF_H), WSP(bf16_t, OFF_Z), WSP(bf16_t, OFF_Z + (size_t)MT * 1024 * 2), WSP(bf16_t, OFF_ST), ARGF(A_gla_norm), WSP(bf16_t, OFF_MIX)); PHASE_END
        }
        PHASE_BEGIN_G(1) { pg8::EpiZ<false> e{(const void*)WSP(bf16_t, OFF_XB), WSP(bf16_t, OFF_Z), ALPHA, 1.0f}; GEMM_CALL(pg8::EpiZ<false>, WSP(bf16_t, OFF_MIX), WSP(bf16_t, (L == 0 ? OFF_WOAB : OFF_WOC)), DM, DM, e); } PHASE_END_ROWS
        PHASE_BEGIN_G(3) ln_phase<0>(C, WSP(bf16_t, OFF_Z), ARGF(A_ln_g) + (size_t)(3 * L + 1) * DM, ARGF(A_ln_b) + (size_t)(3 * L + 1) * DM, WSP(bf16_t, OFF_XB), nullptr, 0, 0, nullptr); PHASE_END_ROWS
        PHASE_BEGIN_G(1) { pg8::EpiSwiglu e{WSP(bf16_t, OFF_H), DFF}; GEMM_CALL(pg8::EpiSwiglu, WSP(bf16_t, OFF_XB), WSP(bf16_t, OFF_WFI) + (size_t)(2 * L + 1) * NFF2 * DM, NFF2, DM, e); } PHASE_END_ROWS
        PHASE_BEGIN_G(1) { pg8::EpiZ<false> e{(const void*)WSP(bf16_t, OFF_XB), WSP(bf16_t, OFF_Z), ALPHA, 0.5f}; GEMM_CALL(pg8::EpiZ<false>, WSP(bf16_t, OFF_H), WSP(bf16_t, OFF_WFO) + (size_t)(2 * L + 1) * DM * DFF, DM, DFF, e); } PHASE_END_ROWS
        PHASE_BEGIN_G(3) ln_phase<0>(C, WSP(bf16_t, OFF_Z), ARGF(A_ln_g) + (size_t)(3 * L + 2) * DM, ARGF(A_ln_b) + (size_t)(3 * L + 2) * DM, WSP(bf16_t, OFF_XB), nullptr, 0, 0, nullptr); PHASE_END_ROWS
        PHASE_BEGIN { pg8::EpiPle e{WSP(const bf16_t, OFF_XB), WSP(const bf16_t, OFF_XF) + (size_t)L * MT * DM, (L == 1) ? (float*)ldarg(C.lds, A_out) : (float*)nullptr, (L == 1) ? (bf16_t*)nullptr : WSP(bf16_t, OFF_MIX)}; GEMM_CALL(pg8::EpiPle, WSP(bf16_t, OFF_XB), WSP(bf16_t, OFF_WPG) + (size_t)L * DM * DM, DM, DM, e); } PHASE_END_NONE
        }
}

extern "C" void kernel_launch(void* const* d_in, const int* in_sizes, int n_in, void* d_out, int out_size, void* d_ws, size_t ws_size, hipStream_t stream) {
    static int grid = 0;
    if (grid == 0) {
        int dev = 0, cus = 0, per_cu = 0;
        (void)hipGetDevice(&dev); (void)hipDeviceGetAttribute(&cus, hipDeviceAttributeMultiprocessorCount, dev);
        (void)hipFuncSetAttribute((const void*)mega_fwd, hipFuncAttributeMaxDynamicSharedMemorySize, LDS_BYTES);
        (void)hipOccupancyMaxActiveBlocksPerMultiprocessor(&per_cu, (const void*)mega_fwd, 512, LDS_BYTES);
        if (per_cu < 1) per_cu = 1;
        if (cus < 8) cus = 256;
        grid = cus * per_cu;
        if (ws_size < WS_NEED || n_in != 26) { fprintf(stderr, "kernel_launch: ws %zu < %zu or n_in %d != 26\n", ws_size, (size_t)WS_NEED, n_in); }
        (void)hipGetLastError();
    }
    Args a{};
    const float** fp = (const float**)&a;
    for (int i = 0; i < 26; ++i) fp[i] = (const float*)d_in[i];
    a.out = (float*)d_out; a.ws = (unsigned char*)d_ws; a.ph_lo = 0; a.ph_hi = 1000;
    void* args[] = {&a};
    hipError_t e = hipLaunchCooperativeKernel((const void*)mega_fwd, dim3(grid), dim3(512), args, LDS_BYTES, stream);
    if (e != hipSuccess) fprintf(stderr, "cooperative launch failed: %s (grid %d)\n", hipGetErrorString(e), grid);
}
```

```cpp
#include <hip/hip_runtime.h>
#include <hip/hip_cooperative_groups.h>
#include <cstdio>
#include <cstdint>
namespace cg = cooperative_groups;
namespace pg8 {
#define PG8_LAS __attribute__((address_space(3)))
typedef unsigned short bf16_t;
typedef short bf16x8 __attribute__((ext_vector_type(8)));
typedef float f32x4 __attribute__((ext_vector_type(4)));
typedef unsigned u32x4 __attribute__((ext_vector_type(4)));
constexpr int BM = 256, BK = 64, HALF = 128, HTB = HALF * BK * 2  , STAGE_BYTES = 8 * HTB, NXCD = 8, WGM = 8;

__host__ __device__ __forceinline__ int lds_byte(int r, int c) { const int st = (r >> 4) * 2 + (c >> 5), rr = r & 15, cc = c & 31, ob = rr * 64 + cc * 2; return st * 1024 + (ob ^ (((ob >> 9) & 1) << 5)); }
__host__ __device__ __forceinline__ void stage_rc(int b, int& R, int& C) { const int st = b / 1024, sb = b % 1024, swz = sb ^ (((sb >> 9) & 1) << 5); R = (st >> 1) * 16 + swz / 64; C = (st & 1) * 32 + (swz % 64) / 2; }
__host__ __device__ __forceinline__ int perm32(int rho) { const int n = rho >> 4, i = rho & 15; return 8 * (i >> 2) + 4 * n + (i & 3); }

struct Unit { int pm, pn; };
struct Gemm { const bf16_t* A; const bf16_t* Bt; int M, N, K; };

struct StaticOrder {
    int nM, nN, nwg, G, c;
    __host__ __device__ void init(int M, int N, int G_, int c_) { nM = M / BM; nN = N / BM; nwg = nM * nN; G = G_; c = c_; }
    __host__ __device__ bool next(int i, Unit& u) const {
        const long L = (long)i * G + c; if (L >= nwg) return false;
        int wgid = (int)L; { const int q = nwg / NXCD, r = nwg % NXCD, xcd = wgid % NXCD, off = wgid / NXCD; wgid = (xcd < r ? xcd * (q + 1) : r * (q + 1) + (xcd - r) * q) + off; }
        const int nig = WGM * nN, gid = wgid / nig, fm = gid * WGM, gsz = (nM - fm) < WGM ? (nM - fm) : WGM;
        u.pm = fm + ((wgid % nig) % gsz); u.pn = (wgid % nig) / gsz; return true;
    }
    __device__ __forceinline__ void a_ready(const Unit&) const {}
    __device__ __forceinline__ void done(const Unit&) const {}
};

__device__ __forceinline__ unsigned cvt_pk_bf16(float lo, float hi) { unsigned r; asm volatile("v_cvt_pk_bf16_f32 %0, %1, %2" : "=v"(r) : "v"(lo), "v"(hi)); return r; }
typedef float f32x2 __attribute__((ext_vector_type(2)));
template <class Epi, class Sched, bool ALIGN_EPI = false, bool SP2 = false>
__device__ __forceinline__ void gemm_phase(PG8_LAS unsigned char* lds, const Gemm g, const Sched& S, const Epi& E, const int tid_in) {
    const int tid = tid_in, wid = __builtin_amdgcn_readfirstlane(tid >> 6), lane = tid & 63, wr = wid >> 2, wc = wid & 3, fr = lane & 15, fq = lane >> 4;
    const int K = g.K, nt = K / BK;
    unsigned voffA[2], voffB[2];
#pragma unroll
    for (int i = 0; i < 2; ++i) { int R, C; stage_rc(tid * 16 + i * 8192, R, C); const int Rb = Epi::PERM ? ((R & ~31) + perm32(R & 31)) : R;
        voffA[i] = (unsigned)(R * K + C) * 2u; voffB[i] = (unsigned)(Rb * K + C) * 2u; }
    const size_t kstep = (size_t)(BK * 2);
    const size_t hstep = (size_t)HALF * K * 2;
    const size_t tstep = 2 * hstep;
    const unsigned ldsw = (unsigned)wid * 1024u;
    const int aoff = lds_byte(wr * 64 + fr, fq * 8), boff = lds_byte(wc * 32 + fr, fq * 8);
#define PG8_SA(b, h) (((b) * 2 + (h)) * HTB)
#define PG8_SB(b, h) ((4 + (b) * 2 + (h)) * HTB)
#define PG8_STAGE(bufoff, gbase, voff) do { _Pragma("unroll") for (int _i = 0; _i < 2; ++_i) \
        __builtin_amdgcn_global_load_lds((const unsigned*)((const char*)(gbase) + (voff)[_i]), (PG8_LAS unsigned*)(lds + (bufoff) + ldsw + _i * 8192), 16, 0, 0); } while (0)
#define PG8_LDA(dst, b, h) do { _Pragma("unroll") for (int m = 0; m < 4; ++m) _Pragma("unroll") for (int k = 0; k < 2; ++k) dst[m][k] = *(const PG8_LAS bf16x8*)(lds + PG8_SA(b, h) + aoff + m * 2048 + k * 1024); } while (0)
#define PG8_LDB(dst, b, h) do { _Pragma("unroll") for (int n = 0; n < 2; ++n) _Pragma("unroll") for (int k = 0; k < 2; ++k) dst[n][k] = *(const PG8_LAS bf16x8*)(lds + PG8_SB(b, h) + boff + n * 2048 + k * 1024); } while (0)
#define PG8_MMA(ai, bj, At, Bt) do { __builtin_amdgcn_s_setprio(1); _Pragma("unroll") for (int m = 0; m < 4; ++m) _Pragma("unroll") for (int n = 0; n < 2; ++n) _Pragma("unroll") for (int k = 0; k < 2; ++k) \
        acc[ai][bj][m][n] = __builtin_amdgcn_mfma_f32_16x16x32_bf16(Bt[n][k], At[m][k], acc[ai][bj][m][n], 0, 0, 0); __builtin_amdgcn_s_setprio(0); } while (0)
#define PG8_WAIT_V(n) asm volatile("s_waitcnt vmcnt(" #n ")" ::: "memory")
#define PG8_WAIT_L(n) asm volatile("s_waitcnt lgkmcnt(" #n ")" ::: "memory")
#define PG8_BAR __builtin_amdgcn_s_barrier()
#define PG8_SCHED __builtin_amdgcn_sched_barrier(0)
    Unit cur, nxt; int ui = 0;
    if (!S.next(0, cur)) return;
    f32x4 acc[2][2][4][2];
#pragma unroll
    for (int a = 0; a < 2; ++a)
#pragma unroll
        for (int b = 0; b < 2; ++b)
#pragma unroll
            for (int m = 0; m < 4; ++m)
#pragma unroll
                for (int n = 0; n < 2; ++n) acc[a][b][m][n] = (f32x4){0.f, 0.f, 0.f, 0.f};
    bf16x8 At[4][2], B0[2][2], B1[2][2];
    const char* cA = (const char*)g.A + (size_t)cur.pm * tstep; const char* cB = (const char*)g.Bt + (size_t)cur.pn * tstep;
    S.a_ready(cur);
    if constexpr (SP2) {
        PG8_STAGE(PG8_SB(0, 0), cB, voffB); PG8_STAGE(PG8_SB(0, 1), cB + hstep, voffB); PG8_STAGE(PG8_SA(0, 0), cA, voffA); PG8_STAGE(PG8_SA(0, 1), cA + hstep, voffA);
        if (wr == 1) PG8_BAR;
        PG8_WAIT_V(2); PG8_BAR;
        PG8_STAGE(PG8_SB(1, 0), cB + kstep, voffB); PG8_STAGE(PG8_SA(1, 0), cA + kstep, voffA); PG8_STAGE(PG8_SB(1, 1), cB + hstep + kstep, voffB);
        PG8_WAIT_V(6); PG8_BAR;
    } else {
        PG8_STAGE(PG8_SB(0, 0), cB, voffB); PG8_STAGE(PG8_SA(0, 0), cA, voffA); PG8_STAGE(PG8_SB(0, 1), cB + hstep, voffB); PG8_STAGE(PG8_SA(0, 1), cA + hstep, voffA);
        if (wr == 1) PG8_BAR;
        PG8_WAIT_V(4); PG8_BAR;
        PG8_STAGE(PG8_SB(1, 0), cB + kstep, voffB); PG8_STAGE(PG8_SA(1, 0), cA + kstep, voffA); PG8_STAGE(PG8_SB(1, 1), cB + hstep + kstep, voffB);
        PG8_WAIT_V(6); PG8_BAR;
    }
    for (;;) {
        const bool has_next = S.next(ui + 1, nxt);
        const char* nA = has_next ? (const char*)g.A + (size_t)nxt.pm * tstep : cA; const char* nB = has_next ? (const char*)g.Bt + (size_t)nxt.pn * tstep : cB;
        for (int t = 0; t < nt; t += 2) {
            const bool last = (t == nt - 2);
            const char* a1 = cA + (size_t)(t + 1) * kstep;
            const char* a2 = last ? nA : cA + (size_t)(t + 2) * kstep; const char* b2 = last ? nB : cB + (size_t)(t + 2) * kstep;
            const char* a3 = a2 + kstep; const char* b3 = b2 + kstep;
            if (last && has_next) S.a_ready(nxt);
            if constexpr (SP2) {
            PG8_LDB(B0, 0, 0); PG8_LDB(B1, 0, 1); PG8_SCHED; PG8_LDA(At, 0, 0); PG8_STAGE(PG8_SA(1, 1), a1 + hstep, voffA);
            PG8_WAIT_V(8); PG8_WAIT_L(0); PG8_BAR; PG8_MMA(0, 0, At, B0); PG8_MMA(0, 1, At, B1); PG8_BAR; PG8_SCHED;
            PG8_LDA(At, 0, 1); PG8_STAGE(PG8_SB(0, 0), b2, voffB); PG8_STAGE(PG8_SB(0, 1), b2 + hstep, voffB); PG8_STAGE(PG8_SA(0, 0), a2, voffA);
            PG8_WAIT_V(8); PG8_WAIT_L(0); PG8_BAR; PG8_MMA(1, 0, At, B0); PG8_MMA(1, 1, At, B1); PG8_BAR; PG8_SCHED;
            PG8_LDB(B0, 1, 0); PG8_LDB(B1, 1, 1); PG8_SCHED; PG8_LDA(At, 1, 0); PG8_STAGE(PG8_SA(0, 1), a2 + hstep, voffA);
            PG8_WAIT_V(8); PG8_WAIT_L(0); PG8_BAR; PG8_MMA(0, 0, At, B0); PG8_MMA(0, 1, At, B1); PG8_BAR; PG8_SCHED;
            PG8_LDA(At, 1, 1); PG8_STAGE(PG8_SB(1, 0), b3, voffB); PG8_STAGE(PG8_SB(1, 1), b3 + hstep, voffB); PG8_STAGE(PG8_SA(1, 0), a3, voffA);
            PG8_WAIT_V(8); PG8_WAIT_L(0); PG8_BAR; PG8_MMA(1, 0, At, B0); PG8_MMA(1, 1, At, B1); PG8_BAR; PG8_SCHED;
            } else {
            PG8_LDB(B0, 0, 0); PG8_SCHED; PG8_LDA(At, 0, 0); PG8_STAGE(PG8_SA(1, 1), a1 + hstep, voffA);
            PG8_WAIT_L(8); PG8_BAR; PG8_WAIT_L(0); PG8_MMA(0, 0, At, B0); PG8_BAR; PG8_SCHED;
            PG8_LDB(B1, 0, 1); PG8_STAGE(PG8_SB(0, 0), b2, voffB);
            PG8_BAR; PG8_WAIT_L(0); PG8_MMA(0, 1, At, B1); PG8_BAR;
            PG8_LDA(At, 0, 1); PG8_STAGE(PG8_SA(0, 0), a2, voffA);
            PG8_BAR; PG8_WAIT_L(0); PG8_MMA(1, 0, At, B0); PG8_BAR; PG8_SCHED;
            PG8_STAGE(PG8_SB(0, 1), b2 + hstep, voffB);
            PG8_WAIT_V(6); PG8_BAR; PG8_MMA(1, 1, At, B1); PG8_BAR;
            PG8_LDB(B0, 1, 0); PG8_SCHED; PG8_LDA(At, 1, 0); PG8_STAGE(PG8_SA(0, 1), a2 + hstep, voffA);
            PG8_WAIT_L(8); PG8_BAR; PG8_WAIT_L(0); PG8_MMA(0, 0, At, B0); PG8_BAR; PG8_SCHED;
            PG8_LDB(B1, 1, 1); PG8_STAGE(PG8_SB(1, 0), b3, voffB);
            PG8_BAR; PG8_WAIT_L(0); PG8_MMA(0, 1, At, B1); PG8_BAR;
            PG8_LDA(At, 1, 1); PG8_STAGE(PG8_SA(1, 0), a3, voffA);
            PG8_BAR; PG8_WAIT_L(0); PG8_MMA(1, 0, At, B0); PG8_BAR; PG8_SCHED;
            PG8_STAGE(PG8_SB(1, 1), b3 + hstep, voffB);
            PG8_WAIT_V(6); PG8_BAR; PG8_MMA(1, 1, At, B1); PG8_BAR;
            }
        }
        if constexpr (ALIGN_EPI) { if (wr == 0) PG8_BAR; }
        if constexpr (!Epi::AFTER_DRAIN) { E(acc, cur, wr, wc, fr, fq); S.done(cur); }
        if (!has_next) break;
#pragma unroll
        for (int a = 0; a < 2; ++a)
#pragma unroll
            for (int b = 0; b < 2; ++b)
#pragma unroll
                for (int m = 0; m < 4; ++m)
#pragma unroll
                    for (int n = 0; n < 2; ++n) acc[a][b][m][n] = (f32x4){0.f, 0.f, 0.f, 0.f};
        cur = nxt; cA = nA; cB = nB; ++ui;
        if constexpr (ALIGN_EPI) { if (wr == 1) PG8_BAR; }
    }
    PG8_WAIT_V(0);
    if constexpr (!ALIGN_EPI) { if (wr == 0) PG8_BAR; }
    PG8_BAR;
    if constexpr (Epi::AFTER_DRAIN) { E.fused(acc, cur, wr, wc, fr, fq, lds, wid, lane); S.done(cur); }
#undef PG8_SA
#undef PG8_SB
#undef PG8_STAGE
#undef PG8_LDA
#undef PG8_LDB
#undef PG8_MMA
#undef PG8_WAIT_V
#undef PG8_WAIT_L
#undef PG8_BAR
#undef PG8_SCHED
}
}

namespace pg8 {
typedef unsigned u32x2 __attribute__((ext_vector_type(2)));
__device__ __forceinline__ float sigmoidf_(float v) { return __builtin_amdgcn_rcpf(1.0f + __expf(-v)); }

struct EpiSwiglu {
    static constexpr bool PERM = true, AFTER_DRAIN = false;
    bf16_t* H; int ldh;
    __device__ __forceinline__ void operator()(const f32x4 (&acc)[2][2][4][2], const Unit& u, int wr, int wc, int fr, int fq) const {
        const int row0 = u.pm * BM + wr * 64 + fr; const int col0 = u.pn * HALF + wc * 32 + 8 * fq;
#pragma unroll
        for (int ai = 0; ai < 2; ++ai)
#pragma unroll
            for (int m = 0; m < 4; ++m) {
                bf16_t* p = H + (size_t)(row0 + ai * HALF + m * 16) * ldh + col0;
                f32x4 h0, h1;
#pragma unroll
                for (int e = 0; e < 4; ++e) {
                    const float g0 = acc[ai][0][m][0][e], g1 = acc[ai][0][m][1][e];
                    h0[e] = g0 * sigmoidf_(g0) * acc[ai][1][m][0][e];
                    h1[e] = g1 * sigmoidf_(g1) * acc[ai][1][m][1][e];
                }
                u32x4 w; w.x = cvt_pk_bf16(h0[0], h0[1]); w.y = cvt_pk_bf16(h0[2], h0[3]); w.z = cvt_pk_bf16(h1[0], h1[1]); w.w = cvt_pk_bf16(h1[2], h1[3]);
                *(u32x4*)p = w;
            }
    }
};

template <bool RF32> struct EpiZ {
    static constexpr bool PERM = true, AFTER_DRAIN = false;
    const void* R; bf16_t* Z; float alpha, s;
    __device__ __forceinline__ void operator()(const f32x4 (&acc)[2][2][4][2], const Unit& u, int wr, int wc, int fr, int fq) const {
        const int row0 = u.pm * BM + wr * 64 + fr; const int col0 = u.pn * BM + wc * 32 + 8 * fq;
#pragma unroll
        for (int ai = 0; ai < 2; ++ai)
#pragma unroll
            for (int m = 0; m < 4; ++m) {
                const size_t off = (size_t)(row0 + ai * HALF + m * 16) * 2048 + col0;
#pragma unroll
                for (int bj = 0; bj < 2; ++bj) {
                    f32x4 r0, r1;
                    if (RF32) { r0 = *(const f32x4*)((const float*)R + off + bj * HALF); r1 = *(const f32x4*)((const float*)R + off + bj * HALF + 4); }
                    else { const u32x4 rb = *(const u32x4*)((const bf16_t*)R + off + bj * HALF);
                        r0[0] = __uint_as_float(rb.x << 16); r0[1] = __uint_as_float(rb.x & 0xffff0000u); r0[2] = __uint_as_float(rb.y << 16); r0[3] = __uint_as_float(rb.y & 0xffff0000u);
                        r1[0] = __uint_as_float(rb.z << 16); r1[1] = __uint_as_float(rb.z & 0xffff0000u); r1[2] = __uint_as_float(rb.w << 16); r1[3] = __uint_as_float(rb.w & 0xffff0000u); }
                    const f32x4 z0 = r0 * alpha + acc[ai][bj][m][0] * s, z1 = r1 * alpha + acc[ai][bj][m][1] * s;
                    u32x4 w; w.x = cvt_pk_bf16(z0[0], z0[1]); w.y = cvt_pk_bf16(z0[2], z0[3]); w.z = cvt_pk_bf16(z1[0], z1[1]); w.w = cvt_pk_bf16(z1[2], z1[3]);
                    *(u32x4*)(Z + off + bj * HALF) = w;
                }
            }
    }
};

struct EpiStore {
    static constexpr bool PERM = true, AFTER_DRAIN = false;
    bf16_t* O; int ldc; int ncols; float* GT;
    __device__ __forceinline__ void operator()(const f32x4 (&acc)[2][2][4][2], const Unit& u, int wr, int wc, int fr, int fq) const {
        const int row0 = u.pm * BM + wr * 64 + fr; const int colt = u.pn * BM;
        if (colt < ncols) {
            const int col0 = colt + wc * 32 + 8 * fq;
#pragma unroll
            for (int ai = 0; ai < 2; ++ai)
#pragma unroll
                for (int m = 0; m < 4; ++m) {
                    bf16_t* rowp = O + (size_t)(row0 + ai * HALF + m * 16) * ldc + col0;
#pragma unroll
                    for (int bj = 0; bj < 2; ++bj) {
                        const f32x4 v0 = acc[ai][bj][m][0], v1 = acc[ai][bj][m][1];
                        u32x4 w; w.x = cvt_pk_bf16(v0[0], v0[1]); w.y = cvt_pk_bf16(v0[2], v0[3]); w.z = cvt_pk_bf16(v1[0], v1[1]); w.w = cvt_pk_bf16(v1[2], v1[3]);
                        *(u32x4*)(rowp + bj * HALF) = w;
                    }
                }
        } else if (GT != nullptr && wc == 0 && fq < 2) {
#pragma unroll
            for (int ai = 0; ai < 2; ++ai)
#pragma unroll
                for (int m = 0; m < 4; ++m) {
                    float* g = GT + (size_t)(row0 + ai * HALF + m * 16) * 16 + 8 * fq;
                    *(f32x4*)(g) = acc[ai][0][m][0];
                    *(f32x4*)(g + 4) = acc[ai][0][m][1];
                }
        }
    }
};

struct EpiPle {
    static constexpr bool PERM = true, AFTER_DRAIN = false;
    const bf16_t* X; const bf16_t* E; float* OUTF; bf16_t* XBO;
    __device__ __forceinline__ void operator()(const f32x4 (&acc)[2][2][4][2], const Unit& u, int wr, int wc, int fr, int fq) const {
        const int row0 = u.pm * BM + wr * 64 + fr; const int col0 = u.pn * BM + wc * 32 + 8 * fq;
#pragma unroll
        for (int ai = 0; ai < 2; ++ai)
#pragma unroll
            for (int m = 0; m < 4; ++m) {
                const size_t off = (size_t)(row0 + ai * HALF + m * 16) * 2048 + col0;
#pragma unroll
                for (int bj = 0; bj < 2; ++bj) {
                    const size_t o2 = off + bj * HALF;
                    const u32x4 xb = *(const u32x4*)(X + o2), eb = *(const u32x4*)(E + o2);
                    const unsigned xw[4] = {xb.x, xb.y, xb.z, xb.w}, ew[4] = {eb.x, eb.y, eb.z, eb.w};
                    float o[8];
#pragma unroll
                    for (int q = 0; q < 4; ++q) {
                        const float a0 = acc[ai][bj][m][q >> 1][2 * (q & 1)], a1 = acc[ai][bj][m][q >> 1][2 * (q & 1) + 1];
                        o[2 * q] = __uint_as_float(xw[q] << 16) + __uint_as_float(ew[q] << 16) * sigmoidf_(a0);
                        o[2 * q + 1] = __uint_as_float(xw[q] & 0xffff0000u) + __uint_as_float(ew[q] & 0xffff0000u) * sigmoidf_(a1);
                    }
                    if (OUTF != nullptr) { *(f32x4*)(OUTF + o2) = (f32x4){o[0], o[1], o[2], o[3]}; *(f32x4*)(OUTF + o2 + 4) = (f32x4){o[4], o[5], o[6], o[7]}; }
                    if (XBO != nullptr) { u32x4 w; w.x = cvt_pk_bf16(o[0], o[1]); w.y = cvt_pk_bf16(o[2], o[3]); w.z = cvt_pk_bf16(o[4], o[5]); w.w = cvt_pk_bf16(o[6], o[7]); *(u32x4*)(XBO + o2) = w; }
                }
            }
    }
};
}

#define LAS __attribute__((address_space(3)))
using pg8::bf16_t; using pg8::bf16x8; using pg8::f32x4; using pg8::u32x4; using pg8::u32x2;
typedef short s16x4 __attribute__((ext_vector_type(4)));
typedef float f32x16 __attribute__((ext_vector_type(16)));
typedef short v4i16_t __attribute__((ext_vector_type(4)));

constexpr int MT = 16384, SEQ = 8192, DM = 2048, DFF = 5632, NFF2 = 11264, NIN = 6144, UW = 6144, PLE = 256;
constexpr int LDS_BYTES = 147456;
constexpr float ALPHA = 1.4142135623730951f;
constexpr float LOG2E = 1.4426950408889634f;

constexpr size_t SZ_WFI = (size_t)NFF2 * DM * 2, SZ_WFO = (size_t)DM * DFF * 2, SZ_WIN = (size_t)NIN * DM * 2, SZ_WSQ = (size_t)DM * DM * 2, SZ_WPP = (size_t)DM * PLE * 2;
constexpr size_t OFF_WFI = 0;
constexpr size_t OFF_WFO = OFF_WFI + 4 * SZ_WFI;
constexpr size_t OFF_WAB = OFF_WFO + 4 * SZ_WFO;
constexpr size_t OFF_WC = OFF_WAB + SZ_WIN;
constexpr size_t OFF_WOAB = OFF_WC + SZ_WIN;
constexpr size_t OFF_WOC = OFF_WOAB + SZ_WSQ;
constexpr size_t OFF_WPG = OFF_WOC + SZ_WSQ;
constexpr size_t OFF_WPP = OFF_WPG + 2 * SZ_WSQ;
constexpr size_t OFF_XF = OFF_WPP + 2 * SZ_WPP;
constexpr size_t OFF_XB = OFF_XF + (size_t)MT * DM * 4;
constexpr size_t OFF_Z = OFF_XB + (size_t)MT * DM * 2;
constexpr size_t OFF_H = OFF_Z + (size_t)MT * DM * 4;
constexpr size_t OFF_MIX = OFF_H + (size_t)MT * UW * 2;
constexpr size_t OFF_PB = OFF_MIX + (size_t)MT * DM * 2;
constexpr size_t OFF_GT = OFF_PB + (size_t)2 * MT * PLE * 2;
constexpr size_t OFF_QB = OFF_GT + (size_t)MT * 16 * 4;
constexpr size_t OFF_KB = OFF_QB + (size_t)MT * 512 * 2;
constexpr size_t OFF_BC = OFF_KB + (size_t)MT * 512 * 2;
constexpr size_t OFF_IP = OFF_BC + (size_t)MT * 4 * 4;
constexpr size_t OFF_MSC = OFF_IP + (size_t)MT * 4 * 4;
constexpr size_t OFF_NL = OFF_MSC + 3 * 1024 * 4;
constexpr size_t OFF_DC = OFF_NL + (size_t)8 * 128 * 128 * 4;
constexpr size_t OFF_ST = OFF_DC + (size_t)8 * 128 * 256 * 4;
constexpr size_t OFF_CTL = OFF_ST + (size_t)8 * 128 * 512 * 256 * 2;
constexpr size_t WS_NEED = OFF_CTL + 32768;

#define LDS_WAIT() asm volatile("s_waitcnt lgkmcnt(0)" ::: "memory")
__device__ __forceinline__ unsigned f2bf(float f) { unsigned u = __builtin_bit_cast(unsigned, f); return (u + 0x7fffu + ((u >> 16) & 1u)) >> 16; }
__device__ __forceinline__ unsigned pk2(float lo, float hi) { return f2bf(lo) | (f2bf(hi) << 16); }
__device__ __forceinline__ float bf2f(unsigned h) { return __uint_as_float(h << 16); }
__device__ __forceinline__ float bflo(unsigned w) { return __uint_as_float(w << 16); }
__device__ __forceinline__ float bfhi(unsigned w) { return __uint_as_float(w & 0xffff0000u); }
__device__ __forceinline__ float wave_sum(float v) {
#pragma unroll
    for (int o = 1; o < 64; o <<= 1) v += __shfl_xor(v, o);
    return v;
}
__device__ __forceinline__ float logsigmoidf_(float x) { return fminf(x, 0.f) - __logf(1.f + __expf(-fabsf(x))); }
__device__ __forceinline__ s16x4 vtr(const LAS unsigned char* p) { return __builtin_bit_cast(s16x4, __builtin_amdgcn_ds_read_tr16_b64_v4i16((LAS v4i16_t*)p)); }
__device__ __forceinline__ bf16x8 tr8(const LAS unsigned char* p0, const LAS unsigned char* p1) {
    const s16x4 a = vtr(p0), b = vtr(p1); bf16x8 r; r[0] = a[0]; r[1] = a[1]; r[2] = a[2]; r[3] = a[3]; r[4] = b[0]; r[5] = b[1]; r[6] = b[2]; r[7] = b[3]; return r;
}
__device__ __forceinline__ f32x4 mfma16(bf16x8 a, bf16x8 b, f32x4 c) { return __builtin_amdgcn_mfma_f32_16x16x32_bf16(a, b, c, 0, 0, 0); }
__device__ __forceinline__ f32x16 mfma32(bf16x8 a, bf16x8 b, f32x16 c) { return __builtin_amdgcn_mfma_f32_32x32x16_bf16(a, b, c, 0, 0, 0); }
__device__ __forceinline__ bf16x8 ldsv8(const LAS unsigned char* p) { return *(const LAS bf16x8*)p; }

struct Ctx { LAS unsigned char* lds; int tid, lane, wave, G, bid, gw, NGW; };

__device__ __forceinline__ void tr_decode(int it, int nnb, int mode, int& k0, int& n0, int& drow0, float& scale) {
    const int kb = it / nnb, nb = it - kb * nnb; k0 = 64 * kb; n0 = 64 * nb; drow0 = n0; scale = 1.f;
    if (mode == 1) { const int half = n0 >= DFF ? 1 : 0; const int j0 = n0 - half * DFF; drow0 = 256 * (j0 >> 7) + 128 * half + (j0 & 127); }
    if (mode == 2 && n0 < 1024) scale = 0.125f;
}
__device__ __forceinline__ void tr_load(float (&r)[64], const float* __restrict__ W, int N, int k0, int n0, int lane) {
    const int n = n0 + lane; const bool ok = n < N; const float* src = W + (size_t)k0 * N + (ok ? n : 0);
#pragma unroll
    for (int i = 0; i < 64; ++i) { const float v = src[(size_t)i * N]; r[i] = ok ? v : 0.f; }
}
__device__ __forceinline__ void conv_matrix(const Ctx& C, const float* W, int K, int N, int Npad, bf16_t* WT, int mode, int& base) {
    LAS float* scr = (LAS float*)(C.lds + C.wave * 16640);
    const int nnb = Npad / 64, nitems = (K / 64) * nnb, lane = C.lane;
    int first = (C.gw - base) % C.NGW; if (first < 0) first += C.NGW;
    float r[64]; int k0 = 0, n0 = 0, drow0 = 0; float scale = 1.f;
    int it = first;
    if (it < nitems) { tr_decode(it, nnb, mode, k0, n0, drow0, scale); tr_load(r, W, N, k0, n0, lane); }
    while (it < nitems) {
#pragma unroll
        for (int i = 0; i < 64; ++i) scr[i * 65 + lane] = r[i] * scale;
        const int ck0 = k0, cdrow0 = drow0;
        it += C.NGW;
        if (it < nitems) { tr_decode(it, nnb, mode, k0, n0, drow0, scale); tr_load(r, W, N, k0, n0, lane); }
        LDS_WAIT(); asm volatile("" ::: "memory");
        const int c = lane & 7;
#pragma unroll
        for (int j = 0; j < 8; ++j) { const int nn = (lane >> 3) + 8 * j; const LAS float* s = scr + (8 * c) * 65 + nn;
            u32x4 o; o.x = pk2(s[0 * 65], s[1 * 65]); o.y = pk2(s[2 * 65], s[3 * 65]); o.z = pk2(s[4 * 65], s[5 * 65]); o.w = pk2(s[6 * 65], s[7 * 65]);
            *(u32x4*)(WT + (size_t)(cdrow0 + nn) * K + ck0 + 8 * c) = o; }
        LDS_WAIT(); asm volatile("" ::: "memory");
    }
    base = (base + nitems) % C.NGW;
}
__device__ __forceinline__ void cvt_rows(const Ctx& C, const float* src, bf16_t* dst, size_t n4) {
    const size_t stride = (size_t)C.G * 512;
    for (size_t i = (size_t)C.bid * 512 + C.tid; i < n4; i += 4 * stride) {
        f32x4 v[4];
#pragma unroll
        for (int j = 0; j < 4; ++j) if (i + j * stride < n4) v[j] = *(const f32x4*)(src + 4 * (i + j * stride));
#pragma unroll
        for (int j = 0; j < 4; ++j) if (i + j * stride < n4) { u32x2 w; w.x = pk2(v[j][0], v[j][1]); w.y = pk2(v[j][2], v[j][3]); *(u32x2*)(dst + 4 * (i + j * stride)) = w; }
    }
}

template <int NG>
__device__ __forceinline__ void ln_phase(const Ctx& C, const bf16_t* Z, const float* g, const float* b, bf16_t* XB, const float* Wsrc, int ldw, int ngate, float* GT) {
    constexpr bool GATES = NG > 0;
    LAS float* WG = (LAS float*)C.lds;
    if (GATES) {
        for (int col = C.tid; col < DM; col += 512) {
            const float* src = Wsrc + (size_t)col * ldw + 6144;
#pragma unroll
            for (int gi = 0; gi < (NG > 0 ? NG : 1); ++gi) WG[gi * DM + col] = (gi < ngate) ? src[gi] : 0.f;
        }
        __syncthreads();
    }
    f32x4 gv[8], bv[8];
#pragma unroll
    for (int j = 0; j < 4; ++j) { gv[2 * j] = *(const f32x4*)(g + 512 * j + 8 * C.lane); gv[2 * j + 1] = *(const f32x4*)(g + 512 * j + 8 * C.lane + 4);
                                  bv[2 * j] = *(const f32x4*)(b + 512 * j + 8 * C.lane); bv[2 * j + 1] = *(const f32x4*)(b + 512 * j + 8 * C.lane + 4); }
    const bool grp = (C.G & 7) == 0; const int nwg_ = grp ? (C.G >> 3) * 8 : C.NGW; const int first_ = grp ? (C.bid >> 3) * 8 + C.wave : C.gw; const int base_ = grp ? 2048 * (C.bid & 7) : 0; const int lim_ = grp ? 2048 : MT;
    for (int lrow = first_; lrow < lim_; lrow += nwg_) {
        const int row = base_ + lrow;
        const bf16_t* z = Z + (size_t)row * DM + 8 * C.lane;
        u32x4 zb[4];
#pragma unroll
        for (int j = 0; j < 4; ++j) zb[j] = *(const u32x4*)(z + 512 * j);
        f32x4 v[8]; float s = 0.f;
#pragma unroll
        for (int j = 0; j < 4; ++j) { v[2 * j] = (f32x4){bflo(zb[j].x), bfhi(zb[j].x), bflo(zb[j].y), bfhi(zb[j].y)}; v[2 * j + 1] = (f32x4){bflo(zb[j].z), bfhi(zb[j].z), bflo(zb[j].w), bfhi(zb[j].w)}; }
#pragma unroll
        for (int j = 0; j < 8; ++j) s += (v[j][0] + v[j][1]) + (v[j][2] + v[j][3]);
        const float mean = wave_sum(s) * (1.f / DM); float s2 = 0.f;
#pragma unroll
        for (int j = 0; j < 8; ++j) { v[j] = v[j] - mean; s2 += (v[j][0] * v[j][0] + v[j][1] * v[j][1]) + (v[j][2] * v[j][2] + v[j][3] * v[j][3]); }
        const float rstd = __builtin_amdgcn_rsqf(wave_sum(s2) * (1.f / DM) + 1e-5f);
        bf16_t* bo = XB + (size_t)row * DM + 8 * C.lane;
#pragma unroll
        for (int j = 0; j < 4; ++j) { const f32x4 o0 = v[2 * j] * rstd * gv[2 * j] + bv[2 * j], o1 = v[2 * j + 1] * rstd * gv[2 * j + 1] + bv[2 * j + 1];
            u32x4 w; w.x = pg8::cvt_pk_bf16(o0[0], o0[1]); w.y = pg8::cvt_pk_bf16(o0[2], o0[3]); w.z = pg8::cvt_pk_bf16(o1[0], o1[1]); w.w = pg8::cvt_pk_bf16(o1[2], o1[3]); *(u32x4*)(bo + 512 * j) = w;
            if (GATES) { v[2 * j] = o0; v[2 * j + 1] = o1; } }
        if (GATES) {
            float mine = 0.f;
#pragma unroll 4
            for (int gi = 0; gi < (NG > 0 ? NG : 1); ++gi) {
                float s0 = 0.f, s1 = 0.f;
#pragma unroll
                for (int j = 0; j < 4; ++j) { const f32x4 w0 = *(const LAS f32x4*)(WG + gi * DM + 512 * j + 8 * C.lane), w1 = *(const LAS f32x4*)(WG + gi * DM + 512 * j + 8 * C.lane + 4);
                    s0 += (v[2 * j][0] * w0[0] + v[2 * j][1] * w0[1]) + (v[2 * j][2] * w0[2] + v[2 * j][3] * w0[3]);
                    s1 += (v[2 * j + 1][0] * w1[0] + v[2 * j + 1][1] * w1[1]) + (v[2 * j + 1][2] * w1[2] + v[2 * j + 1][3] * w1[3]); }
                const float tot = wave_sum(s0 + s1);
                mine = (C.lane == gi) ? tot : mine;
            }
            if (C.lane < NG) GT[(size_t)row * 16 + C.lane] = mine;
        }
    }
    if (GATES) __syncthreads();
}

__device__ __forceinline__ void m1_phase(const Ctx& C, const bf16_t* U, const float* GT, const float* conv_w, const float* conv_b, const float* b_i, const float* b_f,
                                         bf16_t* QB, bf16_t* KB, float* BC, float* IP, float* MSC) {
    if (C.bid < 8) {
        LAS float* sb = (LAS float*)C.lds; LAS float* su = sb + 128;
        const int bh = C.bid, b = bh >> 2, h = bh & 3;
        {
            const float bi = b_i[h], bf = b_f[h]; const int ln = C.lane;
            float fv[16], iv[16];
#pragma unroll
            for (int k = 0; k < 16; ++k) { const size_t row = (size_t)b * SEQ + (C.wave * 16 + k) * 64 + ln; fv[k] = GT[row * 16 + 4 + h]; iv[k] = GT[row * 16 + h]; }
#pragma unroll
            for (int k = 0; k < 16; ++k) {
                const int c = C.wave * 16 + k; const size_t row = (size_t)b * SEQ + c * 64 + ln;
                float cum = logsigmoidf_(fv[k] + bf);
#pragma unroll
                for (int off = 1; off < 64; off <<= 1) { const float t = __shfl_up(cum, off); if (ln >= off) cum += t; }
                const float ip = iv[k] + bi;
                BC[row * 4 + h] = cum; IP[row * 4 + h] = ip;
                float um = ip - cum;
#pragma unroll
                for (int off = 1; off < 64; off <<= 1) um = fmaxf(um, __shfl_xor(um, off));
                const float bl = __shfl(cum, 63);
                if (ln == 0) { sb[c] = bl; su[c] = um; }
            }
        }
        __syncthreads();
        if (C.tid == 0) {
            float m = 0.f;
#pragma unroll 1
            for (int c = 0; c < 128; ++c) {
                const float bl = sb[c], mn = fmaxf(bl + m, bl + su[c]);
                MSC[bh * 128 + c] = m; MSC[1024 + bh * 128 + c] = mn; MSC[2048 + bh * 128 + c] = __expf(bl + m - mn); m = mn;
            }
        }
        __syncthreads();
    }
    {
        const int c0 = (int)(((size_t)C.bid * 512 + C.tid) & 127) * 8;
        f32x4 w0[4], w1[4];
#pragma unroll
        for (int j = 0; j < 4; ++j) { w0[j] = *(const f32x4*)(conv_w + j * 1024 + c0); w1[j] = *(const f32x4*)(conv_w + j * 1024 + c0 + 4); }
        const f32x4 cb0 = *(const f32x4*)(conv_b + c0), cb1 = *(const f32x4*)(conv_b + c0 + 4);
        const float sc = (c0 < 512) ? 0.08838834764831845f : 1.f;
        for (size_t i = (size_t)C.bid * 512 + C.tid; i < (size_t)MT * 128; i += (size_t)C.G * 512) {
            const int row = (int)(i >> 7), t = row & (SEQ - 1);
            float acc[8] = {cb0[0], cb0[1], cb0[2], cb0[3], cb1[0], cb1[1], cb1[2], cb1[3]};
#pragma unroll
            for (int j = 0; j < 4; ++j) {
                const int tt = t - 3 + j;
                if (tt >= 0) {
                    const u32x4 xv = *(const u32x4*)(U + (size_t)(row - 3 + j) * UW + 3072 + c0);
                    acc[0] += w0[j][0] * bflo(xv.x); acc[1] += w0[j][1] * bfhi(xv.x); acc[2] += w0[j][2] * bflo(xv.y); acc[3] += w0[j][3] * bfhi(xv.y);
                    acc[4] += w1[j][0] * bflo(xv.z); acc[5] += w1[j][1] * bfhi(xv.z); acc[6] += w1[j][2] * bflo(xv.w); acc[7] += w1[j][3] * bfhi(xv.w);
                }
            }
#pragma unroll
            for (int e = 0; e < 8; ++e) acc[e] = acc[e] * pg8::sigmoidf_(acc[e]) * sc;
            u32x4 w; w.x = pk2(acc[0], acc[1]); w.y = pk2(acc[2], acc[3]); w.z = pk2(acc[4], acc[5]); w.w = pk2(acc[6], acc[7]);
            if (c0 < 512) *(u32x4*)(QB + (size_t)row * 512 + c0) = w; else *(u32x4*)(KB + (size_t)row * 512 + c0 - 512) = w;
        }
    }
}

__device__ __forceinline__ void mlstm_passA(const Ctx& C, const bf16_t* U, const bf16_t* KB, const float* BC, const float* IP, const float* MSC, bf16_t* ST, float* NL) {
    LAS unsigned char* KW = C.lds; LAS unsigned char* V = C.lds + 17408; LAS float* wk = (LAS float*)(C.lds + 52224);
    const int l = C.lane, g = l >> 4, q = (l & 15) >> 2, p = l & 3, w = C.wave;
    for (int u = C.bid; u < 1024; u += C.G) {
        const int bh = u >> 7, c = u & 127, b = bh >> 2, h = bh & 3; const size_t row0 = (size_t)b * SEQ + c * 64;
        if (C.tid < 64) { const float bl = BC[(row0 + 63) * 4 + h], mn = MSC[1024 + bh * 128 + c]; wk[C.tid] = __expf(bl - BC[(row0 + C.tid) * 4 + h] + IP[(row0 + C.tid) * 4 + h] - mn); }
        __syncthreads();
        { const int s = C.tid >> 3, seg = C.tid & 7; const float ws = wk[s];
          const bf16_t* kp = KB + (row0 + s) * 512 + h * 128 + seg * 16;
#pragma unroll
          for (int i = 0; i < 2; ++i) { const u32x4 kv = *(const u32x4*)(kp + 8 * i); u32x4 o;
              o.x = pk2(bflo(kv.x) * ws, bfhi(kv.x) * ws); o.y = pk2(bflo(kv.y) * ws, bfhi(kv.y) * ws); o.z = pk2(bflo(kv.z) * ws, bfhi(kv.z) * ws); o.w = pk2(bflo(kv.w) * ws, bfhi(kv.w) * ws);
              *(LAS u32x4*)(KW + s * 272 + seg * 32 + 16 * i) = o; }
          const bf16_t* vp = U + (row0 + s) * UW + 4096 + h * 256 + seg * 32;
#pragma unroll
          for (int i = 0; i < 4; ++i) *(LAS u32x4*)(V + s * 544 + seg * 64 + 16 * i) = *(const u32x4*)(vp + 8 * i); }
        __syncthreads();
        f32x4 acc[2][8];
#pragma unroll
        for (int mi = 0; mi < 2; ++mi)
#pragma unroll
            for (int ni = 0; ni < 8; ++ni) acc[mi][ni] = (f32x4){0.f, 0.f, 0.f, 0.f};
#pragma unroll
        for (int ks = 0; ks < 2; ++ks) {
            const int r0 = 32 * ks + 8 * g + q;
            bf16x8 a[2];
#pragma unroll
            for (int mi = 0; mi < 2; ++mi) { const LAS unsigned char* ap = V + r0 * 544 + (32 * w + 16 * mi + 4 * p) * 2; a[mi] = tr8(ap, ap + 4 * 544); }
#pragma unroll
            for (int ni = 0; ni < 8; ++ni) { const LAS unsigned char* bp = KW + r0 * 272 + (16 * ni + 4 * p) * 2; const bf16x8 bb = tr8(bp, bp + 4 * 272);
#pragma unroll
                for (int mi = 0; mi < 2; ++mi) acc[mi][ni] = mfma16(bb, a[mi], acc[mi][ni]); }
        }
        bf16_t* st = ST + ((size_t)(bh * 128 + c) << 15);
#pragma unroll
        for (int mi = 0; mi < 2; ++mi)
#pragma unroll
            for (int ni = 0; ni < 8; ++ni) { u32x2 wv; wv.x = pg8::cvt_pk_bf16(acc[mi][ni][0], acc[mi][ni][1]); wv.y = pg8::cvt_pk_bf16(acc[mi][ni][2], acc[mi][ni][3]);
                *(u32x2*)(st + (32 * w + 16 * mi + (l & 15)) * 128 + 16 * ni + 4 * g) = wv; }
        if (C.tid < 128) { float s = 0.f;
#pragma unroll 4
            for (int t = 0; t < 64; ++t) s += bf2f(*(const LAS unsigned short*)(KW + t * 272 + C.tid * 2)); NL[(size_t)(bh * 128 + c) * 128 + C.tid] = s; }
        __syncthreads();
    }
}

__device__ __forceinline__ void mlstm_scan(const Ctx& C, bf16_t* ST, float* NL, const float* MSC) {
    for (int e2 = C.bid * 512 + C.tid; e2 < 8 * 16384; e2 += C.G * 512) {
        const int bh = e2 >> 14, off = e2 & 16383; float c0 = 0.f, c1 = 0.f;
        unsigned* p = (unsigned*)(ST + ((size_t)(bh * 128) << 15)) + off;
#pragma unroll 1
        for (int cb = 0; cb < 128; cb += 8) {
            unsigned t[8]; float d[8];
#pragma unroll
            for (int i = 0; i < 8; ++i) { t[i] = p[(size_t)(cb + i) << 14]; d[i] = MSC[2048 + bh * 128 + cb + i]; }
#pragma unroll
            for (int i = 0; i < 8; ++i) { p[(size_t)(cb + i) << 14] = pk2(c0, c1); c0 = d[i] * c0 + bflo(t[i]); c1 = d[i] * c1 + bfhi(t[i]); }
        }
    }
    const int gt = C.bid * 512 + C.tid;
    if (gt < 1024) { const int bh = gt >> 7, dk = gt & 127; float n = 0.f;
#pragma unroll 2
        for (int c = 0; c < 128; ++c) { float* p = NL + (size_t)(bh * 128 + c) * 128 + dk; const float t = *p; *p = n; n = MSC[2048 + bh * 128 + c] * n + t; } }
}

__device__ __forceinline__ void mlstm_passC(const Ctx& C, const bf16_t* U, const bf16_t* QB, const bf16_t* KB, const float* BC, const float* IP, const float* MSC,
                                            const bf16_t* ST, const float* NL, const float* mg, bf16_t* MIX) {
    LAS unsigned char* Q = C.lds; LAS unsigned char* K = C.lds + 17408; LAS unsigned char* V = C.lds + 34816; LAS unsigned char* SW = C.lds + 69632;
    LAS float* fu = (LAS float*)(C.lds + 78848); LAS float* fM = fu + 64; LAS float* fw = fu + 128; LAS float* fb = fu + 192; LAS float* finv = fu + 256; LAS float* fn = fu + 320; LAS float* fss = fu + 448;
    const int l = C.lane, g = l >> 4, q = (l & 15) >> 2, p = l & 3, w = C.wave, lr = l & 15;
    for (int u = C.bid; u < 1024; u += C.G) {
        const int bh = u >> 7, c = u & 127, b = bh >> 2, h = bh & 3; const size_t row0 = (size_t)b * SEQ + c * 64;
        const float mprev = MSC[bh * 128 + c];
        if (C.tid < 64) { const float bt = BC[(row0 + C.tid) * 4 + h]; fb[C.tid] = bt; fu[C.tid] = IP[(row0 + C.tid) * 4 + h] - bt; }
        if (C.tid >= 64 && C.tid < 192) fn[C.tid - 64] = NL[(size_t)(bh * 128 + c) * 128 + C.tid - 64];
        { const int s = C.tid >> 3, seg = C.tid & 7;
          const bf16_t* qp = QB + (row0 + s) * 512 + h * 128 + seg * 16; const bf16_t* kp = KB + (row0 + s) * 512 + h * 128 + seg * 16;
#pragma unroll
          for (int i = 0; i < 2; ++i) { *(LAS u32x4*)(Q + s * 272 + seg * 32 + 16 * i) = *(const u32x4*)(qp + 8 * i); *(LAS u32x4*)(K + s * 272 + seg * 32 + 16 * i) = *(const u32x4*)(kp + 8 * i); }
          const bf16_t* vp = U + (row0 + s) * UW + 4096 + h * 256 + seg * 32;
#pragma unroll
          for (int i = 0; i < 4; ++i) *(LAS u32x4*)(V + s * 544 + seg * 64 + 16 * i) = *(const u32x4*)(vp + 8 * i); }
        __syncthreads();
        if (C.tid < 64) { float pm = -3.0e38f;
#pragma unroll 1
            for (int s = 0; s <= C.tid; ++s) pm = fmaxf(pm, fu[s]); const float Mt = fmaxf(mprev, pm); fM[C.tid] = Mt; fw[C.tid] = __expf(mprev - Mt); }
        __syncthreads();
#pragma unroll
        for (int tt = 0; tt < 2; ++tt) {
            const int tile = 2 * w + tt, ti = tile >> 2, si = tile & 3;
            f32x4 s4 = (f32x4){0.f, 0.f, 0.f, 0.f};
            if (si <= ti) {
#pragma unroll
                for (int ks = 0; ks < 4; ++ks) { const bf16x8 a = ldsv8(Q + (16 * ti + lr) * 272 + (32 * ks + 8 * g) * 2), bb = ldsv8(K + (16 * si + lr) * 272 + (32 * ks + 8 * g) * 2); s4 = mfma16(a, bb, s4); }
            }
            const int sidx = 16 * si + lr; const float us = fu[sidx];
#pragma unroll
            for (int j = 0; j < 4; ++j) { const int t = 16 * ti + 4 * g + j; const float wgt = (sidx <= t) ? __expf(us - fM[t]) : 0.f;
                *(LAS unsigned short*)(SW + t * 144 + sidx * 2) = (unsigned short)f2bf(s4[j] * wgt); }
        }
        __syncthreads();
        if (C.tid < 64) { const int t = C.tid; float rs = 0.f, qn = 0.f;
#pragma unroll 4
            for (int s = 0; s < 64; ++s) rs += bf2f(*(const LAS unsigned short*)(SW + t * 144 + s * 2));
#pragma unroll 4
            for (int d = 0; d < 128; ++d) qn += bf2f(*(const LAS unsigned short*)(Q + t * 272 + d * 2)) * fn[d];
            const float den = fw[t] * qn + rs; finv[t] = __builtin_amdgcn_rcpf(fmaxf(fabsf(den), __expf(-(fb[t] + fM[t])))); }
        f32x4 acc[4][2];
#pragma unroll
        for (int mi = 0; mi < 4; ++mi)
#pragma unroll
            for (int ni = 0; ni < 2; ++ni) acc[mi][ni] = (f32x4){0.f, 0.f, 0.f, 0.f};
        const bf16_t* st = ST + ((size_t)(bh * 128 + c) << 15);
#pragma unroll
        for (int ks = 0; ks < 4; ++ks) {
            bf16x8 bb[2];
#pragma unroll
            for (int ni = 0; ni < 2; ++ni) bb[ni] = *(const bf16x8*)(st + (32 * w + 16 * ni + lr) * 128 + 32 * ks + 8 * g);
#pragma unroll
            for (int mi = 0; mi < 4; ++mi) { const bf16x8 a = ldsv8(Q + (16 * mi + lr) * 272 + (32 * ks + 8 * g) * 2);
#pragma unroll
                for (int ni = 0; ni < 2; ++ni) acc[mi][ni] = mfma16(bb[ni], a, acc[mi][ni]); }
        }
#pragma unroll
        for (int mi = 0; mi < 4; ++mi) { const float wi = fw[16 * mi + lr]; acc[mi][0] = acc[mi][0] * wi; acc[mi][1] = acc[mi][1] * wi; }
#pragma unroll
        for (int ks = 0; ks < 2; ++ks) {
            const int r0 = 32 * ks + 8 * g + q; bf16x8 bb[2];
#pragma unroll
            for (int ni = 0; ni < 2; ++ni) { const LAS unsigned char* bp = V + r0 * 544 + (32 * w + 16 * ni + 4 * p) * 2; bb[ni] = tr8(bp, bp + 4 * 544); }
#pragma unroll
            for (int mi = 0; mi < 4; ++mi) { const bf16x8 a = ldsv8(SW + (16 * mi + lr) * 144 + (32 * ks + 8 * g) * 2);
#pragma unroll
                for (int ni = 0; ni < 2; ++ni) acc[mi][ni] = mfma16(bb[ni], a, acc[mi][ni]); }
        }
        __syncthreads();
#pragma unroll
        for (int mi = 0; mi < 4; ++mi) { const float iv = finv[16 * mi + lr]; acc[mi][0] = acc[mi][0] * iv; acc[mi][1] = acc[mi][1] * iv;
            float ss = 0.f;
#pragma unroll
            for (int ni = 0; ni < 2; ++ni) ss += (acc[mi][ni][0] * acc[mi][ni][0] + acc[mi][ni][1] * acc[mi][ni][1]) + (acc[mi][ni][2] * acc[mi][ni][2] + acc[mi][ni][3] * acc[mi][ni][3]);
            ss += __shfl_xor(ss, 16); ss += __shfl_xor(ss, 32);
            if (g == 0) fss[w * 64 + 16 * mi + lr] = ss; }
        __syncthreads();
#pragma unroll
        for (int mi = 0; mi < 4; ++mi) { const int t = 16 * mi + lr; float tot = 0.f;
#pragma unroll
            for (int ww = 0; ww < 8; ++ww) tot += fss[ww * 64 + t];
            const float r = __builtin_amdgcn_rsqf(tot * (1.f / 256.f) + 1e-6f);
#pragma unroll
            for (int ni = 0; ni < 2; ++ni) { const int dv = 32 * w + 16 * ni + 4 * g;
                const u32x2 ogb = *(const u32x2*)(U + (row0 + t) * UW + 5120 + h * 256 + dv); const f32x4 gv = *(const f32x4*)(mg + h * 256 + dv);
                const float o0 = acc[mi][ni][0] * r * gv[0] * pg8::sigmoidf_(bflo(ogb.x)), o1 = acc[mi][ni][1] * r * gv[1] * pg8::sigmoidf_(bfhi(ogb.x));
                const float o2 = acc[mi][ni][2] * r * gv[2] * pg8::sigmoidf_(bflo(ogb.y)), o3 = acc[mi][ni][3] * r * gv[3] * pg8::sigmoidf_(bfhi(ogb.y));
                u32x2 wv; wv.x = pg8::cvt_pk_bf16(o0, o1); wv.y = pg8::cvt_pk_bf16(o2, o3);
                *(u32x2*)(MIX + (row0 + t) * DM + 1024 + h * 256 + dv) = wv; } }
        __syncthreads();
    }
}

__device__ __forceinline__ float gla_decay(const Ctx& C, const float* w_a2, const float* b_a, int h, LAS float* A1, LAS float* tot0, LAS unsigned char* QD, LAS unsigned char* KD) {
    const int ch = C.tid & 255, half = C.tid >> 8, t0 = 32 * half;
    float wv[16];
#pragma unroll
    for (int i = 0; i < 16; ++i) wv[i] = w_a2[i * 1024 + h * 256 + ch];
    const float ba = b_a[h * 256 + ch];
    float c[32]; float run = 0.f;
#pragma unroll
    for (int i = 0; i < 32; ++i) {
        const LAS float* ap = A1 + (t0 + i) * 16;
        const f32x4 a0 = *(const LAS f32x4*)(ap), a1 = *(const LAS f32x4*)(ap + 4), a2 = *(const LAS f32x4*)(ap + 8), a3 = *(const LAS f32x4*)(ap + 12);
        float z0 = ba, z1 = 0.f, z2 = 0.f, z3 = 0.f;
#pragma unroll
        for (int j = 0; j < 4; ++j) { z0 += a0[j] * wv[j]; z1 += a1[j] * wv[4 + j]; z2 += a2[j] * wv[8 + j]; z3 += a3[j] * wv[12 + j]; }
        const float z = (z0 + z1) + (z2 + z3);
        run += (fminf(z, 0.f) - __logf(1.f + __expf(-fabsf(z)))) * 0.0625f;
        c[i] = run;
    }
    if (half == 0) tot0[ch] = run;
    __syncthreads();
    const float off = half ? tot0[ch] : 0.f;
#pragma unroll
    for (int i = 0; i < 32; ++i) {
        const float cum = c[i] + off; const int t = t0 + i;
        LAS unsigned short* kp = (LAS unsigned short*)(KD + t * 528 + ch * 2); *kp = (unsigned short)f2bf(bf2f(*kp) * __expf(-cum));
        LAS unsigned short* qp = (LAS unsigned short*)(QD + t * 528 + ch * 2); *qp = (unsigned short)f2bf(bf2f(*qp) * __expf(cum) * 0.0625f);
    }
    return __expf(c[31] + off);
}

__device__ __forceinline__ void gla_passA(const Ctx& C, const bf16_t* U, const float* GT, const float* w_a2, const float* b_a, bf16_t* ST, float* DC, bf16_t* QDG, bf16_t* KDG) {
    LAS unsigned char* QD = C.lds; LAS unsigned char* KD = C.lds + 33792; LAS unsigned char* V = C.lds + 67584;
    LAS float* A1 = (LAS float*)(C.lds + 135168); LAS float* bl = (LAS float*)(C.lds + 139264); LAS float* tot0 = (LAS float*)(C.lds + 140288);
    const int l = C.lane, g = l >> 4, q = (l & 15) >> 2, p = l & 3, w = C.wave, lr = l & 15;
    for (int u = C.bid; u < 1024; u += C.G) {
        const int bh = u >> 7, c = u & 127, b = bh >> 2, h = bh & 3; const size_t row0 = (size_t)b * SEQ + c * 64;
        A1[C.tid] = GT[row0 * 16 + C.tid]; A1[C.tid + 512] = GT[row0 * 16 + C.tid + 512];
        { const int s = C.tid >> 3, seg = C.tid & 7; const bf16_t* vp = U + (row0 + s) * UW + 2048 + h * 512 + seg * 64;
#pragma unroll
          for (int i = 0; i < 8; ++i) *(LAS u32x4*)(V + s * 1056 + seg * 128 + 16 * i) = *(const u32x4*)(vp + 8 * i);
          const bf16_t* qp = U + (row0 + s) * UW + h * 256 + seg * 32;
#pragma unroll
          for (int i = 0; i < 4; ++i) { *(LAS u32x4*)(QD + s * 528 + seg * 64 + 16 * i) = *(const u32x4*)(qp + 8 * i); *(LAS u32x4*)(KD + s * 528 + seg * 64 + 16 * i) = *(const u32x4*)(qp + 1024 + 8 * i); } }
        __syncthreads();
        const float eb = gla_decay(C, w_a2, b_a, h, A1, tot0, QD, KD);
        if (C.tid >= 256) { bl[C.tid - 256] = eb; DC[(size_t)(bh * 128 + c) * 256 + C.tid - 256] = eb; }
        __syncthreads();
        { const int s = C.tid >> 3, seg = C.tid & 7; bf16_t* qg = QDG + (row0 + s) * 1024 + h * 256 + seg * 32; bf16_t* kg = KDG + (row0 + s) * 1024 + h * 256 + seg * 32;
#pragma unroll
          for (int i = 0; i < 4; ++i) { *(u32x4*)(qg + 8 * i) = *(const LAS u32x4*)(QD + s * 528 + seg * 64 + 16 * i); *(u32x4*)(kg + 8 * i) = *(const LAS u32x4*)(KD + s * 528 + seg * 64 + 16 * i); } }
#pragma unroll 1
        for (int dvq = 0; dvq < 4; ++dvq) {
            f32x4 acc[16];
#pragma unroll
            for (int ni = 0; ni < 16; ++ni) acc[ni] = (f32x4){0.f, 0.f, 0.f, 0.f};
#pragma unroll
            for (int ks = 0; ks < 2; ++ks) {
                const int r0 = 32 * ks + 8 * g + q;
                const LAS unsigned char* ap = V + r0 * 1056 + (dvq * 128 + 16 * w + 4 * p) * 2; const bf16x8 a = tr8(ap, ap + 4 * 1056);
#pragma unroll
                for (int ni = 0; ni < 16; ++ni) { const LAS unsigned char* bp = KD + r0 * 528 + (16 * ni + 4 * p) * 2; acc[ni] = mfma16(tr8(bp, bp + 4 * 528), a, acc[ni]); }
            }
            bf16_t* st = ST + ((size_t)(bh * 128 + c) << 17) + (size_t)(dvq * 128 + 16 * w + lr) * 256 + 4 * g;
#pragma unroll
            for (int ni = 0; ni < 16; ++ni) { const f32x4 e4 = *(const LAS f32x4*)(bl + 16 * ni + 4 * g); const f32x4 v4 = acc[ni] * e4;
                u32x2 wv; wv.x = pg8::cvt_pk_bf16(v4[0], v4[1]); wv.y = pg8::cvt_pk_bf16(v4[2], v4[3]); *(u32x2*)(st + 16 * ni) = wv; }
        }
        __syncthreads();
    }
}

__device__ __forceinline__ void gla_scan(const Ctx& C, bf16_t* ST, const float* DC) {
    for (int e8 = C.bid * 512 + C.tid; e8 < 8 * 16384; e8 += C.G * 512) {
        const int bh = e8 >> 14, off = e8 & 16383, dk = (off * 8) & 255;
        float s[8];
#pragma unroll
        for (int i = 0; i < 8; ++i) s[i] = 0.f;
        u32x4* p = (u32x4*)(ST + ((size_t)(bh * 128) << 17)) + off;
#pragma unroll 1
        for (int cb = 0; cb < 128; cb += 4) {
            u32x4 t[4]; f32x4 d0[4], d1[4];
#pragma unroll
            for (int i = 0; i < 4; ++i) { t[i] = p[(size_t)(cb + i) << 14]; const float* d = DC + (size_t)(bh * 128 + cb + i) * 256 + dk; d0[i] = *(const f32x4*)d; d1[i] = *(const f32x4*)(d + 4); }
#pragma unroll
            for (int i = 0; i < 4; ++i) {
                u32x4 o; o.x = pk2(s[0], s[1]); o.y = pk2(s[2], s[3]); o.z = pk2(s[4], s[5]); o.w = pk2(s[6], s[7]); p[(size_t)(cb + i) << 14] = o;
                s[0] = d0[i][0] * s[0] + bflo(t[i].x); s[1] = d0[i][1] * s[1] + bfhi(t[i].x); s[2] = d0[i][2] * s[2] + bflo(t[i].y); s[3] = d0[i][3] * s[3] + bfhi(t[i].y);
                s[4] = d1[i][0] * s[4] + bflo(t[i].z); s[5] = d1[i][1] * s[5] + bfhi(t[i].z); s[6] = d1[i][2] * s[6] + bflo(t[i].w); s[7] = d1[i][3] * s[7] + bfhi(t[i].w);
            }
        }
    }
}

__device__ __forceinline__ void gla_passC(const Ctx& C, const bf16_t* U, const bf16_t* QDG, const bf16_t* KDG, const bf16_t* ST, const float* gg, bf16_t* MIX) {
    LAS unsigned char* QD = C.lds; LAS unsigned char* KD = C.lds + 33792; LAS unsigned char* V = C.lds + 67584; LAS unsigned char* ATT = C.lds + 135168;
    LAS float* fss = (LAS float*)(C.lds + 144384);
    const int l = C.lane, g = l >> 4, q = (l & 15) >> 2, p = l & 3, w = C.wave, lr = l & 15;
    for (int u = C.bid; u < 1024; u += C.G) {
        const int bh = u >> 7, c = u & 127, b = bh >> 2, h = bh & 3; const size_t row0 = (size_t)b * SEQ + c * 64;
        { const int s = C.tid >> 3, seg = C.tid & 7; const bf16_t* vp = U + (row0 + s) * UW + 2048 + h * 512 + seg * 64;
#pragma unroll
          for (int i = 0; i < 8; ++i) *(LAS u32x4*)(V + s * 1056 + seg * 128 + 16 * i) = *(const u32x4*)(vp + 8 * i);
          const bf16_t* qg = QDG + (row0 + s) * 1024 + h * 256 + seg * 32; const bf16_t* kg = KDG + (row0 + s) * 1024 + h * 256 + seg * 32;
#pragma unroll
          for (int i = 0; i < 4; ++i) { *(LAS u32x4*)(QD + s * 528 + seg * 64 + 16 * i) = *(const u32x4*)(qg + 8 * i); *(LAS u32x4*)(KD + s * 528 + seg * 64 + 16 * i) = *(const u32x4*)(kg + 8 * i); } }
        __syncthreads();
#pragma unroll
        for (int tt = 0; tt < 2; ++tt) {
            const int tile = 2 * w + tt, ti = tile >> 2, si = tile & 3;
            f32x4 s4 = (f32x4){0.f, 0.f, 0.f, 0.f};
            if (si <= ti) {
#pragma unroll
                for (int ks = 0; ks < 8; ++ks) { const bf16x8 a = ldsv8(QD + (16 * ti + lr) * 528 + (32 * ks + 8 * g) * 2), bb = ldsv8(KD + (16 * si + lr) * 528 + (32 * ks + 8 * g) * 2); s4 = mfma16(a, bb, s4); }
            }
            const int sidx = 16 * si + lr;
#pragma unroll
            for (int j = 0; j < 4; ++j) { const int t = 16 * ti + 4 * g + j; *(LAS unsigned short*)(ATT + t * 144 + sidx * 2) = (unsigned short)f2bf((sidx <= t) ? s4[j] : 0.f); }
        }
        __syncthreads();
        f32x4 acc[4][4];
#pragma unroll
        for (int mi = 0; mi < 4; ++mi)
#pragma unroll
            for (int ni = 0; ni < 4; ++ni) acc[mi][ni] = (f32x4){0.f, 0.f, 0.f, 0.f};
        const bf16_t* st = ST + ((size_t)(bh * 128 + c) << 17);
#pragma unroll 4
        for (int ks = 0; ks < 8; ++ks) {
            bf16x8 bb[4];
#pragma unroll
            for (int ni = 0; ni < 4; ++ni) bb[ni] = *(const bf16x8*)(st + (size_t)(64 * w + 16 * ni + lr) * 256 + 32 * ks + 8 * g);
#pragma unroll
            for (int mi = 0; mi < 4; ++mi) { const bf16x8 a = ldsv8(QD + (16 * mi + lr) * 528 + (32 * ks + 8 * g) * 2);
#pragma unroll
                for (int ni = 0; ni < 4; ++ni) acc[mi][ni] = mfma16(bb[ni], a, acc[mi][ni]); }
        }
#pragma unroll
        for (int ks = 0; ks < 2; ++ks) {
            const int r0 = 32 * ks + 8 * g + q; bf16x8 bb[4];
#pragma unroll
            for (int ni = 0; ni < 4; ++ni) { const LAS unsigned char* bp = V + r0 * 1056 + (64 * w + 16 * ni + 4 * p) * 2; bb[ni] = tr8(bp, bp + 4 * 1056); }
#pragma unroll
            for (int mi = 0; mi < 4; ++mi) { const bf16x8 a = ldsv8(ATT + (16 * mi + lr) * 144 + (32 * ks + 8 * g) * 2);
#pragma unroll
                for (int ni = 0; ni < 4; ++ni) acc[mi][ni] = mfma16(bb[ni], a, acc[mi][ni]); }
        }
#pragma unroll
        for (int mi = 0; mi < 4; ++mi) { float ss = 0.f;
#pragma unroll
            for (int ni = 0; ni < 4; ++ni) ss += (acc[mi][ni][0] * acc[mi][ni][0] + acc[mi][ni][1] * acc[mi][ni][1]) + (acc[mi][ni][2] * acc[mi][ni][2] + acc[mi][ni][3] * acc[mi][ni][3]);
            ss += __shfl_xor(ss, 16); ss += __shfl_xor(ss, 32);
            if (g == 0) fss[w * 64 + 16 * mi + lr] = ss; }
        __syncthreads();
#pragma unroll
        for (int mi = 0; mi < 4; ++mi) { const int t = 16 * mi + lr; float tot = 0.f;
#pragma unroll
            for (int ww = 0; ww < 8; ++ww) tot += fss[ww * 64 + t];
            const float r = __builtin_amdgcn_rsqf(tot * (1.f / 512.f) + 1e-6f);
#pragma unroll
            for (int ni = 0; ni < 4; ++ni) { const int dv = 64 * w + 16 * ni + 4 * g;
                const u32x2 rgb = *(const u32x2*)(U + (row0 + t) * UW + 4096 + h * 512 + dv); const f32x4 gv = *(const f32x4*)(gg + h * 512 + dv);
                const float r0 = bflo(rgb.x), r1 = bfhi(rgb.x), r2 = bflo(rgb.y), r3 = bfhi(rgb.y);
                const float o0 = acc[mi][ni][0] * r * gv[0] * r0 * pg8::sigmoidf_(r0), o1 = acc[mi][ni][1] * r * gv[1] * r1 * pg8::sigmoidf_(r1);
                const float o2 = acc[mi][ni][2] * r * gv[2] * r2 * pg8::sigmoidf_(r2), o3 = acc[mi][ni][3] * r * gv[3] * r3 * pg8::sigmoidf_(r3);
                u32x2 wv; wv.x = pg8::cvt_pk_bf16(o0, o1); wv.y = pg8::cvt_pk_bf16(o2, o3);
                *(u32x2*)(MIX + (row0 + t) * DM + h * 512 + dv) = wv; } }
        __syncthreads();
    }
}

__device__ __forceinline__ int crow(int r, int hi) { return (r & 3) + 8 * (r >> 2) + 4 * hi; }
__device__ __forceinline__ void attn_unit(const Ctx& C, const bf16_t* U, const float* rel_bias, const float* dg, float lam, int b, int h, int qb, bf16_t* MIX) {
    LAS unsigned char* KT0 = C.lds; LAS unsigned char* VT0 = C.lds + 2 * 17408; LAS float* tab = (LAS float*)(C.lds + 131072); LAS float* OX = (LAS float*)(C.lds);
    constexpr int KS = 272, VS = 320;
    const int l = C.lane, ql = l & 31, hi = l >> 5, g = l >> 4, qq = (l & 15) >> 2, pp = l & 3, w = C.wave, comp = w >> 2, rw = w & 3;
    const int qpos = qb * 128 + 32 * rw + ql;
    const size_t rowq = (size_t)b * SEQ + qpos;
    __syncthreads();
    if (C.tid < 128) { const int n = C.tid; int bk;
        if (n < 16) bk = n; else { bk = 16 + (int)(__logf((float)n * 0.0625f) / 2.0794415416798357f * 16.f); bk = bk < 31 ? bk : 31; }
        tab[n] = rel_bias[bk * 8 + h] * LOG2E; }
    const float b31 = rel_bias[31 * 8 + h] * LOG2E;
    LAS unsigned char* QT = C.lds + 96256;
    { const int row = C.tid >> 2, part = C.tid & 3; const bf16_t* qsrc = U + ((size_t)b * SEQ + qb * 128 + row) * UW + h * 128 + part * 32;
#pragma unroll
      for (int i = 0; i < 4; ++i) *(LAS u32x4*)(QT + row * 272 + part * 64 + 16 * i) = *(const u32x4*)(qsrc + 8 * i); }
    const LAS unsigned char* qfrag = QT + (32 * rw + ql) * 272 + (comp * 64 + 8 * hi) * 2;
    f32x16 o[4];
#pragma unroll
    for (int mb = 0; mb < 4; ++mb)
#pragma unroll
        for (int r = 0; r < 16; ++r) o[mb][r] = 0.f;
    float mrun = -1.0e30f, lrun = 0.f;
    u32x4 kreg[2], vreg[2];
    const bf16_t* srcb = U + ((size_t)b * SEQ + (C.tid >> 4)) * UW + h * 128 + (C.tid & 15) * 8;
    const int ntiles = 2 * (qb + 1);
#pragma unroll
    for (int i = 0; i < 2; ++i) { kreg[i] = *(const u32x4*)(srcb + (size_t)(32 * i) * UW + 1024); vreg[i] = *(const u32x4*)(srcb + (size_t)(32 * i) * UW + 2048); }
#pragma unroll
    for (int i = 0; i < 2; ++i) { const int key = (C.tid >> 4) + 32 * i, seg = C.tid & 15;
        *(LAS u32x4*)(KT0 + key * KS + seg * 16) = kreg[i]; *(LAS u32x4*)(VT0 + key * VS + seg * 16) = vreg[i]; }
#pragma unroll
    for (int i = 0; i < 2; ++i) { kreg[i] = *(const u32x4*)(srcb + (size_t)(64 + 32 * i) * UW + 1024); vreg[i] = *(const u32x4*)(srcb + (size_t)(64 + 32 * i) * UW + 2048); }
    int vs_cur = 0, vs_prev = 0; const bool rot = comp == 1;
    bf16x8 pb[4];
#pragma unroll
    for (int i = 0; i < 4; ++i) pb[i] = (bf16x8){0, 0, 0, 0, 0, 0, 0, 0};
#define ATT_PV(VSLOT) do { const LAS unsigned char* vb_ = VT0 + (VSLOT) * 20480 + (4 * hi + qq) * VS + (16 * (g & 1) + 4 * pp) * 2; _Pragma("unroll") for (int k2 = 0; k2 < 2; ++k2) _Pragma("unroll") for (int ks = 0; ks < 2; ++ks) { \
        bf16x8 af_[4]; _Pragma("unroll") for (int mb = 0; mb < 4; ++mb) { const LAS unsigned char* ap = vb_ + (32 * k2 + 16 * ks) * VS + 64 * mb; af_[mb] = tr8(ap, ap + 8 * VS); } \
        __builtin_amdgcn_sched_barrier(0); \
        _Pragma("unroll") for (int mb = 0; mb < 4; ++mb) o[mb] = mfma32(af_[mb], pb[2 * k2 + ks], o[mb]); } } while (0)
    for (int kt = 0; kt < ntiles; ++kt) {
        const int kb = kt * 64;
        __syncthreads();
        LAS unsigned char* KT = KT0 + (kt & 1) * 17408; LAS unsigned char* VT = VT0 + vs_cur * 20480;
        const int vs_nxt = vs_cur == 2 ? 0 : vs_cur + 1;
        if (kt + 1 < ntiles) {
            LAS unsigned char* KN = KT0 + ((kt + 1) & 1) * 17408; LAS unsigned char* VN = VT0 + vs_nxt * 20480;
#pragma unroll
            for (int i = 0; i < 2; ++i) { const int key = (C.tid >> 4) + 32 * i, seg = C.tid & 15;
                *(LAS u32x4*)(KN + key * KS + seg * 16) = kreg[i]; *(LAS u32x4*)(VN + key * VS + seg * 16) = vreg[i]; }
            if (kt + 2 < ntiles) {
#pragma unroll
                for (int i = 0; i < 2; ++i) { kreg[i] = *(const u32x4*)(srcb + (size_t)(kb + 128 + 32 * i) * UW + 1024); vreg[i] = *(const u32x4*)(srcb + (size_t)(kb + 128 + 32 * i) * UW + 2048); }
            }
        }
        if (rot && kt > 0) ATT_PV(vs_prev);
        __builtin_amdgcn_sched_barrier(0);
        f32x16 st[2];
#pragma unroll
        for (int k2 = 0; k2 < 2; ++k2) {
#pragma unroll
            for (int r = 0; r < 16; ++r) st[k2][r] = 0.f;
#pragma unroll
            for (int kk = 0; kk < 4; ++kk) st[k2] = mfma32(ldsv8(KT + (32 * k2 + ql) * KS + (comp * 64 + 16 * kk + 8 * hi) * 2), ldsv8(qfrag + 32 * kk), st[k2]);
        }
        __builtin_amdgcn_sched_barrier(0);
        const bool far = (qb * 128 + 32 * rw - (kb + 63)) >= 127;
        float mx = -1.0e30f, cadd;
        if (far) {
#pragma unroll
            for (int k2 = 0; k2 < 2; ++k2)
#pragma unroll
                for (int r = 0; r < 16; r += 2) mx = fmaxf(fmaxf(st[k2][r], st[k2][r + 1]), mx);
            mx = mx * LOG2E + b31; cadd = b31;
        } else {
#pragma unroll
            for (int k2 = 0; k2 < 2; ++k2)
#pragma unroll
                for (int r = 0; r < 16; ++r) { const int rel = qpos - (kb + 32 * k2 + crow(r, hi)); const int ri = rel < 0 ? 0 : (rel > 127 ? 127 : rel);
                    const float t = st[k2][r] * LOG2E + tab[ri]; st[k2][r] = (rel >= 0 ? t : -1.0e30f) * (1.0f / LOG2E); mx = fmaxf(mx, rel >= 0 ? t : -1.0e30f); }
            cadd = 0.f;
        }
        mx = fmaxf(mx, __shfl_xor(mx, 32));
        const float mnew = fmaxf(mrun, mx), alpha = __builtin_amdgcn_exp2f(mrun - mnew);
        const bool grew = mnew > mrun; mrun = mnew;
        const float cst = cadd - mnew;
        float ps = 0.f;
#pragma unroll
        for (int k2 = 0; k2 < 2; ++k2)
#pragma unroll
            for (int r = 0; r < 16; ++r) { const float pv = __builtin_amdgcn_exp2f(__builtin_fmaf(st[k2][r], LOG2E, cst)); st[k2][r] = pv; ps += pv; }
        lrun = lrun * alpha + ps;
        if (__any(grew)) {
#pragma unroll
            for (int mb = 0; mb < 4; ++mb)
#pragma unroll
                for (int r = 0; r < 16; ++r) o[mb][r] *= alpha;
        }
        __builtin_amdgcn_sched_barrier(0);
#pragma unroll
        for (int k2 = 0; k2 < 2; ++k2)
#pragma unroll
            for (int ks = 0; ks < 2; ++ks) { const int r8 = 8 * ks;
                const unsigned w0 = pg8::cvt_pk_bf16(st[k2][r8 + 0], st[k2][r8 + 1]), w1 = pg8::cvt_pk_bf16(st[k2][r8 + 2], st[k2][r8 + 3]), w2 = pg8::cvt_pk_bf16(st[k2][r8 + 4], st[k2][r8 + 5]), w3 = pg8::cvt_pk_bf16(st[k2][r8 + 6], st[k2][r8 + 7]);
                const u32x4 wv = (u32x4){w0, w1, w2, w3}; pb[2 * k2 + ks] = __builtin_bit_cast(bf16x8, wv); }
        __builtin_amdgcn_sched_barrier(0);
        if (!rot) ATT_PV(vs_cur);
        vs_prev = vs_cur; vs_cur = vs_nxt;
    }
    if (rot) ATT_PV(vs_prev);
#undef ATT_PV
    const float ltot = lrun + __shfl_xor(lrun, 32), inv = __builtin_amdgcn_rcpf(ltot);
    int l2 = C.lane; asm volatile("" : "+v"(l2));
    const int ql_e = l2 & 31, hi_e = l2 >> 5;
    const size_t rowq_e = (size_t)b * SEQ + qb * 128 + 32 * rw + ql_e;
    __syncthreads();
    if (comp == 1) {
#pragma unroll
        for (int mb = 0; mb < 4; ++mb)
#pragma unroll
            for (int r = 0; r < 16; ++r) OX[(rw * 128 + 32 * mb + crow(r, hi_e)) * 32 + ql_e] = o[mb][r] * inv;
    }
    __syncthreads();
    if (comp == 0) {
        float ss = 0.f;
#pragma unroll
        for (int mb = 0; mb < 4; ++mb)
#pragma unroll
            for (int r = 0; r < 16; ++r) { const float y = o[mb][r] * inv - lam * OX[(rw * 128 + 32 * mb + crow(r, hi_e)) * 32 + ql_e]; o[mb][r] = y; ss += y * y; }
        ss += __shfl_xor(ss, 32);
        const float rn = __builtin_amdgcn_rsqf(ss * (1.f / 128.f) + 1e-6f) * 0.8f;
#pragma unroll
        for (int mb = 0; mb < 4; ++mb)
#pragma unroll
            for (int r4 = 0; r4 < 4; ++r4) { const int dv = 32 * mb + 8 * r4 + 4 * hi_e; const f32x4 gv = *(const f32x4*)(dg + h * 128 + dv);
                u32x2 wv; wv.x = pk2(o[mb][4 * r4] * rn * gv[0], o[mb][4 * r4 + 1] * rn * gv[1]); wv.y = pk2(o[mb][4 * r4 + 2] * rn * gv[2], o[mb][4 * r4 + 3] * rn * gv[3]);
                *(u32x2*)(MIX + rowq_e * DM + h * 128 + dv) = wv; }
    }
}
__device__ __forceinline__ void attn_phase(const Ctx& C, const bf16_t* U, const float* rel_bias, const float* dg, const float* lq1, const float* lk1, const float* lq2, const float* lk2, bf16_t* MIX) {
    const float s1 = wave_sum(lq1[C.lane] * lk1[C.lane]), s2 = wave_sum(lq2[C.lane] * lk2[C.lane]);
    const float lam = __expf(s1) - __expf(s2) + 0.2f;
    const bool xa = (C.G == 256);
#pragma unroll 1
    for (int k = 0; k < 512; ++k) {
        int pr;
        if (xa) { if (k >= 2) break; pr = (2 * (C.bid & 7) + k) * 32 + (C.bid >> 3); } else { pr = C.bid + k * C.G; if (pr >= 512) break; }
        const int bh = pr >> 5, i = pr & 31, b = bh >> 3, h = bh & 7;
        attn_unit(C, U, rel_bias, dg, lam, b, h, i, MIX);
        attn_unit(C, U, rel_bias, dg, lam, b, h, 63 - i, MIX);
    }
    __syncthreads();
}

struct Args {
    const float* x; const float* p; const float* ln_g; const float* ln_b; const float* w_ffn_in; const float* w_ffn_out; const float* w_in_ab; const float* w_out_ab;
    const float* rel_bias; const float* lq1; const float* lk1; const float* lq2; const float* lk2; const float* diff_norm; const float* conv_w; const float* conv_b;
    const float* b_igate; const float* b_fgate; const float* mlstm_norm; const float* w_in_c; const float* w_alpha2; const float* b_alpha; const float* gla_norm;
    const float* w_out_c; const float* w_ple_proj; const float* w_ple_gate;
    float* out; unsigned char* ws;
    int ph_lo, ph_hi;
};


constexpr int ARGS_OFF = 147200;
enum { A_x = 0, A_p, A_ln_g, A_ln_b, A_w_ffn_in, A_w_ffn_out, A_w_in_ab, A_w_out_ab, A_rel_bias, A_lq1, A_lk1, A_lq2, A_lk2, A_diff_norm, A_conv_w, A_conv_b,
       A_b_igate, A_b_fgate, A_mlstm_norm, A_w_in_c, A_w_alpha2, A_b_alpha, A_gla_norm, A_w_out_c, A_w_ple_proj, A_w_ple_gate, A_out, A_ws };
__device__ __forceinline__ unsigned char* ldarg(LAS unsigned char* lds, int i) {
    volatile LAS unsigned* p = (volatile LAS unsigned*)(lds + ARGS_OFF) + 2 * i;
    const unsigned lo = __builtin_amdgcn_readfirstlane(p[0]), hi = __builtin_amdgcn_readfirstlane(p[1]);
    return (unsigned char*)(__attribute__((address_space(1))) unsigned char*)(((unsigned long long)hi << 32) | lo);
}
#define ARGF(i) ((const float*)ldarg(C.lds, (i)))
#define WSP(T, off) ((T*)(ldarg(C.lds, A_ws) + (off)))


__device__ __forceinline__ void grid_barrier(unsigned* ctr, unsigned target, bool leader) {
    asm volatile("s_waitcnt vmcnt(0) lgkmcnt(0)" ::: "memory");
    __syncthreads();
    if (leader) {
        __builtin_amdgcn_fence(__ATOMIC_RELEASE, "agent");
        asm volatile("s_waitcnt vmcnt(0)" ::: "memory");
        (void)__hip_atomic_fetch_add(ctr, 1u, __ATOMIC_RELAXED, __HIP_MEMORY_SCOPE_AGENT);
        while (__hip_atomic_load(ctr, __ATOMIC_RELAXED, __HIP_MEMORY_SCOPE_AGENT) < target) __builtin_amdgcn_s_sleep(1);
        __builtin_amdgcn_fence(__ATOMIC_ACQUIRE, "agent");
        asm volatile("s_waitcnt vmcnt(0)" ::: "memory");
    }
    __syncthreads();
}

#define XB_TMO      128
#define XB_XCNT(j)  (256  + 64 * (j))
#define XB_XSUB(j)  (1280 + 64 * (j))
#define XB_XGEN(j)  (2304 + 64 * (j))
#define XB_TOP      3328
#define XB_TOPGEN   3392
#define XCD_BAR_WORDS 3456
#define XB_SPIN_CAP (1u << 22)
__device__ __forceinline__ unsigned xb_ld(unsigned* p)              { return __hip_atomic_load(p, __ATOMIC_RELAXED, __HIP_MEMORY_SCOPE_AGENT); }
__device__ __forceinline__ unsigned xb_add(unsigned* p, unsigned v) { return __hip_atomic_fetch_add(p, v, __ATOMIC_RELAXED, __HIP_MEMORY_SCOPE_AGENT); }
__device__ __forceinline__ unsigned xb_xcc_id() { return (unsigned)__builtin_amdgcn_s_getreg((3 << 11) | 20) & 0xFu; }
#define XB_SPIN(cond, bar) do { unsigned _sp = 0; while (cond) { __builtin_amdgcn_s_sleep(1); \
    if ((++_sp & 255u) == 0u) { if (xb_ld(&(bar)[XB_TMO])) break; if (_sp > XB_SPIN_CAP) { atomicAdd(&(bar)[XB_TMO], 1u); break; } } } } while (0)
__device__ __forceinline__ void xcd_barrier_complete(unsigned* bar, unsigned x, unsigned& nloc, unsigned& nx) {
    const unsigned G = gridDim.x;
    unsigned sum, cnt, mine, sp = 0u;
    for (;;) {
        sum = 0u; cnt = 0u; mine = 0u;
#pragma unroll
        for (unsigned j = 0; j < 16; ++j) { const unsigned c = xb_ld(&bar[XB_XCNT(j)]); sum += c; cnt += (c > 0u) ? 1u : 0u; mine = (j == x) ? c : mine; }
        if (sum == G) break;
        __builtin_amdgcn_s_sleep(1);
        if ((++sp & 255u) == 0u) { if (xb_ld(&bar[XB_TMO])) break; if (sp > XB_SPIN_CAP) { atomicAdd(&bar[XB_TMO], 1u); break; } }
    }
    nloc = mine > 0u ? mine : 1u; nx = cnt > 0u ? cnt : 1u;
}
__device__ __forceinline__ void xcd_barrier(unsigned* bar, volatile LAS unsigned* st, bool leader) {
    asm volatile("s_waitcnt vmcnt(0)" ::: "memory");
    __syncthreads();
    if (leader) {
        __builtin_amdgcn_s_waitcnt(0);
        const unsigned x = xb_xcc_id();
        unsigned nloc = st[0], nx = st[1];
        if (nloc == 0u) { xcd_barrier_complete(bar, x, nloc, nx); st[0] = nloc; st[1] = nx; }
        const unsigned old = xb_add(&bar[XB_XSUB(x)], 1u);
        const unsigned gen = old / nloc;
        if (old + 1u == (gen + 1u) * nloc) {
            __builtin_amdgcn_fence(__ATOMIC_RELEASE, "agent");
            asm volatile("s_waitcnt vmcnt(0)" ::: "memory");
            const unsigned og = xb_add(&bar[XB_TOP], 1u);
            const unsigned tg = og / nx;
            if (og + 1u == (tg + 1u) * nx) xb_add(&bar[XB_TOPGEN], 1u);
            else XB_SPIN(xb_ld(&bar[XB_TOPGEN]) == tg, bar);
            __builtin_amdgcn_fence(__ATOMIC_ACQUIRE, "agent");
            xb_add(&bar[XB_XGEN(x)], 1u);
            asm volatile("s_waitcnt vmcnt(0)" ::: "memory");
        } else {
            XB_SPIN(xb_ld(&bar[XB_XGEN(x)]) == gen, bar);
            __builtin_amdgcn_fence(__ATOMIC_ACQUIRE, "agent");
            asm volatile("s_waitcnt vmcnt(0)" ::: "memory");
        }
    }
    __syncthreads();
}

#define GEMM_CALL(EPI, Aptr, Bptr, Nn, Kk, Eobj) do { pg8::Gemm g_{(const bf16_t*)(Aptr), (const bf16_t*)(Bptr), MT, (Nn), (Kk)}; pg8::StaticOrder S_; S_.init(MT, (Nn), C.G, C.bid); \
    pg8::gemm_phase<EPI, pg8::StaticOrder, true, true>(C.lds, g_, S_, Eobj, C.tid); } while (0)

__global__ void __launch_bounds__(512, 2) mega_fwd(Args a) {
    extern __shared__ __attribute__((aligned(16))) unsigned char lds_raw[];
    cg::grid_group grid = cg::this_grid();
    if (threadIdx.x == 0) {
        LAS unsigned long long* t = (LAS unsigned long long*)((LAS unsigned char*)lds_raw + ARGS_OFF);
        t[A_x] = (unsigned long long)a.x; t[A_p] = (unsigned long long)a.p; t[A_ln_g] = (unsigned long long)a.ln_g; t[A_ln_b] = (unsigned long long)a.ln_b;
        t[A_w_ffn_in] = (unsigned long long)a.w_ffn_in; t[A_w_ffn_out] = (unsigned long long)a.w_ffn_out; t[A_w_in_ab] = (unsigned long long)a.w_in_ab; t[A_w_out_ab] = (unsigned long long)a.w_out_ab;
        t[A_rel_bias] = (unsigned long long)a.rel_bias; t[A_lq1] = (unsigned long long)a.lq1; t[A_lk1] = (unsigned long long)a.lk1; t[A_lq2] = (unsigned long long)a.lq2; t[A_lk2] = (unsigned long long)a.lk2;
        t[A_diff_norm] = (unsigned long long)a.diff_norm; t[A_conv_w] = (unsigned long long)a.conv_w; t[A_conv_b] = (unsigned long long)a.conv_b; t[A_b_igate] = (unsigned long long)a.b_igate;
        t[A_b_fgate] = (unsigned long long)a.b_fgate; t[A_mlstm_norm] = (unsigned long long)a.mlstm_norm; t[A_w_in_c] = (unsigned long long)a.w_in_c; t[A_w_alpha2] = (unsigned long long)a.w_alpha2;
        t[A_b_alpha] = (unsigned long long)a.b_alpha; t[A_gla_norm] = (unsigned long long)a.gla_norm; t[A_w_out_c] = (unsigned long long)a.w_out_c; t[A_w_ple_proj] = (unsigned long long)a.w_ple_proj;
        t[A_w_ple_gate] = (unsigned long long)a.w_ple_gate; t[A_out] = (unsigned long long)a.out; t[A_ws] = (unsigned long long)a.ws;
        t[30] = 0ull;
    }
    __syncthreads();
    const int ph_lo = a.ph_lo, ph_hi = a.ph_hi;
    int ph = 0; unsigned nbar = 0, ngb = 0;
    const int wave_s = __builtin_amdgcn_readfirstlane((int)(threadIdx.x >> 6));
#ifndef REPMASK
#define REPMASK 0
#endif
#define PHASE_BEGIN_G(grp) if (ph >= ph_lo && ph < ph_hi) for (int rep_ = 0; rep_ < (((REPMASK >> (grp)) & 1) ? 2 : 1); ++rep_) { Ctx C; { int t_ = wave_s * 64 + (int)__builtin_amdgcn_mbcnt_hi(~0u, __builtin_amdgcn_mbcnt_lo(~0u, 0u)); asm volatile("" : "+v"(t_)); C.lds = (LAS unsigned char*)lds_raw; C.tid = t_; C.lane = t_ & 63; C.wave = __builtin_amdgcn_readfirstlane(t_ >> 6); \
    C.G = gridDim.x; C.bid = blockIdx.x; C.gw = C.bid * 8 + C.wave; C.NGW = C.G * 8; }
#define PHASE_BEGIN PHASE_BEGIN_G(31)
#ifndef SYNCREP
#define SYNCREP 1
#endif
#define PHASE_END_K(GROUPWISE) } ++ph; if (ph > ph_lo && ph < ph_hi) { for (int sr_ = 0; sr_ < SYNCREP; ++sr_) { \
        unsigned* ctl_ = (unsigned*)(ldarg((LAS unsigned char*)lds_raw, A_ws) + OFF_CTL); const bool lead_ = wave_s == 0 && __builtin_amdgcn_mbcnt_hi(~0u, __builtin_amdgcn_mbcnt_lo(~0u, 0u)) == 0u; \
        if ((GROUPWISE) && (gridDim.x & 7u) == 0u) { ++ngb; grid_barrier(ctl_ + 64 * (1 + (blockIdx.x & 7u)), ngb * (gridDim.x >> 3), lead_); } \
        else { xcd_barrier(ctl_ + 1024, (volatile LAS unsigned*)((LAS unsigned char*)lds_raw + ARGS_OFF + 240), lead_); } } }
#define PHASE_END PHASE_END_K(0)
#define PHASE_END_NONE } ++ph;
#define PHASE_END_ROWS PHASE_END_K(0)

    PHASE_BEGIN_G(0)
        if (C.bid == 0) { unsigned* ctl0_ = (unsigned*)(ldarg(C.lds, A_ws) + OFF_CTL); for (int i_ = C.tid; i_ < 1024 + XCD_BAR_WORDS; i_ += 512) ctl0_[i_] = 0u; }
        int base = 0;
        for (int i = 0; i < 4; ++i) conv_matrix(C, ARGF(A_w_ffn_in) + (size_t)i * DM * NFF2, DM, NFF2, NFF2, WSP(bf16_t, OFF_WFI) + (size_t)i * NFF2 * DM, 1, base);
        for (int i = 0; i < 4; ++i) conv_matrix(C, ARGF(A_w_ffn_out) + (size_t)i * DFF * DM, DFF, DM, DM, WSP(bf16_t, OFF_WFO) + (size_t)i * DM * DFF, 0, base);
        conv_matrix(C, ARGF(A_w_in_ab), DM, 6152, NIN, WSP(bf16_t, OFF_WAB), 2, base);
        conv_matrix(C, ARGF(A_w_in_c), DM, 6160, NIN, WSP(bf16_t, OFF_WC), 0, base);
        conv_matrix(C, ARGF(A_w_out_ab), DM, DM, DM, WSP(bf16_t, OFF_WOAB), 0, base);
        conv_matrix(C, ARGF(A_w_out_c), DM, DM, DM, WSP(bf16_t, OFF_WOC), 0, base);
        for (int i = 0; i < 2; ++i) conv_matrix(C, ARGF(A_w_ple_gate) + (size_t)i * DM * DM, DM, DM, DM, WSP(bf16_t, OFF_WPG) + (size_t)i * DM * DM, 0, base);
        for (int i = 0; i < 2; ++i) conv_matrix(C, ARGF(A_w_ple_proj) + (size_t)i * PLE * DM, PLE, DM, DM, WSP(bf16_t, OFF_WPP) + (size_t)i * DM * PLE, 0, base);
        cvt_rows(C, ARGF(A_x), WSP(bf16_t, OFF_XB), (size_t)MT * DM / 4);
        cvt_rows(C, ARGF(A_p), WSP(bf16_t, OFF_PB), (size_t)2 * MT * PLE / 4);
        __syncthreads();
    } ++ph; if (ph > ph_lo && ph < ph_hi) { grid.sync(); if (wave_s == 0 && __builtin_amdgcn_mbcnt_hi(~0u, __builtin_amdgcn_mbcnt_lo(~0u, 0u)) == 0u) (void)xb_add((unsigned*)(ldarg((LAS unsigned char*)lds_raw, A_ws) + OFF_CTL) + 1024 + XB_XCNT(xb_xcc_id()), 1u); }

    { constexpr int L = 0;
        PHASE_BEGIN_G(1) { pg8::EpiSwiglu e{WSP(bf16_t, OFF_H), DFF}; GEMM_CALL(pg8::EpiSwiglu, WSP(bf16_t, (L == 0 ? OFF_XB : OFF_MIX)), WSP(bf16_t, OFF_WFI) + (size_t)(2 * L) * NFF2 * DM, NFF2, DM, e); }
            if (L == 0) { for (int l2 = 0; l2 < 2; ++l2) { pg8::EpiStore e2{WSP(bf16_t, OFF_XF) + (size_t)l2 * MT * DM, DM, DM, nullptr}; GEMM_CALL(pg8::EpiStore, WSP(bf16_t, OFF_PB) + (size_t)l2 * MT * PLE, WSP(bf16_t, OFF_WPP) + (size_t)l2 * DM * PLE, DM, PLE, e2); } } PHASE_END_ROWS
        PHASE_BEGIN_G(1) { if (L == 0) { pg8::EpiZ<true> e{(const void*)ARGF(A_x), WSP(bf16_t, OFF_Z), ALPHA, 0.5f}; GEMM_CALL(pg8::EpiZ<true>, WSP(bf16_t, OFF_H), WSP(bf16_t, OFF_WFO) + (size_t)(2 * L) * DM * DFF, DM, DFF, e); } else { pg8::EpiZ<false> e{(const void*)WSP(bf16_t, OFF_MIX), WSP(bf16_t, OFF_Z), ALPHA, 0.5f}; GEMM_CALL(pg8::EpiZ<false>, WSP(bf16_t, OFF_H), WSP(bf16_t, OFF_WFO) + (size_t)(2 * L) * DM * DFF, DM, DFF, e); } } PHASE_END_ROWS
        PHASE_BEGIN_G(3) ln_phase<(L == 0 ? 8 : 16)>(C, WSP(bf16_t, OFF_Z), ARGF(A_ln_g) + (size_t)(3 * L) * DM, ARGF(A_ln_b) + (size_t)(3 * L) * DM, WSP(bf16_t, OFF_XB), (L == 0 ? ARGF(A_w_in_ab) : ARGF(A_w_in_c)), (L == 0 ? 6152 : 6160), (L == 0 ? 8 : 16), WSP(float, OFF_GT)); PHASE_END
        PHASE_BEGIN_G(2) { pg8::EpiStore e{WSP(bf16_t, OFF_H), UW, UW, nullptr}; GEMM_CALL(pg8::EpiStore, WSP(bf16_t, OFF_XB), WSP(bf16_t, (L == 0 ? OFF_WAB : OFF_WC)), NIN, DM, e); } PHASE_END
        if (L == 0) {
            PHASE_BEGIN_G(5) m1_phase(C, WSP(bf16_t, OFF_H), WSP(float, OFF_GT), ARGF(A_conv_w), ARGF(A_conv_b), ARGF(A_b_igate), ARGF(A_b_fgate), WSP(bf16_t, OFF_QB), WSP(bf16_t, OFF_KB), WSP(float, OFF_BC), WSP(float, OFF_IP), WSP(float, OFF_MSC)); PHASE_END
            PHASE_BEGIN
                mlstm_passA(C, WSP(bf16_t, OFF_H), WSP(bf16_t, OFF_KB), WSP(float, OFF_BC), WSP(float, OFF_IP), WSP(float, OFF_MSC), WSP(bf16_t, OFF_ST), WSP(float, OFF_NL));
                for (int rep2_ = 0; rep2_ < (((REPMASK >> 4) & 1) ? 2 : 1); ++rep2_)
                attn_phase(C, WSP(bf16_t, OFF_H), ARGF(A_rel_bias), ARGF(A_diff_norm), ARGF(A_lq1), ARGF(A_lk1), ARGF(A_lq2), ARGF(A_lk2), WSP(bf16_t, OFF_MIX));
            PHASE_END
            PHASE_BEGIN mlstm_scan(C, WSP(bf16_t, OFF_ST), WSP(float, OFF_NL), WSP(float, OFF_MSC)); PHASE_END
            PHASE_BEGIN_G(5) mlstm_passC(C, WSP(bf16_t, OFF_H), WSP(bf16_t, OFF_QB), WSP(bf16_t, OFF_KB), WSP(float, OFF_BC), WSP(float, OFF_IP), WSP(float, OFF_MSC), WSP(bf16_t, OFF_ST), WSP(float, OFF_NL), ARGF(A_mlstm_norm), WSP(bf16_t, OFF_MIX)); PHASE_END
        } else {
            PHASE_BEGIN_G(6) gla_passA(C, WSP(bf16_t, OFF_H), WSP(float, OFF_GT), ARGF(A_w_alpha2), ARGF(A_b_alpha), WSP(bf16_t, OFF_ST), WSP(float, OFF_DC), WSP(bf16_t, OFF_Z), WSP(bf16_t, OFF_Z + (size_t)MT * 1024 * 2)); PHASE_END
            PHASE_BEGIN gla_scan(C, WSP(bf16_t, OFF_ST), WSP(float, OFF_DC)); PHASE_END
            PHASE_BEGIN_G(7) gla_passC(C, WSP(bf16_t, OFF_H), WSP(bf16_t, OFF_Z), WSP(bf16_t, OFF_Z + (size_t)MT * 1024 * 2), WSP(bf16_t, OFF_ST), ARGF(A_gla_norm), WSP(bf16_t, OFF_MIX)); PHASE_END
        }
        PHASE_BEGIN_G(1) { pg8::EpiZ<false> e{(const void*)WSP(bf16_t, OFF_XB), WSP(bf16_t, OFF_Z), ALPHA, 1.0f}; GEMM_CALL(pg8::EpiZ<false>, WSP(bf16_t, OFF_MIX), WSP(bf16_t, (L == 0 ? OFF_WOAB : OFF_WOC)), DM, DM, e); } PHASE_END_ROWS
        PHASE_BEGIN_G(3) ln_phase<0>(C, WSP(bf16_t, OFF_Z), ARGF(A_ln_g) + (size_t)(3 * L + 1) * DM, ARGF(A_ln_b) + (size_t)(3 * L + 1) * DM, WSP(bf16_t, OFF_XB), nullptr, 0, 0, nullptr); PHASE_END_ROWS
        PHASE_BEGIN_G(1) { pg8::EpiSwiglu e{WSP(bf16_t, OFF_H), DFF}; GEMM_CALL(pg8::EpiSwiglu, WSP(bf16_t, OFF_XB), WSP(bf16_t, OFF_WFI) + (size_t)(2 * L + 1) * NFF2 * DM, NFF2, DM, e); } PHASE_END_ROWS
        PHASE_BEGIN_G(1) { pg8::EpiZ<false> e{(const void*)WSP(bf16_t, OFF_XB), WSP(bf16_t, OFF_Z), ALPHA, 0.5f}; GEMM_CALL(pg8::EpiZ<false>, WSP(bf16_t, OFF_H), WSP(bf16_t, OFF_WFO) + (size_t)(2 * L + 1) * DM * DFF, DM, DFF, e); } PHASE_END_ROWS
        PHASE_BEGIN_G(3) ln_phase<0>(C, WSP(bf16_t, OFF_Z), ARGF(A_ln_g) + (size_t)(3 * L + 2) * DM, ARGF(A_ln_b) + (size_t)(3 * L + 2) * DM, WSP(bf16_t, OFF_XB), nullptr, 0, 0, nullptr); PHASE_END_ROWS
        PHASE_BEGIN { pg8::EpiPle e{WSP(const bf16_t, OFF_XB), WSP(const bf16_t, OFF_XF) + (size_t)L * MT * DM, (L == 1) ? (float*)ldarg(C.lds, A_out) : (float*)nullptr, (L == 1) ? (bf16_t*)nullptr : WSP(bf16_t, OFF_MIX)}; GEMM_CALL(pg8::EpiPle, WSP(bf16_t, OFF_XB), WSP(bf16_t, OFF_WPG) + (size_t)L * DM * DM, DM, DM, e); } PHASE_END_ROWS
        }
    { constexpr int L = 1;
        PHASE_BEGIN_G(1) { pg8::EpiSwiglu e{WSP(bf16_t, OFF_H), DFF}; GEMM_CALL(pg8::EpiSwiglu, WSP(bf16_t, (L == 0 ? OFF_XB : OFF_MIX)), WSP(bf16_t, OFF_WFI) + (size_t)(2 * L) * NFF2 * DM, NFF2, DM, e); }
            if (L == 0) { for (int l2 = 0; l2 < 2; ++l2) { pg8::EpiStore e2{WSP(bf16_t, OFF_XF) + (size_t)l2 * MT * DM, DM, DM, nullptr}; GEMM_CALL(pg8::EpiStore, WSP(bf16_t, OFF_PB) + (size_t)l2 * MT * PLE, WSP(bf16_t, OFF_WPP) + (size_t)l2 * DM * PLE, DM, PLE, e2); } } PHASE_END_ROWS
        PHASE_BEGIN_G(1) { if (L == 0) { pg8::EpiZ<true> e{(const void*)ARGF(A_x), WSP(bf16_t, OFF_Z), ALPHA, 0.5f}; GEMM_CALL(pg8::EpiZ<true>, WSP(bf16_t, OFF_H), WSP(bf16_t, OFF_WFO) + (size_t)(2 * L) * DM * DFF, DM, DFF, e); } else { pg8::EpiZ<false> e{(const void*)WSP(bf16_t, OFF_MIX), WSP(bf16_t, OFF_Z), ALPHA, 0.5f}; GEMM_CALL(pg8::EpiZ<false>, WSP(bf16_t, OFF_H), WSP(bf16_t, OFF_WFO) + (size_t)(2 * L) * DM * DFF, DM, DFF, e); } } PHASE_END_ROWS
        PHASE_BEGIN_G(3) ln_phase<(L == 0 ? 8 : 16)>(C, WSP(bf16_t, OFF_Z), ARGF(A_ln_g) + (size_t)(3 * L) * DM, ARGF(A_ln_b) + (size_t)(3 * L) * DM, WSP(bf16_t, OFF_XB), (L == 0 ? ARGF(A_w_in_ab) : ARGF(A_w_in_c)), (L == 0 ? 6152 : 6160), (L == 0 ? 8 : 16), WSP(float, OFF_GT)); PHASE_END
        PHASE_BEGIN_G(2) { pg8::EpiStore e{WSP(bf16_t, OFF_H), UW, UW, nullptr}; GEMM_CALL(pg8::EpiStore, WSP(bf16_t, OFF_XB), WSP(bf16_t, (L == 0 ? OFF_WAB : OFF_WC)), NIN, DM, e); } PHASE_END
        if (L == 0) {
            PHASE_BEGIN_G(5) m1_phase(C, WSP(bf16_t, OFF_H), WSP(float, OFF_GT), ARGF(A_conv_w), ARGF(A_conv_b), ARGF(A_b_igate), ARGF(A_b_fgate), WSP(bf16_t, OFF_QB), WSP(bf16_t, OFF_KB), WSP(float, OFF_BC), WSP(float, OFF_IP), WSP(float, OFF_MSC)); PHASE_END
            PHASE_BEGIN
                mlstm_passA(C, WSP(bf16_t, OFF_H), WSP(bf16_t, OFF_KB), WSP(float, OFF_BC), WSP(float, OFF_IP), WSP(float, OFF_MSC), WSP(bf16_t, OFF_ST), WSP(float, OFF_NL));
                for (int rep2_ = 0; rep2_ < (((REPMASK >> 4) & 1) ? 2 : 1); ++rep2_)
                attn_phase(C, WSP(bf16_t, OFF_H), ARGF(A_rel_bias), ARGF(A_diff_norm), ARGF(A_lq1), ARGF(A_lk1), ARGF(A_lq2), ARGF(A_lk2), WSP(bf16_t, OFF_MIX));
            PHASE_END
            PHASE_BEGIN mlstm_scan(C, WSP(bf16_t, OFF_ST), WSP(float, OFF_NL), WSP(float, OFF_MSC)); PHASE_END
            PHASE_BEGIN_G(5) mlstm_passC(C, WSP(bf16_t, OFF_H), WSP(bf16_t, OFF_QB), WSP(bf16_t, OFF_KB), WSP(float, OFF_BC), WSP(float, OFF_IP), WSP(float, OFF_MSC), WSP(bf16_t, OFF_ST), WSP(float, OFF_NL), ARGF(A_mlstm_norm), WSP(bf16_t, OFF_MIX)); PHASE_END
        } else {
            PHASE_BEGIN_G(6) gla_passA(C, WSP(bf16_t, OFF_H), WSP(float, OFF_GT), ARGF(A_w_alpha2), ARGF(A_b_alpha), WSP(bf16_t, OFF_ST), WSP(float, OFF_DC), WSP(bf16_t, OFF_Z), WSP(bf16_t, OFF_Z + (size_t)MT * 1024 * 2)); PHASE_END
            PHASE_BEGIN gla_scan(C, WSP(bf16_t, OFF_ST), WSP(float, OFF_DC)); PHASE_END
            PHASE_BEGIN_G(7) gla_passC(C, WSP(bf16_t, OFF_H), WSP(bf16_t, OFF_Z), WSP(bf16_t, OFF_Z + (size_t)MT * 1024 * 2), WSP(bf16_t, OFF_ST), ARGF(A_gla_norm), WSP(bf16_t, OFF_MIX)); PHASE_END
        }
        PHASE_BEGIN_G(1) { pg8::EpiZ<false> e{(const void*)WSP(bf16_t, OFF_XB), WSP(bf16_t, OFF_Z), ALPHA, 1.0f}; GEMM_CALL(pg8::EpiZ<false>, WSP(bf16_t, OFF_MIX), WSP(bf16_t, (L == 0 ? OFF_WOAB : OFF_WOC)), DM, DM, e); } PHASE_END_ROWS
        PHASE_BEGIN_G(3) ln_phase<0>(C, WSP(bf16_t, OFF_Z), ARGF(A_ln_g) + (size_t)(3 * L + 1) * DM, ARGF(A_ln_b) + (size_t)(3 * L + 1) * DM, WSP(bf16_t, OFF_XB), nullptr, 0, 0, nullptr); PHASE_END_ROWS
        PHASE_BEGIN_G(1) { pg8::EpiSwiglu e{WSP(bf16_t, OFF_H), DFF}; GEMM_CALL(pg8::EpiSwiglu, WSP(bf16_t, OFF_XB), WSP(bf16_t, OFF_WFI) + (size_t)(2 * L + 1) * NFF2 * DM, NFF2, DM, e); } PHASE_END_ROWS
        PHASE_BEGIN_G(1) { pg8::EpiZ<false> e{(const void*)WSP(bf16_t, OFF_XB), WSP(bf16_t, OFF_Z), ALPHA, 0.5f}; GEMM_CALL(pg8::EpiZ<false>, WSP(bf16_t, OFF_H), WSP(bf16_t, OFF_WFO) + (size_t)(2 * L + 1) * DM * DFF, DM, DFF, e); } PHASE_END_ROWS
        PHASE_BEGIN_G(3) ln_phase<0>(C, WSP(bf16_t, OFF_Z), ARGF(A_ln_g) + (size_t)(3 * L + 2) * DM, ARGF(A_ln_b) + (size_t)(3 * L + 2) * DM, WSP(bf16_t, OFF_XB), nullptr, 0, 0, nullptr); PHASE_END_ROWS
        PHASE_BEGIN { pg8::EpiPle e{WSP(const bf16_t, OFF_XB), WSP(const bf16_t, OFF_XF) + (size_t)L * MT * DM, (L == 1) ? (float*)ldarg(C.lds, A_out) : (float*)nullptr, (L == 1) ? (bf16_t*)nullptr : WSP(bf16_t, OFF_MIX)}; GEMM_CALL(pg8::EpiPle, WSP(bf16_t, OFF_XB), WSP(bf16_t, OFF_WPG) + (size_t)L * DM * DM, DM, DM, e); } PHASE_END_NONE
        }
}

extern "C" void kernel_launch(void* const* d_in, const int* in_sizes, int n_in, void* d_out, int out_size, void* d_ws, size_t ws_size, hipStream_t stream) {
    static int grid = 0;
    if (grid == 0) {
        int dev = 0, cus = 0, per_cu = 0;
        (void)hipGetDevice(&dev); (void)hipDeviceGetAttribute(&cus, hipDeviceAttributeMultiprocessorCount, dev);
        (void)hipFuncSetAttribute((const void*)mega_fwd, hipFuncAttributeMaxDynamicSharedMemorySize, LDS_BYTES);
        (void)hipOccupancyMaxActiveBlocksPerMultiprocessor(&per_cu, (const void*)mega_fwd, 512, LDS_BYTES);
        if (per_cu < 1) per_cu = 1;
        if (cus < 8) cus = 256;
        grid = cus * per_cu;
        if (ws_size < WS_NEED || n_in != 26) { fprintf(stderr, "kernel_launch: ws %zu < %zu or n_in %d != 26\n", ws_size, (size_t)WS_NEED, n_in); }
        (void)hipGetLastError();
    }
    Args a{};
    const float** fp = (const float**)&a;
    for (int i = 0; i < 26; ++i) fp[i] = (const float*)d_in[i];
    a.out = (float*)d_out; a.ws = (unsigned char*)d_ws; a.ph_lo = 0; a.ph_hi = 1000;
    void* args[] = {&a};
    hipError_t e = hipLaunchCooperativeKernel((const void*)mega_fwd, dim3(grid), dim3(512), args, LDS_BYTES, stream);
    if (e != hipSuccess) fprintf(stderr, "cooperative launch failed: %s (grid %d)\n", hipGetErrorString(e), grid);
}
```

```cpp
#include <hip/hip_runtime.h>
#include <hip/hip_cooperative_groups.h>
#include <cstdio>
#include <cstdint>
namespace cg = cooperative_groups;
namespace pg8 {
#define PG8_LAS __attribute__((address_space(3)))
typedef unsigned short bf16_t;
typedef short bf16x8 __attribute__((ext_vector_type(8)));
typedef float f32x4 __attribute__((ext_vector_type(4)));
typedef unsigned u32x4 __attribute__((ext_vector_type(4)));
constexpr int BM = 256, BK = 64, HALF = 128, HTB = HALF * BK * 2  , STAGE_BYTES = 8 * HTB, NXCD = 8, WGM = 8;

__host__ __device__ __forceinline__ int lds_byte(int r, int c) { const int st = (r >> 4) * 2 + (c >> 5), rr = r & 15, cc = c & 31, ob = rr * 64 + cc * 2; return st * 1024 + (ob ^ (((ob >> 9) & 1) << 5)); }
__host__ __device__ __forceinline__ void stage_rc(int b, int& R, int& C) { const int st = b / 1024, sb = b % 1024, swz = sb ^ (((sb >> 9) & 1) << 5); R = (st >> 1) * 16 + swz / 64; C = (st & 1) * 32 + (swz % 64) / 2; }
__host__ __device__ __forceinline__ int perm32(int rho) { const int n = rho >> 4, i = rho & 15; return 8 * (i >> 2) + 4 * n + (i & 3); }

struct Unit { int pm, pn; };
struct Gemm { const bf16_t* A; const bf16_t* Bt; int M, N, K; };

struct StaticOrder {
    int nM, nN, nwg, G, c;
    __host__ __device__ void init(int M, int N, int G_, int c_) { nM = M / BM; nN = N / BM; nwg = nM * nN; G = G_; c = c_; }
    __host__ __device__ bool next(int i, Unit& u) const {
        const long L = (long)i * G + c; if (L >= nwg) return false;
        int wgid = (int)L; { const int q = nwg / NXCD, r = nwg % NXCD, xcd = wgid % NXCD, off = wgid / NXCD; wgid = (xcd < r ? xcd * (q + 1) : r * (q + 1) + (xcd - r) * q) + off; }
        const int nig = WGM * nN, gid = wgid / nig, fm = gid * WGM, gsz = (nM - fm) < WGM ? (nM - fm) : WGM;
        u.pm = fm + ((wgid % nig) % gsz); u.pn = (wgid % nig) / gsz; return true;
    }
    __device__ __forceinline__ void a_ready(const Unit&) const {}
    __device__ __forceinline__ void done(const Unit&) const {}
};

__device__ __forceinline__ unsigned cvt_pk_bf16(float lo, float hi) { unsigned r; asm volatile("v_cvt_pk_bf16_f32 %0, %1, %2" : "=v"(r) : "v"(lo), "v"(hi)); return r; }
typedef float f32x2 __attribute__((ext_vector_type(2)));
template <class Epi, class Sched, bool ALIGN_EPI = false, bool SP2 = false>
__device__ __forceinline__ void gemm_phase(PG8_LAS unsigned char* lds, const Gemm g, const Sched& S, const Epi& E, const int tid_in) {
    const int tid = tid_in, wid = __builtin_amdgcn_readfirstlane(tid >> 6), lane = tid & 63, wr = wid >> 2, wc = wid & 3, fr = lane & 15, fq = lane >> 4;
    const int K = g.K, nt = K / BK;
    unsigned voffA[2], voffB[2];
#pragma unroll
    for (int i = 0; i < 2; ++i) { int R, C; stage_rc(tid * 16 + i * 8192, R, C); const int Rb = Epi::PERM ? ((R & ~31) + perm32(R & 31)) : R;
        voffA[i] = (unsigned)(R * K + C) * 2u; voffB[i] = (unsigned)(Rb * K + C) * 2u; }
    const size_t kstep = (size_t)(BK * 2);
    const size_t hstep = (size_t)HALF * K * 2;
    const size_t tstep = 2 * hstep;
    const unsigned ldsw = (unsigned)wid * 1024u;
    const int aoff = lds_byte(wr * 64 + fr, fq * 8), boff = lds_byte(wc * 32 + fr, fq * 8);
#define PG8_SA(b, h) (((b) * 2 + (h)) * HTB)
#define PG8_SB(b, h) ((4 + (b) * 2 + (h)) * HTB)
#define PG8_STAGE(bufoff, gbase, voff) do { _Pragma("unroll") for (int _i = 0; _i < 2; ++_i) \
        __builtin_amdgcn_global_load_lds((const unsigned*)((const char*)(gbase) + (voff)[_i]), (PG8_LAS unsigned*)(lds + (bufoff) + ldsw + _i * 8192), 16, 0, 0); } while (0)
#define PG8_LDA(dst, b, h) do { _Pragma("unroll") for (int m = 0; m < 4; ++m) _Pragma("unroll") for (int k = 0; k < 2; ++k) dst[m][k] = *(const PG8_LAS bf16x8*)(lds + PG8_SA(b, h) + aoff + m * 2048 + k * 1024); } while (0)
#define PG8_LDB(dst, b, h) do { _Pragma("unroll") for (int n = 0; n < 2; ++n) _Pragma("unroll") for (int k = 0; k < 2; ++k) dst[n][k] = *(const PG8_LAS bf16x8*)(lds + PG8_SB(b, h) + boff + n * 2048 + k * 1024); } while (0)
#define PG8_MMA(ai, bj, At, Bt) do { __builtin_amdgcn_s_setprio(1); _Pragma("unroll") for (int m = 0; m < 4; ++m) _Pragma("unroll") for (int n = 0; n < 2; ++n) _Pragma("unroll") for (int k = 0; k < 2; ++k) \
        acc[ai][bj][m][n] = __builtin_amdgcn_mfma_f32_16x16x32_bf16(Bt[n][k], At[m][k], acc[ai][bj][m][n], 0, 0, 0); __builtin_amdgcn_s_setprio(0); } while (0)
#define PG8_WAIT_V(n) asm volatile("s_waitcnt vmcnt(" #n ")" ::: "memory")
#define PG8_WAIT_L(n) asm volatile("s_waitcnt lgkmcnt(" #n ")" ::: "memory")
#define PG8_BAR __builtin_amdgcn_s_barrier()
#define PG8_SCHED __builtin_amdgcn_sched_barrier(0)
    Unit cur, nxt; int ui = 0;
    if (!S.next(0, cur)) return;
    f32x4 acc[2][2][4][2];
#pragma unroll
    for (int a = 0; a < 2; ++a)
#pragma unroll
        for (int b = 0; b < 2; ++b)
#pragma unroll
            for (int m = 0; m < 4; ++m)
#pragma unroll
                for (int n = 0; n < 2; ++n) acc[a][b][m][n] = (f32x4){0.f, 0.f, 0.f, 0.f};
    bf16x8 At[4][2], B0[2][2], B1[2][2];
    const char* cA = (const char*)g.A + (size_t)cur.pm * tstep; const char* cB = (const char*)g.Bt + (size_t)cur.pn * tstep;
    S.a_ready(cur);
    if constexpr (SP2) {
        PG8_STAGE(PG8_SB(0, 0), cB, voffB); PG8_STAGE(PG8_SB(0, 1), cB + hstep, voffB); PG8_STAGE(PG8_SA(0, 0), cA, voffA); PG8_STAGE(PG8_SA(0, 1), cA + hstep, voffA);
        if (wr == 1) PG8_BAR;
        PG8_WAIT_V(2); PG8_BAR;
        PG8_STAGE(PG8_SB(1, 0), cB + kstep, voffB); PG8_STAGE(PG8_SA(1, 0), cA + kstep, voffA); PG8_STAGE(PG8_SB(1, 1), cB + hstep + kstep, voffB);
        PG8_WAIT_V(6); PG8_BAR;
    } else {
        PG8_STAGE(PG8_SB(0, 0), cB, voffB); PG8_STAGE(PG8_SA(0, 0), cA, voffA); PG8_STAGE(PG8_SB(0, 1), cB + hstep, voffB); PG8_STAGE(PG8_SA(0, 1), cA + hstep, voffA);
        if (wr == 1) PG8_BAR;
        PG8_WAIT_V(4); PG8_BAR;
        PG8_STAGE(PG8_SB(1, 0), cB + kstep, voffB); PG8_STAGE(PG8_SA(1, 0), cA + kstep, voffA); PG8_STAGE(PG8_SB(1, 1), cB + hstep + kstep, voffB);
        PG8_WAIT_V(6); PG8_BAR;
    }
    for (;;) {
        const bool has_next = S.next(ui + 1, nxt);
        const char* nA = has_next ? (const char*)g.A + (size_t)nxt.pm * tstep : cA; const char* nB = has_next ? (const char*)g.Bt + (size_t)nxt.pn * tstep : cB;
        for (int t = 0; t < nt; t += 2) {
            const bool last = (t == nt - 2);
            const char* a1 = cA + (size_t)(t + 1) * kstep;
            const char* a2 = last ? nA : cA + (size_t)(t + 2) * kstep; const char* b2 = last ? nB : cB + (size_t)(t + 2) * kstep;
            const char* a3 = a2 + kstep; const char* b3 = b2 + kstep;
            if (last && has_next) S.a_ready(nxt);
            if constexpr (SP2) {
            PG8_LDB(B0, 0, 0); PG8_LDB(B1, 0, 1); PG8_SCHED; PG8_LDA(At, 0, 0); PG8_STAGE(PG8_SA(1, 1), a1 + hstep, voffA);
            PG8_WAIT_V(8); PG8_WAIT_L(0); PG8_BAR; PG8_MMA(0, 0, At, B0); PG8_MMA(0, 1, At, B1); PG8_BAR; PG8_SCHED;
            PG8_LDA(At, 0, 1); PG8_STAGE(PG8_SB(0, 0), b2, voffB); PG8_STAGE(PG8_SB(0, 1), b2 + hstep, voffB); PG8_STAGE(PG8_SA(0, 0), a2, voffA);
            PG8_WAIT_V(8); PG8_WAIT_L(0); PG8_BAR; PG8_MMA(1, 0, At, B0); PG8_MMA(1, 1, At, B1); PG8_BAR; PG8_SCHED;
            PG8_LDB(B0, 1, 0); PG8_LDB(B1, 1, 1); PG8_SCHED; PG8_LDA(At, 1, 0); PG8_STAGE(PG8_SA(0, 1), a2 + hstep, voffA);
            PG8_WAIT_V(8); PG8_WAIT_L(0); PG8_BAR; PG8_MMA(0, 0, At, B0); PG8_MMA(0, 1, At, B1); PG8_BAR; PG8_SCHED;
            PG8_LDA(At, 1, 1); PG8_STAGE(PG8_SB(1, 0), b3, voffB); PG8_STAGE(PG8_SB(1, 1), b3 + hstep, voffB); PG8_STAGE(PG8_SA(1, 0), a3, voffA);
            PG8_WAIT_V(8); PG8_WAIT_L(0); PG8_BAR; PG8_MMA(1, 0, At, B0); PG8_MMA(1, 1, At, B1); PG8_BAR; PG8_SCHED;
            } else {
            PG8_LDB(B0, 0, 0); PG8_SCHED; PG8_LDA(At, 0, 0); PG8_STAGE(PG8_SA(1, 1), a1 + hstep, voffA);
            PG8_WAIT_L(8); PG8_BAR; PG8_WAIT_L(0); PG8_MMA(0, 0, At, B0); PG8_BAR; PG8_SCHED;
            PG8_LDB(B1, 0, 1); PG8_STAGE(PG8_SB(0, 0), b2, voffB);
            PG8_BAR; PG8_WAIT_L(0); PG8_MMA(0, 1, At, B1); PG8_BAR;
            PG8_LDA(At, 0, 1); PG8_STAGE(PG8_SA(0, 0), a2, voffA);
            PG8_BAR; PG8_WAIT_L(0); PG8_MMA(1, 0, At, B0); PG8_BAR; PG8_SCHED;
            PG8_STAGE(PG8_SB(0, 1), b2 + hstep, voffB);
            PG8_WAIT_V(6); PG8_BAR; PG8_MMA(1, 1, At, B1); PG8_BAR;
            PG8_LDB(B0, 1, 0); PG8_SCHED; PG8_LDA(At, 1, 0); PG8_STAGE(PG8_SA(0, 1), a2 + hstep, voffA);
            PG8_WAIT_L(8); PG8_BAR; PG8_WAIT_L(0); PG8_MMA(0, 0, At, B0); PG8_BAR; PG8_SCHED;
            PG8_LDB(B1, 1, 1); PG8_STAGE(PG8_SB(1, 0), b3, voffB);
            PG8_BAR; PG8_WAIT_L(0); PG8_MMA(0, 1, At, B1); PG8_BAR;
            PG8_LDA(At, 1, 1); PG8_STAGE(PG8_SA(1, 0), a3, voffA);
            PG8_BAR; PG8_WAIT_L(0); PG8_MMA(1, 0, At, B0); PG8_BAR; PG8_SCHED;
            PG8_STAGE(PG8_SB(1, 1), b3 + hstep, voffB);
            PG8_WAIT_V(6); PG8_BAR; PG8_MMA(1, 1, At, B1); PG8_BAR;
            }
        }
        if constexpr (ALIGN_EPI) { if (wr == 0) PG8_BAR; }
        if constexpr (!Epi::AFTER_DRAIN) { E(acc, cur, wr, wc, fr, fq); S.done(cur); }
        if (!has_next) break;
#pragma unroll
        for (int a = 0; a < 2; ++a)
#pragma unroll
            for (int b = 0; b < 2; ++b)
#pragma unroll
                for (int m = 0; m < 4; ++m)
#pragma unroll
                    for (int n = 0; n < 2; ++n) acc[a][b][m][n] = (f32x4){0.f, 0.f, 0.f, 0.f};
        cur = nxt; cA = nA; cB = nB; ++ui;
        if constexpr (ALIGN_EPI) { if (wr == 1) PG8_BAR; }
    }
    PG8_WAIT_V(0);
    if constexpr (!ALIGN_EPI) { if (wr == 0) PG8_BAR; }
    PG8_BAR;
    if constexpr (Epi::AFTER_DRAIN) { E.fused(acc, cur, wr, wc, fr, fq, lds, wid, lane); S.done(cur); }
#undef PG8_SA
#undef PG8_SB
#undef PG8_STAGE
#undef PG8_LDA
#undef PG8_LDB
#undef PG8_MMA
#undef PG8_WAIT_V
#undef PG8_WAIT_L
#undef PG8_BAR
#undef PG8_SCHED
}
}

namespace pg8 {
typedef unsigned u32x2 __attribute__((ext_vector_type(2)));
__device__ __forceinline__ float sigmoidf_(float v) { return __builtin_amdgcn_rcpf(1.0f + __expf(-v)); }

struct EpiSwiglu {
    static constexpr bool PERM = true, AFTER_DRAIN = false;
    bf16_t* H; int ldh;
    __device__ __forceinline__ void operator()(const f32x4 (&acc)[2][2][4][2], const Unit& u, int wr, int wc, int fr, int fq) const {
        const int row0 = u.pm * BM + wr * 64 + fr; const int col0 = u.pn * HALF + wc * 32 + 8 * fq;
#pragma unroll
        for (int ai = 0; ai < 2; ++ai)
#pragma unroll
            for (int m = 0; m < 4; ++m) {
                bf16_t* p = H + (size_t)(row0 + ai * HALF + m * 16) * ldh + col0;
                f32x4 h0, h1;
#pragma unroll
                for (int e = 0; e < 4; ++e) {
                    const float g0 = acc[ai][0][m][0][e], g1 = acc[ai][0][m][1][e];
                    h0[e] = g0 * sigmoidf_(g0) * acc[ai][1][m][0][e];
                    h1[e] = g1 * sigmoidf_(g1) * acc[ai][1][m][1][e];
                }
                u32x4 w; w.x = cvt_pk_bf16(h0[0], h0[1]); w.y = cvt_pk_bf16(h0[2], h0[3]); w.z = cvt_pk_bf16(h1[0], h1[1]); w.w = cvt_pk_bf16(h1[2], h1[3]);
                *(u32x4*)p = w;
            }
    }
};

template <bool RF32> struct EpiZ {
    static constexpr bool PERM = true, AFTER_DRAIN = false;
    const void* R; bf16_t* Z; float alpha, s;
    __device__ __forceinline__ void operator()(const f32x4 (&acc)[2][2][4][2], const Unit& u, int wr, int wc, int fr, int fq) const {
        const int row0 = u.pm * BM + wr * 64 + fr; const int col0 = u.pn * BM + wc * 32 + 8 * fq;
#pragma unroll
        for (int ai = 0; ai < 2; ++ai)
#pragma unroll
            for (int m = 0; m < 4; ++m) {
                const size_t off = (size_t)(row0 + ai * HALF + m * 16) * 2048 + col0;
#pragma unroll
                for (int bj = 0; bj < 2; ++bj) {
                    f32x4 r0, r1;
                    if (RF32) { r0 = *(const f32x4*)((const float*)R + off + bj * HALF); r1 = *(const f32x4*)((const float*)R + off + bj * HALF + 4); }
                    else { const u32x4 rb = *(const u32x4*)((const bf16_t*)R + off + bj * HALF);
                        r0[0] = __uint_as_float(rb.x << 16); r0[1] = __uint_as_float(rb.x & 0xffff0000u); r0[2] = __uint_as_float(rb.y << 16); r0[3] = __uint_as_float(rb.y & 0xffff0000u);
                        r1[0] = __uint_as_float(rb.z << 16); r1[1] = __uint_as_float(rb.z & 0xffff0000u); r1[2] = __uint_as_float(rb.w << 16); r1[3] = __uint_as_float(rb.w & 0xffff0000u); }
                    const f32x4 z0 = r0 * alpha + acc[ai][bj][m][0] * s, z1 = r1 * alpha + acc[ai][bj][m][1] * s;
                    u32x4 w; w.x = cvt_pk_bf16(z0[0], z0[1]); w.y = cvt_pk_bf16(z0[2], z0[3]); w.z = cvt_pk_bf16(z1[0], z1[1]); w.w = cvt_pk_bf16(z1[2], z1[3]);
                    *(u32x4*)(Z + off + bj * HALF) = w;
                }
            }
    }
};

struct EpiStore {
    static constexpr bool PERM = true, AFTER_DRAIN = false;
    bf16_t* O; int ldc; int ncols; float* GT;
    __device__ __forceinline__ void operator()(const f32x4 (&acc)[2][2][4][2], const Unit& u, int wr, int wc, int fr, int fq) const {
        const int row0 = u.pm * BM + wr * 64 + fr; const int colt = u.pn * BM;
        if (colt < ncols) {
            const int col0 = colt + wc * 32 + 8 * fq;
#pragma unroll
            for (int ai = 0; ai < 2; ++ai)
#pragma unroll
                for (int m = 0; m < 4; ++m) {
                    bf16_t* rowp = O + (size_t)(row0 + ai * HALF + m * 16) * ldc + col0;
#pragma unroll
                    for (int bj = 0; bj < 2; ++bj) {
                        const f32x4 v0 = acc[ai][bj][m][0], v1 = acc[ai][bj][m][1];
                        u32x4 w; w.x = cvt_pk_bf16(v0[0], v0[1]); w.y = cvt_pk_bf16(v0[2], v0[3]); w.z = cvt_pk_bf16(v1[0], v1[1]); w.w = cvt_pk_bf16(v1[2], v1[3]);
                        *(u32x4*)(rowp + bj * HALF) = w;
                    }
                }
        } else if (GT != nullptr && wc == 0 && fq < 2) {
#pragma unroll
            for (int ai = 0; ai < 2; ++ai)
#pragma unroll
                for (int m = 0; m < 4; ++m) {
                    float* g = GT + (size_t)(row0 + ai * HALF + m * 16) * 16 + 8 * fq;
                    *(f32x4*)(g) = acc[ai][0][m][0];
                    *(f32x4*)(g + 4) = acc[ai][0][m][1];
                }
        }
    }
};

struct EpiPle {
    static constexpr bool PERM = true, AFTER_DRAIN = false;
    const bf16_t* X; const bf16_t* E; float* OUTF; bf16_t* XBO;
    __device__ __forceinline__ void operator()(const f32x4 (&acc)[2][2][4][2], const Unit& u, int wr, int wc, int fr, int fq) const {
        const int row0 = u.pm * BM + wr * 64 + fr; const int col0 = u.pn * BM + wc * 32 + 8 * fq;
#pragma unroll
        for (int ai = 0; ai < 2; ++ai)
#pragma unroll
            for (int m = 0; m < 4; ++m) {
                const size_t off = (size_t)(row0 + ai * HALF + m * 16) * 2048 + col0;
#pragma unroll
                for (int bj = 0; bj < 2; ++bj) {
                    const size_t o2 = off + bj * HALF;
                    const u32x4 xb = *(const u32x4*)(X + o2), eb = *(const u32x4*)(E + o2);
                    const unsigned xw[4] = {xb.x, xb.y, xb.z, xb.w}, ew[4] = {eb.x, eb.y, eb.z, eb.w};
                    float o[8];
#pragma unroll
                    for (int q = 0; q < 4; ++q) {
                        const float a0 = acc[ai][bj][m][q >> 1][2 * (q & 1)], a1 = acc[ai][bj][m][q >> 1][2 * (q & 1) + 1];
                        o[2 * q] = __uint_as_float(xw[q] << 16) + __uint_as_float(ew[q] << 16) * sigmoidf_(a0);
                        o[2 * q + 1] = __uint_as_float(xw[q] & 0xffff0000u) + __uint_as_float(ew[q] & 0xffff0000u) * sigmoidf_(a1);
                    }
                    if (OUTF != nullptr) { *(f32x4*)(OUTF + o2) = (f32x4){o[0], o[1], o[2], o[3]}; *(f32x4*)(OUTF + o2 + 4) = (f32x4){o[4], o[5], o[6], o[7]}; }
                    if (XBO != nullptr) { u32x4 w; w.x = cvt_pk_bf16(o[0], o[1]); w.y = cvt_pk_bf16(o[2], o[3]); w.z = cvt_pk_bf16(o[4], o[5]); w.w = cvt_pk_bf16(o[6], o[7]); *(u32x4*)(XBO + o2) = w; }
                }
            }
    }
};
}

#define LAS __attribute__((address_space(3)))
using pg8::bf16_t; using pg8::bf16x8; using pg8::f32x4; using pg8::u32x4; using pg8::u32x2;
typedef short s16x4 __attribute__((ext_vector_type(4)));
typedef float f32x16 __attribute__((ext_vector_type(16)));
typedef short v4i16_t __attribute__((ext_vector_type(4)));

constexpr int MT = 16384, SEQ = 8192, DM = 2048, DFF = 5632, NFF2 = 11264, NIN = 6144, UW = 6144, PLE = 256;
constexpr int LDS_BYTES = 147456;
constexpr float ALPHA = 1.4142135623730951f;
constexpr float LOG2E = 1.4426950408889634f;

constexpr size_t SZ_WFI = (size_t)NFF2 * DM * 2, SZ_WFO = (size_t)DM * DFF * 2, SZ_WIN = (size_t)NIN * DM * 2, SZ_WSQ = (size_t)DM * DM * 2, SZ_WPP = (size_t)DM * PLE * 2;
constexpr size_t OFF_WFI = 0;
constexpr size_t OFF_WFO = OFF_WFI + 4 * SZ_WFI;
constexpr size_t OFF_WAB = OFF_WFO + 4 * SZ_WFO;
constexpr size_t OFF_WC = OFF_WAB + SZ_WIN;
constexpr size_t OFF_WOAB = OFF_WC + SZ_WIN;
constexpr size_t OFF_WOC = OFF_WOAB + SZ_WSQ;
constexpr size_t OFF_WPG = OFF_WOC + SZ_WSQ;
constexpr size_t OFF_WPP = OFF_WPG + 2 * SZ_WSQ;
constexpr size_t OFF_XF = OFF_WPP + 2 * SZ_WPP;
constexpr size_t OFF_XB = OFF_XF + (size_t)MT * DM * 4;
constexpr size_t OFF_Z = OFF_XB + (size_t)MT * DM * 2;
constexpr size_t OFF_H = OFF_Z + (size_t)MT * DM * 4;
constexpr size_t OFF_MIX = OFF_H + (size_t)MT * UW * 2;
constexpr size_t OFF_PB = OFF_MIX + (size_t)MT * DM * 2;
constexpr size_t OFF_GT = OFF_PB + (size_t)2 * MT * PLE * 2;
constexpr size_t OFF_QB = OFF_GT + (size_t)MT * 16 * 4;
constexpr size_t OFF_KB = OFF_QB + (size_t)MT * 512 * 2;
constexpr size_t OFF_BC = OFF_KB + (size_t)MT * 512 * 2;
constexpr size_t OFF_IP = OFF_BC + (size_t)MT * 4 * 4;
constexpr size_t OFF_MSC = OFF_IP + (size_t)MT * 4 * 4;
constexpr size_t OFF_NL = OFF_MSC + 3 * 1024 * 4;
constexpr size_t OFF_DC = OFF_NL + (size_t)8 * 128 * 128 * 4;
constexpr size_t OFF_ST = OFF_DC + (size_t)8 * 128 * 256 * 4;
constexpr size_t OFF_CTL = OFF_ST + (size_t)8 * 128 * 512 * 256 * 2;
constexpr size_t WS_NEED = OFF_CTL + 32768;

#define LDS_WAIT() asm volatile("s_waitcnt lgkmcnt(0)" ::: "memory")
__device__ __forceinline__ unsigned f2bf(float f) { unsigned u = __builtin_bit_cast(unsigned, f); return (u + 0x7fffu + ((u >> 16) & 1u)) >> 16; }
__device__ __forceinline__ unsigned pk2(float lo, float hi) { return f2bf(lo) | (f2bf(hi) << 16); }
__device__ __forceinline__ float bf2f(unsigned h) { return __uint_as_float(h << 16); }
__device__ __forceinline__ float bflo(unsigned w) { return __uint_as_float(w << 16); }
__device__ __forceinline__ float bfhi(unsigned w) { return __uint_as_float(w & 0xffff0000u); }
__device__ __forceinline__ float wave_sum(float v) {
#pragma unroll
    for (int o = 1; o < 64; o <<= 1) v += __shfl_xor(v, o);
    return v;
}
__device__ __forceinline__ float logsigmoidf_(float x) { return fminf(x, 0.f) - __logf(1.f + __expf(-fabsf(x))); }
__device__ __forceinline__ s16x4 vtr(const LAS unsigned char* p) { return __builtin_bit_cast(s16x4, __builtin_amdgcn_ds_read_tr16_b64_v4i16((LAS v4i16_t*)p)); }
__device__ __forceinline__ bf16x8 tr8(const LAS unsigned char* p0, const LAS unsigned char* p1) {
    const s16x4 a = vtr(p0), b = vtr(p1); bf16x8 r; r[0] = a[0]; r[1] = a[1]; r[2] = a[2]; r[3] = a[3]; r[4] = b[0]; r[5] = b[1]; r[6] = b[2]; r[7] = b[3]; return r;
}
__device__ __forceinline__ f32x4 mfma16(bf16x8 a, bf16x8 b, f32x4 c) { return __builtin_amdgcn_mfma_f32_16x16x32_bf16(a, b, c, 0, 0, 0); }
__device__ __forceinline__ f32x16 mfma32(bf16x8 a, bf16x8 b, f32x16 c) { return __builtin_amdgcn_mfma_f32_32x32x16_bf16(a, b, c, 0, 0, 0); }
__device__ __forceinline__ bf16x8 ldsv8(const LAS unsigned char* p) { return *(const LAS bf16x8*)p; }

struct Ctx { LAS unsigned char* lds; int tid, lane, wave, G, bid, gw, NGW; };

__device__ __forceinline__ void tr_decode(int it, int nnb, int mode, int& k0, int& n0, int& drow0, float& scale) {
    const int kb = it / nnb, nb = it - kb * nnb; k0 = 64 * kb; n0 = 64 * nb; drow0 = n0; scale = 1.f;
    if (mode == 1) { const int half = n0 >= DFF ? 1 : 0; const int j0 = n0 - half * DFF; drow0 = 256 * (j0 >> 7) + 128 * half + (j0 & 127); }
    if (mode == 2 && n0 < 1024) scale = 0.125f;
}
__device__ __forceinline__ void tr_load(float (&r)[64], const float* __restrict__ W, int N, int k0, int n0, int lane) {
    const int n = n0 + lane; const bool ok = n < N; const float* src = W + (size_t)k0 * N + (ok ? n : 0);
#pragma unroll
    for (int i = 0; i < 64; ++i) { const float v = src[(size_t)i * N]; r[i] = ok ? v : 0.f; }
}
__device__ __forceinline__ void conv_matrix(const Ctx& C, const float* W, int K, int N, int Npad, bf16_t* WT, int mode, int& base) {
    LAS float* scr = (LAS float*)(C.lds + C.wave * 16640);
    const int nnb = Npad / 64, nitems = (K / 64) * nnb, lane = C.lane;
    int first = (C.gw - base) % C.NGW; if (first < 0) first += C.NGW;
    float r[64]; int k0 = 0, n0 = 0, drow0 = 0; float scale = 1.f;
    int it = first;
    if (it < nitems) { tr_decode(it, nnb, mode, k0, n0, drow0, scale); tr_load(r, W, N, k0, n0, lane); }
    while (it < nitems) {
#pragma unroll
        for (int i = 0; i < 64; ++i) scr[i * 65 + lane] = r[i] * scale;
        const int ck0 = k0, cdrow0 = drow0;
        it += C.NGW;
        if (it < nitems) { tr_decode(it, nnb, mode, k0, n0, drow0, scale); tr_load(r, W, N, k0, n0, lane); }
        LDS_WAIT(); asm volatile("" ::: "memory");
        const int c = lane & 7;
#pragma unroll
        for (int j = 0; j < 8; ++j) { const int nn = (lane >> 3) + 8 * j; const LAS float* s = scr + (8 * c) * 65 + nn;
            u32x4 o; o.x = pk2(s[0 * 65], s[1 * 65]); o.y = pk2(s[2 * 65], s[3 * 65]); o.z = pk2(s[4 * 65], s[5 * 65]); o.w = pk2(s[6 * 65], s[7 * 65]);
            *(u32x4*)(WT + (size_t)(cdrow0 + nn) * K + ck0 + 8 * c) = o; }
        LDS_WAIT(); asm volatile("" ::: "memory");
    }
    base = (base + nitems) % C.NGW;
}
__device__ __forceinline__ void cvt_rows(const Ctx& C, const float* src, bf16_t* dst, size_t n4) {
    const size_t stride = (size_t)C.G * 512;
    for (size_t i = (size_t)C.bid * 512 + C.tid; i < n4; i += 4 * stride) {
        f32x4 v[4];
#pragma unroll
        for (int j = 0; j < 4; ++j) if (i + j * stride < n4) v[j] = *(const f32x4*)(src + 4 * (i + j * stride));
#pragma unroll
        for (int j = 0; j < 4; ++j) if (i + j * stride < n4) { u32x2 w; w.x = pk2(v[j][0], v[j][1]); w.y = pk2(v[j][2], v[j][3]); *(u32x2*)(dst + 4 * (i + j * stride)) = w; }
    }
}

template <int NG>
__device__ __forceinline__ void ln_phase(const Ctx& C, const bf16_t* Z, const float* g, const float* b, bf16_t* XB, const float* Wsrc, int ldw, int ngate, float* GT) {
    constexpr bool GATES = NG > 0;
    LAS float* WG = (LAS float*)C.lds;
    if (GATES) {
        for (int col = C.tid; col < DM; col += 512) {
            const float* src = Wsrc + (size_t)col * ldw + 6144;
#pragma unroll
            for (int gi = 0; gi < (NG > 0 ? NG : 1); ++gi) WG[gi * DM + col] = (gi < ngate) ? src[gi] : 0.f;
        }
        __syncthreads();
    }
    f32x4 gv[8], bv[8];
#pragma unroll
    for (int j = 0; j < 4; ++j) { gv[2 * j] = *(const f32x4*)(g + 512 * j + 8 * C.lane); gv[2 * j + 1] = *(const f32x4*)(g + 512 * j + 8 * C.lane + 4);
                                  bv[2 * j] = *(const f32x4*)(b + 512 * j + 8 * C.lane); bv[2 * j + 1] = *(const f32x4*)(b + 512 * j + 8 * C.lane + 4); }
    const bool grp = (C.G & 7) == 0; const int nwg_ = grp ? (C.G >> 3) * 8 : C.NGW; const int first_ = grp ? (C.bid >> 3) * 8 + C.wave : C.gw; const int base_ = grp ? 2048 * (C.bid & 7) : 0; const int lim_ = grp ? 2048 : MT;
    for (int lrow = first_; lrow < lim_; lrow += nwg_) {
        const int row = base_ + lrow;
        const bf16_t* z = Z + (size_t)row * DM + 8 * C.lane;
        u32x4 zb[4];
#pragma unroll
        for (int j = 0; j < 4; ++j) zb[j] = *(const u32x4*)(z + 512 * j);
        f32x4 v[8]; float s = 0.f;
#pragma unroll
        for (int j = 0; j < 4; ++j) { v[2 * j] = (f32x4){bflo(zb[j].x), bfhi(zb[j].x), bflo(zb[j].y), bfhi(zb[j].y)}; v[2 * j + 1] = (f32x4){bflo(zb[j].z), bfhi(zb[j].z), bflo(zb[j].w), bfhi(zb[j].w)}; }
#pragma unroll
        for (int j = 0; j < 8; ++j) s += (v[j][0] + v[j][1]) + (v[j][2] + v[j][3]);
        const float mean = wave_sum(s) * (1.f / DM); float s2 = 0.f;
#pragma unroll
        for (int j = 0; j < 8; ++j) { v[j] = v[j] - mean; s2 += (v[j][0] * v[j][0] + v[j][1] * v[j][1]) + (v[j][2] * v[j][2] + v[j][3] * v[j][3]); }
        const float rstd = __builtin_amdgcn_rsqf(wave_sum(s2) * (1.f / DM) + 1e-5f);
        bf16_t* bo = XB + (size_t)row * DM + 8 * C.lane;
#pragma unroll
        for (int j = 0; j < 4; ++j) { const f32x4 o0 = v[2 * j] * rstd * gv[2 * j] + bv[2 * j], o1 = v[2 * j + 1] * rstd * gv[2 * j + 1] + bv[2 * j + 1];
            u32x4 w; w.x = pg8::cvt_pk_bf16(o0[0], o0[1]); w.y = pg8::cvt_pk_bf16(o0[2], o0[3]); w.z = pg8::cvt_pk_bf16(o1[0], o1[1]); w.w = pg8::cvt_pk_bf16(o1[2], o1[3]); *(u32x4*)(bo + 512 * j) = w;
            if (GATES) { v[2 * j] = o0; v[2 * j + 1] = o1; } }
        if (GATES) {
            float mine = 0.f;
#pragma unroll 4
            for (int gi = 0; gi < (NG > 0 ? NG : 1); ++gi) {
                float s0 = 0.f, s1 = 0.f;
#pragma unroll
                for (int j = 0; j < 4; ++j) { const f32x4 w0 = *(const LAS f32x4*)(WG + gi * DM + 512 * j + 8 * C.lane), w1 = *(const LAS f32x4*)(WG + gi * DM + 512 * j + 8 * C.lane + 4);
                    s0 += (v[2 * j][0] * w0[0] + v[2 * j][1] * w0[1]) + (v[2 * j][2] * w0[2] + v[2 * j][3] * w0[3]);
                    s1 += (v[2 * j + 1][0] * w1[0] + v[2 * j + 1][1] * w1[1]) + (v[2 * j + 1][2] * w1[2] + v[2 * j + 1][3] * w1[3]); }
                const float tot = wave_sum(s0 + s1);
                mine = (C.lane == gi) ? tot : mine;
            }
            if (C.lane < NG) GT[(size_t)row * 16 + C.lane] = mine;
        }
    }
    if (GATES) __syncthreads();
}

__device__ __forceinline__ void m1_phase(const Ctx& C, const bf16_t* U, const float* GT, const float* conv_w, const float* conv_b, const float* b_i, const float* b_f,
                                         bf16_t* QB, bf16_t* KB, float* BC, float* IP, float* MSC) {
    if (C.bid < 8) {
        LAS float* sb = (LAS float*)C.lds; LAS float* su = sb + 128;
        const int bh = C.bid, b = bh >> 2, h = bh & 3;
        {
            const float bi = b_i[h], bf = b_f[h]; const int ln = C.lane;
            float fv[16], iv[16];
#pragma unroll
            for (int k = 0; k < 16; ++k) { const size_t row = (size_t)b * SEQ + (C.wave * 16 + k) * 64 + ln; fv[k] = GT[row * 16 + 4 + h]; iv[k] = GT[row * 16 + h]; }
#pragma unroll
            for (int k = 0; k < 16; ++k) {
                const int c = C.wave * 16 + k; const size_t row = (size_t)b * SEQ + c * 64 + ln;
                float cum = logsigmoidf_(fv[k] + bf);
#pragma unroll
                for (int off = 1; off < 64; off <<= 1) { const float t = __shfl_up(cum, off); if (ln >= off) cum += t; }
                const float ip = iv[k] + bi;
                BC[row * 4 + h] = cum; IP[row * 4 + h] = ip;
                float um = ip - cum;
#pragma unroll
                for (int off = 1; off < 64; off <<= 1) um = fmaxf(um, __shfl_xor(um, off));
                const float bl = __shfl(cum, 63);
                if (ln == 0) { sb[c] = bl; su[c] = um; }
            }
        }
        __syncthreads();
        if (C.tid == 0) {
            float m = 0.f;
#pragma unroll 1
            for (int c = 0; c < 128; ++c) {
                const float bl = sb[c], mn = fmaxf(bl + m, bl + su[c]);
                MSC[bh * 128 + c] = m; MSC[1024 + bh * 128 + c] = mn; MSC[2048 + bh * 128 + c] = __expf(bl + m - mn); m = mn;
            }
        }
        __syncthreads();
    }
    {
        const int c0 = (int)(((size_t)C.bid * 512 + C.tid) & 127) * 8;
        f32x4 w0[4], w1[4];
#pragma unroll
        for (int j = 0; j < 4; ++j) { w0[j] = *(const f32x4*)(conv_w + j * 1024 + c0); w1[j] = *(const f32x4*)(conv_w + j * 1024 + c0 + 4); }
        const f32x4 cb0 = *(const f32x4*)(conv_b + c0), cb1 = *(const f32x4*)(conv_b + c0 + 4);
        const float sc = (c0 < 512) ? 0.08838834764831845f : 1.f;
        for (size_t i = (size_t)C.bid * 512 + C.tid; i < (size_t)MT * 128; i += (size_t)C.G * 512) {
            const int row = (int)(i >> 7), t = row & (SEQ - 1);
            float acc[8] = {cb0[0], cb0[1], cb0[2], cb0[3], cb1[0], cb1[1], cb1[2], cb1[3]};
#pragma unroll
            for (int j = 0; j < 4; ++j) {
                const int tt = t - 3 + j;
                if (tt >= 0) {
                    const u32x4 xv = *(const u32x4*)(U + (size_t)(row - 3 + j) * UW + 3072 + c0);
                    acc[0] += w0[j][0] * bflo(xv.x); acc[1] += w0[j][1] * bfhi(xv.x); acc[2] += w0[j][2] * bflo(xv.y); acc[3] += w0[j][3] * bfhi(xv.y);
                    acc[4] += w1[j][0] * bflo(xv.z); acc[5] += w1[j][1] * bfhi(xv.z); acc[6] += w1[j][2] * bflo(xv.w); acc[7] += w1[j][3] * bfhi(xv.w);
                }
            }
#pragma unroll
            for (int e = 0; e < 8; ++e) acc[e] = acc[e] * pg8::sigmoidf_(acc[e]) * sc;
            u32x4 w; w.x = pk2(acc[0], acc[1]); w.y = pk2(acc[2], acc[3]); w.z = pk2(acc[4], acc[5]); w.w = pk2(acc[6], acc[7]);
            if (c0 < 512) *(u32x4*)(QB + (size_t)row * 512 + c0) = w; else *(u32x4*)(KB + (size_t)row * 512 + c0 - 512) = w;
        }
    }
}

__device__ __forceinline__ void mlstm_passA(const Ctx& C, const bf16_t* U, const bf16_t* KB, const float* BC, const float* IP, const float* MSC, bf16_t* ST, float* NL) {
    LAS unsigned char* KW = C.lds; LAS unsigned char* V = C.lds + 17408; LAS float* wk = (LAS float*)(C.lds + 52224);
    const int l = C.lane, g = l >> 4, q = (l & 15) >> 2, p = l & 3, w = C.wave;
    for (int u = C.bid; u < 1024; u += C.G) {
        const int bh = u >> 7, c = u & 127, b = bh >> 2, h = bh & 3; const size_t row0 = (size_t)b * SEQ + c * 64;
        if (C.tid < 64) { const float bl = BC[(row0 + 63) * 4 + h], mn = MSC[1024 + bh * 128 + c]; wk[C.tid] = __expf(bl - BC[(row0 + C.tid) * 4 + h] + IP[(row0 + C.tid) * 4 + h] - mn); }
        __syncthreads();
        { const int s = C.tid >> 3, seg = C.tid & 7; const float ws = wk[s];
          const bf16_t* kp = KB + (row0 + s) * 512 + h * 128 + seg * 16;
#pragma unroll
          for (int i = 0; i < 2; ++i) { const u32x4 kv = *(const u32x4*)(kp + 8 * i); u32x4 o;
              o.x = pk2(bflo(kv.x) * ws, bfhi(kv.x) * ws); o.y = pk2(bflo(kv.y) * ws, bfhi(kv.y) * ws); o.z = pk2(bflo(kv.z) * ws, bfhi(kv.z) * ws); o.w = pk2(bflo(kv.w) * ws, bfhi(kv.w) * ws);
              *(LAS u32x4*)(KW + s * 272 + seg * 32 + 16 * i) = o; }
          const bf16_t* vp = U + (row0 + s) * UW + 4096 + h * 256 + seg * 32;
#pragma unroll
          for (int i = 0; i < 4; ++i) *(LAS u32x4*)(V + s * 544 + seg * 64 + 16 * i) = *(const u32x4*)(vp + 8 * i); }
        __syncthreads();
        f32x4 acc[2][8];
#pragma unroll
        for (int mi = 0; mi < 2; ++mi)
#pragma unroll
            for (int ni = 0; ni < 8; ++ni) acc[mi][ni] = (f32x4){0.f, 0.f, 0.f, 0.f};
#pragma unroll
        for (int ks = 0; ks < 2; ++ks) {
            const int r0 = 32 * ks + 8 * g + q;
            bf16x8 a[2];
#pragma unroll
            for (int mi = 0; mi < 2; ++mi) { const LAS unsigned char* ap = V + r0 * 544 + (32 * w + 16 * mi + 4 * p) * 2; a[mi] = tr8(ap, ap + 4 * 544); }
#pragma unroll
            for (int ni = 0; ni < 8; ++ni) { const LAS unsigned char* bp = KW + r0 * 272 + (16 * ni + 4 * p) * 2; const bf16x8 bb = tr8(bp, bp + 4 * 272);
#pragma unroll
                for (int mi = 0; mi < 2; ++mi) acc[mi][ni] = mfma16(bb, a[mi], acc[mi][ni]); }
        }
        bf16_t* st = ST + ((size_t)(bh * 128 + c) << 15);
#pragma unroll
        for (int mi = 0; mi < 2; ++mi)
#pragma unroll
            for (int ni = 0; ni < 8; ++ni) { u32x2 wv; wv.x = pg8::cvt_pk_bf16(acc[mi][ni][0], acc[mi][ni][1]); wv.y = pg8::cvt_pk_bf16(acc[mi][ni][2], acc[mi][ni][3]);
                *(u32x2*)(st + (32 * w + 16 * mi + (l & 15)) * 128 + 16 * ni + 4 * g) = wv; }
        if (C.tid < 128) { float s = 0.f;
#pragma unroll 4
            for (int t = 0; t < 64; ++t) s += bf2f(*(const LAS unsigned short*)(KW + t * 272 + C.tid * 2)); NL[(size_t)(bh * 128 + c) * 128 + C.tid] = s; }
        __syncthreads();
    }
}

__device__ __forceinline__ void mlstm_scan(const Ctx& C, bf16_t* ST, float* NL, const float* MSC) {
    for (int e2 = C.bid * 512 + C.tid; e2 < 8 * 16384; e2 += C.G * 512) {
        const int bh = e2 >> 14, off = e2 & 16383; float c0 = 0.f, c1 = 0.f;
        unsigned* p = (unsigned*)(ST + ((size_t)(bh * 128) << 15)) + off;
#pragma unroll 1
        for (int cb = 0; cb < 128; cb += 8) {
            unsigned t[8]; float d[8];
#pragma unroll
            for (int i = 0; i < 8; ++i) { t[i] = p[(size_t)(cb + i) << 14]; d[i] = MSC[2048 + bh * 128 + cb + i]; }
#pragma unroll
            for (int i = 0; i < 8; ++i) { p[(size_t)(cb + i) << 14] = pk2(c0, c1); c0 = d[i] * c0 + bflo(t[i]); c1 = d[i] * c1 + bfhi(t[i]); }
        }
    }
    const int gt = C.bid * 512 + C.tid;
    if (gt < 1024) { const int bh = gt >> 7, dk = gt & 127; float n = 0.f;
#pragma unroll 2
        for (int c = 0; c < 128; ++c) { float* p = NL + (size_t)(bh * 128 + c) * 128 + dk; const float t = *p; *p = n; n = MSC[2048 + bh * 128 + c] * n + t; } }
}

__device__ __forceinline__ void mlstm_passC(const Ctx& C, const bf16_t* U, const bf16_t* QB, const bf16_t* KB, const float* BC, const float* IP, const float* MSC,
                                            const bf16_t* ST, const float* NL, const float* mg, bf16_t* MIX) {
    LAS unsigned char* Q = C.lds; LAS unsigned char* K = C.lds + 17408; LAS unsigned char* V = C.lds + 34816; LAS unsigned char* SW = C.lds + 69632;
    LAS float* fu = (LAS float*)(C.lds + 78848); LAS float* fM = fu + 64; LAS float* fw = fu + 128; LAS float* fb = fu + 192; LAS float* finv = fu + 256; LAS float* fn = fu + 320; LAS float* fss = fu + 448;
    const int l = C.lane, g = l >> 4, q = (l & 15) >> 2, p = l & 3, w = C.wave, lr = l & 15;
    for (int u = C.bid; u < 1024; u += C.G) {
        const int bh = u >> 7, c = u & 127, b = bh >> 2, h = bh & 3; const size_t row0 = (size_t)b * SEQ + c * 64;
        const float mprev = MSC[bh * 128 + c];
        if (C.tid < 64) { const float bt = BC[(row0 + C.tid) * 4 + h]; fb[C.tid] = bt; fu[C.tid] = IP[(row0 + C.tid) * 4 + h] - bt; }
        if (C.tid >= 64 && C.tid < 192) fn[C.tid - 64] = NL[(size_t)(bh * 128 + c) * 128 + C.tid - 64];
        { const int s = C.tid >> 3, seg = C.tid & 7;
          const bf16_t* qp = QB + (row0 + s) * 512 + h * 128 + seg * 16; const bf16_t* kp = KB + (row0 + s) * 512 + h * 128 + seg * 16;
#pragma unroll
          for (int i = 0; i < 2; ++i) { *(LAS u32x4*)(Q + s * 272 + seg * 32 + 16 * i) = *(const u32x4*)(qp + 8 * i); *(LAS u32x4*)(K + s * 272 + seg * 32 + 16 * i) = *(const u32x4*)(kp + 8 * i); }
          const bf16_t* vp = U + (row0 + s) * UW + 4096 + h * 256 + seg * 32;
#pragma unroll
          for (int i = 0; i < 4; ++i) *(LAS u32x4*)(V + s * 544 + seg * 64 + 16 * i) = *(const u32x4*)(vp + 8 * i); }
        __syncthreads();
        if (C.wave == 0) {
            float pm = fu[C.lane];
#pragma unroll
            for (int off = 1; off < 64; off <<= 1) { const float t_ = __shfl_up(pm, off); if (C.lane >= off) pm = fmaxf(pm, t_); }
            const float Mt = fmaxf(mprev, pm); fM[C.lane] = Mt; fw[C.lane] = __expf(mprev - Mt); }
        __syncthreads();
#pragma unroll
        for (int tt = 0; tt < 2; ++tt) {
            const int tile = 2 * w + tt, ti = tile >> 2, si = tile & 3;
            f32x4 s4 = (f32x4){0.f, 0.f, 0.f, 0.f};
            if (si <= ti) {
#pragma unroll
                for (int ks = 0; ks < 4; ++ks) { const bf16x8 a = ldsv8(Q + (16 * ti + lr) * 272 + (32 * ks + 8 * g) * 2), bb = ldsv8(K + (16 * si + lr) * 272 + (32 * ks + 8 * g) * 2); s4 = mfma16(a, bb, s4); }
            }
            const int sidx = 16 * si + lr; const float us = fu[sidx];
#pragma unroll
            for (int j = 0; j < 4; ++j) { const int t = 16 * ti + 4 * g + j; const float wgt = (sidx <= t) ? __expf(us - fM[t]) : 0.f;
                *(LAS unsigned short*)(SW + t * 144 + sidx * 2) = (unsigned short)f2bf(s4[j] * wgt); }
        }
        __syncthreads();
        if (C.tid < 64) { const int t = C.tid; float rs = 0.f, qn = 0.f;
#pragma unroll 4
            for (int s = 0; s < 64; ++s) rs += bf2f(*(const LAS unsigned short*)(SW + t * 144 + s * 2));
#pragma unroll 4
            for (int d = 0; d < 128; ++d) qn += bf2f(*(const LAS unsigned short*)(Q + t * 272 + d * 2)) * fn[d];
            const float den = fw[t] * qn + rs; finv[t] = __builtin_amdgcn_rcpf(fmaxf(fabsf(den), __expf(-(fb[t] + fM[t])))); }
        f32x4 acc[4][2];
#pragma unroll
        for (int mi = 0; mi < 4; ++mi)
#pragma unroll
            for (int ni = 0; ni < 2; ++ni) acc[mi][ni] = (f32x4){0.f, 0.f, 0.f, 0.f};
        const bf16_t* st = ST + ((size_t)(bh * 128 + c) << 15);
#pragma unroll
        for (int ks = 0; ks < 4; ++ks) {
            bf16x8 bb[2];
#pragma unroll
            for (int ni = 0; ni < 2; ++ni) bb[ni] = *(const bf16x8*)(st + (32 * w + 16 * ni + lr) * 128 + 32 * ks + 8 * g);
#pragma unroll
            for (int mi = 0; mi < 4; ++mi) { const bf16x8 a = ldsv8(Q + (16 * mi + lr) * 272 + (32 * ks + 8 * g) * 2);
#pragma unroll
                for (int ni = 0; ni < 2; ++ni) acc[mi][ni] = mfma16(bb[ni], a, acc[mi][ni]); }
        }
#pragma unroll
        for (int mi = 0; mi < 4; ++mi) { const float wi = fw[16 * mi + lr]; acc[mi][0] = acc[mi][0] * wi; acc[mi][1] = acc[mi][1] * wi; }
#pragma unroll
        for (int ks = 0; ks < 2; ++ks) {
            const int r0 = 32 * ks + 8 * g + q; bf16x8 bb[2];
#pragma unroll
            for (int ni = 0; ni < 2; ++ni) { const LAS unsigned char* bp = V + r0 * 544 + (32 * w + 16 * ni + 4 * p) * 2; bb[ni] = tr8(bp, bp + 4 * 544); }
#pragma unroll
            for (int mi = 0; mi < 4; ++mi) { const bf16x8 a = ldsv8(SW + (16 * mi + lr) * 144 + (32 * ks + 8 * g) * 2);
#pragma unroll
                for (int ni = 0; ni < 2; ++ni) acc[mi][ni] = mfma16(bb[ni], a, acc[mi][ni]); }
        }
        __syncthreads();
#pragma unroll
        for (int mi = 0; mi < 4; ++mi) { const float iv = finv[16 * mi + lr]; acc[mi][0] = acc[mi][0] * iv; acc[mi][1] = acc[mi][1] * iv;
            float ss = 0.f;
#pragma unroll
            for (int ni = 0; ni < 2; ++ni) ss += (acc[mi][ni][0] * acc[mi][ni][0] + acc[mi][ni][1] * acc[mi][ni][1]) + (acc[mi][ni][2] * acc[mi][ni][2] + acc[mi][ni][3] * acc[mi][ni][3]);
            ss += __shfl_xor(ss, 16); ss += __shfl_xor(ss, 32);
            if (g == 0) fss[w * 64 + 16 * mi + lr] = ss; }
        __syncthreads();
#pragma unroll
        for (int mi = 0; mi < 4; ++mi) { const int t = 16 * mi + lr; float tot = 0.f;
#pragma unroll
            for (int ww = 0; ww < 8; ++ww) tot += fss[ww * 64 + t];
            const float r = __builtin_amdgcn_rsqf(tot * (1.f / 256.f) + 1e-6f);
#pragma unroll
            for (int ni = 0; ni < 2; ++ni) { const int dv = 32 * w + 16 * ni + 4 * g;
                const u32x2 ogb = *(const u32x2*)(U + (row0 + t) * UW + 5120 + h * 256 + dv); const f32x4 gv = *(const f32x4*)(mg + h * 256 + dv);
                const float o0 = acc[mi][ni][0] * r * gv[0] * pg8::sigmoidf_(bflo(ogb.x)), o1 = acc[mi][ni][1] * r * gv[1] * pg8::sigmoidf_(bfhi(ogb.x));
                const float o2 = acc[mi][ni][2] * r * gv[2] * pg8::sigmoidf_(bflo(ogb.y)), o3 = acc[mi][ni][3] * r * gv[3] * pg8::sigmoidf_(bfhi(ogb.y));
                u32x2 wv; wv.x = pg8::cvt_pk_bf16(o0, o1); wv.y = pg8::cvt_pk_bf16(o2, o3);
                *(u32x2*)(MIX + (row0 + t) * DM + 1024 + h * 256 + dv) = wv; } }
        __syncthreads();
    }
}

__device__ __forceinline__ float gla_decay(const Ctx& C, const float* w_a2, const float* b_a, int h, LAS float* A1, LAS float* tot0, LAS unsigned char* QD, LAS unsigned char* KD) {
    const int ch = C.tid & 255, half = C.tid >> 8, t0 = 32 * half;
    float wv[16];
#pragma unroll
    for (int i = 0; i < 16; ++i) wv[i] = w_a2[i * 1024 + h * 256 + ch];
    const float ba = b_a[h * 256 + ch];
    float c[32]; float run = 0.f;
#pragma unroll
    for (int i = 0; i < 32; ++i) {
        const LAS float* ap = A1 + (t0 + i) * 16;
        const f32x4 a0 = *(const LAS f32x4*)(ap), a1 = *(const LAS f32x4*)(ap + 4), a2 = *(const LAS f32x4*)(ap + 8), a3 = *(const LAS f32x4*)(ap + 12);
        float z0 = ba, z1 = 0.f, z2 = 0.f, z3 = 0.f;
#pragma unroll
        for (int j = 0; j < 4; ++j) { z0 += a0[j] * wv[j]; z1 += a1[j] * wv[4 + j]; z2 += a2[j] * wv[8 + j]; z3 += a3[j] * wv[12 + j]; }
        const float z = (z0 + z1) + (z2 + z3);
        run += (fminf(z, 0.f) - __logf(1.f + __expf(-fabsf(z)))) * 0.0625f;
        c[i] = run;
    }
    if (half == 0) tot0[ch] = run;
    __syncthreads();
    const float off = half ? tot0[ch] : 0.f;
#pragma unroll
    for (int i = 0; i < 32; ++i) {
        const float cum = c[i] + off; const int t = t0 + i;
        LAS unsigned short* kp = (LAS unsigned short*)(KD + t * 528 + ch * 2); *kp = (unsigned short)f2bf(bf2f(*kp) * __expf(-cum));
        LAS unsigned short* qp = (LAS unsigned short*)(QD + t * 528 + ch * 2); *qp = (unsigned short)f2bf(bf2f(*qp) * __expf(cum) * 0.0625f);
    }
    return __expf(c[31] + off);
}

__device__ __forceinline__ void gla_passA(const Ctx& C, const bf16_t* U, const float* GT, const float* w_a2, const float* b_a, bf16_t* ST, float* DC, bf16_t* QDG, bf16_t* KDG) {
    LAS unsigned char* QD = C.lds; LAS unsigned char* KD = C.lds + 33792; LAS unsigned char* V = C.lds + 67584;
    LAS float* A1 = (LAS float*)(C.lds + 135168); LAS float* bl = (LAS float*)(C.lds + 139264); LAS float* tot0 = (LAS float*)(C.lds + 140288);
    const int l = C.lane, g = l >> 4, q = (l & 15) >> 2, p = l & 3, w = C.wave, lr = l & 15;
    for (int u = C.bid; u < 1024; u += C.G) {
        const int bh = u >> 7, c = u & 127, b = bh >> 2, h = bh & 3; const size_t row0 = (size_t)b * SEQ + c * 64;
        A1[C.tid] = GT[row0 * 16 + C.tid]; A1[C.tid + 512] = GT[row0 * 16 + C.tid + 512];
        { const int s = C.tid >> 3, seg = C.tid & 7; const bf16_t* vp = U + (row0 + s) * UW + 2048 + h * 512 + seg * 64;
#pragma unroll
          for (int i = 0; i < 8; ++i) *(LAS u32x4*)(V + s * 1056 + seg * 128 + 16 * i) = *(const u32x4*)(vp + 8 * i);
          const bf16_t* qp = U + (row0 + s) * UW + h * 256 + seg * 32;
#pragma unroll
          for (int i = 0; i < 4; ++i) { *(LAS u32x4*)(QD + s * 528 + seg * 64 + 16 * i) = *(const u32x4*)(qp + 8 * i); *(LAS u32x4*)(KD + s * 528 + seg * 64 + 16 * i) = *(const u32x4*)(qp + 1024 + 8 * i); } }
        __syncthreads();
        const float eb = gla_decay(C, w_a2, b_a, h, A1, tot0, QD, KD);
        if (C.tid >= 256) { bl[C.tid - 256] = eb; DC[(size_t)(bh * 128 + c) * 256 + C.tid - 256] = eb; }
        __syncthreads();
        { const int s = C.tid >> 3, seg = C.tid & 7; bf16_t* qg = QDG + (row0 + s) * 1024 + h * 256 + seg * 32; bf16_t* kg = KDG + (row0 + s) * 1024 + h * 256 + seg * 32;
#pragma unroll
          for (int i = 0; i < 4; ++i) { *(u32x4*)(qg + 8 * i) = *(const LAS u32x4*)(QD + s * 528 + seg * 64 + 16 * i); *(u32x4*)(kg + 8 * i) = *(const LAS u32x4*)(KD + s * 528 + seg * 64 + 16 * i); } }
#pragma unroll 1
        for (int dvq = 0; dvq < 4; ++dvq) {
            f32x4 acc[16];
#pragma unroll
            for (int ni = 0; ni < 16; ++ni) acc[ni] = (f32x4){0.f, 0.f, 0.f, 0.f};
#pragma unroll
            for (int ks = 0; ks < 2; ++ks) {
                const int r0 = 32 * ks + 8 * g + q;
                const LAS unsigned char* ap = V + r0 * 1056 + (dvq * 128 + 16 * w + 4 * p) * 2; const bf16x8 a = tr8(ap, ap + 4 * 1056);
#pragma unroll
                for (int ni = 0; ni < 16; ++ni) { const LAS unsigned char* bp = KD + r0 * 528 + (16 * ni + 4 * p) * 2; acc[ni] = mfma16(tr8(bp, bp + 4 * 528), a, acc[ni]); }
            }
            bf16_t* st = ST + ((size_t)(bh * 128 + c) << 17) + (size_t)(dvq * 128 + 16 * w + lr) * 256 + 4 * g;
#pragma unroll
            for (int ni = 0; ni < 16; ++ni) { const f32x4 e4 = *(const LAS f32x4*)(bl + 16 * ni + 4 * g); const f32x4 v4 = acc[ni] * e4;
                u32x2 wv; wv.x = pg8::cvt_pk_bf16(v4[0], v4[1]); wv.y = pg8::cvt_pk_bf16(v4[2], v4[3]); *(u32x2*)(st + 16 * ni) = wv; }
        }
        __syncthreads();
    }
}

__device__ __forceinline__ void gla_scan(const Ctx& C, bf16_t* ST, const float* DC) {
    for (int e8 = C.bid * 512 + C.tid; e8 < 8 * 16384; e8 += C.G * 512) {
        const int bh = e8 >> 14, off = e8 & 16383, dk = (off * 8) & 255;
        float s[8];
#pragma unroll
        for (int i = 0; i < 8; ++i) s[i] = 0.f;
        u32x4* p = (u32x4*)(ST + ((size_t)(bh * 128) << 17)) + off;
#pragma unroll 1
        for (int cb = 0; cb < 128; cb += 4) {
            u32x4 t[4]; f32x4 d0[4], d1[4];
#pragma unroll
            for (int i = 0; i < 4; ++i) { t[i] = p[(size_t)(cb + i) << 14]; const float* d = DC + (size_t)(bh * 128 + cb + i) * 256 + dk; d0[i] = *(const f32x4*)d; d1[i] = *(const f32x4*)(d + 4); }
#pragma unroll
            for (int i = 0; i < 4; ++i) {
                u32x4 o; o.x = pk2(s[0], s[1]); o.y = pk2(s[2], s[3]); o.z = pk2(s[4], s[5]); o.w = pk2(s[6], s[7]); p[(size_t)(cb + i) << 14] = o;
                s[0] = d0[i][0] * s[0] + bflo(t[i].x); s[1] = d0[i][1] * s[1] + bfhi(t[i].x); s[2] = d0[i][2] * s[2] + bflo(t[i].y); s[3] = d0[i][3] * s[3] + bfhi(t[i].y);
                s[4] = d1[i][0] * s[4] + bflo(t[i].z); s[5] = d1[i][1] * s[5] + bfhi(t[i].z); s[6] = d1[i][2] * s[6] + bflo(t[i].w); s[7] = d1[i][3] * s[7] + bfhi(t[i].w);
            }
        }
    }
}

__device__ __forceinline__ void gla_passC(const Ctx& C, const bf16_t* U, const bf16_t* QDG, const bf16_t* KDG, const bf16_t* ST, const float* gg, bf16_t* MIX) {
    LAS unsigned char* QD = C.lds; LAS unsigned char* KD = C.lds + 33792; LAS unsigned char* V = C.lds + 67584; LAS unsigned char* ATT = C.lds + 135168;
    LAS float* fss = (LAS float*)(C.lds + 144384);
    const int l = C.lane, g = l >> 4, q = (l & 15) >> 2, p = l & 3, w = C.wave, lr = l & 15;
    for (int u = C.bid; u < 1024; u += C.G) {
        const int bh = u >> 7, c = u & 127, b = bh >> 2, h = bh & 3; const size_t row0 = (size_t)b * SEQ + c * 64;
        { const int s = C.tid >> 3, seg = C.tid & 7; const bf16_t* vp = U + (row0 + s) * UW + 2048 + h * 512 + seg * 64;
#pragma unroll
          for (int i = 0; i < 8; ++i) *(LAS u32x4*)(V + s * 1056 + seg * 128 + 16 * i) = *(const u32x4*)(vp + 8 * i);
          const bf16_t* qg = QDG + (row0 + s) * 1024 + h * 256 + seg * 32; const bf16_t* kg = KDG + (row0 + s) * 1024 + h * 256 + seg * 32;
#pragma unroll
          for (int i = 0; i < 4; ++i) { *(LAS u32x4*)(QD + s * 528 + seg * 64 + 16 * i) = *(const u32x4*)(qg + 8 * i); *(LAS u32x4*)(KD + s * 528 + seg * 64 + 16 * i) = *(const u32x4*)(kg + 8 * i); } }
        __syncthreads();
#pragma unroll
        for (int tt = 0; tt < 2; ++tt) {
            const int tile = 2 * w + tt, ti = tile >> 2, si = tile & 3;
            f32x4 s4 = (f32x4){0.f, 0.f, 0.f, 0.f};
            if (si <= ti) {
#pragma unroll
                for (int ks = 0; ks < 8; ++ks) { const bf16x8 a = ldsv8(QD + (16 * ti + lr) * 528 + (32 * ks + 8 * g) * 2), bb = ldsv8(KD + (16 * si + lr) * 528 + (32 * ks + 8 * g) * 2); s4 = mfma16(a, bb, s4); }
            }
            const int sidx = 16 * si + lr;
#pragma unroll
            for (int j = 0; j < 4; ++j) { const int t = 16 * ti + 4 * g + j; *(LAS unsigned short*)(ATT + t * 144 + sidx * 2) = (unsigned short)f2bf((sidx <= t) ? s4[j] : 0.f); }
        }
        __syncthreads();
        f32x4 acc[4][4];
#pragma unroll
        for (int mi = 0; mi < 4; ++mi)
#pragma unroll
            for (int ni = 0; ni < 4; ++ni) acc[mi][ni] = (f32x4){0.f, 0.f, 0.f, 0.f};
        const bf16_t* st = ST + ((size_t)(bh * 128 + c) << 17);
#pragma unroll 4
        for (int ks = 0; ks < 8; ++ks) {
            bf16x8 bb[4];
#pragma unroll
            for (int ni = 0; ni < 4; ++ni) bb[ni] = *(const bf16x8*)(st + (size_t)(64 * w + 16 * ni + lr) * 256 + 32 * ks + 8 * g);
#pragma unroll
            for (int mi = 0; mi < 4; ++mi) { const bf16x8 a = ldsv8(QD + (16 * mi + lr) * 528 + (32 * ks + 8 * g) * 2);
#pragma unroll
                for (int ni = 0; ni < 4; ++ni) acc[mi][ni] = mfma16(bb[ni], a, acc[mi][ni]); }
        }
#pragma unroll
        for (int ks = 0; ks < 2; ++ks) {
            const int r0 = 32 * ks + 8 * g + q; bf16x8 bb[4];
#pragma unroll
            for (int ni = 0; ni < 4; ++ni) { const LAS unsigned char* bp = V + r0 * 1056 + (64 * w + 16 * ni + 4 * p) * 2; bb[ni] = tr8(bp, bp + 4 * 1056); }
#pragma unroll
            for (int mi = 0; mi < 4; ++mi) { const bf16x8 a = ldsv8(ATT + (16 * mi + lr) * 144 + (32 * ks + 8 * g) * 2);
#pragma unroll
                for (int ni = 0; ni < 4; ++ni) acc[mi][ni] = mfma16(bb[ni], a, acc[mi][ni]); }
        }
#pragma unroll
        for (int mi = 0; mi < 4; ++mi) { float ss = 0.f;
#pragma unroll
            for (int ni = 0; ni < 4; ++ni) ss += (acc[mi][ni][0] * acc[mi][ni][0] + acc[mi][ni][1] * acc[mi][ni][1]) + (acc[mi][ni][2] * acc[mi][ni][2] + acc[mi][ni][3] * acc[mi][ni][3]);
            ss += __shfl_xor(ss, 16); ss += __shfl_xor(ss, 32);
            if (g == 0) fss[w * 64 + 16 * mi + lr] = ss; }
        __syncthreads();
#pragma unroll
        for (int mi = 0; mi < 4; ++mi) { const int t = 16 * mi + lr; float tot = 0.f;
#pragma unroll
            for (int ww = 0; ww < 8; ++ww) tot += fss[ww * 64 + t];
            const float r = __builtin_amdgcn_rsqf(tot * (1.f / 512.f) + 1e-6f);
#pragma unroll
            for (int ni = 0; ni < 4; ++ni) { const int dv = 64 * w + 16 * ni + 4 * g;
                const u32x2 rgb = *(const u32x2*)(U + (row0 + t) * UW + 4096 + h * 512 + dv); const f32x4 gv = *(const f32x4*)(gg + h * 512 + dv);
                const float r0 = bflo(rgb.x), r1 = bfhi(rgb.x), r2 = bflo(rgb.y), r3 = bfhi(rgb.y);
                const float o0 = acc[mi][ni][0] * r * gv[0] * r0 * pg8::sigmoidf_(r0), o1 = acc[mi][ni][1] * r * gv[1] * r1 * pg8::sigmoidf_(r1);
                const float o2 = acc[mi][ni][2] * r * gv[2] * r2 * pg8::sigmoidf_(r2), o3 = acc[mi][ni][3] * r * gv[3] * r3 * pg8::sigmoidf_(r3);
                u32x2 wv; wv.x = pg8::cvt_pk_bf16(o0, o1); wv.y = pg8::cvt_pk_bf16(o2, o3);
                *(u32x2*)(MIX + (row0 + t) * DM + h * 512 + dv) = wv; } }
        __syncthreads();
    }
}

__device__ __forceinline__ int crow(int r, int hi) { return (r & 3) + 8 * (r >> 2) + 4 * hi; }
__device__ __forceinline__ void attn_unit(const Ctx& C, const bf16_t* U, const float* rel_bias, const float* dg, float lam, int b, int h, int qb, bf16_t* MIX) {
    LAS unsigned char* KT0 = C.lds; LAS unsigned char* VT0 = C.lds + 2 * 17408; LAS float* tab = (LAS float*)(C.lds + 131072); LAS float* OX = (LAS float*)(C.lds);
    constexpr int KS = 272, VS = 320;
    const int l = C.lane, ql = l & 31, hi = l >> 5, g = l >> 4, qq = (l & 15) >> 2, pp = l & 3, w = C.wave, comp = w >> 2, rw = w & 3;
    const int qpos = qb * 128 + 32 * rw + ql;
    const size_t rowq = (size_t)b * SEQ + qpos;
    __syncthreads();
    if (C.tid < 128) { const int n = C.tid; int bk;
        if (n < 16) bk = n; else { bk = 16 + (int)(__logf((float)n * 0.0625f) / 2.0794415416798357f * 16.f); bk = bk < 31 ? bk : 31; }
        tab[n] = rel_bias[bk * 8 + h] * LOG2E; }
    const float b31 = rel_bias[31 * 8 + h] * LOG2E;
    LAS unsigned char* QT = C.lds + 96256;
    { const int row = C.tid >> 2, part = C.tid & 3; const bf16_t* qsrc = U + ((size_t)b * SEQ + qb * 128 + row) * UW + h * 128 + part * 32;
#pragma unroll
      for (int i = 0; i < 4; ++i) *(LAS u32x4*)(QT + row * 272 + part * 64 + 16 * i) = *(const u32x4*)(qsrc + 8 * i); }
    const LAS unsigned char* qfrag = QT + (32 * rw + ql) * 272 + (comp * 64 + 8 * hi) * 2;
    f32x16 o[4];
#pragma unroll
    for (int mb = 0; mb < 4; ++mb)
#pragma unroll
        for (int r = 0; r < 16; ++r) o[mb][r] = 0.f;
    float mrun = -1.0e30f, lrun = 0.f;
    u32x4 kreg[2], vreg[2];
    const bf16_t* srcb = U + ((size_t)b * SEQ + (C.tid >> 4)) * UW + h * 128 + (C.tid & 15) * 8;
    const int ntiles = 2 * (qb + 1);
#pragma unroll
    for (int i = 0; i < 2; ++i) { kreg[i] = *(const u32x4*)(srcb + (size_t)(32 * i) * UW + 1024); vreg[i] = *(const u32x4*)(srcb + (size_t)(32 * i) * UW + 2048); }
#pragma unroll
    for (int i = 0; i < 2; ++i) { const int key = (C.tid >> 4) + 32 * i, seg = C.tid & 15;
        *(LAS u32x4*)(KT0 + key * KS + seg * 16) = kreg[i]; *(LAS u32x4*)(VT0 + key * VS + seg * 16) = vreg[i]; }
#pragma unroll
    for (int i = 0; i < 2; ++i) { kreg[i] = *(const u32x4*)(srcb + (size_t)(64 + 32 * i) * UW + 1024); vreg[i] = *(const u32x4*)(srcb + (size_t)(64 + 32 * i) * UW + 2048); }
    int vs_cur = 0, vs_prev = 0; const bool rot = comp == 1;
    bf16x8 pb[4];
#pragma unroll
    for (int i = 0; i < 4; ++i) pb[i] = (bf16x8){0, 0, 0, 0, 0, 0, 0, 0};
#define ATT_PV(VSLOT) do { const LAS unsigned char* vb_ = VT0 + (VSLOT) * 20480 + (4 * hi + qq) * VS + (16 * (g & 1) + 4 * pp) * 2; _Pragma("unroll") for (int k2 = 0; k2 < 2; ++k2) _Pragma("unroll") for (int ks = 0; ks < 2; ++ks) { \
        bf16x8 af_[4]; _Pragma("unroll") for (int mb = 0; mb < 4; ++mb) { const LAS unsigned char* ap = vb_ + (32 * k2 + 16 * ks) * VS + 64 * mb; af_[mb] = tr8(ap, ap + 8 * VS); } \
        __builtin_amdgcn_sched_barrier(0); \
        _Pragma("unroll") for (int mb = 0; mb < 4; ++mb) o[mb] = mfma32(af_[mb], pb[2 * k2 + ks], o[mb]); } } while (0)
    for (int kt = 0; kt < ntiles; ++kt) {
        const int kb = kt * 64;
        __syncthreads();
        LAS unsigned char* KT = KT0 + (kt & 1) * 17408; LAS unsigned char* VT = VT0 + vs_cur * 20480;
        const int vs_nxt = vs_cur == 2 ? 0 : vs_cur + 1;
        if (kt + 1 < ntiles) {
            LAS unsigned char* KN = KT0 + ((kt + 1) & 1) * 17408; LAS unsigned char* VN = VT0 + vs_nxt * 20480;
#pragma unroll
            for (int i = 0; i < 2; ++i) { const int key = (C.tid >> 4) + 32 * i, seg = C.tid & 15;
                *(LAS u32x4*)(KN + key * KS + seg * 16) = kreg[i]; *(LAS u32x4*)(VN + key * VS + seg * 16) = vreg[i]; }
            if (kt + 2 < ntiles) {
#pragma unroll
                for (int i = 0; i < 2; ++i) { kreg[i] = *(const u32x4*)(srcb + (size_t)(kb + 128 + 32 * i) * UW + 1024); vreg[i] = *(const u32x4*)(srcb + (size_t)(kb + 128 + 32 * i) * UW + 2048); }
            }
        }
        if (rot && kt > 0) ATT_PV(vs_prev);
        __builtin_amdgcn_sched_barrier(0);
        f32x16 st[2];
#pragma unroll
        for (int k2 = 0; k2 < 2; ++k2) {
#pragma unroll
            for (int r = 0; r < 16; ++r) st[k2][r] = 0.f;
#pragma unroll
            for (int kk = 0; kk < 4; ++kk) st[k2] = mfma32(ldsv8(KT + (32 * k2 + ql) * KS + (comp * 64 + 16 * kk + 8 * hi) * 2), ldsv8(qfrag + 32 * kk), st[k2]);
        }
        __builtin_amdgcn_sched_barrier(0);
        const bool far = (qb * 128 + 32 * rw - (kb + 63)) >= 127;
        float mx = -1.0e30f, cadd;
        if (far) {
#pragma unroll
            for (int k2 = 0; k2 < 2; ++k2)
#pragma unroll
                for (int r = 0; r < 16; r += 2) mx = fmaxf(fmaxf(st[k2][r], st[k2][r + 1]), mx);
            mx = mx * LOG2E + b31; cadd = b31;
        } else {
#pragma unroll
            for (int k2 = 0; k2 < 2; ++k2)
#pragma unroll
                for (int r = 0; r < 16; ++r) { const int rel = qpos - (kb + 32 * k2 + crow(r, hi)); const int ri = rel < 0 ? 0 : (rel > 127 ? 127 : rel);
                    const float t = st[k2][r] * LOG2E + tab[ri]; st[k2][r] = (rel >= 0 ? t : -1.0e30f) * (1.0f / LOG2E); mx = fmaxf(mx, rel >= 0 ? t : -1.0e30f); }
            cadd = 0.f;
        }
        mx = fmaxf(mx, __shfl_xor(mx, 32));
        const float mnew = fmaxf(mrun, mx), alpha = __builtin_amdgcn_exp2f(mrun - mnew);
        const bool grew = mnew > mrun; mrun = mnew;
        const float cst = cadd - mnew;
        float ps = 0.f;
#pragma unroll
        for (int k2 = 0; k2 < 2; ++k2)
#pragma unroll
            for (int r = 0; r < 16; ++r) { const float pv = __builtin_amdgcn_exp2f(__builtin_fmaf(st[k2][r], LOG2E, cst)); st[k2][r] = pv; ps += pv; }
        lrun = lrun * alpha + ps;
        if (__any(grew)) {
#pragma unroll
            for (int mb = 0; mb < 4; ++mb)
#pragma unroll
                for (int r = 0; r < 16; ++r) o[mb][r] *= alpha;
        }
        __builtin_amdgcn_sched_barrier(0);
#pragma unroll
        for (int k2 = 0; k2 < 2; ++k2)
#pragma unroll
            for (int ks = 0; ks < 2; ++ks) { const int r8 = 8 * ks;
                const unsigned w0 = pg8::cvt_pk_bf16(st[k2][r8 + 0], st[k2][r8 + 1]), w1 = pg8::cvt_pk_bf16(st[k2][r8 + 2], st[k2][r8 + 3]), w2 = pg8::cvt_pk_bf16(st[k2][r8 + 4], st[k2][r8 + 5]), w3 = pg8::cvt_pk_bf16(st[k2][r8 + 6], st[k2][r8 + 7]);
                const u32x4 wv = (u32x4){w0, w1, w2, w3}; pb[2 * k2 + ks] = __builtin_bit_cast(bf16x8, wv); }
        __builtin_amdgcn_sched_barrier(0);
        if (!rot) ATT_PV(vs_cur);
        vs_prev = vs_cur; vs_cur = vs_nxt;
    }
    if (rot) ATT_PV(vs_prev);
#undef ATT_PV
    const float ltot = lrun + __shfl_xor(lrun, 32), inv = __builtin_amdgcn_rcpf(ltot);
    int l2 = C.lane; asm volatile("" : "+v"(l2));
    const int ql_e = l2 & 31, hi_e = l2 >> 5;
    const size_t rowq_e = (size_t)b * SEQ + qb * 128 + 32 * rw + ql_e;
    __syncthreads();
    if (comp == 1) {
#pragma unroll
        for (int mb = 0; mb < 4; ++mb)
#pragma unroll
            for (int r = 0; r < 16; ++r) OX[(rw * 128 + 32 * mb + crow(r, hi_e)) * 32 + ql_e] = o[mb][r] * inv;
    }
    __syncthreads();
    if (comp == 0) {
        float ss = 0.f;
#pragma unroll
        for (int mb = 0; mb < 4; ++mb)
#pragma unroll
            for (int r = 0; r < 16; ++r) { const float y = o[mb][r] * inv - lam * OX[(rw * 128 + 32 * mb + crow(r, hi_e)) * 32 + ql_e]; o[mb][r] = y; ss += y * y; }
        ss += __shfl_xor(ss, 32);
        const float rn = __builtin_amdgcn_rsqf(ss * (1.f / 128.f) + 1e-6f) * 0.8f;
#pragma unroll
        for (int mb = 0; mb < 4; ++mb)
#pragma unroll
            for (int r4 = 0; r4 < 4; ++r4) { const int dv = 32 * mb + 8 * r4 + 4 * hi_e; const f32x4 gv = *(const f32x4*)(dg + h * 128 + dv);
                u32x2 wv; wv.x = pk2(o[mb][4 * r4] * rn * gv[0], o[mb][4 * r4 + 1] * rn * gv[1]); wv.y = pk2(o[mb][4 * r4 + 2] * rn * gv[2], o[mb][4 * r4 + 3] * rn * gv[3]);
                *(u32x2*)(MIX + rowq_e * DM + h * 128 + dv) = wv; }
    }
}
__device__ __forceinline__ void attn_phase(const Ctx& C, const bf16_t* U, const float* rel_bias, const float* dg, const float* lq1, const float* lk1, const float* lq2, const float* lk2, bf16_t* MIX) {
    const float s1 = wave_sum(lq1[C.lane] * lk1[C.lane]), s2 = wave_sum(lq2[C.lane] * lk2[C.lane]);
    const float lam = __expf(s1) - __expf(s2) + 0.2f;
    const bool xa = (C.G == 256);
#pragma unroll 1
    for (int k = 0; k < 512; ++k) {
        int pr;
        if (xa) { if (k >= 2) break; pr = (2 * (C.bid & 7) + k) * 32 + (C.bid >> 3); } else { pr = C.bid + k * C.G; if (pr >= 512) break; }
        const int bh = pr >> 5, i = pr & 31, b = bh >> 3, h = bh & 7;
        attn_unit(C, U, rel_bias, dg, lam, b, h, i, MIX);
        attn_unit(C, U, rel_bias, dg, lam, b, h, 63 - i, MIX);
    }
    __syncthreads();
}

struct Args {
    const float* x; const float* p; const float* ln_g; const float* ln_b; const float* w_ffn_in; const float* w_ffn_out; const float* w_in_ab; const float* w_out_ab;
    const float* rel_bias; const float* lq1; const float* lk1; const float* lq2; const float* lk2; const float* diff_norm; const float* conv_w; const float* conv_b;
    const float* b_igate; const float* b_fgate; const float* mlstm_norm; const float* w_in_c; const float* w_alpha2; const float* b_alpha; const float* gla_norm;
    const float* w_out_c; const float* w_ple_proj; const float* w_ple_gate;
    float* out; unsigned char* ws;
    int ph_lo, ph_hi;
};


constexpr int ARGS_OFF = 147200;
enum { A_x = 0, A_p, A_ln_g, A_ln_b, A_w_ffn_in, A_w_ffn_out, A_w_in_ab, A_w_out_ab, A_rel_bias, A_lq1, A_lk1, A_lq2, A_lk2, A_diff_norm, A_conv_w, A_conv_b,
       A_b_igate, A_b_fgate, A_mlstm_norm, A_w_in_c, A_w_alpha2, A_b_alpha, A_gla_norm, A_w_out_c, A_w_ple_proj, A_w_ple_gate, A_out, A_ws };
__device__ __forceinline__ unsigned char* ldarg(LAS unsigned char* lds, int i) {
    volatile LAS unsigned* p = (volatile LAS unsigned*)(lds + ARGS_OFF) + 2 * i;
    const unsigned lo = __builtin_amdgcn_readfirstlane(p[0]), hi = __builtin_amdgcn_readfirstlane(p[1]);
    return (unsigned char*)(__attribute__((address_space(1))) unsigned char*)(((unsigned long long)hi << 32) | lo);
}
#define ARGF(i) ((const float*)ldarg(C.lds, (i)))
#define WSP(T, off) ((T*)(ldarg(C.lds, A_ws) + (off)))


__device__ __forceinline__ void grid_barrier(unsigned* ctr, unsigned target, bool leader) {
    asm volatile("s_waitcnt vmcnt(0) lgkmcnt(0)" ::: "memory");
    __syncthreads();
    if (leader) {
        __builtin_amdgcn_fence(__ATOMIC_RELEASE, "agent");
        asm volatile("s_waitcnt vmcnt(0)" ::: "memory");
        (void)__hip_atomic_fetch_add(ctr, 1u, __ATOMIC_RELAXED, __HIP_MEMORY_SCOPE_AGENT);
        while (__hip_atomic_load(ctr, __ATOMIC_RELAXED, __HIP_MEMORY_SCOPE_AGENT) < target) __builtin_amdgcn_s_sleep(1);
        __builtin_amdgcn_fence(__ATOMIC_ACQUIRE, "agent");
        asm volatile("s_waitcnt vmcnt(0)" ::: "memory");
    }
    __syncthreads();
}

#define XB_TMO      128
#define XB_XCNT(j)  (256  + 64 * (j))
#define XB_XSUB(j)  (1280 + 64 * (j))
#define XB_XGEN(j)  (2304 + 64 * (j))
#define XB_TOP      3328
#define XB_TOPGEN   3392
#define XCD_BAR_WORDS 3456
#define XB_SPIN_CAP (1u << 22)
__device__ __forceinline__ unsigned xb_ld(unsigned* p)              { return __hip_atomic_load(p, __ATOMIC_RELAXED, __HIP_MEMORY_SCOPE_AGENT); }
__device__ __forceinline__ unsigned xb_add(unsigned* p, unsigned v) { return __hip_atomic_fetch_add(p, v, __ATOMIC_RELAXED, __HIP_MEMORY_SCOPE_AGENT); }
__device__ __forceinline__ unsigned xb_xcc_id() { return (unsigned)__builtin_amdgcn_s_getreg((3 << 11) | 20) & 0xFu; }
#define XB_SPIN(cond, bar) do { unsigned _sp = 0; while (cond) { __builtin_amdgcn_s_sleep(1); \
    if ((++_sp & 255u) == 0u) { if (xb_ld(&(bar)[XB_TMO])) break; if (_sp > XB_SPIN_CAP) { atomicAdd(&(bar)[XB_TMO], 1u); break; } } } } while (0)
__device__ __forceinline__ void xcd_barrier_complete(unsigned* bar, unsigned x, unsigned& nloc, unsigned& nx) {
    const unsigned G = gridDim.x;
    unsigned sum, cnt, mine, sp = 0u;
    for (;;) {
        sum = 0u; cnt = 0u; mine = 0u;
#pragma unroll
        for (unsigned j = 0; j < 16; ++j) { const unsigned c = xb_ld(&bar[XB_XCNT(j)]); sum += c; cnt += (c > 0u) ? 1u : 0u; mine = (j == x) ? c : mine; }
        if (sum == G) break;
        __builtin_amdgcn_s_sleep(1);
        if ((++sp & 255u) == 0u) { if (xb_ld(&bar[XB_TMO])) break; if (sp > XB_SPIN_CAP) { atomicAdd(&bar[XB_TMO], 1u); break; } }
    }
    nloc = mine > 0u ? mine : 1u; nx = cnt > 0u ? cnt : 1u;
}
__device__ __forceinline__ void xcd_barrier(unsigned* bar, volatile LAS unsigned* st, bool leader) {
    asm volatile("s_waitcnt vmcnt(0)" ::: "memory");
    __syncthreads();
    if (leader) {
        __builtin_amdgcn_s_waitcnt(0);
        const unsigned x = xb_xcc_id();
        unsigned nloc = st[0], nx = st[1];
        if (nloc == 0u) { xcd_barrier_complete(bar, x, nloc, nx); st[0] = nloc; st[1] = nx; }
        const unsigned old = xb_add(&bar[XB_XSUB(x)], 1u);
        const unsigned gen = old / nloc;
        if (old + 1u == (gen + 1u) * nloc) {
            __builtin_amdgcn_fence(__ATOMIC_RELEASE, "agent");
            asm volatile("s_waitcnt vmcnt(0)" ::: "memory");
            const unsigned og = xb_add(&bar[XB_TOP], 1u);
            const unsigned tg = og / nx;
            if (og + 1u == (tg + 1u) * nx) xb_add(&bar[XB_TOPGEN], 1u);
            else XB_SPIN(xb_ld(&bar[XB_TOPGEN]) == tg, bar);
            __builtin_amdgcn_fence(__ATOMIC_ACQUIRE, "agent");
            xb_add(&bar[XB_XGEN(x)], 1u);
            asm volatile("s_waitcnt vmcnt(0)" ::: "memory");
        } else {
            XB_SPIN(xb_ld(&bar[XB_XGEN(x)]) == gen, bar);
            __builtin_amdgcn_fence(__ATOMIC_ACQUIRE, "agent");
            asm volatile("s_waitcnt vmcnt(0)" ::: "memory");
        }
    }
    __syncthreads();
}

#define GEMM_CALL(EPI, Aptr, Bptr, Nn, Kk, Eobj) do { pg8::Gemm g_{(const bf16_t*)(Aptr), (const bf16_t*)(Bptr), MT, (Nn), (Kk)}; pg8::StaticOrder S_; S_.init(MT, (Nn), C.G, C.bid); \
    pg8::gemm_phase<EPI, pg8::StaticOrder, true, true>(C.lds, g_, S_, Eobj, C.tid); } while (0)

__global__ void __launch_bounds__(512, 2) mega_fwd(Args a) {
    extern __shared__ __attribute__((aligned(16))) unsigned char lds_raw[];
    cg::grid_group grid = cg::this_grid();
    if (threadIdx.x == 0) {
        LAS unsigned long long* t = (LAS unsigned long long*)((LAS unsigned char*)lds_raw + ARGS_OFF);
        t[A_x] = (unsigned long long)a.x; t[A_p] = (unsigned long long)a.p; t[A_ln_g] = (unsigned long long)a.ln_g; t[A_ln_b] = (unsigned long long)a.ln_b;
        t[A_w_ffn_in] = (unsigned long long)a.w_ffn_in; t[A_w_ffn_out] = (unsigned long long)a.w_ffn_out; t[A_w_in_ab] = (unsigned long long)a.w_in_ab; t[A_w_out_ab] = (unsigned long long)a.w_out_ab;
        t[A_rel_bias] = (unsigned long long)a.rel_bias; t[A_lq1] = (unsigned long long)a.lq1; t[A_lk1] = (unsigned long long)a.lk1; t[A_lq2] = (unsigned long long)a.lq2; t[A_lk2] = (unsigned long long)a.lk2;
        t[A_diff_norm] = (unsigned long long)a.diff_norm; t[A_conv_w] = (unsigned long long)a.conv_w; t[A_conv_b] = (unsigned long long)a.conv_b; t[A_b_igate] = (unsigned long long)a.b_igate;
        t[A_b_fgate] = (unsigned long long)a.b_fgate; t[A_mlstm_norm] = (unsigned long long)a.mlstm_norm; t[A_w_in_c] = (unsigned long long)a.w_in_c; t[A_w_alpha2] = (unsigned long long)a.w_alpha2;
        t[A_b_alpha] = (unsigned long long)a.b_alpha; t[A_gla_norm] = (unsigned long long)a.gla_norm; t[A_w_out_c] = (unsigned long long)a.w_out_c; t[A_w_ple_proj] = (unsigned long long)a.w_ple_proj;
        t[A_w_ple_gate] = (unsigned long long)a.w_ple_gate; t[A_out] = (unsigned long long)a.out; t[A_ws] = (unsigned long long)a.ws;
        t[30] = 0ull;
    }
    __syncthreads();
    const int ph_lo = a.ph_lo, ph_hi = a.ph_hi;
    int ph = 0; unsigned nbar = 0, ngb = 0;
    const int wave_s = __builtin_amdgcn_readfirstlane((int)(threadIdx.x >> 6));
#ifndef REPMASK
#define REPMASK 0
#endif
#define PHASE_BEGIN_G(grp) if (ph >= ph_lo && ph < ph_hi) for (int rep_ = 0; rep_ < (((REPMASK >> (grp)) & 1) ? 2 : 1); ++rep_) { Ctx C; { int t_ = wave_s * 64 + (int)__builtin_amdgcn_mbcnt_hi(~0u, __builtin_amdgcn_mbcnt_lo(~0u, 0u)); asm volatile("" : "+v"(t_)); C.lds = (LAS unsigned char*)lds_raw; C.tid = t_; C.lane = t_ & 63; C.wave = __builtin_amdgcn_readfirstlane(t_ >> 6); \
    C.G = gridDim.x; C.bid = blockIdx.x; C.gw = C.bid * 8 + C.wave; C.NGW = C.G * 8; }
#define PHASE_BEGIN PHASE_BEGIN_G(31)
#ifndef SYNCREP
#define SYNCREP 1
#endif
#define PHASE_END_K(GROUPWISE) } ++ph; if (ph > ph_lo && ph < ph_hi) { for (int sr_ = 0; sr_ < SYNCREP; ++sr_) { \
        unsigned* ctl_ = (unsigned*)(ldarg((LAS unsigned char*)lds_raw, A_ws) + OFF_CTL); const bool lead_ = wave_s == 0 && __builtin_amdgcn_mbcnt_hi(~0u, __builtin_amdgcn_mbcnt_lo(~0u, 0u)) == 0u; \
        if ((GROUPWISE) && (gridDim.x & 7u) == 0u) { ++ngb; grid_barrier(ctl_ + 64 * (1 + (blockIdx.x & 7u)), ngb * (gridDim.x >> 3), lead_); } \
        else { xcd_barrier(ctl_ + 1024, (volatile LAS unsigned*)((LAS unsigned char*)lds_raw + ARGS_OFF + 240), lead_); } } }
#define PHASE_END PHASE_END_K(0)
#define PHASE_END_NONE } ++ph;
#define PHASE_END_ROWS PHASE_END_K(0)

    PHASE_BEGIN_G(0)
        if (C.bid == 0) { unsigned* ctl0_ = (unsigned*)(ldarg(C.lds, A_ws) + OFF_CTL); for (int i_ = C.tid; i_ < 1024 + XCD_BAR_WORDS; i_ += 512) ctl0_[i_] = 0u; }
        int base = 0;
        for (int i = 0; i < 4; ++i) conv_matrix(C, ARGF(A_w_ffn_in) + (size_t)i * DM * NFF2, DM, NFF2, NFF2, WSP(bf16_t, OFF_WFI) + (size_t)i * NFF2 * DM, 1, base);
        for (int i = 0; i < 4; ++i) conv_matrix(C, ARGF(A_w_ffn_out) + (size_t)i * DFF * DM, DFF, DM, DM, WSP(bf16_t, OFF_WFO) + (size_t)i * DM * DFF, 0, base);
        conv_matrix(C, ARGF(A_w_in_ab), DM, 6152, NIN, WSP(bf16_t, OFF_WAB), 2, base);
        conv_matrix(C, ARGF(A_w_in_c), DM, 6160, NIN, WSP(bf16_t, OFF_WC), 0, base);
        conv_matrix(C, ARGF(A_w_out_ab), DM, DM, DM, WSP(bf16_t, OFF_WOAB), 0, base);
        conv_matrix(C, ARGF(A_w_out_c), DM, DM, DM, WSP(bf16_t, OFF_WOC), 0, base);
        for (int i = 0; i < 2; ++i) conv_matrix(C, ARGF(A_w_ple_gate) + (size_t)i * DM * DM, DM, DM, DM, WSP(bf16_t, OFF_WPG) + (size_t)i * DM * DM, 0, base);
        for (int i = 0; i < 2; ++i) conv_matrix(C, ARGF(A_w_ple_proj) + (size_t)i * PLE * DM, PLE, DM, DM, WSP(bf16_t, OFF_WPP) + (size_t)i * DM * PLE, 0, base);
        cvt_rows(C, ARGF(A_x), WSP(bf16_t, OFF_XB), (size_t)MT * DM / 4);
        cvt_rows(C, ARGF(A_p), WSP(bf16_t, OFF_PB), (size_t)2 * MT * PLE / 4);
        __syncthreads();
    } ++ph; if (ph > ph_lo && ph < ph_hi) { grid.sync(); if (wave_s == 0 && __builtin_amdgcn_mbcnt_hi(~0u, __builtin_amdgcn_mbcnt_lo(~0u, 0u)) == 0u) (void)xb_add((unsigned*)(ldarg((LAS unsigned char*)lds_raw, A_ws) + OFF_CTL) + 1024 + XB_XCNT(xb_xcc_id()), 1u); }

    { constexpr int L = 0;
        PHASE_BEGIN_G(1) { pg8::EpiSwiglu e{WSP(bf16_t, OFF_H), DFF}; GEMM_CALL(pg8::EpiSwiglu, WSP(bf16_t, (L == 0 ? OFF_XB : OFF_MIX)), WSP(bf16_t, OFF_WFI) + (size_t)(2 * L) * NFF2 * DM, NFF2, DM, e); }
            if (L == 0) { for (int l2 = 0; l2 < 2; ++l2) { pg8::EpiStore e2{WSP(bf16_t, OFF_XF) + (size_t)l2 * MT * DM, DM, DM, nullptr}; GEMM_CALL(pg8::EpiStore, WSP(bf16_t, OFF_PB) + (size_t)l2 * MT * PLE, WSP(bf16_t, OFF_WPP) + (size_t)l2 * DM * PLE, DM, PLE, e2); } } PHASE_END_ROWS
        PHASE_BEGIN_G(1) { if (L == 0) { pg8::EpiZ<true> e{(const void*)ARGF(A_x), WSP(bf16_t, OFF_Z), ALPHA, 0.5f}; GEMM_CALL(pg8::EpiZ<true>, WSP(bf16_t, OFF_H), WSP(bf16_t, OFF_WFO) + (size_t)(2 * L) * DM * DFF, DM, DFF, e); } else { pg8::EpiZ<false> e{(const void*)WSP(bf16_t, OFF_MIX), WSP(bf16_t, OFF_Z), ALPHA, 0.5f}; GEMM_CALL(pg8::EpiZ<false>, WSP(bf16_t, OFF_H), WSP(bf16_t, OFF_WFO) + (size_t)(2 * L) * DM * DFF, DM, DFF, e); } } PHASE_END_ROWS
        PHASE_BEGIN_G(3) ln_phase<(L == 0 ? 8 : 16)>(C, WSP(bf16_t, OFF_Z), ARGF(A_ln_g) + (size_t)(3 * L) * DM, ARGF(A_ln_b) + (size_t)(3 * L) * DM, WSP(bf16_t, OFF_XB), (L == 0 ? ARGF(A_w_in_ab) : ARGF(A_w_in_c)), (L == 0 ? 6152 : 6160), (L == 0 ? 8 : 16), WSP(float, OFF_GT)); PHASE_END
        PHASE_BEGIN_G(2) { pg8::EpiStore e{WSP(bf16_t, OFF_H), UW, UW, nullptr}; GEMM_CALL(pg8::EpiStore, WSP(bf16_t, OFF_XB), WSP(bf16_t, (L == 0 ? OFF_WAB : OFF_WC)), NIN, DM, e); } PHASE_END
        if (L == 0) {
            PHASE_BEGIN_G(5) m1_phase(C, WSP(bf16_t, OFF_H), WSP(float, OFF_GT), ARGF(A_conv_w), ARGF(A_conv_b), ARGF(A_b_igate), ARGF(A_b_fgate), WSP(bf16_t, OFF_QB), WSP(bf16_t, OFF_KB), WSP(float, OFF_BC), WSP(float, OFF_IP), WSP(float, OFF_MSC)); PHASE_END
            PHASE_BEGIN
                mlstm_passA(C, WSP(bf16_t, OFF_H), WSP(bf16_t, OFF_KB), WSP(float, OFF_BC), WSP(float, OFF_IP), WSP(float, OFF_MSC), WSP(bf16_t, OFF_ST), WSP(float, OFF_NL));
                for (int rep2_ = 0; rep2_ < (((REPMASK >> 4) & 1) ? 2 : 1); ++rep2_)
                attn_phase(C, WSP(bf16_t, OFF_H), ARGF(A_rel_bias), ARGF(A_diff_norm), ARGF(A_lq1), ARGF(A_lk1), ARGF(A_lq2), ARGF(A_lk2), WSP(bf16_t, OFF_MIX));
            PHASE_END
            PHASE_BEGIN mlstm_scan(C, WSP(bf16_t, OFF_ST), WSP(float, OFF_NL), WSP(float, OFF_MSC)); PHASE_END
            PHASE_BEGIN_G(5) mlstm_passC(C, WSP(bf16_t, OFF_H), WSP(bf16_t, OFF_QB), WSP(bf16_t, OFF_KB), WSP(float, OFF_BC), WSP(float, OFF_IP), WSP(float, OFF_MSC), WSP(bf16_t, OFF_ST), WSP(float, OFF_NL), ARGF(A_mlstm_norm), WSP(bf16_t, OFF_MIX)); PHASE_END
        } else {
            PHASE_BEGIN_G(6) gla_passA(C, WSP(bf16_t, OFF_H), WSP(float, OFF_GT), ARGF(A_w_alpha2), ARGF(A_b_alpha), WSP(bf16_t, OFF_ST), WSP(float, OFF_DC), WSP(bf16_t, OFF_Z), WSP(bf16_t, OFF_Z + (size_t)MT * 1024 * 2)); PHASE_END
            PHASE_BEGIN gla_scan(C, WSP(bf16_t, OFF_ST), WSP(float, OFF_DC)); PHASE_END
            PHASE_BEGIN_G(7) gla_passC(C, WSP(bf16_t, OFF_H), WSP(bf16_t, OFF_Z), WSP(bf16_t, OFF_Z + (size_t)MT * 1024 * 2), WSP(bf16_t, OFF_ST), ARGF(A_gla_norm), WSP(bf16_t, OFF_MIX)); PHASE_END
        }
        PHASE_BEGIN_G(1) { pg8::EpiZ<false> e{(const void*)WSP(bf16_t, OFF_XB), WSP(bf16_t, OFF_Z), ALPHA, 1.0f}; GEMM_CALL(pg8::EpiZ<false>, WSP(bf16_t, OFF_MIX), WSP(bf16_t, (L == 0 ? OFF_WOAB : OFF_WOC)), DM, DM, e); } PHASE_END_ROWS
        PHASE_BEGIN_G(3) ln_phase<0>(C, WSP(bf16_t, OFF_Z), ARGF(A_ln_g) + (size_t)(3 * L + 1) * DM, ARGF(A_ln_b) + (size_t)(3 * L + 1) * DM, WSP(bf16_t, OFF_XB), nullptr, 0, 0, nullptr); PHASE_END_ROWS
        PHASE_BEGIN_G(1) { pg8::EpiSwiglu e{WSP(bf16_t, OFF_H), DFF}; GEMM_CALL(pg8::EpiSwiglu, WSP(bf16_t, OFF_XB), WSP(bf16_t, OFF_WFI) + (size_t)(2 * L + 1) * NFF2 * DM, NFF2, DM, e); } PHASE_END_ROWS
        PHASE_BEGIN_G(1) { pg8::EpiZ<false> e{(const void*)WSP(bf16_t, OFF_XB), WSP(bf16_t, OFF_Z), ALPHA, 0.5f}; GEMM_CALL(pg8::EpiZ<false>, WSP(bf16_t, OFF_H), WSP(bf16_t, OFF_WFO) + (size_t)(2 * L + 1) * DM * DFF, DM, DFF, e); } PHASE_END_ROWS
        PHASE_BEGIN_G(3) ln_phase<0>(C, WSP(bf16_t, OFF_Z), ARGF(A_ln_g) + (size_t)(3 * L + 2) * DM, ARGF(A_ln_b) + (size_t)(3 * L + 2) * DM, WSP(bf16_t, OFF_XB), nullptr, 0, 0, nullptr); PHASE_END_ROWS
        PHASE_BEGIN { pg8::EpiPle e{WSP(const bf16_t, OFF_XB), WSP(const bf16_t, OFF_XF) + (size_t)L * MT * DM, (L == 1) ? (float*)ldarg(C.lds, A_out) : (float*)nullptr, (L == 1) ? (bf16_t*)nullptr : WSP(bf16_t, OFF_MIX)}; GEMM_CALL(pg8::EpiPle, WSP(bf16_t, OFF_XB), WSP(bf16_t, OFF_WPG) + (size_t)L * DM * DM, DM, DM, e); } PHASE_END_ROWS
        }
    { constexpr int L = 1;
        PHASE_BEGIN_G(1) { pg8::EpiSwiglu e{WSP(bf16_t, OFF_H), DFF}; GEMM_CALL(pg8::EpiSwiglu, WSP(bf16_t, (L == 0 ? OFF_XB : OFF_MIX)), WSP(bf16_t, OFF_WFI) + (size_t)(2 * L) * NFF2 * DM, NFF2, DM, e); }
            if (L == 0) { for (int l2 = 0; l2 < 2; ++l2) { pg8::EpiStore e2{WSP(bf16_t, OFF_XF) + (size_t)l2 * MT * DM, DM, DM, nullptr}; GEMM_CALL(pg8::EpiStore, WSP(bf16_t, OFF_PB) + (size_t)l2 * MT * PLE, WSP(bf16_t, OFF_WPP) + (size_t)l2 * DM * PLE, DM, PLE, e2); } } PHASE_END_ROWS
        PHASE_BEGIN_G(1) { if (L == 0) { pg8::EpiZ<true> e{(const void*)ARGF(A_x), WSP(bf16_t, OFF_Z), ALPHA, 0.5f}; GEMM_CALL(pg8::EpiZ<true>, WSP(bf16_t, OFF_H), WSP(bf16_t, OFF_WFO) + (size_t)(2 * L) * DM * DFF, DM, DFF, e); } else { pg8::EpiZ<false> e{(const void*)WSP(bf16_t, OFF_MIX), WSP(bf16_t, OFF_Z), ALPHA, 0.5f}; GEMM_CALL(pg8::EpiZ<false>, WSP(bf16_t, OFF_H), WSP(bf16_t, OFF_WFO) + (size_t)(2 * L) * DM * DFF, DM, DFF, e); } } PHASE_END_ROWS
        PHASE_BEGIN_G(3) ln_phase<(L == 0 ? 8 : 16)>(C, WSP(bf16_t, OFF_Z), ARGF(A_ln_g) + (size_t)(3 * L) * DM, ARGF(A_ln_b) + (size_t)(3 * L) * DM, WSP(bf16_t, OFF_XB), (L == 0 ? ARGF(A_w_in_ab) : ARGF(A_w_in_c)), (L == 0 ? 6152 : 6160), (L == 0 ? 8 : 16), WSP(float, OFF_GT)); PHASE_END
        PHASE_BEGIN_G(2) { pg8::EpiStore e{WSP(bf16_t, OFF_H), UW, UW, nullptr}; GEMM_CALL(pg8::EpiStore, WSP(bf16_t, OFF_XB), WSP(bf16_t, (L == 0 ? OFF_WAB : OFF_WC)), NIN, DM, e); } PHASE_END
        if (L == 0) {
            PHASE_BEGIN_G(5) m1_phase(C, WSP(bf16_t, OFF_H), WSP(float, OFF_GT), ARGF(A_conv_w), ARGF(A_conv_b), ARGF(A_b_igate), ARGF(A_b_fgate), WSP(bf16_t, OFF_QB), WSP(bf16_t, OFF_KB), WSP(float, OFF_BC), WSP(float, OFF_IP), WSP(float, OFF_MSC)); PHASE_END
            PHASE_BEGIN
                mlstm_passA(C, WSP(bf16_t, OFF_H), WSP(bf16_t, OFF_KB), WSP(float, OFF_BC), WSP(float, OFF_IP), WSP(float, OFF_MSC), WSP(bf16_t, OFF_ST), WSP(float, OFF_NL));
                for (int rep2_ = 0; rep2_ < (((REPMASK >> 4) & 1) ? 2 : 1); ++rep2_)
                attn_phase(C, WSP(bf16_t, OFF_H), ARGF(A_rel_bias), ARGF(A_diff_norm), ARGF(A_lq1), ARGF(A_lk1), ARGF(A_lq2), ARGF(A_lk2), WSP(bf16_t, OFF_MIX));
            PHASE_END
            PHASE_BEGIN mlstm_scan(C, WSP(bf16_t, OFF_ST), WSP(float, OFF_NL), WSP(float, OFF_MSC)); PHASE_END
            PHASE_BEGIN_G(5) mlstm_passC(C, WSP(bf16_t, OFF_H), WSP(bf16_t, OFF_QB), WSP(bf16_t, OFF_KB), WSP(float, OFF_BC), WSP(float, OFF_IP), WSP(float, OFF_MSC), WSP(bf16_t, OFF_ST), WSP(float, OFF_NL), ARGF(A_mlstm_norm), WSP(bf16_t, OFF_MIX)); PHASE_END
        } else {
            PHASE_BEGIN_G(6) gla_passA(C, WSP(bf16_t, OFF_H), WSP(float, OFF_GT), ARGF(A_w_alpha2), ARGF(A_b_alpha), WSP(bf16_t, OFF_ST), WSP(float, OFF_DC), WSP(bf16_t, OFF_Z), WSP(bf16_t, OFF_Z + (size_t)MT * 1024 * 2)); PHASE_END
            PHASE_BEGIN gla_scan(C, WSP(bf16_t, OFF_ST), WSP(float, OFF_DC)); PHASE_END
            PHASE_BEGIN_G(7) gla_passC(C, WSP(bf16_t, OFF_H), WSP(bf16_t, OFF_Z), WSP(bf16_t, OFF_Z + (size_t)MT * 1024 * 2), WSP(bf16_t, OFF_ST), ARGF(A_gla_norm), WSP(bf16_t, OFF_MIX)); PHASE_END
        }
        PHASE_BEGIN_G(1) { pg8::EpiZ<false> e{(const void*)WSP(bf16_t, OFF_XB), WSP(bf16_t, OFF_Z), ALPHA, 1.0f}; GEMM_CALL(pg8::EpiZ<false>, WSP(bf16_t, OFF_MIX), WSP(bf16_t, (L == 0 ? OFF_WOAB : OFF_WOC)), DM, DM, e); } PHASE_END_ROWS
        PHASE_BEGIN_G(3) ln_phase<0>(C, WSP(bf16_t, OFF_Z), ARGF(A_ln_g) + (size_t)(3 * L + 1) * DM, ARGF(A_ln_b) + (size_t)(3 * L + 1) * DM, WSP(bf16_t, OFF_XB), nullptr, 0, 0, nullptr); PHASE_END_ROWS
        PHASE_BEGIN_G(1) { pg8::EpiSwiglu e{WSP(bf16_t, OFF_H), DFF}; GEMM_CALL(pg8::EpiSwiglu, WSP(bf16_t, OFF_XB), WSP(bf16_t, OFF_WFI) + (size_t)(2 * L + 1) * NFF2 * DM, NFF2, DM, e); } PHASE_END_ROWS
        PHASE_BEGIN_G(1) { pg8::EpiZ<false> e{(const void*)WSP(bf16_t, OFF_XB), WSP(bf16_t, OFF_Z), ALPHA, 0.5f}; GEMM_CALL(pg8::EpiZ<false>, WSP(bf16_t, OFF_H), WSP(bf16_t, OFF_WFO) + (size_t)(2 * L + 1) * DM * DFF, DM, DFF, e); } PHASE_END_ROWS
        PHASE_BEGIN_G(3) ln_phase<0>(C, WSP(bf16_t, OFF_Z), ARGF(A_ln_g) + (size_t)(3 * L + 2) * DM, ARGF(A_ln_b) + (size_t)(3 * L + 2) * DM, WSP(bf16_t, OFF_XB), nullptr, 0, 0, nullptr); PHASE_END_ROWS
        PHASE_BEGIN { pg8::EpiPle e{WSP(const bf16_t, OFF_XB), WSP(const bf16_t, OFF_XF) + (size_t)L * MT * DM, (L == 1) ? (float*)ldarg(C.lds, A_out) : (float*)nullptr, (L == 1) ? (bf16_t*)nullptr : WSP(bf16_t, OFF_MIX)}; GEMM_CALL(pg8::EpiPle, WSP(bf16_t, OFF_XB), WSP(bf16_t, OFF_WPG) + (size_t)L * DM * DM, DM, DM, e); } PHASE_END_NONE
        }
}

extern "C" void kernel_launch(void* const* d_in, const int* in_sizes, int n_in, void* d_out, int out_size, void* d_ws, size_t ws_size, hipStream_t stream) {
    static int grid = 0;
    if (grid == 0) {
        int dev = 0, cus = 0, per_cu = 0;
        (void)hipGetDevice(&dev); (void)hipDeviceGetAttribute(&cus, hipDeviceAttributeMultiprocessorCount, dev);
        (void)hipFuncSetAttribute((const void*)mega_fwd, hipFuncAttributeMaxDynamicSharedMemorySize, LDS_BYTES);
        (void)hipOccupancyMaxActiveBlocksPerMultiprocessor(&per_cu, (const void*)mega_fwd, 512, LDS_BYTES);
        if (per_cu < 1) per_cu = 1;
        if (cus < 8) cus = 256;
        grid = cus * per_cu;
        if (ws_size < WS_NEED || n_in != 26) { fprintf(stderr, "kernel_launch: ws %zu < %zu or n_in %d != 26\n", ws_size, (size_t)WS_NEED, n_in); }
        (void)hipGetLastError();
    }
    Args a{};
    const float** fp = (const float**)&a;
    for (int i = 0; i < 26; ++i) fp[i] = (const float*)d_in[i];
    a.out = (float*)d_out; a.ws = (unsigned char*)d_ws; a.ph_lo = 0; a.ph_hi = 1000;
    void* args[] = {&a};
    hipError_t e = hipLaunchCooperativeKernel((const void*)mega_fwd, dim3(grid), dim3(512), args, LDS_BYTES, stream);
    if (e != hipSuccess) fprintf(stderr, "cooperative launch failed: %s (grid %d)\n", hipGetErrorString(e), grid);
}
```
